# Optimizing an MI355X kernel written in HIP

```python
import jax
import jax.numpy as jnp
from jax import lax
import numpy as np

D_MODEL = 2048
BATCH = 8
SEQ = 2048
DEPTH = 2

HG_WIDTH = 1024
HG_HEADS = 8
HG_HEAD_DIM = HG_WIDTH // HG_HEADS
HG_CHUNK = 32
RW_WIDTH = 1024
RW_HEAD_DIM = 64
RW_HEADS = RW_WIDTH // RW_HEAD_DIM
RW_DECAY_LORA = 64
RW_AAA_LORA = 64
RW_MV_LORA = 32
RW_GATE_LORA = 160
RW_SHIFT_WIDTH = 3 * RW_WIDTH + RW_DECAY_LORA + RW_AAA_LORA + RW_GATE_LORA
IN_WIDTH = 4 * HG_WIDTH + RW_SHIFT_WIDTH + 2 * D_MODEL
IN_SPLITS = (HG_WIDTH, 2 * HG_WIDTH, 3 * HG_WIDTH, 4 * HG_WIDTH,
             4 * HG_WIDTH + RW_SHIFT_WIDTH, 4 * HG_WIDTH + RW_SHIFT_WIDTH + D_MODEL)
RW_SPLITS = (RW_WIDTH, 2 * RW_WIDTH, 3 * RW_WIDTH, 3 * RW_WIDTH + RW_DECAY_LORA,
             3 * RW_WIDTH + RW_DECAY_LORA + RW_AAA_LORA)
N_GROUPS = 4
EXPERTS_PER_GROUP = 8
N_EXPERTS = N_GROUPS * EXPERTS_PER_GROUP
TOP_K_IN_GROUP = 2
D_EXPERT = 512
DISPATCH_BLOCK = 128

NORM_EPS = 1e-6
RW_GN_EPS = 64e-5

kernel_name = 'hybrid_hgrn2_rwkv7_hier_moe'


def rmsnorm(x, w):
    xf = x.astype(jnp.float32)
    y = xf * lax.rsqrt(jnp.mean(xf * xf, axis=-1, keepdims=True) + NORM_EPS)
    return (y * w.astype(jnp.float32)).astype(x.dtype)


def token_shift(z):
    return jnp.pad(z, ((0, 0), (1, 0), (0, 0)))[:, :-1]


def hgrn2_chunked(q, k, v, log_f):
    bsz, seqlen, nh, dk = q.shape
    dv = v.shape[-1]
    n_chunks = seqlen // HG_CHUNK

    def to_chunks(t):
        return t.reshape(bsz, n_chunks, HG_CHUNK, nh, t.shape[-1]).transpose(1, 0, 3, 2, 4)

    causal = jnp.tril(jnp.ones((HG_CHUNK, HG_CHUNK), dtype=bool))[:, :, None]

    def step(state, inp):
        qc, kc, vc, gc = inp
        b = jnp.cumsum(gc, axis=2)
        o_inter = jnp.einsum('bhtd,bhde->bhte', qc * jnp.exp(b), state)
        diff = b[:, :, :, None, :] - b[:, :, None, :, :]
        decay = jnp.exp(jnp.where(causal, diff, -jnp.inf))
        scores = jnp.einsum('bhtd,bhsd,bhtsd->bhts', qc, kc, decay)
        o_intra = jnp.einsum('bhts,bhse->bhte', scores, vc)
        b_last = b[:, :, -1, :]
        k_dec = kc * jnp.exp(b_last[:, :, None, :] - b)
        state = jnp.exp(b_last)[..., None] * state + jnp.einsum('bhsd,bhse->bhde', k_dec, vc)
        return state, o_inter + o_intra

    s0 = jnp.zeros((bsz, nh, dk, dv), jnp.float32)
    _, o = lax.scan(step, s0, (to_chunks(q), to_chunks(k), to_chunks(v), to_chunks(log_f)))
    return o.transpose(1, 0, 3, 2, 4).reshape(bsz, seqlen, nh, dv)


def hgrn2_branch(zq, zf, zi, zo, lb, onorm_w):
    bsz, seqlen, _ = zq.shape
    heads = lambda t: t.reshape(bsz, seqlen, HG_HEADS, HG_HEAD_DIM)
    q = jax.nn.silu(zq.astype(jnp.float32))
    f_gate = lb + (1.0 - lb) * jax.nn.sigmoid(zf.astype(jnp.float32))
    o = hgrn2_chunked(heads(q), heads(1.0 - f_gate), heads(zi.astype(jnp.float32)),
                      heads(jnp.log(f_gate)))
    o = rmsnorm(o, onorm_w).reshape(bsz, seqlen, HG_WIDTH)
    return (o * jax.nn.sigmoid(zo.astype(jnp.float32))).astype(zq.dtype)


def rwkv7_scan(r, log_w, k, v, a_vec, b_vec):
    bsz, seqlen, nh, hd = r.shape
    tm = lambda t: t.transpose(1, 0, 2, 3)

    def step(state, inp):
        rt, lwt, kt, vt, at, bt = inp
        sa = jnp.einsum('bhvk,bhk->bhv', state, at)
        state = (state * jnp.exp(lwt)[:, :, None, :] + sa[..., None] * bt[:, :, None, :]
                 + vt[..., None] * kt[:, :, None, :])
        return state, jnp.einsum('bhvk,bhk->bhv', state, rt)

    s0 = jnp.zeros((bsz, nh, hd, hd), jnp.float32)
    _, y = lax.scan(step, s0, (tm(r), tm(log_w), tm(k), tm(v), tm(a_vec), tm(b_vec)))
    return y.transpose(1, 0, 2, 3)


def rwkv7_branch(zs, mu, w0, w_up, a0, a_up, g_up, k_k, k_a, r_k, ln_w, ln_b, v_first, v_res):
    bsz, seqlen, _ = zs.shape
    f32 = jnp.float32
    heads = lambda t: t.reshape(bsz, seqlen, RW_HEADS, RW_HEAD_DIM)
    zs = zs + mu * (token_shift(zs) - zs)
    r, k, v, wd, ad, gd = jnp.split(zs, RW_SPLITS, axis=-1)
    log_w = -jnp.exp(-jax.nn.softplus(-(w0 + jnp.tanh(wd) @ w_up).astype(f32)) - 0.5)
    a = jax.nn.sigmoid((a0 + ad @ a_up).astype(f32))
    g = jax.nn.sigmoid(gd) @ g_up
    if v_res is None:
        v_first = v
    else:
        v0, v_down, v_up = v_res
        v = v + (v_first - v) * jax.nn.sigmoid(v0 + (v @ v_down) @ v_up)
    kk = heads((k * k_k).astype(f32))
    kk = kk * lax.rsqrt(jnp.maximum(jnp.sum(kk * kk, axis=-1, keepdims=True), 1e-12))
    a_h = heads(a)
    k_h = heads(k.astype(f32) * (1.0 + (a - 1.0) * k_a.astype(f32)))
    r_h = heads(r.astype(f32))
    v_h = heads(v.astype(f32))
    y = rwkv7_scan(r_h, heads(log_w), k_h, v_h, -kk, kk * a_h)
    mean = jnp.mean(y, axis=-1, keepdims=True)
    var = jnp.mean(jnp.square(y - mean), axis=-1, keepdims=True)
    y = ((y - mean) * lax.rsqrt(var + RW_GN_EPS) * ln_w.astype(f32).reshape(RW_HEADS, RW_HEAD_DIM)
         + ln_b.astype(f32).reshape(RW_HEADS, RW_HEAD_DIM))
    y = y + jnp.sum(r_h * k_h * r_k.astype(f32), axis=-1, keepdims=True) * v_h
    y = y.reshape(bsz, seqlen, RW_WIDTH) * g.astype(f32)
    return y.astype(zs.dtype), v_first


def hier_moe(h, wg_r, bg_r, we_r, be_r, w_gate, w_up, w_down):
    bsz, seqlen, d = h.shape
    n_tok = bsz * seqlen
    hf = h.reshape(n_tok, d)
    f32 = jnp.float32
    g_logits = (hf @ wg_r + bg_r).astype(f32)
    g_prob = jax.nn.softmax(g_logits, axis=-1)
    g_sel = jnp.argmax(g_logits, axis=-1)
    p_group = jnp.take_along_axis(g_prob, g_sel[:, None], axis=-1)
    e_logits = (hf @ we_r + be_r).astype(f32).reshape(n_tok, N_GROUPS, EXPERTS_PER_GROUP)
    e_logits = jnp.take_along_axis(e_logits, g_sel[:, None, None], axis=1)[:, 0]
    top_l, top_i = lax.top_k(e_logits, TOP_K_IN_GROUP)
    weights = p_group * jax.nn.softmax(top_l, axis=-1)
    expert_id = g_sel[:, None] * EXPERTS_PER_GROUP + top_i
    n_assign = n_tok * TOP_K_IN_GROUP
    eid = expert_id.reshape(n_assign).astype(jnp.int32)
    w_flat = weights.reshape(n_assign)
    tok = jnp.repeat(jnp.arange(n_tok, dtype=jnp.int32), TOP_K_IN_GROUP)
    counts = jnp.bincount(eid, length=N_EXPERTS)
    padded = ((counts + DISPATCH_BLOCK - 1) // DISPATCH_BLOCK) * DISPATCH_BLOCK
    pad_end = jnp.cumsum(padded)
    pad_start = pad_end - padded
    start = jnp.cumsum(counts) - counts
    order = jnp.argsort(eid)
    se = eid[order]
    dest = pad_start[se] + (jnp.arange(n_assign, dtype=jnp.int32) - start[se])
    n_slots = n_assign + N_EXPERTS * DISPATCH_BLOCK
    n_blocks = n_slots // DISPATCH_BLOCK
    buf_tok = jnp.full((n_slots,), n_tok, jnp.int32).at[dest].set(tok[order])
    buf_w = jnp.zeros((n_slots,), f32).at[dest].set(w_flat[order])
    blk_e = jnp.clip(jnp.searchsorted(pad_end, jnp.arange(n_blocks) * DISPATCH_BLOCK, side='right'),
                     0, N_EXPERTS - 1)
    hpad = jnp.concatenate([hf, jnp.zeros((1, d), hf.dtype)], axis=0)
    xs = hpad[buf_tok].reshape(n_blocks, DISPATCH_BLOCK, d)

    def expert_block(args):
        xb, e = args
        return (jax.nn.silu(xb @ w_gate[e]) * (xb @ w_up[e])) @ w_down[e]

    ys = lax.map(expert_block, (xs, blk_e)).reshape(n_slots, d)
    out = jax.ops.segment_sum(ys * buf_w[:, None], buf_tok, num_segments=n_tok + 1)[:n_tok]
    return out.astype(h.dtype).reshape(bsz, seqlen, d)


def setup_inputs(seed: int = 0) -> dict:
    key = jax.random.key(seed)
    ks = jax.random.split(key, 40)
    counter = [0]

    def nxt():
        counter[0] += 1
        return ks[counter[0] - 1]

    def normal(shape, scale):
        return scale * jax.random.normal(nxt(), shape, jnp.float32)

    def gain(shape):
        return 1.0 + normal(shape, 0.02)

    L = DEPTH
    D = D_MODEL
    return {
        'x': normal((BATCH, SEQ, D), 1.0),
        'norm_mix_w': gain((L, D)),
        'w_in': normal((L, D, IN_WIDTH), D ** -0.5),
        'hgrn_lb_raw': normal((L, HG_WIDTH), 0.5),
        'hgrn_onorm_w': gain((L, HG_HEAD_DIM)),
        'rw_mu': jax.random.uniform(nxt(), (L, RW_SHIFT_WIDTH), jnp.float32),
        'rw_w0': jax.random.uniform(nxt(), (L, RW_WIDTH), jnp.float32, -3.0, 1.0),
        'rw_w_up': normal((L, RW_DECAY_LORA, RW_WIDTH), 0.1),
        'rw_a0': normal((L, RW_WIDTH), 0.1),
        'rw_a_up': normal((L, RW_AAA_LORA, RW_WIDTH), 0.1),
        'rw_g_up': normal((L, RW_GATE_LORA, RW_WIDTH), RW_GATE_LORA ** -0.5),
        'rw_k_k': 0.85 + normal((L, RW_WIDTH), 0.05),
        'rw_k_a': 1.0 + normal((L, RW_WIDTH), 0.05),
        'rw_r_k': normal((L, RW_HEADS, RW_HEAD_DIM), 0.1),
        'rw_ln_w': gain((L, RW_WIDTH)),
        'rw_ln_b': normal((L, RW_WIDTH), 0.02),
        'rw_v0': normal((L - 1, RW_WIDTH), 0.1),
        'rw_v_down': normal((L - 1, RW_WIDTH, RW_MV_LORA), RW_WIDTH ** -0.5),
        'rw_v_up': normal((L - 1, RW_MV_LORA, RW_WIDTH), 0.1),
        'w_branch_hg': normal((L, HG_WIDTH, D), HG_WIDTH ** -0.5),
        'w_branch_rw': normal((L, RW_WIDTH, D), RW_WIDTH ** -0.5),
        'w_out': normal((L, D, D), D ** -0.5),
        'norm_ffn_w': gain((L, D)),
        'router_group_w': normal((L, D, N_GROUPS), D ** -0.5),
        'router_group_b': normal((L, N_GROUPS), 0.01),
        'router_expert_w': normal((L, D, N_EXPERTS), D ** -0.5),
        'router_expert_b': normal((L, N_EXPERTS), 0.01),
        'expert_w_gate': normal((L, N_EXPERTS, D, D_EXPERT), D ** -0.5),
        'expert_w_up': normal((L, N_EXPERTS, D, D_EXPERT), D ** -0.5),
        'expert_w_down': normal((L, N_EXPERTS, D_EXPERT, D), D_EXPERT ** -0.5),
        'final_norm_w': gain((D,)),
    }


def reference(x, norm_mix_w, w_in, hgrn_lb_raw, hgrn_onorm_w, rw_mu, rw_w0, rw_w_up, rw_a0,
              rw_a_up, rw_g_up, rw_k_k, rw_k_a, rw_r_k, rw_ln_w, rw_ln_b, rw_v0, rw_v_down,
              rw_v_up, w_branch_hg, w_branch_rw, w_out, norm_ffn_w, router_group_w,
              router_group_b, router_expert_w, router_expert_b, expert_w_gate, expert_w_up,
              expert_w_down, final_norm_w):
    lb_all = jnp.cumsum(jax.nn.softmax(hgrn_lb_raw.astype(jnp.float32), axis=0), axis=0)
    lb_all = lb_all - lb_all[:1]
    h = x
    v_first = None
    for l in range(DEPTH):
        xn = rmsnorm(h, norm_mix_w[l])
        z = xn @ w_in[l]
        zq, zf, zi, zo, zs, zga, zgb = jnp.split(z, IN_SPLITS, axis=-1)
        y_hg = hgrn2_branch(zq, zf, zi, zo, lb_all[l], hgrn_onorm_w[l])
        v_res = None if l == 0 else (rw_v0[l - 1], rw_v_down[l - 1], rw_v_up[l - 1])
        y_rw, v_first = rwkv7_branch(zs, rw_mu[l], rw_w0[l], rw_w_up[l], rw_a0[l], rw_a_up[l],
                                     rw_g_up[l], rw_k_k[l], rw_k_a[l], rw_r_k[l], rw_ln_w[l],
                                     rw_ln_b[l], v_first, v_res)
        merged = (jax.nn.sigmoid(zga) * (y_hg @ w_branch_hg[l])
                  + jax.nn.sigmoid(zgb) * (y_rw @ w_branch_rw[l]))
        h = h + merged @ w_out[l]
        hn = rmsnorm(h, norm_ffn_w[l])
        h = h + hier_moe(hn, router_group_w[l], router_group_b[l], router_expert_w[l],
                         router_expert_b[l], expert_w_gate[l], expert_w_up[l], expert_w_down[l])
    return rmsnorm(h, final_norm_w)
```

```cpp
#include <hip/hip_runtime.h>
#include <stdint.h>
#include <stdio.h>
#ifndef MK_ONE_LAUNCH
#define MK_ONE_LAUNCH 0
#endif
#define DI __device__ __forceinline__
#define LAS __attribute__((address_space(3)))
typedef unsigned short bf16_t;
typedef short bf16x8 __attribute__((ext_vector_type(8)));
typedef short s16x4 __attribute__((ext_vector_type(4)));
typedef float f32x4 __attribute__((ext_vector_type(4)));
typedef float f32x2 __attribute__((ext_vector_type(2)));
typedef unsigned u32x4 __attribute__((ext_vector_type(4)));
typedef unsigned u32x2 __attribute__((ext_vector_type(2)));

constexpr int M = 16384, D = 2048, TSEQ = 2048, NBATCH = 8;
constexpr int NZ = 11776;
constexpr int ZC_Q = 0, ZC_F = 1024, ZC_I = 2048, ZC_O = 3072, ZC_R = 4096, ZC_K = 5120, ZC_V = 6144, ZC_WD = 7168, ZC_AD = 7232, ZC_GD = 7296,
              ZC_GA = 7456, ZC_GB = 9504, ZC_VDA = 11552, ZC_VDB = 11584;
constexpr int IN_WIDTH = 11552;
constexpr int NEXP = 32, DEXP = 512, MAXSLOTS = 40960;
constexpr float NORM_EPS = 1e-6f, RW_GN_EPS = 64e-5f;
constexpr size_t MiB = 1u << 20;
constexpr size_t WS_CTL = 0, CTL_BYTES = 1 * MiB;
constexpr size_t WS_TOKE = 1 * MiB, WS_TOKW = WS_TOKE + 128 * 1024, WS_TOKS = WS_TOKW + 128 * 1024, WS_CNT = WS_TOKS + 128 * 1024;
constexpr size_t WS_LORA = 2 * MiB;
constexpr size_t LO_WUP = 0, LO_AUP = 128 * 1024, LO_GUP = 256 * 1024, LO_VUP = 576 * 1024, LO_WR = 640 * 1024;
constexpr size_t WS_WIN = 4 * MiB, WS_WBH = 50 * MiB, WS_WBR = 54 * MiB, WS_WO = 58 * MiB;
constexpr size_t WS_Z = 66 * MiB;
constexpr size_t WS_XS = WS_Z, WS_ACT = WS_Z + 160 * MiB, WS_YS = WS_Z + 200 * MiB;
constexpr size_t WS_XN = 434 * MiB;
constexpr size_t WS_YHG = 498 * MiB, WS_YRW = 530 * MiB, WS_VFIRST = 562 * MiB;
constexpr size_t WS_X = 594 * MiB;
constexpr size_t WS_NT = WS_X, WS_DC = WS_X + 128 * MiB, WS_QH = WS_X + 130 * MiB, WS_OI = WS_X + 162 * MiB;
constexpr size_t WS_MT = WS_X + 194 * MiB, WS_NN = WS_X + 226 * MiB, WS_RP = WS_X + 258 * MiB, WS_Y0 = WS_X + 290 * MiB, WS_SS = WS_X + 322 * MiB,
                 WS_RK = WS_X + 354 * MiB, WS_VF = WS_X + 355 * MiB;
constexpr size_t WS_WGU = WS_X, WS_WDN = WS_X + 128 * MiB;
constexpr size_t WS_END = 981 * MiB;
constexpr int CW_BAR = 4096;
constexpr int LDS_CTL_OFF = 148 * 1024, LDS_BYTES = 152 * 1024;
constexpr int LC_TOT = 16, LC_PAD = 48, LC_TILE = 96, LC_MISC = 256;

DI float bf2f(unsigned short b) { return __uint_as_float(((unsigned)b) << 16); }
typedef __bf16 nbf16x2 __attribute__((ext_vector_type(2)));
DI unsigned cvt_pk(float lo, float hi) { const f32x2 f = {lo, hi}; const nbf16x2 v = __builtin_convertvector(f, nbf16x2); return __builtin_bit_cast(unsigned, v); }
DI void unpack8(const u32x4 v, float (&f)[8]) {
    f[0] = __uint_as_float(v.x << 16); f[1] = __uint_as_float(v.x & 0xffff0000u); f[2] = __uint_as_float(v.y << 16); f[3] = __uint_as_float(v.y & 0xffff0000u);
    f[4] = __uint_as_float(v.z << 16); f[5] = __uint_as_float(v.z & 0xffff0000u); f[6] = __uint_as_float(v.w << 16); f[7] = __uint_as_float(v.w & 0xffff0000u); }
DI u32x4 pack8(const float (&f)[8]) { u32x4 v; v.x = cvt_pk(f[0], f[1]); v.y = cvt_pk(f[2], f[3]); v.z = cvt_pk(f[4], f[5]); v.w = cvt_pk(f[6], f[7]); return v; }
DI void unpack4(const u32x2 v, float (&f)[4]) { f[0] = __uint_as_float(v.x << 16); f[1] = __uint_as_float(v.x & 0xffff0000u); f[2] = __uint_as_float(v.y << 16); f[3] = __uint_as_float(v.y & 0xffff0000u); }
DI u32x2 pack4(float a, float b, float c, float d) { u32x2 v; v.x = cvt_pk(a, b); v.y = cvt_pk(c, d); return v; }
DI float sigm(float x) { return 1.0f / (1.0f + __expf(-x)); }
DI float wave_sum(float v) {
#pragma unroll
    for (int o = 1; o < 64; o <<= 1) v += __shfl_xor(v, o);
    return v;
}
namespace pg8 {
#define PG8_LAS __attribute__((address_space(3)))
typedef unsigned short bf16_t;
typedef short bf16x8 __attribute__((ext_vector_type(8)));
typedef float f32x4 __attribute__((ext_vector_type(4)));
typedef unsigned u32x4 __attribute__((ext_vector_type(4)));
constexpr int BM = 256, BK = 64, HALF = 128, HTB = HALF * BK * 2  , STAGE_BYTES = 8 * HTB, NXCD = 8, WGM = 8;

__host__ __device__ __forceinline__ int lds_byte(int r, int c) { const int st = (r >> 4) * 2 + (c >> 5), rr = r & 15, cc = c & 31, ob = rr * 64 + cc * 2; return st * 1024 + (ob ^ (((ob >> 9) & 1) << 5)); }
__host__ __device__ __forceinline__ void stage_rc(int b, int& R, int& C) { const int st = b / 1024, sb = b % 1024, swz = sb ^ (((sb >> 9) & 1) << 5); R = (st >> 1) * 16 + swz / 64; C = (st & 1) * 32 + (swz % 64) / 2; }
__host__ __device__ __forceinline__ int perm32(int rho) { const int n = rho >> 4, i = rho & 15; return 8 * (i >> 2) + 4 * n + (i & 3); }

struct Unit { int pm, pn; };
struct Gemm { const bf16_t* A; const bf16_t* Bt; int M, N, K; };

struct StaticOrder {
    int nM, nN, nwg, G, c;
    __host__ __device__ void init(int M, int N, int G_, int c_) { nM = M / BM; nN = N / BM; nwg = nM * nN; G = G_; c = c_; }
    __host__ __device__ bool next(int i, Unit& u) const {
        const long L = (long)i * G + c; if (L >= nwg) return false;
        int wgid = (int)L; { const int q = nwg / NXCD, r = nwg % NXCD, xcd = wgid % NXCD, off = wgid / NXCD; wgid = (xcd < r ? xcd * (q + 1) : r * (q + 1) + (xcd - r) * q) + off; }
        const int nig = WGM * nN, gid = wgid / nig, fm = gid * WGM, gsz = (nM - fm) < WGM ? (nM - fm) : WGM;
        u.pm = fm + ((wgid % nig) % gsz); u.pn = (wgid % nig) / gsz; return true;
    }
    __device__ __forceinline__ void a_ready(const Unit&) const {}
    __device__ __forceinline__ void done(const Unit&) const {}
};
__device__ __forceinline__ unsigned cvt_pk_bf16(float lo, float hi) { return ::cvt_pk(lo, hi); }
typedef float f32x2 __attribute__((ext_vector_type(2)));
struct EpiBf16P {
    static constexpr bool PERM = true, AFTER_DRAIN = false;
    bf16_t* O; int ldc;
    __device__ __forceinline__ void operator()(const f32x4 (&acc)[2][2][4][2], const Unit& u, int wr, int wc, int fr, int fq) const {
        const int row0 = u.pm * BM + wr * 64 + fr, col0 = u.pn * BM + wc * 32 + 8 * fq;
#pragma unroll
        for (int ai = 0; ai < 2; ++ai)
#pragma unroll
            for (int m = 0; m < 4; ++m) { bf16_t* rowp = O + (size_t)(row0 + ai * HALF + m * 16) * ldc + col0;
#pragma unroll
                for (int bj = 0; bj < 2; ++bj) { const f32x4 v0 = acc[ai][bj][m][0], v1 = acc[ai][bj][m][1];
                    u32x4 w; w.x = cvt_pk_bf16(v0[0], v0[1]); w.y = cvt_pk_bf16(v0[2], v0[3]); w.z = cvt_pk_bf16(v1[0], v1[1]); w.w = cvt_pk_bf16(v1[2], v1[3]);
                    *(u32x4*)(rowp + bj * HALF) = w; } asm volatile("" ::: "memory"); }
    }
};
struct EpiGate {
    static constexpr bool PERM = true, AFTER_DRAIN = false;
    bf16_t* O; int ldo; const bf16_t* Zg; int ldz; int accum;
    __device__ __forceinline__ void operator()(const f32x4 (&acc)[2][2][4][2], const Unit& u, int wr, int wc, int fr, int fq) const {
        const int row0 = u.pm * BM + wr * 64 + fr, col0 = u.pn * BM + wc * 32 + 8 * fq;
#pragma unroll
        for (int ai = 0; ai < 2; ++ai)
#pragma unroll
            for (int m = 0; m < 4; ++m) { const size_t row = (size_t)(row0 + ai * HALF + m * 16);
#pragma unroll
                for (int bj = 0; bj < 2; ++bj) { const f32x4 v0 = acc[ai][bj][m][0], v1 = acc[ai][bj][m][1];
                    const u32x4 zg = *(const u32x4*)(Zg + row * ldz + col0 + bj * HALF);
                    float z[8]; z[0] = __uint_as_float(zg.x << 16); z[1] = __uint_as_float(zg.x & 0xffff0000u); z[2] = __uint_as_float(zg.y << 16); z[3] = __uint_as_float(zg.y & 0xffff0000u);
                    z[4] = __uint_as_float(zg.z << 16); z[5] = __uint_as_float(zg.z & 0xffff0000u); z[6] = __uint_as_float(zg.w << 16); z[7] = __uint_as_float(zg.w & 0xffff0000u);
                    float o[8];
#pragma unroll
                    for (int j = 0; j < 4; ++j) { o[j] = v0[j] / (1.0f + __expf(-z[j])); o[4 + j] = v1[j] / (1.0f + __expf(-z[4 + j])); }
                    bf16_t* op = O + row * ldo + col0 + bj * HALF;
                    if (accum) { const u32x4 pv = *(const u32x4*)op;
                        o[0] += __uint_as_float(pv.x << 16); o[1] += __uint_as_float(pv.x & 0xffff0000u); o[2] += __uint_as_float(pv.y << 16); o[3] += __uint_as_float(pv.y & 0xffff0000u);
                        o[4] += __uint_as_float(pv.z << 16); o[5] += __uint_as_float(pv.z & 0xffff0000u); o[6] += __uint_as_float(pv.w << 16); o[7] += __uint_as_float(pv.w & 0xffff0000u); }
                    u32x4 w; w.x = cvt_pk_bf16(o[0], o[1]); w.y = cvt_pk_bf16(o[2], o[3]); w.z = cvt_pk_bf16(o[4], o[5]); w.w = cvt_pk_bf16(o[6], o[7]);
                    *(u32x4*)op = w; asm volatile("" ::: "memory"); } }
    }
};
struct EpiRes {
    static constexpr bool PERM = false, AFTER_DRAIN = false;
    const float* base; float* out; int ldc;
    __device__ __forceinline__ void operator()(const f32x4 (&acc)[2][2][4][2], const Unit& u, int wr, int wc, int fr, int fq) const {
        const int row0 = u.pm * BM + wr * 64 + fr, col0 = u.pn * BM + wc * 32 + 4 * fq;
#pragma unroll
        for (int ai = 0; ai < 2; ++ai)
#pragma unroll
            for (int m = 0; m < 4; ++m) { const size_t off = (size_t)(row0 + ai * HALF + m * 16) * ldc + col0;
#pragma unroll
                for (int bj = 0; bj < 2; ++bj)
#pragma unroll
                    for (int n = 0; n < 2; ++n) { const f32x4 bs = *(const f32x4*)(base + off + bj * HALF + n * 16); *(f32x4*)(out + off + bj * HALF + n * 16) = bs + acc[ai][bj][m][n]; } asm volatile("" ::: "memory"); }
    }
};
struct EpiSwiGLU {
    static constexpr bool PERM = true, AFTER_DRAIN = false;
    bf16_t* O;
    __device__ __forceinline__ void operator()(const f32x4 (&acc)[2][2][4][2], const Unit& u, int wr, int wc, int fr, int fq) const {
        const int row0 = u.pm * BM + wr * 64 + fr, col0 = (u.pn & 3) * 128 + wc * 32 + 8 * fq;
#pragma unroll
        for (int ai = 0; ai < 2; ++ai)
#pragma unroll
            for (int m = 0; m < 4; ++m) { bf16_t* rowp = O + (size_t)(row0 + ai * HALF + m * 16) * 512 + col0;
                float o[8];
#pragma unroll
                for (int n = 0; n < 2; ++n)
#pragma unroll
                    for (int j = 0; j < 4; ++j) { const float g = acc[ai][0][m][n][j], up = acc[ai][1][m][n][j]; o[4 * n + j] = g / (1.0f + __expf(-g)) * up; }
                u32x4 w; w.x = cvt_pk_bf16(o[0], o[1]); w.y = cvt_pk_bf16(o[2], o[3]); w.z = cvt_pk_bf16(o[4], o[5]); w.w = cvt_pk_bf16(o[6], o[7]);
                *(u32x4*)rowp = w; asm volatile("" ::: "memory"); }
    }
};
struct EpiDown {
    static constexpr bool PERM = true, AFTER_DRAIN = false;
    bf16_t* O;
    __device__ __forceinline__ void operator()(const f32x4 (&acc)[2][2][4][2], const Unit& u, int wr, int wc, int fr, int fq) const {
        const int row0 = u.pm * BM + wr * 64 + fr, col0 = (u.pn & 7) * BM + wc * 32 + 8 * fq;
#pragma unroll
        for (int ai = 0; ai < 2; ++ai)
#pragma unroll
            for (int m = 0; m < 4; ++m) { bf16_t* rowp = O + (size_t)(row0 + ai * HALF + m * 16) * 2048 + col0;
#pragma unroll
                for (int bj = 0; bj < 2; ++bj) { const f32x4 v0 = acc[ai][bj][m][0], v1 = acc[ai][bj][m][1];
                    u32x4 w; w.x = cvt_pk_bf16(v0[0], v0[1]); w.y = cvt_pk_bf16(v0[2], v0[3]); w.z = cvt_pk_bf16(v1[0], v1[1]); w.w = cvt_pk_bf16(v1[2], v1[3]);
                    *(u32x4*)(rowp + bj * HALF) = w; } asm volatile("" ::: "memory"); }
    }
};
template <int NTN> struct GroupedOrder {
    static constexpr int ntn = NTN; int nunits, G, c; const PG8_LAS int* tile_e;
    __device__ __forceinline__ bool next(int i, Unit& u) const { const long L = (long)i * G + c; if (L >= nunits) return false; const int rt = (int)L / ntn, pl = (int)L % ntn; u.pm = rt; u.pn = tile_e[rt] * ntn + pl; return true; }
    __device__ __forceinline__ void a_ready(const Unit&) const {}
    __device__ __forceinline__ void done(const Unit&) const {}
};
template <class Epi, class Sched, bool STAMP = false>
__device__ __forceinline__ void gemm_phase(PG8_LAS unsigned char* lds, const Gemm g, const Sched& S, const Epi& E, unsigned long long* stamps) {
    int tid_ = threadIdx.x; asm volatile("" : "+v"(tid_));
    const int tid = tid_, wid = __builtin_amdgcn_readfirstlane(tid >> 6), lane = tid & 63, wr = wid >> 2, wc = wid & 3, fr = lane & 15, fq = lane >> 4;
    const int K = g.K, nt = K / BK;
    int ts_lo = 0, ts_hi = 0, nts = 0; const unsigned long long rt_entry = STAMP ? (unsigned long long)wall_clock64() : 0ull;
#define PG8_STAMP() do { if (STAMP && wid == 0 && nts < 64) { const unsigned long long _c = (unsigned long long)clock64(); \
        ts_lo = (lane == nts) ? (int)(unsigned)_c : ts_lo; ts_hi = (lane == nts) ? (int)(unsigned)(_c >> 32) : ts_hi; ++nts; } } while (0)
    PG8_STAMP();
    unsigned voffA[2], voffB[2];
#pragma unroll
    for (int i = 0; i < 2; ++i) { int R, C; stage_rc(tid * 16 + i * 8192, R, C); const int Rb = Epi::PERM ? ((R & ~31) + perm32(R & 31)) : R;
        voffA[i] = (unsigned)(R * K + C) * 2u; voffB[i] = (unsigned)(Rb * K + C) * 2u; }
    const size_t kstep = (size_t)(BK * 2);
    const size_t hstep = (size_t)HALF * K * 2;
    const size_t tstep = 2 * hstep;
    const unsigned ldsw = (unsigned)wid * 1024u;
    const int aoff = lds_byte(wr * 64 + fr, fq * 8), boff = lds_byte(wc * 32 + fr, fq * 8);
#define PG8_SA(b, h) (((b) * 2 + (h)) * HTB)
#define PG8_SB(b, h) ((4 + (b) * 2 + (h)) * HTB)
#define PG8_STAGE(bufoff, gbase, voff) do { _Pragma("unroll") for (int _i = 0; _i < 2; ++_i) \
        __builtin_amdgcn_global_load_lds((const unsigned*)((const char*)(gbase) + (voff)[_i]), (PG8_LAS unsigned*)(lds + (bufoff) + ldsw + _i * 8192), 16, 0, 0); } while (0)
#define PG8_LDA(dst, b, h) do { _Pragma("unroll") for (int m = 0; m < 4; ++m) _Pragma("unroll") for (int k = 0; k < 2; ++k) dst[m][k] = *(const PG8_LAS bf16x8*)(lds + PG8_SA(b, h) + aoff + m * 2048 + k * 1024); } while (0)
#define PG8_LDB(dst, b, h) do { _Pragma("unroll") for (int n = 0; n < 2; ++n) _Pragma("unroll") for (int k = 0; k < 2; ++k) dst[n][k] = *(const PG8_LAS bf16x8*)(lds + PG8_SB(b, h) + boff + n * 2048 + k * 1024); } while (0)
#define PG8_MMA(ai, bj, At, Bt) do { __builtin_amdgcn_s_setprio(1); _Pragma("unroll") for (int m = 0; m < 4; ++m) _Pragma("unroll") for (int n = 0; n < 2; ++n) _Pragma("unroll") for (int k = 0; k < 2; ++k) \
        acc[ai][bj][m][n] = __builtin_amdgcn_mfma_f32_16x16x32_bf16(Bt[n][k], At[m][k], acc[ai][bj][m][n], 0, 0, 0); __builtin_amdgcn_s_setprio(0); } while (0)
#define PG8_WAIT_V(n) asm volatile("s_waitcnt vmcnt(" #n ")" ::: "memory")
#define PG8_WAIT_L(n) asm volatile("s_waitcnt lgkmcnt(" #n ")" ::: "memory")
#define PG8_BAR __builtin_amdgcn_s_barrier()
#define PG8_SCHED __builtin_amdgcn_sched_barrier(0)
    Unit cur, nxt; int ui = 0;
    if (!S.next(0, cur)) return;
    f32x4 acc[2][2][4][2];
#pragma unroll
    for (int a = 0; a < 2; ++a)
#pragma unroll
        for (int b = 0; b < 2; ++b)
#pragma unroll
            for (int m = 0; m < 4; ++m)
#pragma unroll
                for (int n = 0; n < 2; ++n) acc[a][b][m][n] = (f32x4){0.f, 0.f, 0.f, 0.f};
    bf16x8 At[4][2], B0[2][2], B1[2][2];
    const char* cA = (const char*)g.A + (size_t)cur.pm * tstep; const char* cB = (const char*)g.Bt + (size_t)cur.pn * tstep;
    S.a_ready(cur);
    PG8_STAGE(PG8_SB(0, 0), cB, voffB); PG8_STAGE(PG8_SA(0, 0), cA, voffA); PG8_STAGE(PG8_SB(0, 1), cB + hstep, voffB); PG8_STAGE(PG8_SA(0, 1), cA + hstep, voffA);
    if (wr == 1) PG8_BAR;
    PG8_WAIT_V(4); PG8_BAR;
    PG8_STAGE(PG8_SB(1, 0), cB + kstep, voffB); PG8_STAGE(PG8_SA(1, 0), cA + kstep, voffA); PG8_STAGE(PG8_SB(1, 1), cB + hstep + kstep, voffB);
    PG8_WAIT_V(6); PG8_BAR;
    PG8_STAMP();
    for (;;) {
        const bool has_next = S.next(ui + 1, nxt);
        const char* nA = has_next ? (const char*)g.A + (size_t)nxt.pm * tstep : cA; const char* nB = has_next ? (const char*)g.Bt + (size_t)nxt.pn * tstep : cB;
        for (int t = 0; t < nt; t += 2) {
            const bool last = (t == nt - 2);
            const char* a1 = cA + (size_t)(t + 1) * kstep;
            const char* a2 = last ? nA : cA + (size_t)(t + 2) * kstep; const char* b2 = last ? nB : cB + (size_t)(t + 2) * kstep;
            const char* a3 = a2 + kstep; const char* b3 = b2 + kstep;
            if (last && has_next) S.a_ready(nxt);
            PG8_LDB(B0, 0, 0); PG8_SCHED; PG8_LDA(At, 0, 0); PG8_STAGE(PG8_SA(1, 1), a1 + hstep, voffA);
            PG8_WAIT_L(8); PG8_BAR; PG8_WAIT_L(0); PG8_MMA(0, 0, At, B0); PG8_BAR; PG8_SCHED;
            PG8_LDB(B1, 0, 1); PG8_STAGE(PG8_SB(0, 0), b2, voffB);
            PG8_BAR; PG8_WAIT_L(0); PG8_MMA(0, 1, At, B1); PG8_BAR;
            PG8_LDA(At, 0, 1); PG8_STAGE(PG8_SA(0, 0), a2, voffA);
            PG8_BAR; PG8_WAIT_L(0); PG8_MMA(1, 0, At, B0); PG8_BAR; PG8_SCHED;
            PG8_STAGE(PG8_SB(0, 1), b2 + hstep, voffB);
            PG8_WAIT_V(6); PG8_BAR; PG8_MMA(1, 1, At, B1); PG8_BAR;
            PG8_LDB(B0, 1, 0); PG8_SCHED; PG8_LDA(At, 1, 0); PG8_STAGE(PG8_SA(0, 1), a2 + hstep, voffA);
            PG8_WAIT_L(8); PG8_BAR; PG8_WAIT_L(0); PG8_MMA(0, 0, At, B0); PG8_BAR; PG8_SCHED;
            PG8_LDB(B1, 1, 1); PG8_STAGE(PG8_SB(1, 0), b3, voffB);
            PG8_BAR; PG8_WAIT_L(0); PG8_MMA(0, 1, At, B1); PG8_BAR;
            PG8_LDA(At, 1, 1); PG8_STAGE(PG8_SA(1, 0), a3, voffA);
            PG8_BAR; PG8_WAIT_L(0); PG8_MMA(1, 0, At, B0); PG8_BAR; PG8_SCHED;
            PG8_STAGE(PG8_SB(1, 1), b3 + hstep, voffB);
            PG8_WAIT_V(6); PG8_BAR; PG8_MMA(1, 1, At, B1); PG8_BAR;
        }
        PG8_STAMP();
        if constexpr (!Epi::AFTER_DRAIN) { E(acc, cur, wr, wc, fr, fq); S.done(cur); }
        PG8_STAMP();
        if (!has_next) break;
#pragma unroll
        for (int a = 0; a < 2; ++a)
#pragma unroll
            for (int b = 0; b < 2; ++b)
#pragma unroll
                for (int m = 0; m < 4; ++m)
#pragma unroll
                    for (int n = 0; n < 2; ++n) acc[a][b][m][n] = (f32x4){0.f, 0.f, 0.f, 0.f};
        cur = nxt; cA = nA; cB = nB; ++ui;
    }
    PG8_WAIT_V(0);
    if (wr == 0) PG8_BAR;
    PG8_BAR;
    if constexpr (Epi::AFTER_DRAIN) { E.fused(acc, cur, wr, wc, fr, fq, lds, wid, lane); S.done(cur); }
    PG8_STAMP();
    if (STAMP && wid == 0) { stamps[lane] = lane < nts ? (((unsigned long long)(unsigned)ts_hi << 32) | (unsigned)ts_lo) : 0ull;
        if (lane == 62) stamps[62] = rt_entry; if (lane == 63) stamps[63] = (unsigned long long)wall_clock64(); }
#undef PG8_STAMP
#undef PG8_SA
#undef PG8_SB
#undef PG8_STAGE
#undef PG8_LDA
#undef PG8_LDB
#undef PG8_MMA
#undef PG8_WAIT_V
#undef PG8_WAIT_L
#undef PG8_BAR
#undef PG8_SCHED
}
}
#define XB_TMO      128
#define XB_XCNT(j)  (256  + 64 * (j))
#define XB_XSUB(j)  (1280 + 64 * (j))
#define XB_XGEN(j)  (2304 + 64 * (j))
#define XB_TOP      3328
#define XB_TOPGEN   3392
#define XCD_BAR_WORDS 3456
#define XB_SPIN_CAP (1u << 18)

__device__ __forceinline__ unsigned xb_ld(unsigned* p)              { return __hip_atomic_load(p, __ATOMIC_RELAXED, __HIP_MEMORY_SCOPE_AGENT); }
__device__ __forceinline__ unsigned xb_add(unsigned* p, unsigned v) { return __hip_atomic_fetch_add(p, v, __ATOMIC_RELAXED, __HIP_MEMORY_SCOPE_AGENT); }
__device__ __forceinline__ unsigned xb_xcc_id() { return (unsigned)__builtin_amdgcn_s_getreg((3 << 11) | 20) & 0xFu; }
#define XB_SPIN(cond, bar) do { unsigned _sp = 0; while (cond) { __builtin_amdgcn_s_sleep(1); \
    if ((++_sp & 255u) == 0u) { if (xb_ld(&(bar)[XB_TMO])) break; if (_sp > XB_SPIN_CAP) { atomicAdd(&(bar)[XB_TMO], 1u); break; } } } } while (0)

struct XcdBarrier {
    unsigned* bar; unsigned x;
    volatile LAS unsigned* st;
};

__device__ __forceinline__ XcdBarrier xcd_barrier_post(unsigned* bar, volatile LAS unsigned* st) {
    XcdBarrier b; b.bar = bar; b.x = xb_xcc_id(); b.st = st;
    if (threadIdx.x == 0) (void)xb_add(&bar[XB_XCNT(b.x)], 1u);
    return b;
}
__device__ __forceinline__ void xcd_barrier_complete(unsigned* bar, unsigned x, unsigned& nloc, unsigned& nx) {
    const unsigned G = gridDim.x * gridDim.y * gridDim.z;
    unsigned sum, cnt, mine, sp = 0u;
    for (;;) {
        sum = 0u; cnt = 0u; mine = 0u;
#pragma unroll
        for (unsigned j = 0; j < 16; ++j) { const unsigned c = xb_ld(&bar[XB_XCNT(j)]); sum += c; cnt += (c > 0u) ? 1u : 0u; mine = (j == x) ? c : mine; }
        if (sum == G) break;
        __builtin_amdgcn_s_sleep(1);
        if ((++sp & 255u) == 0u) { if (xb_ld(&bar[XB_TMO])) break; if (sp > XB_SPIN_CAP) { atomicAdd(&bar[XB_TMO], 1u); break; } }
    }
    nloc = mine > 0u ? mine : 1u; nx = cnt > 0u ? cnt : 1u;
}

__device__ __forceinline__ void xcd_barrier(const XcdBarrier& b) {
    asm volatile("s_waitcnt vmcnt(0)" ::: "memory");
    __syncthreads();
    if (threadIdx.x == 0) {
        unsigned* bar = b.bar;
        __builtin_amdgcn_s_waitcnt(0);
        unsigned nloc = b.st[0], nx = b.st[1];
        if (nloc == 0u) { xcd_barrier_complete(bar, b.x, nloc, nx); b.st[0] = nloc; b.st[1] = nx; }
        const unsigned old = xb_add(&bar[XB_XSUB(b.x)], 1u);
        const unsigned gen = old / nloc;
        if (old + 1u == (gen + 1u) * nloc) {
            __builtin_amdgcn_fence(__ATOMIC_RELEASE, "agent");
            asm volatile("s_waitcnt vmcnt(0)" ::: "memory");
            const unsigned og = xb_add(&bar[XB_TOP], 1u);
            const unsigned tg = og / nx;
            if (og + 1u == (tg + 1u) * nx) xb_add(&bar[XB_TOPGEN], 1u);
            else XB_SPIN(xb_ld(&bar[XB_TOPGEN]) == tg, bar);
            __builtin_amdgcn_fence(__ATOMIC_ACQUIRE, "agent");
            xb_add(&bar[XB_XGEN(b.x)], 1u);
            asm volatile("s_waitcnt vmcnt(0)" ::: "memory");
        } else {
            XB_SPIN(xb_ld(&bar[XB_XGEN(b.x)]) == gen, bar);
            __builtin_amdgcn_fence(__ATOMIC_ACQUIRE, "agent");
            asm volatile("s_waitcnt vmcnt(0)" ::: "memory");
        }
    }
    __syncthreads();
}
template <int LD> DI bf16x8 frag_n(const LAS bf16_t* A, int row0, int k0, int lane) {
    return *(const LAS bf16x8*)(A + (row0 + (lane & 15)) * LD + k0 + 8 * (lane >> 4));
}
template <int LD> DI bf16x8 frag_t(const LAS bf16_t* A, int row0, int k0, int lane) {
    const int l = lane & 15, g = lane >> 4;
    const unsigned addr = (unsigned)(uintptr_t)(A + (k0 + 8 * g + (l >> 2)) * LD + row0 + 4 * (l & 3));
    s16x4 lo, hi;
    asm volatile("ds_read_b64_tr_b16 %0, %2\n\tds_read_b64_tr_b16 %1, %2 offset:%3\n\ts_waitcnt lgkmcnt(0)" : "=&v"(lo), "=&v"(hi) : "v"(addr), "n"(4 * LD * 2) : "memory");
    bf16x8 r; r[0] = lo[0]; r[1] = lo[1]; r[2] = lo[2]; r[3] = lo[3]; r[4] = hi[0]; r[5] = hi[1]; r[6] = hi[2]; r[7] = hi[3];
    return r;
}
DI bf16x8 gfrag(const bf16_t* A, int ld, int row0, int k0, int lane) {
    return *(const bf16x8*)(A + (size_t)(row0 + (lane & 15)) * ld + k0 + 8 * (lane >> 4));
}
#define MFMA16(a, b, c) __builtin_amdgcn_mfma_f32_16x16x32_bf16((a), (b), (c), 0, 0, 0)
template <bool XT, bool YT, int KS, int LDX, int LDY>
DI f32x4 mm16(const LAS bf16_t* X, const LAS bf16_t* Y, int p0, int q0, int lane, f32x4 acc) {
#pragma unroll
    for (int ks = 0; ks < KS; ++ks) {
        const bf16x8 xb = XT ? frag_t<LDX>(X, p0, 32 * ks, lane) : frag_n<LDX>(X, p0, 32 * ks, lane);
        const bf16x8 ya = YT ? frag_t<LDY>(Y, q0, 32 * ks, lane) : frag_n<LDY>(Y, q0, 32 * ks, lane);
        acc = MFMA16(ya, xb, acc);
    }
    return acc;
}
DI void st4_bf16(LAS bf16_t* p, const f32x4 v) { *(LAS u32x2*)p = pack4(v[0], v[1], v[2], v[3]); }
DI f32x4 ld4_bf16(const LAS bf16_t* p) { const u32x2 w = *(const LAS u32x2*)p; float f[4]; unpack4(w, f); return (f32x4){f[0], f[1], f[2], f[3]}; }
constexpr f32x4 F4Z = {0.f, 0.f, 0.f, 0.f};
struct Params { const float* in[31]; float* out; unsigned char* ws; int ph_lo, ph_hi; };
#define CAS __attribute__((address_space(4)))
typedef const CAS Params& PR;
enum { I_X = 0, I_NMIX, I_WIN, I_LBRAW, I_ONORM, I_MU, I_W0, I_WUP, I_A0, I_AUP, I_GUP, I_KK, I_KA, I_RK, I_LNW, I_LNB, I_V0, I_VDOWN, I_VUP, I_WBH, I_WBR, I_WOUT, I_NFFN,
       I_RGW, I_RGB, I_REW, I_REB, I_EWG, I_EWU, I_EWD, I_FNW };
struct Ctx { LAS unsigned char* lds; int tid, lane, wave, G, bid; };

DI void transpose_item(const float* W, int ldw, int k0, int n0, bf16_t* WT, int ldt, int drow0, LAS float* scr, int lane) {
#pragma unroll 8
    for (int i = 0; i < 32; ++i) { const int kk = 2 * i + (lane >> 5); scr[kk * 33 + (lane & 31)] = W[(size_t)(k0 + kk) * ldw + n0 + (lane & 31)]; }
    asm volatile("s_waitcnt lgkmcnt(0)" ::: "memory");
    const int c = lane & 7;
#pragma unroll
    for (int j = 0; j < 4; ++j) { const int n = (lane >> 3) + 8 * j; const LAS float* s = scr + (8 * c) * 33 + n;
        u32x4 o; o.x = cvt_pk(s[0 * 33], s[1 * 33]); o.y = cvt_pk(s[2 * 33], s[3 * 33]); o.z = cvt_pk(s[4 * 33], s[5 * 33]); o.w = cvt_pk(s[6 * 33], s[7 * 33]);
        *(u32x4*)(WT + (size_t)(drow0 + n) * ldt + k0 + 8 * c) = o; }
    asm volatile("s_waitcnt lgkmcnt(0)" ::: "memory");
}
DI void convert_small(PR p, const Ctx& c, int l) {
    unsigned char* ws = p.ws;
    LAS float* scr = (LAS float*)(c.lds + c.wave * 8448);
    const int gw = c.bid * 8 + c.wave, NGW = c.G * 8;
    bf16_t* WIN = (bf16_t*)(ws + WS_WIN); bf16_t* WBH = (bf16_t*)(ws + WS_WBH); bf16_t* WBR = (bf16_t*)(ws + WS_WBR); bf16_t* WO = (bf16_t*)(ws + WS_WO);
    const float* w_in = p.in[I_WIN] + (size_t)l * D * IN_WIDTH;
    constexpr int I_IN = 32 * 361, I_B = 16 * 64, I_O = 32 * 64;
    for (int it = gw; it < I_IN + 2 * I_B + I_O; it += NGW) {
        int r = it;
        if (r < I_IN) { transpose_item(w_in, IN_WIDTH, 64 * (r / 361), 32 * (r % 361), WIN, D, 32 * (r % 361), scr, c.lane); continue; } r -= I_IN;
        if (r < I_B) { transpose_item(p.in[I_WBH] + (size_t)l * 1024 * D, D, 64 * (r / 64), 32 * (r % 64), WBH, 1024, 32 * (r % 64), scr, c.lane); continue; } r -= I_B;
        if (r < I_B) { transpose_item(p.in[I_WBR] + (size_t)l * 1024 * D, D, 64 * (r / 64), 32 * (r % 64), WBR, 1024, 32 * (r % 64), scr, c.lane); continue; } r -= I_B;
        transpose_item(p.in[I_WOUT] + (size_t)l * D * D, D, 64 * (r / 64), 32 * (r % 64), WO, D, 32 * (r % 64), scr, c.lane);
    }
    const int gt = c.bid * 512 + c.tid, NT = c.G * 512;
    bf16_t* WUPT = (bf16_t*)(ws + WS_LORA + LO_WUP); bf16_t* AUPT = (bf16_t*)(ws + WS_LORA + LO_AUP); bf16_t* GUPT = (bf16_t*)(ws + WS_LORA + LO_GUP); bf16_t* VUPT = (bf16_t*)(ws + WS_LORA + LO_VUP);
    float* WRT = (float*)(ws + WS_LORA + LO_WR);
    const float* wup = p.in[I_WUP] + (size_t)l * 64 * 1024; const float* aup = p.in[I_AUP] + (size_t)l * 64 * 1024; const float* gup = p.in[I_GUP] + (size_t)l * 160 * 1024;
    for (int i = gt; i < 1024 * 64; i += NT) { const int n = i >> 6, k = i & 63; WUPT[i] = (bf16_t)(cvt_pk(wup[k * 1024 + n], 0.f) & 0xffff); AUPT[i] = (bf16_t)(cvt_pk(aup[k * 1024 + n], 0.f) & 0xffff); }
    for (int i = gt; i < 1024 * 160; i += NT) { const int n = i / 160, k = i % 160; GUPT[i] = (bf16_t)(cvt_pk(gup[k * 1024 + n], 0.f) & 0xffff); }
    if (l == 1) { const float* vup = p.in[I_VUP]; for (int i = gt; i < 1024 * 32; i += NT) { const int n = i >> 5, k = i & 31; VUPT[i] = (bf16_t)(cvt_pk(vup[k * 1024 + n], 0.f) & 0xffff); } }
    const float* rgw = p.in[I_RGW] + (size_t)l * D * 4; const float* rew = p.in[I_REW] + (size_t)l * D * 32;
    for (int i = gt; i < 36 * 2048; i += NT) { const int cc = i >> 11, k = i & 2047; WRT[i] = cc < 4 ? rgw[k * 4 + cc] : rew[k * 32 + (cc - 4)]; }
    if (l == 1) {
        const float* mu = p.in[I_MU] + 3360 + 2048; const float* vd = p.in[I_VDOWN];
        for (int k = gw; k < D; k += NGW) {
            float wv[16], wm[16];
#pragma unroll
            for (int j = 0; j < 16; ++j) { const int cc = c.lane + 64 * j; const float w = w_in[(size_t)k * IN_WIDTH + 6144 + cc], m = mu[cc]; wv[j] = w * (1.f - m); wm[j] = w * m; }
            float ra = 0.f, rb = 0.f;
            for (int n = 0; n < 32; ++n) { float sa = 0.f, sb = 0.f;
#pragma unroll
                for (int j = 0; j < 16; ++j) { const float v = vd[(size_t)(c.lane + 64 * j) * 32 + n]; sa += wv[j] * v; sb += wm[j] * v; }
                sa = wave_sum(sa); sb = wave_sum(sb); if (c.lane == n) { ra = sa; rb = sb; } }
            if (c.lane < 32) { WIN[(size_t)(ZC_VDA + c.lane) * D + k] = (bf16_t)(cvt_pk(ra, 0.f) & 0xffff); WIN[(size_t)(ZC_VDB + c.lane) * D + k] = (bf16_t)(cvt_pk(rb, 0.f) & 0xffff); }
        }
    }
}
DI void convert_experts(PR p, const Ctx& c, int l) {
    unsigned char* ws = p.ws;
    LAS float* scr = (LAS float*)(c.lds + c.wave * 8448);
    const int gw = c.bid * 8 + c.wave, NGW = c.G * 8;
    bf16_t* WGU = (bf16_t*)(ws + WS_WGU); bf16_t* WDN = (bf16_t*)(ws + WS_WDN);
    const float* eg = p.in[I_EWG] + (size_t)l * NEXP * D * DEXP; const float* eu = p.in[I_EWU] + (size_t)l * NEXP * D * DEXP; const float* ed = p.in[I_EWD] + (size_t)l * NEXP * DEXP * D;
    constexpr int PER_GU = 32 * 16, PER_D = 8 * 64;
    const int total = NEXP * (2 * PER_GU + PER_D);
    for (int it = gw; it < total; it += NGW) {
        const int e = it / (2 * PER_GU + PER_D); int r = it % (2 * PER_GU + PER_D);
        if (r < 2 * PER_GU) { const int up = r >= PER_GU; if (up) r -= PER_GU; const int kb = r / 16, nb = r % 16, j0 = 32 * nb;
            transpose_item((up ? eu : eg) + (size_t)e * D * DEXP, DEXP, 64 * kb, j0, WGU + (size_t)e * 1024 * D, D, 256 * (j0 >> 7) + (j0 & 127) + (up ? 128 : 0), scr, c.lane); }
        else { r -= 2 * PER_GU; const int kb = r / 64, nb = r % 64;
            transpose_item(ed + (size_t)e * DEXP * D, D, 64 * kb, 32 * nb, WDN + (size_t)e * D * DEXP, DEXP, 32 * nb, scr, c.lane); }
    }
}
DI void rms_row_bf16(const float* xrow, const float* w, bf16_t* orow, int lane) {
    const f32x4* xr = (const f32x4*)xrow + lane; f32x4 v[8]; float s = 0.f;
#pragma unroll
    for (int j = 0; j < 8; ++j) { v[j] = xr[64 * j]; s += (v[j].x * v[j].x + v[j].y * v[j].y) + (v[j].z * v[j].z + v[j].w * v[j].w); }
    const float rstd = rsqrtf(wave_sum(s) * (1.f / D) + NORM_EPS);
    const f32x4* wr = (const f32x4*)w + lane; u32x2* o8 = (u32x2*)orow + lane;
#pragma unroll
    for (int j = 0; j < 8; ++j) { const f32x4 ww = wr[64 * j]; o8[64 * j] = pack4(v[j].x * rstd * ww.x, v[j].y * rstd * ww.y, v[j].z * rstd * ww.z, v[j].w * rstd * ww.w); }
}
constexpr int RL = 72;
constexpr int R_SLOT = 64 * RL * 2;
constexpr int R_EXTRA = 12 * R_SLOT;
constexpr int FL = 68;
#define RSLOT(i) ((LAS bf16_t*)(c.lds + (i) * R_SLOT))
DI void r1_task(PR p, const Ctx& c0, int l, int task) {
    Ctx c = c0; { int t_ = c0.tid; asm volatile("" : "+v"(t_)); c.tid = t_; c.lane = t_ & 63; unsigned lb_ = (unsigned)(uintptr_t)c0.lds; asm volatile("" : "+s"(lb_)); c.lds = (LAS unsigned char*)(uintptr_t)lb_; }
    unsigned char* ws = p.ws;
    const int bh = task >> 5, ch = task & 31, b = bh >> 4, h = bh & 15, tok0 = ch * 64, m0 = b * TSEQ + tok0;
    const int tid = c.tid, lane = c.lane, w = c.wave;
    const bf16_t* Z = (const bf16_t*)(ws + WS_Z);
    const int t = tid >> 3, cg = tid & 7, ch0 = 64 * h + 8 * cg;
    LAS float* LW = (LAS float*)(c.lds + R_EXTRA); LAS float* LA = LW + 64 * FL; LAS float* SEG = LA + 64 * FL;
    LAS float* LV = (LAS float*)(c.lds + 1 * R_SLOT);
    float r[8], k[8], v[8];
    {
        const bf16_t* zr = Z + (size_t)(m0 + t) * NZ; const bool has_prev = (tok0 + t) > 0; const bf16_t* zp = zr - NZ;
        const float* mu = p.in[I_MU] + (size_t)l * 3360;
        float cur[8], prv[8], wd[8], ad[8];
#define LERP_LOAD(dst, zcol, mucol) do { unpack8(*(const u32x4*)(zr + (zcol)), cur); if (has_prev) unpack8(*(const u32x4*)(zp + (zcol)), prv); else { _Pragma("unroll") for (int j = 0; j < 8; ++j) prv[j] = 0.f; } \
            const f32x4 mA = *(const f32x4*)(mu + (mucol)), mB = *(const f32x4*)(mu + (mucol) + 4); const float mm[8] = {mA.x, mA.y, mA.z, mA.w, mB.x, mB.y, mB.z, mB.w}; \
            _Pragma("unroll") for (int j = 0; j < 8; ++j) dst[j] = cur[j] + mm[j] * (prv[j] - cur[j]); } while (0)
        LERP_LOAD(r, ZC_R + ch0, ch0); LERP_LOAD(k, ZC_K + ch0, 1024 + ch0); LERP_LOAD(v, ZC_V + ch0, 2048 + ch0);
        LERP_LOAD(wd, ZC_WD + 8 * cg, 3072 + 8 * cg); LERP_LOAD(ad, ZC_AD + 8 * cg, 3136 + 8 * cg);
#pragma unroll
        for (int j = 0; j < 8; ++j) wd[j] = 1.0f - 2.0f / (1.0f + __expf(2.0f * wd[j]));
        *(LAS u32x4*)(RSLOT(7) + t * RL + 8 * cg) = pack8(wd);
        *(LAS u32x4*)(RSLOT(8) + t * RL + 8 * cg) = pack8(ad);
        const bf16_t* WUPT = (const bf16_t*)(ws + WS_LORA + LO_WUP) + (size_t)(64 * h) * 64; const bf16_t* AUPT = (const bf16_t*)(ws + WS_LORA + LO_AUP) + (size_t)(64 * h) * 64;
        *(LAS u32x4*)(RSLOT(9) + t * RL + 8 * cg) = *(const u32x4*)(WUPT + t * 64 + 8 * cg);
        *(LAS u32x4*)(RSLOT(10) + t * RL + 8 * cg) = *(const u32x4*)(AUPT + t * 64 + 8 * cg);
        if (l == 1) {
            if (cg < 4) { float a8[8], b8[8]; unpack8(*(const u32x4*)(zr + ZC_VDA + 8 * cg), a8); if (has_prev) unpack8(*(const u32x4*)(zp + ZC_VDB + 8 * cg), b8); else {
#pragma unroll
                    for (int j = 0; j < 8; ++j) b8[j] = 0.f; }
#pragma unroll
                for (int j = 0; j < 8; ++j) a8[j] += b8[j];
                *(LAS u32x4*)(RSLOT(11) + t * 40 + 8 * cg) = pack8(a8);
                const bf16_t* VUPT = (const bf16_t*)(ws + WS_LORA + LO_VUP) + (size_t)(64 * h) * 32;
                *(LAS u32x4*)(RSLOT(0) + t * 40 + 8 * cg) = *(const u32x4*)(VUPT + t * 32 + 8 * cg); }
        }
    }
    __syncthreads();
    const int pt = w >> 1, qb = 2 * (w & 1), fr = lane & 15, fq = lane >> 4;
    {
#pragma unroll
        for (int i = 0; i < 2; ++i) { const int qt = qb + i;
            const f32x4 aw = mm16<false, false, 2, RL, RL>(RSLOT(7), RSLOT(9), 16 * pt, 16 * qt, lane, F4Z);
            const f32x4 aa = mm16<false, false, 2, RL, RL>(RSLOT(8), RSLOT(10), 16 * pt, 16 * qt, lane, F4Z);
            *(LAS f32x4*)(LW + (16 * pt + fr) * FL + 16 * qt + 4 * fq) = aw; *(LAS f32x4*)(LA + (16 * pt + fr) * FL + 16 * qt + 4 * fq) = aa;
            if (l == 1) { const f32x4 av = mm16<false, false, 1, 40, 40>(RSLOT(11), RSLOT(0), 16 * pt, 16 * qt, lane, F4Z); *(LAS f32x4*)(LV + (16 * pt + fr) * FL + 16 * qt + 4 * fq) = av; }
        }
    }
    __syncthreads();
    float lw[8], a[8], kk[8], kp[8];
    {
        const f32x4 w0A = *(const f32x4*)(p.in[I_W0] + l * 1024 + ch0), w0B = *(const f32x4*)(p.in[I_W0] + l * 1024 + ch0 + 4);
        const f32x4 a0A = *(const f32x4*)(p.in[I_A0] + l * 1024 + ch0), a0B = *(const f32x4*)(p.in[I_A0] + l * 1024 + ch0 + 4);
        const f32x4 kkA = *(const f32x4*)(p.in[I_KK] + l * 1024 + ch0), kkB = *(const f32x4*)(p.in[I_KK] + l * 1024 + ch0 + 4);
        const f32x4 kaA = *(const f32x4*)(p.in[I_KA] + l * 1024 + ch0), kaB = *(const f32x4*)(p.in[I_KA] + l * 1024 + ch0 + 4);
        const f32x4 rkA = *(const f32x4*)(p.in[I_RK] + l * 1024 + ch0), rkB = *(const f32x4*)(p.in[I_RK] + l * 1024 + ch0 + 4);
        const float w0[8] = {w0A.x, w0A.y, w0A.z, w0A.w, w0B.x, w0B.y, w0B.z, w0B.w}, a0[8] = {a0A.x, a0A.y, a0A.z, a0A.w, a0B.x, a0B.y, a0B.z, a0B.w};
        const float k_k[8] = {kkA.x, kkA.y, kkA.z, kkA.w, kkB.x, kkB.y, kkB.z, kkB.w}, k_a[8] = {kaA.x, kaA.y, kaA.z, kaA.w, kaB.x, kaB.y, kaB.z, kaB.w};
        const float r_k[8] = {rkA.x, rkA.y, rkA.z, rkA.w, rkB.x, rkB.y, rkB.z, rkB.w};
        const f32x4 lwA = *(const LAS f32x4*)(LW + t * FL + 8 * cg), lwB = *(const LAS f32x4*)(LW + t * FL + 8 * cg + 4);
        const f32x4 laA = *(const LAS f32x4*)(LA + t * FL + 8 * cg), laB = *(const LAS f32x4*)(LA + t * FL + 8 * cg + 4);
        const float lwr[8] = {lwA.x, lwA.y, lwA.z, lwA.w, lwB.x, lwB.y, lwB.z, lwB.w}, lar[8] = {laA.x, laA.y, laA.z, laA.w, laB.x, laB.y, laB.z, laB.w};
        bf16_t* VFIRST = (bf16_t*)(ws + WS_VFIRST) + (size_t)(m0 + t) * 1024 + ch0;
        if (l == 1) {
            const f32x4 lvA = *(const LAS f32x4*)(LV + t * FL + 8 * cg), lvB = *(const LAS f32x4*)(LV + t * FL + 8 * cg + 4);
            const float lvr[8] = {lvA.x, lvA.y, lvA.z, lvA.w, lvB.x, lvB.y, lvB.z, lvB.w};
            const f32x4 v0A = *(const f32x4*)(p.in[I_V0] + ch0), v0B = *(const f32x4*)(p.in[I_V0] + ch0 + 4); const float v0[8] = {v0A.x, v0A.y, v0A.z, v0A.w, v0B.x, v0B.y, v0B.z, v0B.w};
            float vf[8]; unpack8(*(const u32x4*)VFIRST, vf);
#pragma unroll
            for (int j = 0; j < 8; ++j) v[j] = v[j] + (vf[j] - v[j]) * sigm(v0[j] + lvr[j]);
            *(u32x4*)((bf16_t*)(ws + WS_VF) + (size_t)(m0 + t) * 1024 + ch0) = pack8(v);
        } else { *(u32x4*)VFIRST = pack8(v); }
        float ss = 0.f, rks = 0.f;
#pragma unroll
        for (int j = 0; j < 8; ++j) { lw[j] = -0.60653066f * sigm(w0[j] + lwr[j]); a[j] = sigm(a0[j] + lar[j]); kk[j] = k[j] * k_k[j]; ss += kk[j] * kk[j];
            kp[j] = k[j] * (1.0f + (a[j] - 1.0f) * k_a[j]); rks += r[j] * kp[j] * r_k[j]; }
        ss += __shfl_xor(ss, 1); ss += __shfl_xor(ss, 2); ss += __shfl_xor(ss, 4);
        rks += __shfl_xor(rks, 1); rks += __shfl_xor(rks, 2); rks += __shfl_xor(rks, 4);
        const float inv = rsqrtf(fmaxf(ss, 1e-12f));
#pragma unroll
        for (int j = 0; j < 8; ++j) kk[j] *= inv;
        if (cg == 0) ((float*)(ws + WS_RK))[(size_t)(m0 + t) * 16 + h] = rks;
    }
    __syncthreads();
    *(LAS f32x4*)(LW + t * FL + 8 * cg) = (f32x4){lw[0], lw[1], lw[2], lw[3]}; *(LAS f32x4*)(LW + t * FL + 8 * cg + 4) = (f32x4){lw[4], lw[5], lw[6], lw[7]};
    __syncthreads();
    {
        const int j = tid & 63, sg = tid >> 6; float s = 0.f;
#pragma unroll
        for (int i = 0; i < 8; ++i) s += LW[(8 * sg + i) * FL + j];
        SEG[sg * 64 + j] = s;
        __syncthreads();
        float off = 0.f;
        for (int s2 = 0; s2 < sg; ++s2) off += SEG[s2 * 64 + j];
#pragma unroll
        for (int i = 0; i < 8; ++i) { off += LW[(8 * sg + i) * FL + j]; LW[(8 * sg + i) * FL + j] = off; }
    }
    __syncthreads();
    {
        const f32x4 cA = *(const LAS f32x4*)(LW + t * FL + 8 * cg), cB = *(const LAS f32x4*)(LW + t * FL + 8 * cg + 4);
        const f32x4 eA = *(const LAS f32x4*)(LW + 63 * FL + 8 * cg), eB = *(const LAS f32x4*)(LW + 63 * FL + 8 * cg + 4);
        const float cs[8] = {cA.x, cA.y, cA.z, cA.w, cB.x, cB.y, cB.z, cB.w}, ce[8] = {eA.x, eA.y, eA.z, eA.w, eB.x, eB.y, eB.z, eB.w};
        float Rt[8], At[8], Bt[8], Kt[8], Bp[8], Kp[8];
#pragma unroll
        for (int j = 0; j < 8; ++j) { const float ep = __expf(cs[j]), em = __expf(-cs[j]), el = __expf(ce[j] - cs[j]), ex = __expf(cs[j] - lw[j]); const float bv = kk[j] * a[j];
            Rt[j] = r[j] * ep; At[j] = -kk[j] * ex; Bt[j] = bv * em; Kt[j] = kp[j] * em; Bp[j] = bv * el; Kp[j] = kp[j] * el; }
        *(LAS u32x4*)(RSLOT(0) + t * RL + 8 * cg) = pack8(Rt); *(LAS u32x4*)(RSLOT(1) + t * RL + 8 * cg) = pack8(At); *(LAS u32x4*)(RSLOT(2) + t * RL + 8 * cg) = pack8(Bt);
        *(LAS u32x4*)(RSLOT(3) + t * RL + 8 * cg) = pack8(Kt); *(LAS u32x4*)(RSLOT(4) + t * RL + 8 * cg) = pack8(Bp); *(LAS u32x4*)(RSLOT(5) + t * RL + 8 * cg) = pack8(Kp);
        *(LAS u32x4*)(RSLOT(6) + t * RL + 8 * cg) = pack8(v);
    }
    __syncthreads();
    const int p0 = 16 * pt, prow = p0 + fr;
    {
#pragma unroll
        for (int i = 0; i < 2; ++i) { const int q0 = 16 * (qb + i), qc = q0 + 4 * fq;
            f32x4 ab = mm16<false, false, 2, RL, RL>(RSLOT(1), RSLOT(2), p0, q0, lane, F4Z);
            f32x4 ak = mm16<false, false, 2, RL, RL>(RSLOT(1), RSLOT(3), p0, q0, lane, F4Z);
            f32x4 rb = mm16<false, false, 2, RL, RL>(RSLOT(0), RSLOT(2), p0, q0, lane, F4Z);
            f32x4 rk = mm16<false, false, 2, RL, RL>(RSLOT(0), RSLOT(3), p0, q0, lane, F4Z);
#pragma unroll
            for (int rr = 0; rr < 4; ++rr) { const int s = qc + rr; if (s >= prow) { ab[rr] = 0.f; ak[rr] = 0.f; } if (s > prow) { rb[rr] = 0.f; rk[rr] = 0.f; } }
            st4_bf16(RSLOT(7) + prow * RL + qc, ab); st4_bf16(RSLOT(9) + prow * RL + qc, ak); st4_bf16(RSLOT(10) + prow * RL + qc, rb); st4_bf16(RSLOT(11) + prow * RL + qc, rk); }
    }
    __syncthreads();
    {
#pragma unroll
        for (int i = 0; i < 2; ++i) { const int q0 = 16 * (qb + i), qc = q0 + 4 * fq;
            const f32x4 l2 = mm16<false, true, 2, RL, RL>(RSLOT(7), RSLOT(7), p0, q0, lane, F4Z);
            f32x4 t1 = ld4_bf16(RSLOT(7) + prow * RL + qc);
#pragma unroll
            for (int rr = 0; rr < 4; ++rr) if (qc + rr == prow) t1[rr] += 1.0f;
            st4_bf16(RSLOT(8) + prow * RL + qc, l2); st4_bf16(RSLOT(2) + prow * RL + qc, t1); }
    }
    __syncthreads();
#define NSTEP(LS, LD_, TS, TD, SQ) do { _Pragma("unroll") for (int i = 0; i < 2; ++i) { const int q0 = 16 * (qb + i), qc = q0 + 4 * fq; \
        const f32x4 tn = mm16<false, true, 2, RL, RL>(RSLOT(TS), RSLOT(LS), p0, q0, lane, ld4_bf16(RSLOT(TS) + prow * RL + qc)); \
        if (SQ) { const f32x4 l2 = mm16<false, true, 2, RL, RL>(RSLOT(LS), RSLOT(LS), p0, q0, lane, F4Z); st4_bf16(RSLOT(LD_) + prow * RL + qc, l2); } \
        st4_bf16(RSLOT(TD) + prow * RL + qc, tn); } __syncthreads(); } while (0)
    NSTEP(8, 7, 2, 3, 1);
    NSTEP(7, 8, 3, 2, 1);
    NSTEP(8, 7, 2, 3, 1);
    NSTEP(7, 8, 3, 2, 1);
    NSTEP(8, 7, 2, 3, 0);
#undef NSTEP
    {
#pragma unroll
        for (int i = 0; i < 2; ++i) { const int q0 = 16 * (qb + i), qc = q0 + 4 * fq;
            const f32x4 pp = mm16<false, true, 2, RL, RL>(RSLOT(3), RSLOT(1), p0, q0, lane, F4Z);
            const f32x4 gg = mm16<false, true, 2, RL, RL>(RSLOT(9), RSLOT(6), p0, q0, lane, F4Z);
            st4_bf16(RSLOT(7) + prow * RL + qc, pp); st4_bf16(RSLOT(8) + prow * RL + qc, gg); }
    }
    __syncthreads();
    {
#pragma unroll
        for (int i = 0; i < 2; ++i) { const int q0 = 16 * (qb + i), qc = q0 + 4 * fq;
            const f32x4 qq = mm16<false, true, 2, RL, RL>(RSLOT(3), RSLOT(8), p0, q0, lane, F4Z);
            st4_bf16(RSLOT(9) + prow * RL + qc, qq); }
    }
    __syncthreads();
    {
        const size_t blk = (size_t)task * 4096;
        bf16_t* RP = (bf16_t*)(ws + WS_RP) + blk; bf16_t* Y0 = (bf16_t*)(ws + WS_Y0) + blk; bf16_t* MT = (bf16_t*)(ws + WS_MT) + blk; bf16_t* NN = (bf16_t*)(ws + WS_NN) + blk;
#pragma unroll
        for (int i = 0; i < 2; ++i) { const int q0 = 16 * (qb + i), qc = q0 + 4 * fq;
            const f32x4 rp = mm16<false, true, 2, RL, RL>(RSLOT(10), RSLOT(7), p0, q0, lane, ld4_bf16(RSLOT(0) + prow * RL + qc));
            f32x4 y0 = mm16<false, true, 2, RL, RL>(RSLOT(10), RSLOT(9), p0, q0, lane, F4Z); y0 = mm16<false, true, 2, RL, RL>(RSLOT(11), RSLOT(6), p0, q0, lane, y0);
            f32x4 mt = mm16<true, true, 2, RL, RL>(RSLOT(4), RSLOT(7), p0, q0, lane, F4Z);
#pragma unroll
            for (int rr = 0; rr < 4; ++rr) if (qc + rr == prow) mt[rr] += __expf(LW[63 * FL + prow]);
            f32x4 nn = mm16<true, true, 2, RL, RL>(RSLOT(9), RSLOT(4), p0, q0, lane, F4Z); nn = mm16<true, true, 2, RL, RL>(RSLOT(6), RSLOT(5), p0, q0, lane, nn);
            *(u32x2*)(RP + prow * 64 + qc) = pack4(rp[0], rp[1], rp[2], rp[3]); *(u32x2*)(Y0 + prow * 64 + qc) = pack4(y0[0], y0[1], y0[2], y0[3]);
            *(u32x2*)(MT + prow * 64 + qc) = pack4(mt[0], mt[1], mt[2], mt[3]); *(u32x2*)(NN + prow * 64 + qc) = pack4(nn[0], nn[1], nn[2], nn[3]); }
    }
    __syncthreads();
}
constexpr int HL = 136, HCL = 132, SCL = 40;
constexpr int H_QH = 0, H_KT = 32 * HL * 2, H_KP = 2 * H_KT, H_V = 3 * H_KT, H_CS = 4 * H_KT  , H_SEG = H_CS + 32 * HCL * 4  , H_SC = H_SEG + 4 * 128 * 4  ,
              H_NTS = H_SC + 32 * SCL * 2  ;
DI float hg_lb(PR p, int l, int chn) { if (l == 0) return 0.f; const float* raw = p.in[I_LBRAW]; return sigm(raw[1024 + chn] - raw[chn]); }
DI void h1_task(PR p, const Ctx& c0, int l, int task) {
    Ctx c = c0; { int t_ = c0.tid; asm volatile("" : "+v"(t_)); c.tid = t_; c.lane = t_ & 63; unsigned lb_ = (unsigned)(uintptr_t)c0.lds; asm volatile("" : "+s"(lb_)); c.lds = (LAS unsigned char*)(uintptr_t)lb_; }
    unsigned char* ws = p.ws;
    const int bh = task >> 6, ch = task & 63, b = bh >> 3, h = bh & 7, m0 = b * TSEQ + ch * 32;
    const int tid = c.tid, lane = c.lane, w = c.wave, fr = lane & 15, fq = lane >> 4;
    const bf16_t* Z = (const bf16_t*)(ws + WS_Z);
    LAS bf16_t* QHs = (LAS bf16_t*)(c.lds + H_QH); LAS bf16_t* KTs = (LAS bf16_t*)(c.lds + H_KT); LAS bf16_t* KPs = (LAS bf16_t*)(c.lds + H_KP); LAS bf16_t* Vs = (LAS bf16_t*)(c.lds + H_V);
    LAS float* CS = (LAS float*)(c.lds + H_CS); LAS float* SEG = (LAS float*)(c.lds + H_SEG); LAS bf16_t* SC = (LAS bf16_t*)(c.lds + H_SC); LAS bf16_t* NTS = (LAS bf16_t*)(c.lds + H_NTS);
    const int t = tid >> 4, cg = tid & 15, chn = 128 * h + 8 * cg;
    float q[8], kf[8];
    u32x4 vraw;
    {
        const bf16_t* zr = Z + (size_t)(m0 + t) * NZ;
        float zq[8], zf[8]; unpack8(*(const u32x4*)(zr + ZC_Q + chn), zq); unpack8(*(const u32x4*)(zr + ZC_F + chn), zf); vraw = *(const u32x4*)(zr + ZC_I + chn);
        float g[8];
#pragma unroll
        for (int j = 0; j < 8; ++j) { const float lb = hg_lb(p, l, chn + j); const float f = lb + (1.0f - lb) * sigm(zf[j]); q[j] = zq[j] * sigm(zq[j]); kf[j] = 1.0f - f; g[j] = __logf(f); }
        *(LAS f32x4*)(CS + t * HCL + 8 * cg) = (f32x4){g[0], g[1], g[2], g[3]}; *(LAS f32x4*)(CS + t * HCL + 8 * cg + 4) = (f32x4){g[4], g[5], g[6], g[7]};
    }
    __syncthreads();
    {   const int j = tid & 127, sg = tid >> 7; float s = 0.f;
#pragma unroll
        for (int i = 0; i < 8; ++i) s += CS[(8 * sg + i) * HCL + j];
        SEG[sg * 128 + j] = s;
        __syncthreads();
        float off = 0.f;
        for (int s2 = 0; s2 < sg; ++s2) off += SEG[s2 * 128 + j];
#pragma unroll
        for (int i = 0; i < 8; ++i) { off += CS[(8 * sg + i) * HCL + j]; CS[(8 * sg + i) * HCL + j] = off; }
    }
    __syncthreads();
    {
        const f32x4 cA = *(const LAS f32x4*)(CS + t * HCL + 8 * cg), cB = *(const LAS f32x4*)(CS + t * HCL + 8 * cg + 4);
        const f32x4 eA = *(const LAS f32x4*)(CS + 31 * HCL + 8 * cg), eB = *(const LAS f32x4*)(CS + 31 * HCL + 8 * cg + 4);
        const float cs[8] = {cA.x, cA.y, cA.z, cA.w, cB.x, cB.y, cB.z, cB.w}, ce[8] = {eA.x, eA.y, eA.z, eA.w, eB.x, eB.y, eB.z, eB.w};
        float qh[8], kt[8], kp[8];
#pragma unroll
        for (int j = 0; j < 8; ++j) { qh[j] = q[j] * __expf(cs[j]); kt[j] = kf[j] * __expf(-cs[j]); kp[j] = kf[j] * __expf(ce[j] - cs[j]); }
        const u32x4 qp = pack8(qh);
        *(LAS u32x4*)(QHs + t * HL + 8 * cg) = qp; *(LAS u32x4*)(KTs + t * HL + 8 * cg) = pack8(kt); *(LAS u32x4*)(KPs + t * HL + 8 * cg) = pack8(kp); *(LAS u32x4*)(Vs + t * HL + 8 * cg) = vraw;
        *(u32x4*)((bf16_t*)(ws + WS_QH) + (size_t)(m0 + t) * 1024 + chn) = qp;
        if (t == 31) { float* DC = (float*)(ws + WS_DC) + (size_t)task * 128 + 8 * cg; *(f32x4*)DC = (f32x4){__expf(ce[0]), __expf(ce[1]), __expf(ce[2]), __expf(ce[3])}; *(f32x4*)(DC + 4) = (f32x4){__expf(ce[4]), __expf(ce[5]), __expf(ce[6]), __expf(ce[7])}; }
    }
    __syncthreads();
    {
        if (w < 4) { const int p0 = 16 * (w >> 1), q0 = 16 * (w & 1), prow = p0 + fr, qc = q0 + 4 * fq;
            f32x4 sc = mm16<false, false, 4, HL, HL>(QHs, KTs, p0, q0, lane, F4Z);
#pragma unroll
            for (int rr = 0; rr < 4; ++rr) if (qc + rr > prow) sc[rr] = 0.f;
            st4_bf16(SC + prow * SCL + qc, sc); }
        const bf16x8 xb = frag_t<HL>(Vs, 16 * w, 0, lane);
#pragma unroll
        for (int dn = 0; dn < 8; ++dn) { const bf16x8 ya = frag_t<HL>(KPs, 16 * dn, 0, lane);
            const f32x4 nt = MFMA16(ya, xb, F4Z);
            st4_bf16(NTS + (16 * w + fr) * HL + 16 * dn + 4 * fq, nt); }
    }
    __syncthreads();
    {
        bf16_t* OI = (bf16_t*)(ws + WS_OI);
        const bf16x8 ya = frag_t<HL>(Vs, 16 * w, 0, lane);
#pragma unroll
        for (int pt = 0; pt < 2; ++pt) { const bf16x8 xb = frag_n<SCL>(SC, 16 * pt, 0, lane);
            const f32x4 o = MFMA16(ya, xb, F4Z);
            *(u32x2*)(OI + (size_t)(m0 + 16 * pt + fr) * 1024 + 128 * h + 16 * w + 4 * fq) = pack4(o[0], o[1], o[2], o[3]); }
        bf16_t* NT = (bf16_t*)(ws + WS_NT) + (size_t)task * 16384;
        const int row = tid >> 2, cq = tid & 3;
#pragma unroll
        for (int i = 0; i < 4; ++i) *(u32x4*)(NT + row * 128 + 32 * cq + 8 * i) = *(const LAS u32x4*)(NTS + row * HL + 32 * cq + 8 * i);
    }
    __syncthreads();
}
DI void h23_task(PR p, const Ctx& c, int l, int bh) {
    unsigned char* ws = p.ws;
    const int b = bh >> 3, h = bh & 7, lane = c.lane, w = c.wave, fr = lane & 15, fq = lane >> 4;
    const bf16_t* Z = (const bf16_t*)(ws + WS_Z); const bf16_t* QH = (const bf16_t*)(ws + WS_QH); const bf16_t* OI = (const bf16_t*)(ws + WS_OI);
    const bf16_t* NT = (const bf16_t*)(ws + WS_NT) + (size_t)bh * 64 * 16384; const float* DC = (const float*)(ws + WS_DC) + (size_t)bh * 64 * 128;
    bf16_t* YHG = (bf16_t*)(ws + WS_YHG);
    LAS float* RS = (LAS float*)c.lds;
    float S[4][8];
#pragma unroll
    for (int ks = 0; ks < 4; ++ks)
#pragma unroll
        for (int j = 0; j < 8; ++j) S[ks][j] = 0.f;
    const int ecol = 128 * h + 16 * w + 4 * fq;
    const f32x4 onw = *(const f32x4*)(p.in[I_ONORM] + l * 128 + 16 * w + 4 * fq);
    for (int ch = 0; ch < 64; ++ch) {
        const int m0 = b * TSEQ + ch * 32;
        bf16x8 qf[2][4]; u32x2 oi[2], zo[2]; bf16x8 nt[4]; f32x4 dc[4][2];
#pragma unroll
        for (int tt = 0; tt < 2; ++tt) {
#pragma unroll
            for (int ks = 0; ks < 4; ++ks) qf[tt][ks] = *(const bf16x8*)(QH + (size_t)(m0 + 16 * tt + fr) * 1024 + 128 * h + 32 * ks + 8 * fq);
            oi[tt] = *(const u32x2*)(OI + (size_t)(m0 + 16 * tt + fr) * 1024 + ecol);
            zo[tt] = *(const u32x2*)(Z + (size_t)(m0 + 16 * tt + fr) * NZ + ZC_O + ecol); }
#pragma unroll
        for (int ks = 0; ks < 4; ++ks) { nt[ks] = *(const bf16x8*)(NT + (size_t)ch * 16384 + (16 * w + fr) * 128 + 32 * ks + 8 * fq);
            dc[ks][0] = *(const f32x4*)(DC + ch * 128 + 32 * ks + 8 * fq); dc[ks][1] = *(const f32x4*)(DC + ch * 128 + 32 * ks + 8 * fq + 4); }
        f32x4 o[2] = {F4Z, F4Z};
#pragma unroll
        for (int ks = 0; ks < 4; ++ks) { u32x4 sp; sp.x = cvt_pk(S[ks][0], S[ks][1]); sp.y = cvt_pk(S[ks][2], S[ks][3]); sp.z = cvt_pk(S[ks][4], S[ks][5]); sp.w = cvt_pk(S[ks][6], S[ks][7]);
            const bf16x8 sa = __builtin_bit_cast(bf16x8, sp);
            o[0] = MFMA16(sa, qf[0][ks], o[0]); o[1] = MFMA16(sa, qf[1][ks], o[1]); }
        float ssq[2];
#pragma unroll
        for (int tt = 0; tt < 2; ++tt) { float f[4]; unpack4(oi[tt], f); o[tt][0] += f[0]; o[tt][1] += f[1]; o[tt][2] += f[2]; o[tt][3] += f[3];
            float s = (o[tt][0] * o[tt][0] + o[tt][1] * o[tt][1]) + (o[tt][2] * o[tt][2] + o[tt][3] * o[tt][3]); s += __shfl_xor(s, 16); s += __shfl_xor(s, 32); ssq[tt] = s; }
        LAS float* rs = RS + (ch & 1) * 256;
        if (fq == 0) { rs[w * 32 + fr] = ssq[0]; rs[w * 32 + 16 + fr] = ssq[1]; }
        __syncthreads();
#pragma unroll
        for (int tt = 0; tt < 2; ++tt) { float tot = 0.f;
#pragma unroll
            for (int ww = 0; ww < 8; ++ww) tot += rs[ww * 32 + 16 * tt + fr];
            const float rstd = rsqrtf(tot * (1.0f / 128.0f) + NORM_EPS); float g[4]; unpack4(zo[tt], g);
            *(u32x2*)(YHG + (size_t)(m0 + 16 * tt + fr) * 1024 + ecol) = pack4(o[tt][0] * rstd * onw.x * sigm(g[0]), o[tt][1] * rstd * onw.y * sigm(g[1]), o[tt][2] * rstd * onw.z * sigm(g[2]), o[tt][3] * rstd * onw.w * sigm(g[3])); }
#pragma unroll
        for (int ks = 0; ks < 4; ++ks) { float nf[8]; unpack8(__builtin_bit_cast(u32x4, nt[ks]), nf);
            S[ks][0] = S[ks][0] * dc[ks][0].x + nf[0]; S[ks][1] = S[ks][1] * dc[ks][0].y + nf[1]; S[ks][2] = S[ks][2] * dc[ks][0].z + nf[2]; S[ks][3] = S[ks][3] * dc[ks][0].w + nf[3];
            S[ks][4] = S[ks][4] * dc[ks][1].x + nf[4]; S[ks][5] = S[ks][5] * dc[ks][1].y + nf[5]; S[ks][6] = S[ks][6] * dc[ks][1].z + nf[6]; S[ks][7] = S[ks][7] * dc[ks][1].w + nf[7]; }
    }
    __syncthreads();
}
DI void r2_task(PR p, const Ctx& c, int item) {
    unsigned char* ws = p.ws;
    const int lane = c.lane, w = c.wave, fr = lane & 15, fq = lane >> 4, bh = 2 * item + (w >> 2), et = w & 3;
    const bf16_t* MT = (const bf16_t*)(ws + WS_MT) + (size_t)bh * 32 * 4096; const bf16_t* NN = (const bf16_t*)(ws + WS_NN) + (size_t)bh * 32 * 4096;
    bf16_t* SS = (bf16_t*)(ws + WS_SS) + (size_t)bh * 32 * 4096;
    f32x4 S[4] = {F4Z, F4Z, F4Z, F4Z};
    for (int ch = 0; ch < 32; ++ch) {
        const bf16_t* mt = MT + (size_t)ch * 4096; const bf16_t* nn = NN + (size_t)ch * 4096; bf16_t* ss = SS + (size_t)ch * 4096;
        u32x2 ma[4][2][2]; u32x2 nv[4];
#pragma unroll
        for (int n = 0; n < 4; ++n) {
#pragma unroll
            for (int ks = 0; ks < 2; ++ks) { ma[n][ks][0] = *(const u32x2*)(mt + (16 * n + fr) * 64 + 32 * ks + 4 * fq); ma[n][ks][1] = *(const u32x2*)(mt + (16 * n + fr) * 64 + 32 * ks + 16 + 4 * fq); }
            nv[n] = *(const u32x2*)(nn + (16 * et + fr) * 64 + 16 * n + 4 * fq); }
#pragma unroll
        for (int n = 0; n < 4; ++n) *(u32x2*)(ss + (16 * et + fr) * 64 + 16 * n + 4 * fq) = pack4(S[n][0], S[n][1], S[n][2], S[n][3]);
        bf16x8 sb[2];
#pragma unroll
        for (int ks = 0; ks < 2; ++ks) { u32x4 sp; sp.x = cvt_pk(S[2 * ks][0], S[2 * ks][1]); sp.y = cvt_pk(S[2 * ks][2], S[2 * ks][3]); sp.z = cvt_pk(S[2 * ks + 1][0], S[2 * ks + 1][1]); sp.w = cvt_pk(S[2 * ks + 1][2], S[2 * ks + 1][3]);
            sb[ks] = __builtin_bit_cast(bf16x8, sp); }
#pragma unroll
        for (int n = 0; n < 4; ++n) { float f[4]; unpack4(nv[n], f); f32x4 acc = {f[0], f[1], f[2], f[3]};
#pragma unroll
            for (int ks = 0; ks < 2; ++ks) { u32x4 mp; mp.x = ma[n][ks][0].x; mp.y = ma[n][ks][0].y; mp.z = ma[n][ks][1].x; mp.w = ma[n][ks][1].y;
                acc = MFMA16(__builtin_bit_cast(bf16x8, mp), sb[ks], acc); }
            S[n] = acc; }
    }
}
constexpr int GL = 168;
DI void r3_task(PR p, const Ctx& c0, int l, int task) {
    Ctx c = c0; { int t_ = c0.tid; asm volatile("" : "+v"(t_)); c.tid = t_; c.lane = t_ & 63; unsigned lb_ = (unsigned)(uintptr_t)c0.lds; asm volatile("" : "+s"(lb_)); c.lds = (LAS unsigned char*)(uintptr_t)lb_; }
    unsigned char* ws = p.ws;
    const int bh = task >> 5, ch = task & 31, b = bh >> 4, h = bh & 15, tok0 = ch * 64, m0 = b * TSEQ + tok0;
    const int tid = c.tid, lane = c.lane, w = c.wave, fr = lane & 15, fq = lane >> 4;
    const bf16_t* Z = (const bf16_t*)(ws + WS_Z);
    LAS bf16_t* SG = (LAS bf16_t*)c.lds; LAS float* GX = (LAS float*)(c.lds + 64 * GL * 2);
    {   const float* mu = p.in[I_MU] + (size_t)l * 3360 + 3200;
        for (int it = tid; it < 64 * 20; it += 512) { const int t = it / 20, cq = it % 20; const bf16_t* zr = Z + (size_t)(m0 + t) * NZ + ZC_GD + 8 * cq;
            float cur[8], prv[8]; unpack8(*(const u32x4*)zr, cur);
            if (tok0 + t > 0) unpack8(*(const u32x4*)(zr - NZ), prv); else {
#pragma unroll
                for (int j = 0; j < 8; ++j) prv[j] = 0.f; }
#pragma unroll
            for (int j = 0; j < 8; ++j) cur[j] = sigm(cur[j] + mu[8 * cq + j] * (prv[j] - cur[j]));
            *(LAS u32x4*)(SG + t * GL + 8 * cq) = pack8(cur); }
    }
    __syncthreads();
    const size_t blk = (size_t)task * 4096;
    const bf16_t* SS = (const bf16_t*)(ws + WS_SS) + blk; const bf16_t* RP = (const bf16_t*)(ws + WS_RP) + blk; const bf16_t* Y0 = (const bf16_t*)(ws + WS_Y0) + blk;
    const bf16_t* GUPT = (const bf16_t*)(ws + WS_LORA + LO_GUP) + (size_t)(64 * h) * 160;
    const int pt = w >> 1, trow = 16 * pt + fr;
    f32x4 y[2], g[2]; float s1 = 0.f, s2 = 0.f;
#pragma unroll
    for (int i = 0; i < 2; ++i) { const int qt = 2 * (w & 1) + i, ec = 16 * qt + 4 * fq;
        float f[4]; unpack4(*(const u32x2*)(Y0 + trow * 64 + ec), f); f32x4 acc = {f[0], f[1], f[2], f[3]};
#pragma unroll
        for (int ks = 0; ks < 2; ++ks) acc = MFMA16(gfrag(SS, 64, 16 * qt, 32 * ks, lane), gfrag(RP, 64, 16 * pt, 32 * ks, lane), acc);
        y[i] = acc; s1 += (acc[0] + acc[1]) + (acc[2] + acc[3]); s2 += (acc[0] * acc[0] + acc[1] * acc[1]) + (acc[2] * acc[2] + acc[3] * acc[3]);
        f32x4 ga = F4Z;
#pragma unroll
        for (int ks = 0; ks < 5; ++ks) ga = MFMA16(gfrag(GUPT, 160, 16 * qt, 32 * ks, lane), frag_n<GL>(SG, 16 * pt, 32 * ks, lane), ga);
        g[i] = ga; }
    s1 += __shfl_xor(s1, 16); s1 += __shfl_xor(s1, 32); s2 += __shfl_xor(s2, 16); s2 += __shfl_xor(s2, 32);
    if (fq == 0) { GX[(w * 16 + fr) * 2] = s1; GX[(w * 16 + fr) * 2 + 1] = s2; }
    __syncthreads();
    {   const float t1 = GX[(w * 16 + fr) * 2] + GX[((w ^ 1) * 16 + fr) * 2], t2 = GX[(w * 16 + fr) * 2 + 1] + GX[((w ^ 1) * 16 + fr) * 2 + 1];
        const float mean = t1 * (1.0f / 64.0f), var = fmaxf(t2 * (1.0f / 64.0f) - mean * mean, 0.f), rstd = rsqrtf(var + RW_GN_EPS);
        const size_t m = (size_t)(m0 + trow);
        const float rk = ((const float*)(ws + WS_RK))[m * 16 + h];
        const bf16_t* vsrc = (const bf16_t*)(ws + (l == 0 ? WS_VFIRST : WS_VF));
        bf16_t* YRW = (bf16_t*)(ws + WS_YRW);
#pragma unroll
        for (int i = 0; i < 2; ++i) { const int qt = 2 * (w & 1) + i, col = 64 * h + 16 * qt + 4 * fq;
            const f32x4 lnw = *(const f32x4*)(p.in[I_LNW] + l * 1024 + col), lnb = *(const f32x4*)(p.in[I_LNB] + l * 1024 + col);
            float vv[4]; unpack4(*(const u32x2*)(vsrc + m * 1024 + col), vv);
            float o[4];
#pragma unroll
            for (int r = 0; r < 4; ++r) o[r] = ((y[i][r] - mean) * rstd * lnw[r] + lnb[r] + rk * vv[r]) * g[i][r];
            *(u32x2*)(YRW + m * 1024 + col) = pack4(o[0], o[1], o[2], o[3]); }
    }
    __syncthreads();
}
DI void p7_route(PR p, const Ctx& c, int l) {
    unsigned char* ws = p.ws;
    const int lane = c.lane, w = c.wave;
    const float* H = p.out; bf16_t* HN = (bf16_t*)(ws + WS_XN);
    const float* nw = p.in[I_NFFN] + (size_t)l * D; const float* WRT = (const float*)(ws + WS_LORA + LO_WR);
    const float* bg = p.in[I_RGB] + l * 4; const float* be = p.in[I_REB] + l * 32;
    int* TOKE = (int*)(ws + WS_TOKE); float* TOKW = (float*)(ws + WS_TOKW); int* CNT = (int*)(ws + WS_CNT);
    LAS int* hist = (LAS int*)(c.lds + 70000);
    for (int tile = c.bid; tile < M / 64; tile += c.G) {
        if (c.tid < 32) hist[c.tid] = 0;
        __syncthreads();
        for (int half = 0; half < 4; ++half) {
            const int mb = tile * 64 + w * 8 + half * 2;
            f32x4 v[2][8]; float rstd[2];
#pragma unroll
            for (int tk = 0; tk < 2; ++tk) { const f32x4* xr = (const f32x4*)(H + (size_t)(mb + tk) * D) + lane; float s = 0.f;
#pragma unroll
                for (int j = 0; j < 8; ++j) { v[tk][j] = xr[64 * j]; s += (v[tk][j].x * v[tk][j].x + v[tk][j].y * v[tk][j].y) + (v[tk][j].z * v[tk][j].z + v[tk][j].w * v[tk][j].w); }
                rstd[tk] = rsqrtf(wave_sum(s) * (1.f / D) + NORM_EPS); }
#pragma unroll
            for (int j = 0; j < 8; ++j) { const f32x4 ww = ((const f32x4*)nw)[lane + 64 * j];
#pragma unroll
                for (int tk = 0; tk < 2; ++tk) { v[tk][j] = v[tk][j] * rstd[tk] * ww; ((u32x2*)(HN + (size_t)(mb + tk) * D))[lane + 64 * j] = pack4(v[tk][j].x, v[tk][j].y, v[tk][j].z, v[tk][j].w); } }
            float mylog[2] = {0.f, 0.f};
            for (int cc = 0; cc < 36; ++cc) { const f32x4* wc = (const f32x4*)(WRT + (size_t)cc * D) + lane; float part[2] = {0.f, 0.f};
#pragma unroll
                for (int j = 0; j < 8; ++j) { const f32x4 ww = wc[64 * j];
#pragma unroll
                    for (int tk = 0; tk < 2; ++tk) part[tk] += (v[tk][j].x * ww.x + v[tk][j].y * ww.y) + (v[tk][j].z * ww.z + v[tk][j].w * ww.w); }
#pragma unroll
                for (int tk = 0; tk < 2; ++tk) { const float s = wave_sum(part[tk]); if (lane == cc) mylog[tk] = s; } }
#pragma unroll
            for (int tk = 0; tk < 2; ++tk) {
                float gl[4]; int gs = 0;
#pragma unroll
                for (int i = 0; i < 4; ++i) gl[i] = __shfl(mylog[tk], i) + bg[i];
#pragma unroll
                for (int i = 1; i < 4; ++i) if (gl[i] > gl[gs]) gs = i;
                float den = 0.f;
#pragma unroll
                for (int i = 0; i < 4; ++i) den += __expf(gl[i] - gl[gs]);
                const float pg = 1.0f / den;
                float el[8]; int i1 = 0, i2 = -1;
#pragma unroll
                for (int i = 0; i < 8; ++i) el[i] = __shfl(mylog[tk], 4 + 8 * gs + i) + be[8 * gs + i];
#pragma unroll
                for (int i = 1; i < 8; ++i) if (el[i] > el[i1]) i1 = i;
#pragma unroll
                for (int i = 0; i < 8; ++i) if (i != i1 && (i2 < 0 || el[i] > el[i2])) i2 = i;
                const float e2 = __expf(el[i2] - el[i1]), w1 = pg / (1.0f + e2), w2 = pg * e2 / (1.0f + e2);
                if (lane == 0) { const int m = mb + tk; TOKE[2 * m] = 8 * gs + i1; TOKE[2 * m + 1] = 8 * gs + i2; TOKW[2 * m] = w1; TOKW[2 * m + 1] = w2;
                    atomicAdd((int*)&hist[8 * gs + i1], 1); atomicAdd((int*)&hist[8 * gs + i2], 1); }
            }
        }
        __syncthreads();
        if (c.tid < 32) CNT[tile * 32 + c.tid] = hist[c.tid];
        __syncthreads();
    }
}
DI void moe_tables(PR p, const Ctx& c) {
    const int* CNT = (const int*)(p.ws + WS_CNT);
    LAS int* LC = (LAS int*)(c.lds + LDS_CTL_OFF);
    LAS int* part = (LAS int*)(c.lds + 72000);
    { const int e = c.tid & 31, pr = c.tid >> 5; int s = 0; for (int tl = pr; tl < M / 64; tl += 16) s += CNT[tl * 32 + e]; part[pr * 32 + e] = s; }
    __syncthreads();
    if (c.tid < 32) { int s = 0;
#pragma unroll 1
        for (int pr = 0; pr < 16; ++pr) s += part[pr * 32 + c.tid];
        LC[LC_TOT + c.tid] = s; }
    __syncthreads();
    if (c.tid == 0) { int acc = 0;
#pragma unroll 1
        for (int e = 0; e < 32; ++e) { LC[LC_PAD + e] = acc; const int nt = (LC[LC_TOT + e] + 255) >> 8;
#pragma unroll 1
            for (int i = 0; i < nt; ++i) LC[LC_TILE + (acc >> 8) + i] = e;
            acc += nt << 8; }
        LC[LC_PAD + 32] = acc; }
    __syncthreads();
}
DI void p8_dispatch(PR p, const Ctx& c) {
    unsigned char* ws = p.ws;
    const int* CNT = (const int*)(ws + WS_CNT); const int* TOKE = (const int*)(ws + WS_TOKE); int* TOKS = (int*)(ws + WS_TOKS);
    const bf16_t* HN = (const bf16_t*)(ws + WS_XN); bf16_t* XS = (bf16_t*)(ws + WS_XS);
    LAS int* LC = (LAS int*)(c.lds + LDS_CTL_OFF);
    LAS int* base = (LAS int*)(c.lds + 76000); LAS int* part = (LAS int*)(c.lds + 72000); LAS int* eids = (LAS int*)(c.lds + 77000); LAS int* slots = (LAS int*)(c.lds + 78000);
    for (int tile = c.bid; tile < M / 64; tile += c.G) {
        { const int e = c.tid & 31, pr = c.tid >> 5; int s = 0; for (int tl = pr; tl < tile; tl += 16) s += CNT[tl * 32 + e]; part[pr * 32 + e] = s; }
        if (c.tid < 128) eids[c.tid] = TOKE[tile * 128 + c.tid];
        __syncthreads();
        if (c.tid < 32) { int s = 0; for (int pr = 0; pr < 16; ++pr) s += part[pr * 32 + c.tid]; base[c.tid] = s; }
        __syncthreads();
        if (c.tid < 128) { const int e = eids[c.tid]; int lp = 0; for (int i = 0; i < c.tid; ++i) lp += (eids[i] == e) ? 1 : 0;
            const int s = LC[LC_PAD + e] + base[e] + lp; slots[c.tid] = s; TOKS[tile * 128 + c.tid] = s; }
        __syncthreads();
        for (int a = c.wave; a < 128; a += 8) { const int m = tile * 64 + (a >> 1); const u32x4* src = (const u32x4*)(HN + (size_t)m * D) + c.lane; u32x4* dst = (u32x4*)(XS + (size_t)slots[a] * D) + c.lane;
#pragma unroll
            for (int j = 0; j < 4; ++j) dst[64 * j] = src[64 * j]; }
        __syncthreads();
    }
}
DI void p11_combine(PR p, const Ctx& c, int l) {
    unsigned char* ws = p.ws;
    const int lane = c.lane; const int gw = c.bid * 8 + c.wave, NGW = c.G * 8;
    float* H = p.out; const bf16_t* YS = (const bf16_t*)(ws + WS_YS); const int* TOKS = (const int*)(ws + WS_TOKS); const float* TOKW = (const float*)(ws + WS_TOKW);
    bf16_t* XN = (bf16_t*)(ws + WS_XN);
    const float* nw = (l == 0) ? p.in[I_NMIX] + D : p.in[I_FNW];
    for (int m = gw; m < M; m += NGW) {
        const int s0 = TOKS[2 * m], s1 = TOKS[2 * m + 1]; const float w0 = TOKW[2 * m], w1 = TOKW[2 * m + 1];
        f32x4* hr = (f32x4*)(H + (size_t)m * D) + lane; const u32x2* y0 = (const u32x2*)(YS + (size_t)s0 * D) + lane; const u32x2* y1 = (const u32x2*)(YS + (size_t)s1 * D) + lane;
        f32x4 v[8]; float s = 0.f;
#pragma unroll
        for (int j = 0; j < 8; ++j) { float a[4], b[4]; unpack4(y0[64 * j], a); unpack4(y1[64 * j], b); f32x4 hv = hr[64 * j];
            hv.x += w0 * a[0] + w1 * b[0]; hv.y += w0 * a[1] + w1 * b[1]; hv.z += w0 * a[2] + w1 * b[2]; hv.w += w0 * a[3] + w1 * b[3]; v[j] = hv;
            s += (hv.x * hv.x + hv.y * hv.y) + (hv.z * hv.z + hv.w * hv.w); }
        const float rstd = rsqrtf(wave_sum(s) * (1.f / D) + NORM_EPS);
#pragma unroll
        for (int j = 0; j < 8; ++j) { const f32x4 ww = ((const f32x4*)nw)[lane + 64 * j];
            if (l == 0) { hr[64 * j] = v[j]; ((u32x2*)(XN + (size_t)m * D))[lane + 64 * j] = pack4(v[j].x * rstd * ww.x, v[j].y * rstd * ww.y, v[j].z * rstd * ww.z, v[j].w * rstd * ww.w); }
            else hr[64 * j] = v[j] * rstd * ww; }
    }
}
#ifndef DBG_CUT
#define DBG_CUT 1000
#endif
constexpr int NPHASE = 23;
#ifndef PH_MASK
#define PH_MASK 0xFFFF
#endif
#define PH_EN(n) ((PH_MASK >> (n)) & 1)
__global__ void __launch_bounds__(512, 2) mk_fwd(Params p_byval) {
    const CAS Params* pp = (const CAS Params*)__builtin_amdgcn_kernarg_segment_ptr();
#define p (*pp)
    extern __shared__ __attribute__((aligned(16))) unsigned char lds_raw[];
    Ctx c; unsigned char* ws;
#define FRESH() do { int t_ = threadIdx.x; asm volatile("" : "+v"(t_)); int b_ = blockIdx.x; asm volatile("" : "+s"(b_)); unsigned lb_ = (unsigned)(uintptr_t)(LAS unsigned char*)lds_raw; asm volatile("" : "+s"(lb_)); c.lds = (LAS unsigned char*)(uintptr_t)lb_; c.tid = t_; c.lane = t_ & 63; \
        c.wave = __builtin_amdgcn_readfirstlane(t_ >> 6); c.G = gridDim.x; c.bid = b_; pp = (const CAS Params*)__builtin_amdgcn_kernarg_segment_ptr(); asm volatile("" : "+s"(pp)); ws = p.ws; asm volatile("" : "+s"(ws)); glds = (LAS unsigned char*)c.lds; } while (0)
    LAS unsigned char* glds;
    FRESH();
    LAS unsigned* LCU = (LAS unsigned*)(c.lds + LDS_CTL_OFF);
    if (c.tid < 4) LCU[c.tid] = 0u;
    __syncthreads();
#if MK_ONE_LAUNCH
    XcdBarrier bar = xcd_barrier_post((unsigned*)(ws + WS_CTL) + CW_BAR, (volatile LAS unsigned*)LCU);
#define GRID_BAR() xcd_barrier(bar)
#else
#define GRID_BAR() do { } while (0)
#endif
    const int lo = p.ph_lo, hi = p.ph_hi;
#define IN(k) (lo <= (k) && (k) < hi)
#define SEAM(k) do { if (IN(k) && IN((k) + 1)) GRID_BAR(); } while (0)
    if (PH_EN(0) && IN(0)) { FRESH();
        convert_small(p, c, 0);
        const int gw = c.bid * 8 + c.wave, NGW = c.G * 8;
        for (int m = gw; m < M; m += NGW) rms_row_bf16(p.in[I_X] + (size_t)m * D, p.in[I_NMIX], (bf16_t*)(ws + WS_XN) + (size_t)m * D, c.lane);
    }
    SEAM(0);
    for (int l = 0; l < 2; ++l) {
        const int pb = 1 + 11 * l;
        if (PH_EN(1) && IN(pb + 0)) { FRESH();
            pg8::Gemm g{(const bf16_t*)(ws + WS_XN), (const bf16_t*)(ws + WS_WIN), M, NZ, D}; pg8::StaticOrder S; S.init(M, NZ, c.G, c.bid);
            pg8::EpiBf16P E{(bf16_t*)(ws + WS_Z), NZ};
            pg8::gemm_phase<pg8::EpiBf16P, pg8::StaticOrder>(glds, g, S, E, nullptr);
        }
        SEAM(pb + 0);
        if (PH_EN(2) && IN(pb + 1)) { FRESH();
            for (int it = c.bid; it < 8192; it += c.G) { if (it < 4096) r1_task(p, c, l, it); else h1_task(p, c, l, it - 4096); }
        }
        SEAM(pb + 1);
        if (PH_EN(3) && IN(pb + 2)) { FRESH();
            for (int it = c.bid; it < 128; it += c.G) { if (it < 64) h23_task(p, c, l, it); else r2_task(p, c, it - 64); }
        }
        SEAM(pb + 2);
        if (PH_EN(4) && IN(pb + 3)) { FRESH();
            for (int it = c.bid; it < 4096; it += c.G) r3_task(p, c, l, it);
        }
        SEAM(pb + 3);
        if (PH_EN(5) && IN(pb + 4)) { FRESH();
            pg8::StaticOrder S; S.init(M, D, c.G, c.bid);
#ifndef DBG_NO_HG
            { pg8::Gemm g{(const bf16_t*)(ws + WS_YHG), (const bf16_t*)(ws + WS_WBH), M, D, 1024};
              pg8::EpiGate E{(bf16_t*)(ws + WS_XN), D, (const bf16_t*)(ws + WS_Z) + ZC_GA, NZ, 0};
              pg8::gemm_phase<pg8::EpiGate, pg8::StaticOrder>(glds, g, S, E, nullptr); }
#endif
#ifndef DBG_NO_RW
            { pg8::Gemm g{(const bf16_t*)(ws + WS_YRW), (const bf16_t*)(ws + WS_WBR), M, D, 1024};
#ifdef DBG_NO_HG
              pg8::EpiGate E{(bf16_t*)(ws + WS_XN), D, (const bf16_t*)(ws + WS_Z) + ZC_GB, NZ, 0};
#else
              pg8::EpiGate E{(bf16_t*)(ws + WS_XN), D, (const bf16_t*)(ws + WS_Z) + ZC_GB, NZ, 1};
#endif
              pg8::gemm_phase<pg8::EpiGate, pg8::StaticOrder>(glds, g, S, E, nullptr); }
#endif
        }
        SEAM(pb + 4);
        if (PH_EN(6) && IN(pb + 5)) { FRESH();
            pg8::Gemm g{(const bf16_t*)(ws + WS_XN), (const bf16_t*)(ws + WS_WO), M, D, D}; pg8::StaticOrder S; S.init(M, D, c.G, c.bid);
            pg8::EpiRes E{l == 0 ? p.in[I_X] : p.out, p.out, D};
            pg8::gemm_phase<pg8::EpiRes, pg8::StaticOrder>(glds, g, S, E, nullptr);
        }
        SEAM(pb + 5);
        if (PH_EN(7) && IN(pb + 6)) { FRESH();
            convert_experts(p, c, l);
            __syncthreads();
            p7_route(p, c, l);
        }
        SEAM(pb + 6);
        if (PH_EN(8) && IN(pb + 7)) { FRESH(); moe_tables(p, c); p8_dispatch(p, c); }
        SEAM(pb + 7);
        if (PH_EN(9) && IN(pb + 8)) { FRESH();
            moe_tables(p, c); FRESH();
            const LAS int* LC = (const LAS int*)(c.lds + LDS_CTL_OFF);
            pg8::Gemm g{(const bf16_t*)(ws + WS_XS), (const bf16_t*)(ws + WS_WGU), MAXSLOTS, NEXP * 1024, D};
            pg8::GroupedOrder<4> S{(LC[LC_PAD + 32] >> 8) * 4, c.G, c.bid, LC + LC_TILE};
            pg8::EpiSwiGLU E{(bf16_t*)(ws + WS_ACT)};
            pg8::gemm_phase<pg8::EpiSwiGLU, pg8::GroupedOrder<4>>(glds, g, S, E, nullptr);
        }
        SEAM(pb + 8);
        if (PH_EN(10) && IN(pb + 9)) { FRESH();
            moe_tables(p, c); FRESH();
            const LAS int* LC = (const LAS int*)(c.lds + LDS_CTL_OFF);
            pg8::Gemm g{(const bf16_t*)(ws + WS_ACT), (const bf16_t*)(ws + WS_WDN), MAXSLOTS, NEXP * D, DEXP};
            pg8::GroupedOrder<8> S{(LC[LC_PAD + 32] >> 8) * 8, c.G, c.bid, LC + LC_TILE};
            pg8::EpiDown E{(bf16_t*)(ws + WS_YS)};
            pg8::gemm_phase<pg8::EpiDown, pg8::GroupedOrder<8>>(glds, g, S, E, nullptr);
        }
        SEAM(pb + 9);
        if (PH_EN(11) && IN(pb + 10)) { FRESH();
            p11_combine(p, c, l);
            if (l == 0) convert_small(p, c, 1);
        }
        SEAM(pb + 10);
    }
}
#undef p
__global__ void __launch_bounds__(512) dbg_final(const float* src, const float* fw, float* out) {
    const int lane = threadIdx.x & 63, gw = blockIdx.x * 8 + (threadIdx.x >> 6), NGW = gridDim.x * 8;
    for (int m = gw; m < M; m += NGW) { const f32x4* xr = (const f32x4*)(src + (size_t)m * D) + lane; f32x4 v[8]; float s = 0.f;
#pragma unroll
        for (int j = 0; j < 8; ++j) { v[j] = xr[64 * j]; s += (v[j].x * v[j].x + v[j].y * v[j].y) + (v[j].z * v[j].z + v[j].w * v[j].w); }
        const float rstd = rsqrtf(wave_sum(s) * (1.f / D) + NORM_EPS);
#pragma unroll
        for (int j = 0; j < 8; ++j) ((f32x4*)(out + (size_t)m * D))[lane + 64 * j] = v[j] * rstd * ((const f32x4*)fw)[lane + 64 * j]; }
}
#ifdef DBG_CHECK
__global__ void __launch_bounds__(512) dbg_check(const void* buf, size_t n, int is_f32, unsigned* flag, unsigned idx) {
    size_t i = (size_t)blockIdx.x * 512 + threadIdx.x, st = (size_t)gridDim.x * 512; bool bad = false;
#ifdef DBG_DEAD
    bool alive = false;
    for (; i < n; i += st) { float v = is_f32 ? ((const float*)buf)[i] : bf2f(((const bf16_t*)buf)[i]); if (fabsf(v) > 0.01f && fabsf(v) < 1e6f) alive = true; }
    __shared__ int anyalive; if (threadIdx.x == 0) anyalive = 0; __syncthreads(); if (alive) anyalive = 1; __syncthreads();
    if (threadIdx.x == 0 && anyalive) atomicOr(flag + 1 + idx, 1u);
#else
    for (; i < n; i += st) { float v = is_f32 ? ((const float*)buf)[i] : bf2f(((const bf16_t*)buf)[i]); if (!(v - v == 0.f)) bad = true; }
    if (bad) atomicMin(flag, idx);
#endif
}
__global__ void __launch_bounds__(512) dbg_scale(float* out, const unsigned* flag) {
#ifdef DBG_DEAD
    unsigned f = 1000u; for (unsigned i = 1; i <= 18; ++i) if (flag[1 + i] == 0u) { f = i; break; }
#else
    const unsigned f = *flag;
#endif
    const float s = f < 100u ? 1.0f + 0.25f * (float)f : 1.0f;
    for (size_t i = (size_t)blockIdx.x * 512 + threadIdx.x; i < (size_t)M * D; i += (size_t)gridDim.x * 512) out[i] *= s;
}
#endif
#ifdef DBG_TRTEST
__global__ void __launch_bounds__(64) dbg_trtest(unsigned* flag) {
    __shared__ __attribute__((aligned(16))) bf16_t A[64 * 72];
    const int lane = threadIdx.x;
    for (int i = lane; i < 64 * 72; i += 64) { const int r = i / 72, cc = i % 72; const float v = (float)((r * 5 + cc * 3) & 255); A[i] = (bf16_t)(cvt_pk(v, 0.f) & 0xffff); }
    __syncthreads();
    unsigned bad = 0;
    for (int row0 = 0; row0 < 64; row0 += 16) for (int k0 = 0; k0 < 64; k0 += 32) {
        const bf16x8 f = frag_t<72>((const LAS bf16_t*)A, row0, k0, lane);
        for (int j = 0; j < 8; ++j) { const int k = k0 + 8 * (lane >> 4) + j, i = row0 + (lane & 15); if ((bf16_t)f[j] != A[k * 72 + i]) bad = 1; }
    }
    if (bad) atomicMin(flag, 2u);
    f32x4 acc = {0.f, 0.f, 0.f, 0.f}; bf16x8 xa, yb;
    for (int j = 0; j < 8; ++j) { const int k = 8 * (lane >> 4) + j, r = lane & 15; xa[j] = (short)(cvt_pk(r == k ? 1.f : 0.f, 0.f) & 0xffff); yb[j] = (short)(cvt_pk((float)(r * 8 + (k & 7)), 0.f) & 0xffff); }
    acc = MFMA16(yb, xa, acc);
    for (int r = 0; r < 4; ++r) { const int pp_ = lane & 15, q = 4 * (lane >> 4) + r; if (acc[r] != (float)(q * 8 + (pp_ & 7))) bad |= 2; }
    if (bad & 2) atomicMin(flag, 3u);
}
#endif
#ifdef DBG_H1TEST
__global__ void __launch_bounds__(512) dbg_h1test(unsigned* flag) {
    extern __shared__ __attribute__((aligned(16))) unsigned char lraw[];
    LAS unsigned char* lds = (LAS unsigned char*)lraw;
    LAS bf16_t* Vs = (LAS bf16_t*)(lds + H_V); LAS bf16_t* KPs = (LAS bf16_t*)(lds + H_KP); LAS bf16_t* QHs = (LAS bf16_t*)(lds + H_QH); LAS bf16_t* KTs = (LAS bf16_t*)(lds + H_KT);
    const int tid = threadIdx.x, lane = tid & 63, w = tid >> 6, fr = lane & 15, fq = lane >> 4;
    for (int i = tid; i < 32 * HL; i += 512) { const int r = i / HL, cc = i % HL;
        Vs[i] = (bf16_t)(cvt_pk((float)((r * 3 + cc) % 7 - 3), 0.f) & 0xffff); KPs[i] = (bf16_t)(cvt_pk((float)((r + cc * 5) % 5 - 2), 0.f) & 0xffff);
        QHs[i] = (bf16_t)(cvt_pk((float)((r * 2 + cc) % 3 - 1), 0.f) & 0xffff); KTs[i] = (bf16_t)(cvt_pk((float)((r + cc) % 4 - 1), 0.f) & 0xffff); }
    __syncthreads();
    unsigned bad = 0;
    const bf16x8 xb = frag_t<HL>(Vs, 16 * w, 0, lane);
    for (int dn = 0; dn < 8; ++dn) { const bf16x8 ya = frag_t<HL>(KPs, 16 * dn, 0, lane); const f32x4 nt = MFMA16(ya, xb, F4Z);
        for (int r = 0; r < 4; ++r) { const int e = 16 * w + fr, d = 16 * dn + 4 * fq + r; float ref = 0.f; for (int s = 0; s < 32; ++s) ref += (float)((s * 3 + e) % 7 - 3) * (float)((s + d * 5) % 5 - 2); if (nt[r] != ref) bad |= 1; } }
    if (w < 4) { const int p0 = 16 * (w >> 1), q0 = 16 * (w & 1);
        const f32x4 sc = mm16<false, false, 4, HL, HL>(QHs, KTs, p0, q0, lane, F4Z);
        for (int r = 0; r < 4; ++r) { const int t = p0 + fr, s = q0 + 4 * fq + r; float ref = 0.f; for (int d = 0; d < 128; ++d) ref += (float)((t * 2 + d) % 3 - 1) * (float)((s + d) % 4 - 1); if (sc[r] != ref) bad |= 2; } }
    if (bad & 1) atomicMin(flag, 2u);
    if (bad & 2) atomicMin(flag, 3u);
}
#endif
#ifdef DBG_CLASS
__global__ void __launch_bounds__(512) dbg_class(const bf16_t* buf, size_t n, unsigned* flag) {
    unsigned m = 0;
    for (size_t i = (size_t)blockIdx.x * 512 + threadIdx.x; i < n; i += (size_t)gridDim.x * 512) { const bf16_t b = buf[i]; const float v = bf2f(b); const float a = fabsf(v);
        if (b == 0xAAAA) m |= 4; else if (a == 0.f) m |= 2; else if (a > 0.01f && a < 1e6f) m |= 1; else if (!(a < 1e6f)) m |= 8; else m |= 16; }
    if (m) atomicOr(flag + 40, m);
}
__global__ void __launch_bounds__(512) dbg_scale2(float* out, const unsigned* flag) {
    const unsigned f = flag[40]; const float s = 1.0f + 0.25f * (float)f;
    for (size_t i = (size_t)blockIdx.x * 512 + threadIdx.x; i < (size_t)M * D; i += (size_t)gridDim.x * 512) out[i] *= s;
}
#endif
#ifdef DBG_CSUM
__global__ void __launch_bounds__(512) dbg_csum(const unsigned* buf, size_t nwords, unsigned* flag) {
    unsigned long long s = 0;
    for (size_t i = (size_t)blockIdx.x * 512 + threadIdx.x; i < nwords; i += (size_t)gridDim.x * 512) s += (unsigned long long)buf[i] * (unsigned long long)((i & 1023) + 1);
    atomicAdd((unsigned long long*)(flag + 42), s);
}
__global__ void __launch_bounds__(512) dbg_scale3(float* out, const unsigned* flag) {
    const unsigned long long c = *(const unsigned long long*)(flag + 42); const float s = 1.0f + 0.25f * (float)((c >> 7) & 3ull);
    for (size_t i = (size_t)blockIdx.x * 512 + threadIdx.x; i < (size_t)M * D; i += (size_t)gridDim.x * 512) out[i] *= s;
}
#endif
#ifdef DBG_ZCOLS
__global__ void __launch_bounds__(512) dbg_zcols(const bf16_t* Z, unsigned* flag) {
    const int starts[13] = {0, 1024, 2048, 3072, 4096, 5120, 6144, 7168, 7232, 7296, 7456, 9504, 11552};
    __shared__ int alive[12];
    if (threadIdx.x < 12) alive[threadIdx.x] = 0; __syncthreads();
    for (int row = blockIdx.x; row < M; row += gridDim.x) { const bf16_t* zr = Z + (size_t)row * NZ;
        for (int cidx = threadIdx.x; cidx < 11552; cidx += 512) { const float a = fabsf(bf2f(zr[cidx])); if (a > 0.01f && a < 1e6f) { int seg = 0; for (int s = 0; s < 12; ++s) if (cidx >= starts[s]) seg = s; alive[seg] = 1; } } }
    __syncthreads();
    if (threadIdx.x < 12 && alive[threadIdx.x]) atomicOr(flag + 2 + threadIdx.x, 1u);
}
#endif
#ifdef DBG_WROWS
__global__ void __launch_bounds__(512) dbg_wrows(const bf16_t* W, unsigned* flag) {
    const int starts[13] = {0, 1024, 2048, 3072, 4096, 5120, 6144, 7168, 7232, 7296, 7456, 9504, 11552};
    for (int row = blockIdx.x; row < 11552; row += gridDim.x) { bool alive = false;
        for (int cidx = threadIdx.x; cidx < 2048; cidx += 512) { const float a = fabsf(bf2f(W[(size_t)row * 2048 + cidx])); if (a > 0.001f && a < 1e6f) alive = true; }
        if (alive) { int seg = 0; for (int s = 0; s < 12; ++s) if (row >= starts[s]) seg = s; atomicOr(flag + 2 + seg, 1u); } }
}
#endif
extern "C" void kernel_launch(void* const* d_in, const int* in_sizes, int n_in, void* d_out, int out_size, void* d_ws, size_t ws_size, hipStream_t stream) {
    static int grid = 0;
    if (grid == 0) {
        if (n_in != 31 || out_size != M * D || ws_size < WS_END) { fprintf(stderr, "kernel_launch: unexpected shapes (n_in %d out %d ws %zu)\n", n_in, out_size, ws_size); grid = -1; return; }
        int dev = 0, cus = 0;
        if (hipGetDevice(&dev) != hipSuccess || hipDeviceGetAttribute(&cus, hipDeviceAttributeMultiprocessorCount, dev) != hipSuccess) { grid = -1; return; }
        if (hipFuncSetAttribute((const void*)mk_fwd, hipFuncAttributeMaxDynamicSharedMemorySize, LDS_BYTES) != hipSuccess) { fprintf(stderr, "kernel_launch: hipFuncSetAttribute failed\n"); grid = -1; return; }
        int per_cu = 0;
        if (hipOccupancyMaxActiveBlocksPerMultiprocessor(&per_cu, (const void*)mk_fwd, 512, LDS_BYTES) != hipSuccess || per_cu < 1) { fprintf(stderr, "kernel_launch: occupancy query says %d\n", per_cu); }
        (void)hipGetLastError();
        grid = cus;
    }
    if (grid < 0) return;
    (void)hipMemsetAsync((char*)d_ws + WS_CTL, 0, CTL_BYTES, stream);
    Params p{};
    for (int i = 0; i < 31; ++i) p.in[i] = (const float*)d_in[i];
    p.out = (float*)d_out; p.ws = (unsigned char*)d_ws;
    const int nph = NPHASE < DBG_CUT ? NPHASE : DBG_CUT;
#if MK_ONE_LAUNCH
    p.ph_lo = 0; p.ph_hi = nph;
    hipLaunchKernelGGL(mk_fwd, dim3(grid), dim3(512), LDS_BYTES, stream, p);
#else
    for (int ph = 0; ph < nph; ++ph) { p.ph_lo = ph; p.ph_hi = ph + 1; hipLaunchKernelGGL(mk_fwd, dim3(grid), dim3(512), LDS_BYTES, stream, p); }
#endif
#if defined(DBG_ZCOLS)
    { unsigned* flag = (unsigned*)((char*)d_ws + 512 * 1024); (void)hipMemsetAsync(flag, 0, 256, stream);
#ifdef DBG_WROWS
      hipLaunchKernelGGL(dbg_wrows, dim3(1024), dim3(512), 0, stream, (const bf16_t*)((char*)d_ws + WS_WIN), flag);
#else
      hipLaunchKernelGGL(dbg_zcols, dim3(1024), dim3(512), 0, stream, (const bf16_t*)((char*)d_ws + WS_Z), flag);
#endif
      for (int i = 13; i <= 18; ++i) (void)hipMemsetAsync(flag + 1 + i, 1, 4, stream);
      hipLaunchKernelGGL(dbg_final, dim3(grid), dim3(512), 0, stream, (const float*)d_in[0], (const float*)d_in[30], (float*)d_out);
      hipLaunchKernelGGL(dbg_scale, dim3(1024), dim3(512), 0, stream, (float*)d_out, (const unsigned*)flag); }
#elif defined(DBG_CSUM)
    { unsigned* flag = (unsigned*)((char*)d_ws + 512 * 1024); (void)hipMemsetAsync(flag, 0, 256, stream);
      hipLaunchKernelGGL(dbg_csum, dim3(1024), dim3(512), 0, stream, (const unsigned*)((char*)d_ws + DBG_CSUM_OFF), (size_t)DBG_CSUM_WORDS, flag);
      hipLaunchKernelGGL(dbg_final, dim3(grid), dim3(512), 0, stream, (const float*)d_in[0], (const float*)d_in[30], (float*)d_out);
      hipLaunchKernelGGL(dbg_scale3, dim3(1024), dim3(512), 0, stream, (float*)d_out, (const unsigned*)flag); }
#elif defined(DBG_CLASS)
    { unsigned* flag = (unsigned*)((char*)d_ws + 512 * 1024); (void)hipMemsetAsync(flag, 0, 256, stream);
      hipLaunchKernelGGL(dbg_class, dim3(1024), dim3(512), 0, stream, (const bf16_t*)((char*)d_ws + DBG_CLASS_OFF), (size_t)DBG_CLASS_N, flag);
      hipLaunchKernelGGL(dbg_final, dim3(grid), dim3(512), 0, stream, (const float*)d_in[0], (const float*)d_in[30], (float*)d_out);
      hipLaunchKernelGGL(dbg_scale2, dim3(1024), dim3(512), 0, stream, (float*)d_out, (const unsigned*)flag); }
#elif defined(DBG_CHECK)
    { unsigned* flag = (unsigned*)((char*)d_ws + 512 * 1024); (void)hipMemsetAsync(flag, 0x7f, 4, stream); (void)hipMemsetAsync(flag + 1, 0, 128, stream);
      struct B { size_t off, n; int f32; }; const B bl[] = {
#ifdef DBG_DEAD
        {WS_WIN, (size_t)IN_WIDTH * D, 0}, {WS_XN, (size_t)M * D, 0},
#endif
        {WS_Z, (size_t)M * NZ, 0}, {WS_QH, (size_t)M * 1024, 0}, {WS_QH, (size_t)M * 1024, 0}, {WS_NT, (size_t)64 * 64 * 16384, 0}, {WS_DC, (size_t)64 * 64 * 128, 1},
        {WS_RP, (size_t)M * 1024, 0}, {WS_Y0, (size_t)M * 1024, 0}, {WS_MT, (size_t)M * 1024, 0}, {WS_NN, (size_t)M * 1024, 0}, {WS_RK, (size_t)M * 16, 1}, {WS_VFIRST, (size_t)M * 1024, 0},
        {WS_YHG, (size_t)M * 1024, 0}, {WS_SS, (size_t)M * 1024, 0}, {WS_YRW, (size_t)M * 1024, 0}, {WS_XN, (size_t)M * D, 0} };
#ifdef DBG_TRTEST
      hipLaunchKernelGGL(dbg_trtest, dim3(1), dim3(64), 0, stream, flag);
#endif
#ifdef DBG_H1TEST
      hipLaunchKernelGGL(dbg_h1test, dim3(1), dim3(512), 65536, stream, flag);
#endif
      for (unsigned i = 0; i < sizeof(bl) / sizeof(bl[0]); ++i) hipLaunchKernelGGL(dbg_check, dim3(1024), dim3(512), 0, stream, (const void*)((char*)d_ws + bl[i].off), bl[i].n, bl[i].f32, flag, i + 1);
      hipLaunchKernelGGL(dbg_check, dim3(1024), dim3(512), 0, stream, (const void*)d_out, (size_t)M * D, 1, flag, 18u);
      hipLaunchKernelGGL(dbg_final, dim3(grid), dim3(512), 0, stream, (const float*)d_in[0], (const float*)d_in[30], (float*)d_out);
      hipLaunchKernelGGL(dbg_scale, dim3(1024), dim3(512), 0, stream, (float*)d_out, (const unsigned*)flag); }
#elif DBG_CUT < 1000
    hipLaunchKernelGGL(dbg_final, dim3(grid), dim3(512), 0, stream, (const float*)(DBG_CUT <= 6 ? d_in[0] : d_out), (const float*)d_in[30], (float*)d_out);
#endif
}
```

```cpp
#define MK_ONE_LAUNCH 1
#include <hip/hip_runtime.h>
#include <stdint.h>
#include <stdio.h>
#ifndef MK_ONE_LAUNCH
#define MK_ONE_LAUNCH 0
#endif
#define DI __device__ __forceinline__
#define LAS __attribute__((address_space(3)))
typedef unsigned short bf16_t;
typedef short bf16x8 __attribute__((ext_vector_type(8)));
typedef short s16x4 __attribute__((ext_vector_type(4)));
typedef float f32x4 __attribute__((ext_vector_type(4)));
typedef float f32x2 __attribute__((ext_vector_type(2)));
typedef unsigned u32x4 __attribute__((ext_vector_type(4)));
typedef unsigned u32x2 __attribute__((ext_vector_type(2)));

constexpr int M = 16384, D = 2048, TSEQ = 2048, NBATCH = 8;
constexpr int NZ = 11776;
constexpr int ZC_Q = 0, ZC_F = 1024, ZC_I = 2048, ZC_O = 3072, ZC_R = 4096, ZC_K = 5120, ZC_V = 6144, ZC_WD = 7168, ZC_AD = 7232, ZC_GD = 7296,
              ZC_GA = 7456, ZC_GB = 9504, ZC_VDA = 11552, ZC_VDB = 11584;
constexpr int IN_WIDTH = 11552;
constexpr int NEXP = 32, DEXP = 512, MAXSLOTS = 40960;
constexpr float NORM_EPS = 1e-6f, RW_GN_EPS = 64e-5f;
constexpr size_t MiB = 1u << 20;
constexpr size_t WS_CTL = 0, CTL_BYTES = 1 * MiB;
constexpr size_t WS_TOKE = 1 * MiB, WS_TOKW = WS_TOKE + 128 * 1024, WS_TOKS = WS_TOKW + 128 * 1024, WS_CNT = WS_TOKS + 128 * 1024, WS_SRSTD = WS_CNT + 64 * 1024, WS_TRSTD = WS_SRSTD + 192 * 1024;
constexpr size_t WS_LORA = 2 * MiB;
constexpr size_t LO_WUP = 0, LO_AUP = 128 * 1024, LO_GUP = 256 * 1024, LO_VUP = 576 * 1024, LO_WR = 640 * 1024, LO_WRL = 832 * 1024;
constexpr size_t WS_WIN = 4 * MiB, WS_WBH = 50 * MiB, WS_WBR = 54 * MiB, WS_WO = 58 * MiB;
constexpr size_t WS_Z = 66 * MiB;
constexpr size_t WS_XS = WS_Z, WS_ACT = WS_Z + 160 * MiB, WS_YS = WS_Z + 200 * MiB;
constexpr size_t WS_XN = 434 * MiB;
constexpr size_t WS_YHG = 498 * MiB, WS_YRW = 530 * MiB, WS_VFIRST = 562 * MiB;
constexpr size_t WS_X = 594 * MiB;
constexpr size_t WS_NT = WS_X, WS_DC = WS_X + 128 * MiB, WS_QH = WS_X + 130 * MiB, WS_OI = WS_X + 162 * MiB;
constexpr size_t WS_MT = WS_X + 194 * MiB, WS_NN = WS_X + 226 * MiB, WS_RP = WS_X + 258 * MiB, WS_Y0 = WS_X + 290 * MiB, WS_SS = WS_X + 322 * MiB,
                 WS_RK = WS_X + 354 * MiB, WS_VF = WS_X + 355 * MiB;
constexpr size_t WS_WGU = 981 * MiB, WS_WDN = WS_X + 64 * MiB;
constexpr size_t WS_END = 1109 * MiB;
constexpr int CW_BAR = 4096;
constexpr size_t CTL_SLOTTOK = 256 * 1024;
constexpr int LDS_CTL_OFF = 148 * 1024, LDS_BYTES = 152 * 1024;
constexpr int LC_TOT = 16, LC_PAD = 48, LC_TILE = 96, LC_MISC = 256;

DI float bf2f(unsigned short b) { return __uint_as_float(((unsigned)b) << 16); }
typedef __bf16 nbf16x2 __attribute__((ext_vector_type(2)));
DI unsigned cvt_pk(float lo, float hi) { const f32x2 f = {lo, hi}; const nbf16x2 v = __builtin_convertvector(f, nbf16x2); return __builtin_bit_cast(unsigned, v); }
DI void unpack8(const u32x4 v, float (&f)[8]) {
    f[0] = __uint_as_float(v.x << 16); f[1] = __uint_as_float(v.x & 0xffff0000u); f[2] = __uint_as_float(v.y << 16); f[3] = __uint_as_float(v.y & 0xffff0000u);
    f[4] = __uint_as_float(v.z << 16); f[5] = __uint_as_float(v.z & 0xffff0000u); f[6] = __uint_as_float(v.w << 16); f[7] = __uint_as_float(v.w & 0xffff0000u); }
DI u32x4 pack8(const float (&f)[8]) { u32x4 v; v.x = cvt_pk(f[0], f[1]); v.y = cvt_pk(f[2], f[3]); v.z = cvt_pk(f[4], f[5]); v.w = cvt_pk(f[6], f[7]); return v; }
DI void unpack4(const u32x2 v, float (&f)[4]) { f[0] = __uint_as_float(v.x << 16); f[1] = __uint_as_float(v.x & 0xffff0000u); f[2] = __uint_as_float(v.y << 16); f[3] = __uint_as_float(v.y & 0xffff0000u); }
DI u32x2 pack4(float a, float b, float c, float d) { u32x2 v; v.x = cvt_pk(a, b); v.y = cvt_pk(c, d); return v; }
DI float sigm(float x) { return 1.0f / (1.0f + __expf(-x)); }
DI float wave_sum(float v) {
#pragma unroll
    for (int o = 1; o < 64; o <<= 1) v += __shfl_xor(v, o);
    return v;
}

DI void lds_barrier() { asm volatile("s_waitcnt lgkmcnt(0)\n\ts_barrier" ::: "memory"); }
namespace pg8 {
#define PG8_LAS __attribute__((address_space(3)))
typedef unsigned short bf16_t;
typedef short bf16x8 __attribute__((ext_vector_type(8)));
typedef float f32x4 __attribute__((ext_vector_type(4)));
typedef unsigned u32x4 __attribute__((ext_vector_type(4)));
constexpr int BM = 256, BK = 64, HALF = 128, HTB = HALF * BK * 2  , STAGE_BYTES = 8 * HTB, NXCD = 8, WGM = 8;

__host__ __device__ __forceinline__ int lds_byte(int r, int c) { const int st = (r >> 4) * 2 + (c >> 5), rr = r & 15, cc = c & 31, ob = rr * 64 + cc * 2; return st * 1024 + (ob ^ (((ob >> 9) & 1) << 5)); }
__host__ __device__ __forceinline__ void stage_rc(int b, int& R, int& C) { const int st = b / 1024, sb = b % 1024, swz = sb ^ (((sb >> 9) & 1) << 5); R = (st >> 1) * 16 + swz / 64; C = (st & 1) * 32 + (swz % 64) / 2; }
__host__ __device__ __forceinline__ int perm32(int rho) { const int n = rho >> 4, i = rho & 15; return 8 * (i >> 2) + 4 * n + (i & 3); }

struct Unit { int pm, pn; };
struct Gemm { const bf16_t* A; const bf16_t* Bt; int M, N, K; const int* amap = nullptr; };

struct StaticOrder {
    int nM, nN, nwg, G, c, wgm;
    __host__ __device__ void init(int M, int N, int G_, int c_, int wgm_ = WGM) { nM = M / BM; nN = N / BM; nwg = nM * nN; G = G_; c = c_; wgm = wgm_; }
    __host__ __device__ bool next(int i, Unit& u) const {
        const long L = (long)i * G + c; if (L >= nwg) return false;
        int wgid = (int)L; { const int q = nwg / NXCD, r = nwg % NXCD, xcd = wgid % NXCD, off = wgid / NXCD; wgid = (xcd < r ? xcd * (q + 1) : r * (q + 1) + (xcd - r) * q) + off; }
        const int nig = wgm * nN, gid = wgid / nig, fm = gid * wgm, gsz = (nM - fm) < wgm ? (nM - fm) : wgm;
        u.pm = fm + ((wgid % nig) % gsz); u.pn = (wgid % nig) / gsz; return true;
    }
    __device__ __forceinline__ void a_ready(const Unit&) const {}
    __device__ __forceinline__ void done(const Unit&) const {}
};
__device__ __forceinline__ unsigned cvt_pk_bf16(float lo, float hi) { return ::cvt_pk(lo, hi); }
typedef float f32x2 __attribute__((ext_vector_type(2)));
struct EpiBf16P {
    static constexpr bool PERM = true, AFTER_DRAIN = false;
    bf16_t* O; int ldc; int dbg;
    __device__ __forceinline__ void operator()(const f32x4 (&acc)[2][2][4][2], const Unit& u, int wr, int wc, int fr, int fq) const {
        if (dbg == 1) { float s = 0.f; _Pragma("unroll") for (int ai = 0; ai < 2; ++ai) _Pragma("unroll") for (int bj = 0; bj < 2; ++bj) _Pragma("unroll") for (int m = 0; m < 4; ++m) _Pragma("unroll") for (int n = 0; n < 2; ++n) s += acc[ai][bj][m][n][0] + acc[ai][bj][m][n][3]; asm volatile("" :: "v"(s)); return; }
        const int row0 = u.pm * BM + wr * 64 + fr, col0 = u.pn * BM + wc * 32 + 8 * fq;
#pragma unroll
        for (int ai = 0; ai < 2; ++ai)
#pragma unroll
            for (int m = 0; m < 4; ++m) { bf16_t* rowp = (dbg == 2 ? O + (size_t)(658 * 1024 * 1024 / 2) : O) + (size_t)(dbg == 2 ? (int)(blockIdx.x * 16 + fr) : row0 + ai * HALF + m * 16) * ldc + col0;
#pragma unroll
                for (int bj = 0; bj < 2; ++bj) { const f32x4 v0 = acc[ai][bj][m][0], v1 = acc[ai][bj][m][1];
                    u32x4 w; w.x = cvt_pk_bf16(v0[0], v0[1]); w.y = cvt_pk_bf16(v0[2], v0[3]); w.z = cvt_pk_bf16(v1[0], v1[1]); w.w = cvt_pk_bf16(v1[2], v1[3]);
                    *(u32x4*)(rowp + bj * HALF) = w; } asm volatile("" ::: "memory"); }
    }
};
struct EpiGate {
    static constexpr bool PERM = true, AFTER_DRAIN = false;
    bf16_t* O; int ldo; const bf16_t* Zg; int ldz; int accum; int dbg;
    __device__ __forceinline__ void operator()(const f32x4 (&acc)[2][2][4][2], const Unit& u, int wr, int wc, int fr, int fq) const {
        if (dbg) { float s = 0.f; _Pragma("unroll") for (int ai = 0; ai < 2; ++ai) _Pragma("unroll") for (int bj = 0; bj < 2; ++bj) _Pragma("unroll") for (int m = 0; m < 4; ++m) _Pragma("unroll") for (int n = 0; n < 2; ++n) s += acc[ai][bj][m][n][0] + acc[ai][bj][m][n][3]; asm volatile("" :: "v"(s)); return; }
        const int row0 = u.pm * BM + wr * 64 + fr, col0 = u.pn * BM + wc * 32 + 8 * fq;
#pragma unroll
        for (int ai = 0; ai < 2; ++ai) {
            u32x4 zg[4][2], pv[4][2];
#pragma unroll
            for (int m = 0; m < 4; ++m)
#pragma unroll
                for (int bj = 0; bj < 2; ++bj) { const size_t row = (size_t)(row0 + ai * HALF + m * 16); zg[m][bj] = *(const u32x4*)(Zg + row * ldz + col0 + bj * HALF);
                    if (accum) pv[m][bj] = *(const u32x4*)(O + row * ldo + col0 + bj * HALF); else pv[m][bj] = (u32x4){0u, 0u, 0u, 0u}; }
#pragma unroll
            for (int m = 0; m < 4; ++m)
#pragma unroll
                for (int bj = 0; bj < 2; ++bj) { const size_t row = (size_t)(row0 + ai * HALF + m * 16); const f32x4 v0 = acc[ai][bj][m][0], v1 = acc[ai][bj][m][1];
                    const unsigned zw[4] = {zg[m][bj].x, zg[m][bj].y, zg[m][bj].z, zg[m][bj].w}, pw[4] = {pv[m][bj].x, pv[m][bj].y, pv[m][bj].z, pv[m][bj].w};
                    float o[8];
#pragma unroll
                    for (int j = 0; j < 4; ++j) { const float z0 = __uint_as_float(zw[j] << 16), z1 = __uint_as_float(zw[j] & 0xffff0000u); const float a0 = j < 2 ? v0[2 * j] : v1[2 * j - 4], a1 = j < 2 ? v0[2 * j + 1] : v1[2 * j - 3];
                        o[2 * j] = a0 / (1.0f + __expf(-z0)) + __uint_as_float(pw[j] << 16); o[2 * j + 1] = a1 / (1.0f + __expf(-z1)) + __uint_as_float(pw[j] & 0xffff0000u); }
                    u32x4 w; w.x = cvt_pk_bf16(o[0], o[1]); w.y = cvt_pk_bf16(o[2], o[3]); w.z = cvt_pk_bf16(o[4], o[5]); w.w = cvt_pk_bf16(o[6], o[7]);
                    *(u32x4*)(O + row * ldo + col0 + bj * HALF) = w; }
            asm volatile("" ::: "memory");
        }
    }
};
struct EpiRes {
    static constexpr bool PERM = false, AFTER_DRAIN = false;
    const float* base; float* out; int ldc; int dbg;
    __device__ __forceinline__ void operator()(const f32x4 (&acc)[2][2][4][2], const Unit& u, int wr, int wc, int fr, int fq) const {
        if (dbg) { float s = 0.f; _Pragma("unroll") for (int ai = 0; ai < 2; ++ai) _Pragma("unroll") for (int bj = 0; bj < 2; ++bj) _Pragma("unroll") for (int m = 0; m < 4; ++m) _Pragma("unroll") for (int n = 0; n < 2; ++n) s += acc[ai][bj][m][n][0] + acc[ai][bj][m][n][3]; asm volatile("" :: "v"(s)); return; }
        const int row0 = u.pm * BM + wr * 64 + fr, col0 = u.pn * BM + wc * 32 + 4 * fq;
#pragma unroll
        for (int ai = 0; ai < 2; ++ai) {
            f32x4 bs[4][2][2];
#pragma unroll
            for (int m = 0; m < 4; ++m) { const size_t off = (size_t)(row0 + ai * HALF + m * 16) * ldc + col0;
#pragma unroll
                for (int bj = 0; bj < 2; ++bj)
#pragma unroll
                    for (int n = 0; n < 2; ++n) bs[m][bj][n] = *(const f32x4*)(base + off + bj * HALF + n * 16); }
#pragma unroll
            for (int m = 0; m < 4; ++m) { const size_t off = (size_t)(row0 + ai * HALF + m * 16) * ldc + col0;
#pragma unroll
                for (int bj = 0; bj < 2; ++bj)
#pragma unroll
                    for (int n = 0; n < 2; ++n) *(f32x4*)(out + off + bj * HALF + n * 16) = bs[m][bj][n] + acc[ai][bj][m][n]; }
            asm volatile("" ::: "memory");
        }
    }
};
struct EpiSwiGLU {
    static constexpr bool PERM = true, AFTER_DRAIN = false;
    bf16_t* O; const float* rstd; int dbg;
    __device__ __forceinline__ void operator()(const f32x4 (&acc)[2][2][4][2], const Unit& u, int wr, int wc, int fr, int fq) const {
        if (dbg) { float s = 0.f; _Pragma("unroll") for (int ai = 0; ai < 2; ++ai) _Pragma("unroll") for (int bj = 0; bj < 2; ++bj) _Pragma("unroll") for (int m = 0; m < 4; ++m) _Pragma("unroll") for (int n = 0; n < 2; ++n) s += acc[ai][bj][m][n][0] + acc[ai][bj][m][n][3]; asm volatile("" :: "v"(s)); return; }
        const int row0 = u.pm * BM + wr * 64 + fr, col0 = (u.pn & 3) * 128 + wc * 32 + 8 * fq;
        float rsv[2][4];
#pragma unroll
        for (int ai = 0; ai < 2; ++ai)
#pragma unroll
            for (int m = 0; m < 4; ++m) rsv[ai][m] = rstd[row0 + ai * HALF + m * 16];
#pragma unroll
        for (int ai = 0; ai < 2; ++ai)
#pragma unroll
            for (int m = 0; m < 4; ++m) { bf16_t* rowp = O + (size_t)(row0 + ai * HALF + m * 16) * 512 + col0; const float rs = rsv[ai][m];
                float o[8];
#pragma unroll
                for (int n = 0; n < 2; ++n)
#pragma unroll
                    for (int j = 0; j < 4; ++j) { const float g = acc[ai][0][m][n][j] * rs, up = acc[ai][1][m][n][j] * rs; o[4 * n + j] = g / (1.0f + __expf(-g)) * up; }
                u32x4 w; w.x = cvt_pk_bf16(o[0], o[1]); w.y = cvt_pk_bf16(o[2], o[3]); w.z = cvt_pk_bf16(o[4], o[5]); w.w = cvt_pk_bf16(o[6], o[7]);
                *(u32x4*)rowp = w; asm volatile("" ::: "memory"); }
    }
};
struct EpiDown {
    static constexpr bool PERM = true, AFTER_DRAIN = false;
    bf16_t* O; int dbg;
    __device__ __forceinline__ void operator()(const f32x4 (&acc)[2][2][4][2], const Unit& u, int wr, int wc, int fr, int fq) const {
        if (dbg) { float s = 0.f; _Pragma("unroll") for (int ai = 0; ai < 2; ++ai) _Pragma("unroll") for (int bj = 0; bj < 2; ++bj) _Pragma("unroll") for (int m = 0; m < 4; ++m) _Pragma("unroll") for (int n = 0; n < 2; ++n) s += acc[ai][bj][m][n][0] + acc[ai][bj][m][n][3]; asm volatile("" :: "v"(s)); return; }
        const int row0 = u.pm * BM + wr * 64 + fr, col0 = (u.pn & 7) * BM + wc * 32 + 8 * fq;
#pragma unroll
        for (int ai = 0; ai < 2; ++ai)
#pragma unroll
            for (int m = 0; m < 4; ++m) { bf16_t* rowp = O + (size_t)(row0 + ai * HALF + m * 16) * 2048 + col0;
#pragma unroll
                for (int bj = 0; bj < 2; ++bj) { const f32x4 v0 = acc[ai][bj][m][0], v1 = acc[ai][bj][m][1];
                    u32x4 w; w.x = cvt_pk_bf16(v0[0], v0[1]); w.y = cvt_pk_bf16(v0[2], v0[3]); w.z = cvt_pk_bf16(v1[0], v1[1]); w.w = cvt_pk_bf16(v1[2], v1[3]);
                    *(u32x4*)(rowp + bj * HALF) = w; } asm volatile("" ::: "memory"); }
    }
};
template <int NTN> struct GroupedOrder {
    static constexpr int ntn = NTN; int nunits, G, c; const PG8_LAS int* tile_e;
    __device__ __forceinline__ bool next(int i, Unit& u) const { const long L = (long)i * G + c; if (L >= nunits) return false; const int rt = (int)L / ntn, pl = (int)L % ntn; u.pm = rt; u.pn = tile_e[rt] * ntn + pl; return true; }
    __device__ __forceinline__ void a_ready(const Unit&) const {}
    __device__ __forceinline__ void done(const Unit&) const {}
};
template <class Epi, class Sched, bool STAMP = false, bool GATHER = false>
__device__ __forceinline__ void gemm_phase(PG8_LAS unsigned char* lds, const Gemm g, const Sched& S, const Epi& E, unsigned long long* stamps) {
    int tid_ = threadIdx.x; asm volatile("" : "+v"(tid_));
    const int tid = tid_, wid = __builtin_amdgcn_readfirstlane(tid >> 6), lane = tid & 63, wr = wid >> 2, wc = wid & 3, fr = lane & 15, fq = lane >> 4;
    const int K = g.K, nt = K / BK;
    int ts_lo = 0, ts_hi = 0, nts = 0; const unsigned long long rt_entry = STAMP ? (unsigned long long)wall_clock64() : 0ull;
#define PG8_STAMP() do { if (STAMP && wid == 0 && nts < 64) { const unsigned long long _c = (unsigned long long)clock64(); \
        ts_lo = (lane == nts) ? (int)(unsigned)_c : ts_lo; ts_hi = (lane == nts) ? (int)(unsigned)(_c >> 32) : ts_hi; ++nts; } } while (0)
    PG8_STAMP();
    unsigned voffA[2], voffB[2]; int gR[2]; unsigned gC[2];
#pragma unroll
    for (int i = 0; i < 2; ++i) { int R, C; stage_rc(tid * 16 + i * 8192, R, C); const int Rb = Epi::PERM ? ((R & ~31) + perm32(R & 31)) : R;
        voffA[i] = (unsigned)(R * K + C) * 2u; voffB[i] = (unsigned)(Rb * K + C) * 2u; gR[i] = R; gC[i] = (unsigned)C * 2u; }
    const size_t kstep = (size_t)(BK * 2);
    const size_t hstep = (size_t)HALF * K * 2;
    const size_t tstep = 2 * hstep;
    const unsigned ldsw = (unsigned)wid * 1024u;
    const int aoff = lds_byte(wr * 64 + fr, fq * 8), boff = lds_byte(wc * 32 + fr, fq * 8);
#define PG8_SA(b, h) (((b) * 2 + (h)) * HTB)
#define PG8_SB(b, h) ((4 + (b) * 2 + (h)) * HTB)
#define PG8_STAGE(bufoff, gbase, voff) do { _Pragma("unroll") for (int _i = 0; _i < 2; ++_i) \
        __builtin_amdgcn_global_load_lds((const unsigned*)((const char*)(gbase) + (voff)[_i]), (PG8_LAS unsigned*)(lds + (bufoff) + ldsw + _i * 8192), 16, 0, 0); } while (0)
#define PG8_LDA(dst, b, h) do { _Pragma("unroll") for (int m = 0; m < 4; ++m) _Pragma("unroll") for (int k = 0; k < 2; ++k) dst[m][k] = *(const PG8_LAS bf16x8*)(lds + PG8_SA(b, h) + aoff + m * 2048 + k * 1024); } while (0)
#define PG8_LDB(dst, b, h) do { _Pragma("unroll") for (int n = 0; n < 2; ++n) _Pragma("unroll") for (int k = 0; k < 2; ++k) dst[n][k] = *(const PG8_LAS bf16x8*)(lds + PG8_SB(b, h) + boff + n * 2048 + k * 1024); } while (0)
#define PG8_MMA(ai, bj, At, Bt) do { __builtin_amdgcn_s_setprio(1); _Pragma("unroll") for (int m = 0; m < 4; ++m) _Pragma("unroll") for (int n = 0; n < 2; ++n) _Pragma("unroll") for (int k = 0; k < 2; ++k) \
        acc[ai][bj][m][n] = __builtin_amdgcn_mfma_f32_16x16x32_bf16(Bt[n][k], At[m][k], acc[ai][bj][m][n], 0, 0, 0); __builtin_amdgcn_s_setprio(0); } while (0)
#define PG8_WAIT_V(n) asm volatile("s_waitcnt vmcnt(" #n ")" ::: "memory")
#define PG8_WAIT_L(n) asm volatile("s_waitcnt lgkmcnt(" #n ")" ::: "memory")
#define PG8_BAR __builtin_amdgcn_s_barrier()
#define PG8_SCHED __builtin_amdgcn_sched_barrier(0)
    Unit cur, nxt; int ui = 0;
    if (!S.next(0, cur)) return;
    f32x4 acc[2][2][4][2];
#pragma unroll
    for (int a = 0; a < 2; ++a)
#pragma unroll
        for (int b = 0; b < 2; ++b)
#pragma unroll
            for (int m = 0; m < 4; ++m)
#pragma unroll
                for (int n = 0; n < 2; ++n) acc[a][b][m][n] = (f32x4){0.f, 0.f, 0.f, 0.f};
    bf16x8 At[4][2], B0[2][2], B1[2][2];
    const char* cA = (const char*)g.A + (size_t)cur.pm * tstep; const char* cB = (const char*)g.Bt + (size_t)cur.pn * tstep;
    const char* gA = (const char*)g.A; unsigned voC[2][2], voN[2][2];
#define PG8_GATH(vo, u) do { _Pragma("unroll") for (int _h = 0; _h < 2; ++_h) _Pragma("unroll") for (int _i = 0; _i < 2; ++_i) \
        vo[_h][_i] = (unsigned)g.amap[(u).pm * BM + _h * HALF + gR[_i]] * (unsigned)(K * 2) + gC[_i]; } while (0)
    if constexpr (GATHER) { PG8_GATH(voC, cur); }
    S.a_ready(cur);
    PG8_STAGE(PG8_SB(0, 0), cB, voffB); if constexpr (GATHER) PG8_STAGE(PG8_SA(0, 0), gA, voC[0]); else PG8_STAGE(PG8_SA(0, 0), cA, voffA);
    PG8_STAGE(PG8_SB(0, 1), cB + hstep, voffB); if constexpr (GATHER) PG8_STAGE(PG8_SA(0, 1), gA, voC[1]); else PG8_STAGE(PG8_SA(0, 1), cA + hstep, voffA);
    if (wr == 1) PG8_BAR;
    PG8_WAIT_V(4); PG8_BAR;
    PG8_STAGE(PG8_SB(1, 0), cB + kstep, voffB); if constexpr (GATHER) PG8_STAGE(PG8_SA(1, 0), gA + kstep, voC[0]); else PG8_STAGE(PG8_SA(1, 0), cA + kstep, voffA);
    PG8_STAGE(PG8_SB(1, 1), cB + hstep + kstep, voffB);
    PG8_WAIT_V(6); PG8_BAR;
    PG8_STAMP();
    for (;;) {
        const bool has_next = S.next(ui + 1, nxt);
        if constexpr (GATHER) { if (has_next) { PG8_GATH(voN, nxt); } else { _Pragma("unroll") for (int _h = 0; _h < 2; ++_h) _Pragma("unroll") for (int _i = 0; _i < 2; ++_i) voN[_h][_i] = voC[_h][_i]; } }
        const char* nA = has_next ? (const char*)g.A + (size_t)nxt.pm * tstep : cA; const char* nB = has_next ? (const char*)g.Bt + (size_t)nxt.pn * tstep : cB;
        for (int t = 0; t < nt; t += 2) {
            const bool last = (t == nt - 2);
            const char* a1 = cA + (size_t)(t + 1) * kstep;
            const char* a2 = last ? nA : cA + (size_t)(t + 2) * kstep; const char* b2 = last ? nB : cB + (size_t)(t + 2) * kstep;
            const char* a3 = a2 + kstep; const char* b3 = b2 + kstep;
            const char* g1 = gA + (size_t)(t + 1) * kstep; const char* g2 = last ? gA : gA + (size_t)(t + 2) * kstep; const char* g3 = g2 + kstep; unsigned v2[2][2];
            if constexpr (GATHER) { _Pragma("unroll") for (int _h = 0; _h < 2; ++_h) _Pragma("unroll") for (int _i = 0; _i < 2; ++_i) v2[_h][_i] = last ? voN[_h][_i] : voC[_h][_i]; }
            if (last && has_next) S.a_ready(nxt);
            PG8_LDB(B0, 0, 0); PG8_SCHED; PG8_LDA(At, 0, 0); if constexpr (GATHER) PG8_STAGE(PG8_SA(1, 1), g1, voC[1]); else PG8_STAGE(PG8_SA(1, 1), a1 + hstep, voffA);
            PG8_WAIT_L(8); PG8_BAR; PG8_WAIT_L(0); PG8_MMA(0, 0, At, B0); PG8_BAR; PG8_SCHED;
            PG8_LDB(B1, 0, 1); PG8_STAGE(PG8_SB(0, 0), b2, voffB);
            PG8_BAR; PG8_WAIT_L(0); PG8_MMA(0, 1, At, B1); PG8_BAR;
            PG8_LDA(At, 0, 1); if constexpr (GATHER) PG8_STAGE(PG8_SA(0, 0), g2, v2[0]); else PG8_STAGE(PG8_SA(0, 0), a2, voffA);
            PG8_BAR; PG8_WAIT_L(0); PG8_MMA(1, 0, At, B0); PG8_BAR; PG8_SCHED;
            PG8_STAGE(PG8_SB(0, 1), b2 + hstep, voffB);
            PG8_WAIT_V(6); PG8_BAR; PG8_MMA(1, 1, At, B1); PG8_BAR;
            PG8_LDB(B0, 1, 0); PG8_SCHED; PG8_LDA(At, 1, 0); if constexpr (GATHER) PG8_STAGE(PG8_SA(0, 1), g2, v2[1]); else PG8_STAGE(PG8_SA(0, 1), a2 + hstep, voffA);
            PG8_WAIT_L(8); PG8_BAR; PG8_WAIT_L(0); PG8_MMA(0, 0, At, B0); PG8_BAR; PG8_SCHED;
            PG8_LDB(B1, 1, 1); PG8_STAGE(PG8_SB(1, 0), b3, voffB);
            PG8_BAR; PG8_WAIT_L(0); PG8_MMA(0, 1, At, B1); PG8_BAR;
            PG8_LDA(At, 1, 1); if constexpr (GATHER) PG8_STAGE(PG8_SA(1, 0), g3, v2[0]); else PG8_STAGE(PG8_SA(1, 0), a3, voffA);
            PG8_BAR; PG8_WAIT_L(0); PG8_MMA(1, 0, At, B0); PG8_BAR; PG8_SCHED;
            PG8_STAGE(PG8_SB(1, 1), b3 + hstep, voffB);
            PG8_WAIT_V(6); PG8_BAR; PG8_MMA(1, 1, At, B1); PG8_BAR;
        }
        PG8_STAMP();
        if constexpr (!Epi::AFTER_DRAIN) { E(acc, cur, wr, wc, fr, fq); S.done(cur); }
        PG8_STAMP();
        if (!has_next) break;
#pragma unroll
        for (int a = 0; a < 2; ++a)
#pragma unroll
            for (int b = 0; b < 2; ++b)
#pragma unroll
                for (int m = 0; m < 4; ++m)
#pragma unroll
                    for (int n = 0; n < 2; ++n) acc[a][b][m][n] = (f32x4){0.f, 0.f, 0.f, 0.f};
        cur = nxt; cA = nA; cB = nB; ++ui;
        if constexpr (GATHER) { _Pragma("unroll") for (int _h = 0; _h < 2; ++_h) _Pragma("unroll") for (int _i = 0; _i < 2; ++_i) voC[_h][_i] = voN[_h][_i]; }
    }
    PG8_WAIT_V(0);
    if (wr == 0) PG8_BAR;
    PG8_BAR;
    if constexpr (Epi::AFTER_DRAIN) { E.fused(acc, cur, wr, wc, fr, fq, lds, wid, lane); S.done(cur); }
    PG8_STAMP();
    if (STAMP && wid == 0) { stamps[lane] = lane < nts ? (((unsigned long long)(unsigned)ts_hi << 32) | (unsigned)ts_lo) : 0ull;
        if (lane == 62) stamps[62] = rt_entry; if (lane == 63) stamps[63] = (unsigned long long)wall_clock64(); }
#undef PG8_STAMP
#undef PG8_SA
#undef PG8_SB
#undef PG8_STAGE
#undef PG8_GATH
#undef PG8_LDA
#undef PG8_LDB
#undef PG8_MMA
#undef PG8_WAIT_V
#undef PG8_WAIT_L
#undef PG8_BAR
#undef PG8_SCHED
}
}
#define XB_TMO      128
#define XB_XCNT(j)  (256  + 64 * (j))
#define XB_XSUB(j)  (1280 + 64 * (j))
#define XB_XGEN(j)  (2304 + 64 * (j))
#define XB_TOP      3328
#define XB_TOPGEN   3392
#define XCD_BAR_WORDS 3456
#define XB_SPIN_CAP (1u << 18)

__device__ __forceinline__ unsigned xb_ld(unsigned* p)              { return __hip_atomic_load(p, __ATOMIC_RELAXED, __HIP_MEMORY_SCOPE_AGENT); }
__device__ __forceinline__ unsigned xb_add(unsigned* p, unsigned v) { return __hip_atomic_fetch_add(p, v, __ATOMIC_RELAXED, __HIP_MEMORY_SCOPE_AGENT); }
__device__ __forceinline__ unsigned xb_xcc_id() { return (unsigned)__builtin_amdgcn_s_getreg((3 << 11) | 20) & 0xFu; }
#define XB_SPIN(cond, bar) do { unsigned _sp = 0; while (cond) { __builtin_amdgcn_s_sleep(1); \
    if ((++_sp & 255u) == 0u) { if (xb_ld(&(bar)[XB_TMO])) break; if (_sp > XB_SPIN_CAP) { atomicAdd(&(bar)[XB_TMO], 1u); break; } } } } while (0)

struct XcdBarrier {
    unsigned* bar; unsigned x;
    volatile LAS unsigned* st;
};

__device__ __forceinline__ XcdBarrier xcd_barrier_post(unsigned* bar, volatile LAS unsigned* st) {
    XcdBarrier b; b.bar = bar; b.x = xb_xcc_id(); b.st = st;
    if (threadIdx.x == 0) (void)xb_add(&bar[XB_XCNT(b.x)], 1u);
    return b;
}
__device__ __forceinline__ void xcd_barrier_complete(unsigned* bar, unsigned x, unsigned& nloc, unsigned& nx) {
    const unsigned G = gridDim.x * gridDim.y * gridDim.z;
    unsigned sum, cnt, mine, sp = 0u;
    for (;;) {
        sum = 0u; cnt = 0u; mine = 0u;
#pragma unroll
        for (unsigned j = 0; j < 16; ++j) { const unsigned c = xb_ld(&bar[XB_XCNT(j)]); sum += c; cnt += (c > 0u) ? 1u : 0u; mine = (j == x) ? c : mine; }
        if (sum == G) break;
        __builtin_amdgcn_s_sleep(1);
        if ((++sp & 255u) == 0u) { if (xb_ld(&bar[XB_TMO])) break; if (sp > XB_SPIN_CAP) { atomicAdd(&bar[XB_TMO], 1u); break; } }
    }
    nloc = mine > 0u ? mine : 1u; nx = cnt > 0u ? cnt : 1u;
}

__device__ __forceinline__ void xcd_barrier(const XcdBarrier& b) {
    asm volatile("s_waitcnt vmcnt(0)" ::: "memory");
    __syncthreads();
    if (threadIdx.x == 0) {
        unsigned* bar = b.bar;
        __builtin_amdgcn_s_waitcnt(0);
        unsigned nloc = b.st[0], nx = b.st[1];
        if (nloc == 0u) { xcd_barrier_complete(bar, b.x, nloc, nx); b.st[0] = nloc; b.st[1] = nx; }
        const unsigned old = xb_add(&bar[XB_XSUB(b.x)], 1u);
        const unsigned gen = old / nloc;
        if (old + 1u == (gen + 1u) * nloc) {
            __builtin_amdgcn_fence(__ATOMIC_RELEASE, "agent");
            asm volatile("s_waitcnt vmcnt(0)" ::: "memory");
            const unsigned og = xb_add(&bar[XB_TOP], 1u);
            const unsigned tg = og / nx;
            if (og + 1u == (tg + 1u) * nx) xb_add(&bar[XB_TOPGEN], 1u);
            else XB_SPIN(xb_ld(&bar[XB_TOPGEN]) == tg, bar);
            __builtin_amdgcn_fence(__ATOMIC_ACQUIRE, "agent");
            xb_add(&bar[XB_XGEN(b.x)], 1u);
            asm volatile("s_waitcnt vmcnt(0)" ::: "memory");
        } else {
            XB_SPIN(xb_ld(&bar[XB_XGEN(b.x)]) == gen, bar);
            __builtin_amdgcn_fence(__ATOMIC_ACQUIRE, "agent");
            asm volatile("s_waitcnt vmcnt(0)" ::: "memory");
        }
    }
    __syncthreads();
}
template <int LD> DI bf16x8 frag_n(const LAS bf16_t* A, int row0, int k0, int lane) {
    return *(const LAS bf16x8*)(A + (row0 + (lane & 15)) * LD + k0 + 8 * (lane >> 4));
}
template <int LD> DI bf16x8 frag_t(const LAS bf16_t* A, int row0, int k0, int lane) {
    const int l = lane & 15, g = lane >> 4;
    const unsigned addr = (unsigned)(uintptr_t)(A + (k0 + 8 * g + (l >> 2)) * LD + row0 + 4 * (l & 3));
    s16x4 lo, hi;
    asm volatile("ds_read_b64_tr_b16 %0, %2\n\tds_read_b64_tr_b16 %1, %2 offset:%3\n\ts_waitcnt lgkmcnt(0)" : "=&v"(lo), "=&v"(hi) : "v"(addr), "n"(4 * LD * 2) : "memory");
    bf16x8 r; r[0] = lo[0]; r[1] = lo[1]; r[2] = lo[2]; r[3] = lo[3]; r[4] = hi[0]; r[5] = hi[1]; r[6] = hi[2]; r[7] = hi[3];
    return r;
}
DI bf16x8 gfrag(const bf16_t* A, int ld, int row0, int k0, int lane) {
    return *(const bf16x8*)(A + (size_t)(row0 + (lane & 15)) * ld + k0 + 8 * (lane >> 4));
}
#define MFMA16(a, b, c) __builtin_amdgcn_mfma_f32_16x16x32_bf16((a), (b), (c), 0, 0, 0)
template <bool XT, bool YT, int KS, int LDX, int LDY>
DI f32x4 mm16(const LAS bf16_t* X, const LAS bf16_t* Y, int p0, int q0, int lane, f32x4 acc) {
#pragma unroll
    for (int ks = 0; ks < KS; ++ks) {
        const bf16x8 xb = XT ? frag_t<LDX>(X, p0, 32 * ks, lane) : frag_n<LDX>(X, p0, 32 * ks, lane);
        const bf16x8 ya = YT ? frag_t<LDY>(Y, q0, 32 * ks, lane) : frag_n<LDY>(Y, q0, 32 * ks, lane);
        acc = MFMA16(ya, xb, acc);
    }
    return acc;
}
DI void st4_bf16(LAS bf16_t* p, const f32x4 v) { *(LAS u32x2*)p = pack4(v[0], v[1], v[2], v[3]); }
DI f32x4 ld4_bf16(const LAS bf16_t* p) { const u32x2 w = *(const LAS u32x2*)p; float f[4]; unpack4(w, f); return (f32x4){f[0], f[1], f[2], f[3]}; }
constexpr f32x4 F4Z = {0.f, 0.f, 0.f, 0.f};

struct TrFrag { s16x4 lo, hi; };
template <int LD> DI void tr_issue(TrFrag& f, const LAS bf16_t* A, int row0, int k0, int lane) {
    const int l = lane & 15, g = lane >> 4;
    const unsigned addr = (unsigned)(uintptr_t)(A + (k0 + 8 * g + (l >> 2)) * LD + row0 + 4 * (l & 3));
    asm volatile("ds_read_b64_tr_b16 %0, %2\n\tds_read_b64_tr_b16 %1, %2 offset:%3" : "=&v"(f.lo), "=&v"(f.hi) : "v"(addr), "n"(4 * LD * 2) : "memory");
}
DI bf16x8 tr_get(const TrFrag& f) { bf16x8 r; r[0] = f.lo[0]; r[1] = f.lo[1]; r[2] = f.lo[2]; r[3] = f.lo[3]; r[4] = f.hi[0]; r[5] = f.hi[1]; r[6] = f.hi[2]; r[7] = f.hi[3]; return r; }
template <int LD> DI void tr_issue4(TrFrag (&f)[2][2], const LAS bf16_t* A, int r0, int lane) {
    tr_issue<LD>(f[0][0], A, r0, 0, lane); tr_issue<LD>(f[0][1], A, r0, 32, lane); tr_issue<LD>(f[1][0], A, r0 + 16, 0, lane); tr_issue<LD>(f[1][1], A, r0 + 16, 32, lane); }
template <int LD> DI void tr_issue2(TrFrag (&f)[2], const LAS bf16_t* A, int r0, int lane) { tr_issue<LD>(f[0], A, r0, 0, lane); tr_issue<LD>(f[1], A, r0, 32, lane); }
#define TRW(f) "+v"((f).lo), "+v"((f).hi)
DI void tr_wait4(TrFrag (&a)[2][2]) { asm volatile("s_waitcnt lgkmcnt(0)" : TRW(a[0][0]), TRW(a[0][1]), TRW(a[1][0]), TRW(a[1][1]) :: "memory"); }
DI void tr_wait8(TrFrag (&a)[2][2], TrFrag (&b)[2][2]) { asm volatile("s_waitcnt lgkmcnt(0)" : TRW(a[0][0]), TRW(a[0][1]), TRW(a[1][0]), TRW(a[1][1]), TRW(b[0][0]), TRW(b[0][1]), TRW(b[1][0]), TRW(b[1][1]) :: "memory"); }
DI void tr_wait2(TrFrag (&a)[2]) { asm volatile("s_waitcnt lgkmcnt(0)" : TRW(a[0]), TRW(a[1]) :: "memory"); }
DI void tr_wait42(TrFrag (&a)[2][2], TrFrag (&b)[2]) { asm volatile("s_waitcnt lgkmcnt(0)" : TRW(a[0][0]), TRW(a[0][1]), TRW(a[1][0]), TRW(a[1][1]), TRW(b[0]), TRW(b[1]) :: "memory"); }
DI f32x4 mma2(const bf16x8 x0, const bf16x8 x1, const bf16x8 y0, const bf16x8 y1, f32x4 acc) { acc = MFMA16(y0, x0, acc); return MFMA16(y1, x1, acc); }
struct Params { const float* in[31]; float* out; unsigned char* ws; int ph_lo, ph_hi; };
#define CAS __attribute__((address_space(4)))
typedef const CAS Params& PR;
enum { I_X = 0, I_NMIX, I_WIN, I_LBRAW, I_ONORM, I_MU, I_W0, I_WUP, I_A0, I_AUP, I_GUP, I_KK, I_KA, I_RK, I_LNW, I_LNB, I_V0, I_VDOWN, I_VUP, I_WBH, I_WBR, I_WOUT, I_NFFN,
       I_RGW, I_RGB, I_REW, I_REB, I_EWG, I_EWU, I_EWD, I_FNW };
struct Ctx { LAS unsigned char* lds; int tid, lane, wave, G, bid; };

struct TItem { const float* W; bf16_t* WT; int ldw, ldt; };
DI void titem_load(const TItem& t, f32x4 (&v)[8], int lane) {
#pragma unroll
    for (int i = 0; i < 8; ++i) v[i] = __builtin_nontemporal_load((const f32x4*)(t.W + (size_t)(8 * i + (lane >> 3)) * t.ldw + 4 * (lane & 7)));
}
DI void titem_store(const TItem& t, const f32x4 (&v)[8], LAS float* scr, int lane) {
#pragma unroll
    for (int i = 0; i < 8; ++i) { LAS float* d = scr + (8 * i + (lane >> 3)) * 33 + 4 * (lane & 7); d[0] = v[i].x; d[1] = v[i].y; d[2] = v[i].z; d[3] = v[i].w; }
    asm volatile("s_waitcnt lgkmcnt(0)" ::: "memory");
    const int c = lane & 7;
#pragma unroll
    for (int j = 0; j < 4; ++j) { const int n = (lane >> 3) + 8 * j; const LAS float* s = scr + (8 * c) * 33 + n;
        u32x4 o; o.x = cvt_pk(s[0 * 33], s[1 * 33]); o.y = cvt_pk(s[2 * 33], s[3 * 33]); o.z = cvt_pk(s[4 * 33], s[5 * 33]); o.w = cvt_pk(s[6 * 33], s[7 * 33]);
        *(u32x4*)(t.WT + (size_t)n * t.ldt + 8 * c) = o; }
    asm volatile("s_waitcnt lgkmcnt(0)" ::: "memory");
}
DI TItem mk_titem(const float* W, int ldw, int k0, int n0, bf16_t* WT, int ldt, int drow0) { TItem t; t.W = W + (size_t)k0 * ldw + n0; t.WT = WT + (size_t)drow0 * ldt + k0; t.ldw = ldw; t.ldt = ldt; return t; }
DI TItem small_item(PR p, int l, int it) {
    unsigned char* ws = p.ws;
    constexpr int I_IN = 32 * 361, I_B = 16 * 64;
    int r = it;
    if (r < I_IN) return mk_titem(p.in[I_WIN] + (size_t)l * D * IN_WIDTH, IN_WIDTH, 64 * (r / 361), 32 * (r % 361), (bf16_t*)(ws + WS_WIN), D, 32 * (r % 361)); r -= I_IN;
    if (r < I_B) return mk_titem(p.in[I_WBH] + (size_t)l * 1024 * D, D, 64 * (r / 64), 32 * (r % 64), (bf16_t*)(ws + WS_WBH), 1024, 32 * (r % 64)); r -= I_B;
    if (r < I_B) return mk_titem(p.in[I_WBR] + (size_t)l * 1024 * D, D, 64 * (r / 64), 32 * (r % 64), (bf16_t*)(ws + WS_WBR), 1024, 32 * (r % 64)); r -= I_B;
    return mk_titem(p.in[I_WOUT] + (size_t)l * D * D, D, 64 * (r / 64), 32 * (r % 64), (bf16_t*)(ws + WS_WO), D, 32 * (r % 64));
}
DI TItem expert_item(PR p, int l, int it) {
    unsigned char* ws = p.ws;
    constexpr int PER_GU = 32 * 16, PER_D = 8 * 64;
    const int e = it / (2 * PER_GU + PER_D); int r = it % (2 * PER_GU + PER_D);
    if (r < 2 * PER_GU) { const int up = r >= PER_GU; if (up) r -= PER_GU; const int kb = r / 16, nb = r % 16, j0 = 32 * nb;
        return mk_titem((up ? p.in[I_EWU] : p.in[I_EWG]) + ((size_t)l * NEXP + e) * D * DEXP, DEXP, 64 * kb, j0, (bf16_t*)(ws + WS_WGU) + (size_t)e * 1024 * D, D, 256 * (j0 >> 7) + (j0 & 127) + (up ? 128 : 0)); }
    r -= 2 * PER_GU; const int kb = r / 64, nb = r % 64;
    return mk_titem(p.in[I_EWD] + ((size_t)l * NEXP + e) * DEXP * D, D, 64 * kb, 32 * nb, (bf16_t*)(ws + WS_WDN) + (size_t)e * D * DEXP, DEXP, 32 * nb);
}
template <bool EXPERT> DI void run_titems(PR p, const Ctx& c, int l, int lo, int hi, int wg0, int nwg) {
    LAS float* scr = (LAS float*)(c.lds + c.wave * 8448);
    const int gw = (c.bid - wg0) * 8 + c.wave, NGW = nwg * 8;
    for (int it = lo + gw; it < hi; it += 2 * NGW) {
        const int it2 = it + NGW; const bool has2 = it2 < hi;
        const TItem a = EXPERT ? expert_item(p, l, it) : small_item(p, l, it), b = EXPERT ? expert_item(p, l, has2 ? it2 : it) : small_item(p, l, has2 ? it2 : it);
        f32x4 va[8], vb[8]; titem_load(a, va, c.lane); titem_load(b, vb, c.lane);
        titem_store(a, va, scr, c.lane); if (has2) titem_store(b, vb, scr, c.lane);
    }
}
constexpr int SMALL_ITEMS = 32 * 361 + 2 * 16 * 64 + 32 * 64;
DI void convert_small(PR p, const Ctx& c, int l, int lo) {
    unsigned char* ws = p.ws;
    const int gw = c.bid * 8 + c.wave, NGW = c.G * 8;
    bf16_t* WIN = (bf16_t*)(ws + WS_WIN);
    const float* w_in = p.in[I_WIN] + (size_t)l * D * IN_WIDTH;
    run_titems<false>(p, c, l, lo, SMALL_ITEMS, 0, c.G);
    const int gt = c.bid * 512 + c.tid, NT = c.G * 512;
    bf16_t* WUPT = (bf16_t*)(ws + WS_LORA + LO_WUP); bf16_t* AUPT = (bf16_t*)(ws + WS_LORA + LO_AUP); bf16_t* GUPT = (bf16_t*)(ws + WS_LORA + LO_GUP); bf16_t* VUPT = (bf16_t*)(ws + WS_LORA + LO_VUP);
    bf16_t* WRH = (bf16_t*)(ws + WS_LORA + LO_WR); bf16_t* WRL = (bf16_t*)(ws + WS_LORA + LO_WRL);
    const float* wup = p.in[I_WUP] + (size_t)l * 64 * 1024; const float* aup = p.in[I_AUP] + (size_t)l * 64 * 1024; const float* gup = p.in[I_GUP] + (size_t)l * 160 * 1024;
    for (int i = gt; i < 1024 * 64; i += NT) { const int n = i >> 6, k = i & 63; WUPT[i] = (bf16_t)(cvt_pk(wup[k * 1024 + n], 0.f) & 0xffff); AUPT[i] = (bf16_t)(cvt_pk(aup[k * 1024 + n], 0.f) & 0xffff); }
    for (int i = gt; i < 1024 * 160; i += NT) { const int n = i / 160, k = i % 160; GUPT[i] = (bf16_t)(cvt_pk(gup[k * 1024 + n], 0.f) & 0xffff); }
    if (l == 1) { const float* vup = p.in[I_VUP]; for (int i = gt; i < 1024 * 32; i += NT) { const int n = i >> 5, k = i & 31; VUPT[i] = (bf16_t)(cvt_pk(vup[k * 1024 + n], 0.f) & 0xffff); } }
    const float* rgw = p.in[I_RGW] + (size_t)l * D * 4; const float* rew = p.in[I_REW] + (size_t)l * D * 32;
    for (int i = gt; i < 48 * 2048; i += NT) { const int cc = i >> 11, k = i & 2047; const float v = cc < 4 ? rgw[k * 4 + cc] : (cc < 36 ? rew[k * 32 + (cc - 4)] : 0.f);
        const unsigned hb = cvt_pk(v, 0.f) & 0xffffu; WRH[i] = (bf16_t)hb; WRL[i] = (bf16_t)(cvt_pk(v - __uint_as_float(hb << 16), 0.f) & 0xffffu); }
    if (l == 1) {
        const float* mu = p.in[I_MU] + 3360 + 2048; const float* vd = p.in[I_VDOWN];
        for (int k = gw; k < D; k += NGW) {
            float wv[16], wm[16];
#pragma unroll
            for (int j = 0; j < 16; ++j) { const int cc = c.lane + 64 * j; const float w = w_in[(size_t)k * IN_WIDTH + 6144 + cc], m = mu[cc]; wv[j] = w * (1.f - m); wm[j] = w * m; }
            float ra = 0.f, rb = 0.f;
            for (int n = 0; n < 32; ++n) { float sa = 0.f, sb = 0.f;
#pragma unroll
                for (int j = 0; j < 16; ++j) { const float v = vd[(size_t)(c.lane + 64 * j) * 32 + n]; sa += wv[j] * v; sb += wm[j] * v; }
                sa = wave_sum(sa); sb = wave_sum(sb); if (c.lane == n) { ra = sa; rb = sb; } }
            if (c.lane < 32) { WIN[(size_t)(ZC_VDA + c.lane) * D + k] = (bf16_t)(cvt_pk(ra, 0.f) & 0xffff); WIN[(size_t)(ZC_VDB + c.lane) * D + k] = (bf16_t)(cvt_pk(rb, 0.f) & 0xffff); }
        }
    }
}
constexpr int EXP_ITEMS = NEXP * (2 * 32 * 16 + 8 * 64);
#ifndef EXP_EARLY
#define EXP_EARLY 36864
#endif
DI void convert_experts_early(PR p, const Ctx& c, int l, int wg0, int nwg) { run_titems<true>(p, c, l, 0, EXP_EARLY, wg0, nwg); }
DI void convert_experts(PR p, const Ctx& c, int l, int lo) { run_titems<true>(p, c, l, lo, EXP_ITEMS, 0, c.G); }
DI void rms_row_bf16(const float* xrow, const float* w, bf16_t* orow, int lane) {
    const f32x4* xr = (const f32x4*)xrow + lane; const f32x4* wr = (const f32x4*)w + lane; f32x4 v[8], ww[8]; float s = 0.f;
#pragma unroll
    for (int j = 0; j < 8; ++j) { v[j] = xr[64 * j]; ww[j] = wr[64 * j]; }
#pragma unroll
    for (int j = 0; j < 8; ++j) s += (v[j].x * v[j].x + v[j].y * v[j].y) + (v[j].z * v[j].z + v[j].w * v[j].w);
    const float rstd = rsqrtf(wave_sum(s) * (1.f / D) + NORM_EPS);
    u32x2* o8 = (u32x2*)orow + lane;
#pragma unroll
    for (int j = 0; j < 8; ++j) o8[64 * j] = pack4(v[j].x * rstd * ww[j].x, v[j].y * rstd * ww[j].y, v[j].z * rstd * ww[j].z, v[j].w * rstd * ww[j].w);
}
constexpr int RL = 72;
constexpr int R_SLOT = 64 * RL * 2;
constexpr int R_EXTRA = 12 * R_SLOT;
constexpr int FL = 68;
#define RSLOT(i) ((LAS bf16_t*)(c.lds + (i) * R_SLOT))
struct R1In { u32x4 cur[5], prv[5]; };
DI R1In r1_load(const unsigned char* ws, int task, int tid) {
    R1In in;
    const int bh = task >> 5, ch = task & 31, b = bh >> 4, h = bh & 15, tok0 = ch * 64, m0 = b * TSEQ + tok0, t = tid >> 3, cg = tid & 7, ch0 = 64 * h + 8 * cg;
    const bf16_t* zr = (const bf16_t*)(ws + WS_Z) + (size_t)(m0 + t) * NZ; const bf16_t* zp = (tok0 + t) > 0 ? zr - NZ : zr;
    in.cur[0] = *(const u32x4*)(zr + ZC_R + ch0); in.prv[0] = *(const u32x4*)(zp + ZC_R + ch0); in.cur[1] = *(const u32x4*)(zr + ZC_K + ch0); in.prv[1] = *(const u32x4*)(zp + ZC_K + ch0);
    in.cur[2] = *(const u32x4*)(zr + ZC_V + ch0); in.prv[2] = *(const u32x4*)(zp + ZC_V + ch0); in.cur[3] = *(const u32x4*)(zr + ZC_WD + 8 * cg); in.prv[3] = *(const u32x4*)(zp + ZC_WD + 8 * cg);
    in.cur[4] = *(const u32x4*)(zr + ZC_AD + 8 * cg); in.prv[4] = *(const u32x4*)(zp + ZC_AD + 8 * cg);
    return in;
}
template <int PROF> DI R1In r1_task(PR p, const Ctx& c0, int l, int task, const R1In in, int next_task) {
    R1In nin;
#define SEC(b) (!(PROF & (b)))
#define GST(T, addr, val) do { const T v_ = (val); if (SEC(1)) *(T*)(addr) = v_; else asm volatile("" :: "v"(v_)); } while (0)
    Ctx c = c0; { int t_ = c0.tid; asm volatile("" : "+v"(t_)); c.tid = t_; c.lane = t_ & 63; unsigned lb_ = (unsigned)(uintptr_t)c0.lds; asm volatile("" : "+s"(lb_)); c.lds = (LAS unsigned char*)(uintptr_t)lb_; }
    unsigned char* ws = p.ws;
    const int bh = task >> 5, ch = task & 31, b = bh >> 4, h = bh & 15, tok0 = ch * 64, m0 = b * TSEQ + tok0;
    const int tid = c.tid, lane = c.lane, w = c.wave;
    const bf16_t* Z = (const bf16_t*)(ws + WS_Z);
    const int t = tid >> 3, cg = tid & 7, ch0 = 64 * h + 8 * cg;
    LAS float* LW = (LAS float*)(c.lds + R_EXTRA); LAS float* LA = LW + 64 * FL; LAS float* SEG = LA + 64 * FL;
    LAS float* LV = (LAS float*)(c.lds + 1 * R_SLOT);
    float r[8], k[8], v[8];
    const f32x4 w0A = *(const f32x4*)(p.in[I_W0] + l * 1024 + ch0), w0B = *(const f32x4*)(p.in[I_W0] + l * 1024 + ch0 + 4);
    const f32x4 a0A = *(const f32x4*)(p.in[I_A0] + l * 1024 + ch0), a0B = *(const f32x4*)(p.in[I_A0] + l * 1024 + ch0 + 4);
    const f32x4 kkA = *(const f32x4*)(p.in[I_KK] + l * 1024 + ch0), kkB = *(const f32x4*)(p.in[I_KK] + l * 1024 + ch0 + 4);
    const f32x4 kaA = *(const f32x4*)(p.in[I_KA] + l * 1024 + ch0), kaB = *(const f32x4*)(p.in[I_KA] + l * 1024 + ch0 + 4);
    const f32x4 rkA = *(const f32x4*)(p.in[I_RK] + l * 1024 + ch0), rkB = *(const f32x4*)(p.in[I_RK] + l * 1024 + ch0 + 4);
    if (!SEC(2)) {
#pragma unroll
        for (int j = 0; j < 8; ++j) { r[j] = 0.5f + 1e-3f * tid; k[j] = 0.25f + 1e-3f * lane; v[j] = 0.1f * w + 0.01f * j; } }
    if (SEC(2))
    {
        const bf16_t* zr = Z + (size_t)(m0 + t) * NZ; const bool has_prev = (tok0 + t) > 0; const bf16_t* zp = zr - NZ;
        const float* mu = p.in[I_MU] + (size_t)l * 3360;
        float cur[8], prv[8], wd[8], ad[8];
#define LERP_IN(dst, idx, mucol) do { unpack8(in.cur[idx], cur); if (has_prev) unpack8(in.prv[idx], prv); else { _Pragma("unroll") for (int j = 0; j < 8; ++j) prv[j] = 0.f; } \
            const f32x4 mA = *(const f32x4*)(mu + (mucol)), mB = *(const f32x4*)(mu + (mucol) + 4); const float mm[8] = {mA.x, mA.y, mA.z, mA.w, mB.x, mB.y, mB.z, mB.w}; \
            _Pragma("unroll") for (int j = 0; j < 8; ++j) dst[j] = cur[j] + mm[j] * (prv[j] - cur[j]); } while (0)
        LERP_IN(r, 0, ch0); LERP_IN(k, 1, 1024 + ch0); LERP_IN(v, 2, 2048 + ch0);
        LERP_IN(wd, 3, 3072 + 8 * cg); LERP_IN(ad, 4, 3136 + 8 * cg);
#pragma unroll
        for (int j = 0; j < 8; ++j) wd[j] = 1.0f - 2.0f / (1.0f + __expf(2.0f * wd[j]));
        *(LAS u32x4*)(RSLOT(7) + t * RL + 8 * cg) = pack8(wd);
        *(LAS u32x4*)(RSLOT(8) + t * RL + 8 * cg) = pack8(ad);
        const bf16_t* WUPT = (const bf16_t*)(ws + WS_LORA + LO_WUP) + (size_t)(64 * h) * 64; const bf16_t* AUPT = (const bf16_t*)(ws + WS_LORA + LO_AUP) + (size_t)(64 * h) * 64;
        *(LAS u32x4*)(RSLOT(9) + t * RL + 8 * cg) = *(const u32x4*)(WUPT + t * 64 + 8 * cg);
        *(LAS u32x4*)(RSLOT(10) + t * RL + 8 * cg) = *(const u32x4*)(AUPT + t * 64 + 8 * cg);
        if (l == 1) {
            if (cg < 4) { float a8[8], b8[8]; unpack8(*(const u32x4*)(zr + ZC_VDA + 8 * cg), a8); if (has_prev) unpack8(*(const u32x4*)(zp + ZC_VDB + 8 * cg), b8); else {
#pragma unroll
                    for (int j = 0; j < 8; ++j) b8[j] = 0.f; }
#pragma unroll
                for (int j = 0; j < 8; ++j) a8[j] += b8[j];
                *(LAS u32x4*)(RSLOT(11) + t * 40 + 8 * cg) = pack8(a8);
                const bf16_t* VUPT = (const bf16_t*)(ws + WS_LORA + LO_VUP) + (size_t)(64 * h) * 32;
                *(LAS u32x4*)(RSLOT(0) + t * 40 + 8 * cg) = *(const u32x4*)(VUPT + t * 32 + 8 * cg); }
        }
    }
    lds_barrier();
    const int pt = w >> 1, qb = 2 * (w & 1), fr = lane & 15, fq = lane >> 4;
    if (SEC(4)) {
#pragma unroll
        for (int i = 0; i < 2; ++i) { const int qt = qb + i;
            const f32x4 aw = mm16<false, false, 2, RL, RL>(RSLOT(7), RSLOT(9), 16 * pt, 16 * qt, lane, F4Z);
            const f32x4 aa = mm16<false, false, 2, RL, RL>(RSLOT(8), RSLOT(10), 16 * pt, 16 * qt, lane, F4Z);
            *(LAS f32x4*)(LW + (16 * pt + fr) * FL + 16 * qt + 4 * fq) = aw; *(LAS f32x4*)(LA + (16 * pt + fr) * FL + 16 * qt + 4 * fq) = aa;
            if (l == 1) { const f32x4 av = mm16<false, false, 1, 40, 40>(RSLOT(11), RSLOT(0), 16 * pt, 16 * qt, lane, F4Z); *(LAS f32x4*)(LV + (16 * pt + fr) * FL + 16 * qt + 4 * fq) = av; }
        }
    }
    lds_barrier();
    float lw[8], a[8], kk[8], kp[8];
    {
        const float w0[8] = {w0A.x, w0A.y, w0A.z, w0A.w, w0B.x, w0B.y, w0B.z, w0B.w}, a0[8] = {a0A.x, a0A.y, a0A.z, a0A.w, a0B.x, a0B.y, a0B.z, a0B.w};
        const float k_k[8] = {kkA.x, kkA.y, kkA.z, kkA.w, kkB.x, kkB.y, kkB.z, kkB.w}, k_a[8] = {kaA.x, kaA.y, kaA.z, kaA.w, kaB.x, kaB.y, kaB.z, kaB.w};
        const float r_k[8] = {rkA.x, rkA.y, rkA.z, rkA.w, rkB.x, rkB.y, rkB.z, rkB.w};
        const f32x4 lwA = *(const LAS f32x4*)(LW + t * FL + 8 * cg), lwB = *(const LAS f32x4*)(LW + t * FL + 8 * cg + 4);
        const f32x4 laA = *(const LAS f32x4*)(LA + t * FL + 8 * cg), laB = *(const LAS f32x4*)(LA + t * FL + 8 * cg + 4);
        const float lwr[8] = {lwA.x, lwA.y, lwA.z, lwA.w, lwB.x, lwB.y, lwB.z, lwB.w}, lar[8] = {laA.x, laA.y, laA.z, laA.w, laB.x, laB.y, laB.z, laB.w};
        bf16_t* VFIRST = (bf16_t*)(ws + WS_VFIRST) + (size_t)(m0 + t) * 1024 + ch0;
        if (l == 1) {
            const f32x4 lvA = *(const LAS f32x4*)(LV + t * FL + 8 * cg), lvB = *(const LAS f32x4*)(LV + t * FL + 8 * cg + 4);
            const float lvr[8] = {lvA.x, lvA.y, lvA.z, lvA.w, lvB.x, lvB.y, lvB.z, lvB.w};
            const f32x4 v0A = *(const f32x4*)(p.in[I_V0] + ch0), v0B = *(const f32x4*)(p.in[I_V0] + ch0 + 4); const float v0[8] = {v0A.x, v0A.y, v0A.z, v0A.w, v0B.x, v0B.y, v0B.z, v0B.w};
            float vf[8]; unpack8(*(const u32x4*)VFIRST, vf);
#pragma unroll
            for (int j = 0; j < 8; ++j) v[j] = v[j] + (vf[j] - v[j]) * sigm(v0[j] + lvr[j]);
            GST(u32x4, (bf16_t*)(ws + WS_VF) + (size_t)(m0 + t) * 1024 + ch0, pack8(v));
        } else { GST(u32x4, VFIRST, pack8(v)); }
        float ss = 0.f, rks = 0.f;
#pragma unroll
        for (int j = 0; j < 8; ++j) { lw[j] = -0.60653066f * sigm(w0[j] + lwr[j]); a[j] = sigm(a0[j] + lar[j]); kk[j] = k[j] * k_k[j]; ss += kk[j] * kk[j];
            kp[j] = k[j] * (1.0f + (a[j] - 1.0f) * k_a[j]); rks += r[j] * kp[j] * r_k[j]; }
        ss += __shfl_xor(ss, 1); ss += __shfl_xor(ss, 2); ss += __shfl_xor(ss, 4);
        rks += __shfl_xor(rks, 1); rks += __shfl_xor(rks, 2); rks += __shfl_xor(rks, 4);
        const float inv = rsqrtf(fmaxf(ss, 1e-12f));
#pragma unroll
        for (int j = 0; j < 8; ++j) kk[j] *= inv;
        if (SEC(1) && cg == 0) ((float*)(ws + WS_RK))[(size_t)(m0 + t) * 16 + h] = rks;
    }
    nin = r1_load(ws, next_task, tid);
    lds_barrier();
    *(LAS f32x4*)(LW + t * FL + 8 * cg) = (f32x4){lw[0], lw[1], lw[2], lw[3]}; *(LAS f32x4*)(LW + t * FL + 8 * cg + 4) = (f32x4){lw[4], lw[5], lw[6], lw[7]};
    lds_barrier();
    if (SEC(8)) {
        const int j = tid & 63, sg = tid >> 6; float s = 0.f;
#pragma unroll
        for (int i = 0; i < 8; ++i) s += LW[(8 * sg + i) * FL + j];
        SEG[sg * 64 + j] = s;
        lds_barrier();
        float off = 0.f;
        for (int s2 = 0; s2 < sg; ++s2) off += SEG[s2 * 64 + j];
#pragma unroll
        for (int i = 0; i < 8; ++i) { off += LW[(8 * sg + i) * FL + j]; LW[(8 * sg + i) * FL + j] = off; }
    }
    lds_barrier();
    {
        const f32x4 cA = *(const LAS f32x4*)(LW + t * FL + 8 * cg), cB = *(const LAS f32x4*)(LW + t * FL + 8 * cg + 4);
        const f32x4 eA = *(const LAS f32x4*)(LW + 63 * FL + 8 * cg), eB = *(const LAS f32x4*)(LW + 63 * FL + 8 * cg + 4);
        const float cs[8] = {cA.x, cA.y, cA.z, cA.w, cB.x, cB.y, cB.z, cB.w}, ce[8] = {eA.x, eA.y, eA.z, eA.w, eB.x, eB.y, eB.z, eB.w};
        float Rt[8], At[8], Bt[8], Kt[8], Bp[8], Kp[8];
#pragma unroll
        for (int j = 0; j < 8; ++j) { const float ep = __expf(cs[j]), em = __expf(-cs[j]), el = __expf(ce[j] - cs[j]), ex = __expf(cs[j] - lw[j]); const float bv = kk[j] * a[j];
            Rt[j] = r[j] * ep; At[j] = -kk[j] * ex; Bt[j] = bv * em; Kt[j] = kp[j] * em; Bp[j] = bv * el; Kp[j] = kp[j] * el; }
        *(LAS u32x4*)(RSLOT(0) + t * RL + 8 * cg) = pack8(Rt); *(LAS u32x4*)(RSLOT(1) + t * RL + 8 * cg) = pack8(At); *(LAS u32x4*)(RSLOT(2) + t * RL + 8 * cg) = pack8(Bt);
        *(LAS u32x4*)(RSLOT(3) + t * RL + 8 * cg) = pack8(Kt); *(LAS u32x4*)(RSLOT(4) + t * RL + 8 * cg) = pack8(Bp); *(LAS u32x4*)(RSLOT(5) + t * RL + 8 * cg) = pack8(Kp);
        *(LAS u32x4*)(RSLOT(6) + t * RL + 8 * cg) = pack8(v);
    }
    lds_barrier();
    const int p0 = 16 * pt, prow = p0 + fr;
    if (SEC(16)) {
#pragma unroll
        for (int i = 0; i < 2; ++i) { const int q0 = 16 * (qb + i), qc = q0 + 4 * fq;
            f32x4 ab = mm16<false, false, 2, RL, RL>(RSLOT(1), RSLOT(2), p0, q0, lane, F4Z);
            f32x4 ak = mm16<false, false, 2, RL, RL>(RSLOT(1), RSLOT(3), p0, q0, lane, F4Z);
            f32x4 rb = mm16<false, false, 2, RL, RL>(RSLOT(0), RSLOT(2), p0, q0, lane, F4Z);
            f32x4 rk = mm16<false, false, 2, RL, RL>(RSLOT(0), RSLOT(3), p0, q0, lane, F4Z);
#pragma unroll
            for (int rr = 0; rr < 4; ++rr) { const int s = qc + rr; if (s >= prow) { ab[rr] = 0.f; ak[rr] = 0.f; } if (s > prow) { rb[rr] = 0.f; rk[rr] = 0.f; } }
            st4_bf16(RSLOT(7) + prow * RL + qc, ab); st4_bf16(RSLOT(9) + prow * RL + qc, ak); st4_bf16(RSLOT(10) + prow * RL + qc, rb); st4_bf16(RSLOT(11) + prow * RL + qc, rk); }
    }
    lds_barrier();
    const int qa = 16 * qb, qca = qa + 4 * fq, qcb = qca + 16;
    if (SEC(32)) {
        TrFrag yl[2][2]; tr_issue4<RL>(yl, RSLOT(7), qa, lane);
        const bf16x8 xl0 = frag_n<RL>(RSLOT(7), p0, 0, lane), xl1 = frag_n<RL>(RSLOT(7), p0, 32, lane);
        f32x4 t1a = ld4_bf16(RSLOT(7) + prow * RL + qca), t1b = ld4_bf16(RSLOT(7) + prow * RL + qcb);
        tr_wait4(yl);
        const f32x4 la = mma2(xl0, xl1, tr_get(yl[0][0]), tr_get(yl[0][1]), F4Z), lb = mma2(xl0, xl1, tr_get(yl[1][0]), tr_get(yl[1][1]), F4Z);
#pragma unroll
        for (int rr = 0; rr < 4; ++rr) { if (qca + rr == prow) t1a[rr] += 1.0f; if (qcb + rr == prow) t1b[rr] += 1.0f; }
        st4_bf16(RSLOT(8) + prow * RL + qca, la); st4_bf16(RSLOT(8) + prow * RL + qcb, lb); st4_bf16(RSLOT(2) + prow * RL + qca, t1a); st4_bf16(RSLOT(2) + prow * RL + qcb, t1b);
    }
    lds_barrier();
#define NSTEP(LS, LD_, TS, TD, SQ) do { TrFrag yl[2][2]; tr_issue4<RL>(yl, RSLOT(LS), qa, lane); \
        const bf16x8 xt0 = frag_n<RL>(RSLOT(TS), p0, 0, lane), xt1 = frag_n<RL>(RSLOT(TS), p0, 32, lane), xl0 = frag_n<RL>(RSLOT(LS), p0, 0, lane), xl1 = frag_n<RL>(RSLOT(LS), p0, 32, lane); \
        const f32x4 ta0 = ld4_bf16(RSLOT(TS) + prow * RL + qca), tb0 = ld4_bf16(RSLOT(TS) + prow * RL + qcb); \
        tr_wait4(yl); const bf16x8 y00 = tr_get(yl[0][0]), y01 = tr_get(yl[0][1]), y10 = tr_get(yl[1][0]), y11 = tr_get(yl[1][1]); \
        const f32x4 tna = mma2(xt0, xt1, y00, y01, ta0), tnb = mma2(xt0, xt1, y10, y11, tb0); \
        if (SQ) { const f32x4 la = mma2(xl0, xl1, y00, y01, F4Z), lb = mma2(xl0, xl1, y10, y11, F4Z); st4_bf16(RSLOT(LD_) + prow * RL + qca, la); st4_bf16(RSLOT(LD_) + prow * RL + qcb, lb); } \
        st4_bf16(RSLOT(TD) + prow * RL + qca, tna); st4_bf16(RSLOT(TD) + prow * RL + qcb, tnb); lds_barrier(); } while (0)
    if (SEC(32)) NSTEP(8, 7, 2, 3, 1);
    if (SEC(32)) NSTEP(7, 8, 3, 2, 1);
    if (SEC(32)) NSTEP(8, 7, 2, 3, 1);
    if (SEC(32)) NSTEP(7, 8, 3, 2, 1);
    if (SEC(32)) NSTEP(8, 7, 2, 3, 0);
#undef NSTEP
    if (SEC(64)) {
        TrFrag ya[2][2], yv[2][2]; tr_issue4<RL>(ya, RSLOT(1), qa, lane); tr_issue4<RL>(yv, RSLOT(6), qa, lane);
        const bf16x8 xt0 = frag_n<RL>(RSLOT(3), p0, 0, lane), xt1 = frag_n<RL>(RSLOT(3), p0, 32, lane), xk0 = frag_n<RL>(RSLOT(9), p0, 0, lane), xk1 = frag_n<RL>(RSLOT(9), p0, 32, lane);
        tr_wait8(ya, yv);
        const f32x4 pa = mma2(xt0, xt1, tr_get(ya[0][0]), tr_get(ya[0][1]), F4Z), pb2 = mma2(xt0, xt1, tr_get(ya[1][0]), tr_get(ya[1][1]), F4Z);
        const f32x4 ga = mma2(xk0, xk1, tr_get(yv[0][0]), tr_get(yv[0][1]), F4Z), gb = mma2(xk0, xk1, tr_get(yv[1][0]), tr_get(yv[1][1]), F4Z);
        st4_bf16(RSLOT(7) + prow * RL + qca, pa); st4_bf16(RSLOT(7) + prow * RL + qcb, pb2); st4_bf16(RSLOT(8) + prow * RL + qca, ga); st4_bf16(RSLOT(8) + prow * RL + qcb, gb);
    }
    lds_barrier();
    if (SEC(64)) {
        TrFrag yg[2][2]; tr_issue4<RL>(yg, RSLOT(8), qa, lane);
        const bf16x8 xt0 = frag_n<RL>(RSLOT(3), p0, 0, lane), xt1 = frag_n<RL>(RSLOT(3), p0, 32, lane);
        tr_wait4(yg);
        const f32x4 q0v = mma2(xt0, xt1, tr_get(yg[0][0]), tr_get(yg[0][1]), F4Z), q1v = mma2(xt0, xt1, tr_get(yg[1][0]), tr_get(yg[1][1]), F4Z);
        st4_bf16(RSLOT(9) + prow * RL + qca, q0v); st4_bf16(RSLOT(9) + prow * RL + qcb, q1v);
    }
    lds_barrier();
    if (SEC(64)) {
        const size_t blk = (size_t)task * 4096;
        const int pia = 16 * fq + 4 * qb, pib = pia + 4, mka = 32 * (qb >> 1) + 8 * fq, mkb = mka + 4;
        bf16_t* RP = (bf16_t*)(ws + WS_RP) + blk; bf16_t* Y0 = (bf16_t*)(ws + WS_Y0) + blk; bf16_t* MT = (bf16_t*)(ws + WS_MT) + blk; bf16_t* NN = (bf16_t*)(ws + WS_NN) + blk;
        {
            TrFrag yp[2][2], yq[2][2]; tr_issue4<RL>(yp, RSLOT(7), qa, lane); tr_issue4<RL>(yq, RSLOT(9), qa, lane);
            const bf16x8 xb0 = frag_n<RL>(RSLOT(10), p0, 0, lane), xb1 = frag_n<RL>(RSLOT(10), p0, 32, lane), xk0 = frag_n<RL>(RSLOT(11), p0, 0, lane), xk1 = frag_n<RL>(RSLOT(11), p0, 32, lane);
            const f32x4 r0a = ld4_bf16(RSLOT(0) + prow * RL + qca), r0b = ld4_bf16(RSLOT(0) + prow * RL + qcb);
            tr_wait8(yp, yq);
            const f32x4 rpa = mma2(xb0, xb1, tr_get(yp[0][0]), tr_get(yp[0][1]), r0a), rpb = mma2(xb0, xb1, tr_get(yp[1][0]), tr_get(yp[1][1]), r0b);
            f32x4 y0a = mma2(xb0, xb1, tr_get(yq[0][0]), tr_get(yq[0][1]), F4Z), y0b = mma2(xb0, xb1, tr_get(yq[1][0]), tr_get(yq[1][1]), F4Z);
            TrFrag yv[2][2]; tr_issue4<RL>(yv, RSLOT(6), qa, lane); tr_wait4(yv);
            y0a = mma2(xk0, xk1, tr_get(yv[0][0]), tr_get(yv[0][1]), y0a); y0b = mma2(xk0, xk1, tr_get(yv[1][0]), tr_get(yv[1][1]), y0b);
            GST(u32x2, RP + prow * 64 + pia, pack4(rpa[0], rpa[1], rpa[2], rpa[3])); GST(u32x2, RP + prow * 64 + pib, pack4(rpb[0], rpb[1], rpb[2], rpb[3]));
            GST(u32x2, Y0 + prow * 64 + qca, pack4(y0a[0], y0a[1], y0a[2], y0a[3])); GST(u32x2, Y0 + prow * 64 + qcb, pack4(y0b[0], y0b[1], y0b[2], y0b[3]));
        }
        {
            TrFrag xbp[2], yp[2][2]; tr_issue2<RL>(xbp, RSLOT(4), p0, lane); tr_issue4<RL>(yp, RSLOT(7), qa, lane); tr_wait42(yp, xbp);
            const bf16x8 xb0 = tr_get(xbp[0]), xb1 = tr_get(xbp[1]);
            f32x4 mta = mma2(xb0, xb1, tr_get(yp[0][0]), tr_get(yp[0][1]), F4Z), mtb = mma2(xb0, xb1, tr_get(yp[1][0]), tr_get(yp[1][1]), F4Z);
            const float dg = __expf(LW[63 * FL + prow]);
#pragma unroll
            for (int rr = 0; rr < 4; ++rr) { if (qca + rr == prow) mta[rr] += dg; if (qcb + rr == prow) mtb[rr] += dg; }
            GST(u32x2, MT + prow * 64 + mka, pack4(mta[0], mta[1], mta[2], mta[3])); GST(u32x2, MT + prow * 64 + mkb, pack4(mtb[0], mtb[1], mtb[2], mtb[3]));
            TrFrag xq[2], ybp[2][2]; tr_issue2<RL>(xq, RSLOT(9), p0, lane); tr_issue4<RL>(ybp, RSLOT(4), qa, lane); tr_wait42(ybp, xq);
            f32x4 nna = mma2(tr_get(xq[0]), tr_get(xq[1]), tr_get(ybp[0][0]), tr_get(ybp[0][1]), F4Z), nnb = mma2(tr_get(xq[0]), tr_get(xq[1]), tr_get(ybp[1][0]), tr_get(ybp[1][1]), F4Z);
            TrFrag xv[2], ykp[2][2]; tr_issue2<RL>(xv, RSLOT(6), p0, lane); tr_issue4<RL>(ykp, RSLOT(5), qa, lane); tr_wait42(ykp, xv);
            nna = mma2(tr_get(xv[0]), tr_get(xv[1]), tr_get(ykp[0][0]), tr_get(ykp[0][1]), nna); nnb = mma2(tr_get(xv[0]), tr_get(xv[1]), tr_get(ykp[1][0]), tr_get(ykp[1][1]), nnb);
            GST(u32x2, NN + prow * 64 + pia, pack4(nna[0], nna[1], nna[2], nna[3])); GST(u32x2, NN + prow * 64 + pib, pack4(nnb[0], nnb[1], nnb[2], nnb[3]));
        }
    }
    lds_barrier();
    return nin;
}
#undef SEC
#undef GST
constexpr int HL = 136, HCL = 132, SCL = 72, HC = 64;
constexpr int H_QT = 0, H_KT = HC * HL * 2  , H_KP = 2 * H_KT, H_V = 3 * H_KT, H_CS = 4 * H_KT  , H_SEG = H_CS + HC * HCL * 4  , H_SC = H_SEG + 4 * 128 * 4  ,
              H_NTS = H_CS;
DI float hg_lb(PR p, int l, int chn) { if (l == 0) return 0.f; const float* raw = p.in[I_LBRAW]; return sigm(raw[1024 + chn] - raw[chn]); }
struct H1In { u32x4 zq[2], zf[2], zi[2]; };
DI H1In h1_load(const unsigned char* ws, int task, int tid) {
    const int bh = task >> 5, ch = task & 31, b = bh >> 3, h = bh & 7, m0 = b * TSEQ + ch * HC, t0 = tid >> 4, cg = tid & 15, chn = 128 * h + 8 * cg;
    H1In in;
#pragma unroll
    for (int u = 0; u < 2; ++u) { const bf16_t* zr = (const bf16_t*)(ws + WS_Z) + (size_t)(m0 + t0 + 32 * u) * NZ;
        in.zq[u] = *(const u32x4*)(zr + ZC_Q + chn); in.zf[u] = *(const u32x4*)(zr + ZC_F + chn); in.zi[u] = *(const u32x4*)(zr + ZC_I + chn); }
    return in;
}
DI H1In h1_task(PR p, const Ctx& c0, int l, int task, const H1In in, int next_task) {
    Ctx c = c0; { int t_ = c0.tid; asm volatile("" : "+v"(t_)); c.tid = t_; c.lane = t_ & 63; unsigned lb_ = (unsigned)(uintptr_t)c0.lds; asm volatile("" : "+s"(lb_)); c.lds = (LAS unsigned char*)(uintptr_t)lb_; }
    unsigned char* ws = p.ws;
    const int bh = task >> 5, ch = task & 31, b = bh >> 3, h = bh & 7, m0 = b * TSEQ + ch * HC;
    const int tid = c.tid, lane = c.lane, w = c.wave, fr = lane & 15, fq = lane >> 4;
    const bf16_t* Z = (const bf16_t*)(ws + WS_Z);
    LAS bf16_t* QTs = (LAS bf16_t*)(c.lds + H_QT); LAS bf16_t* KTs = (LAS bf16_t*)(c.lds + H_KT); LAS bf16_t* KPs = (LAS bf16_t*)(c.lds + H_KP); LAS bf16_t* Vs = (LAS bf16_t*)(c.lds + H_V);
    LAS float* CS = (LAS float*)(c.lds + H_CS); LAS float* SEG = (LAS float*)(c.lds + H_SEG); LAS bf16_t* SC = (LAS bf16_t*)(c.lds + H_SC); LAS bf16_t* NTS = (LAS bf16_t*)(c.lds + H_NTS);
    const int t0 = tid >> 4, cg = tid & 15, chn = 128 * h + 8 * cg;
    float q[2][8], kf[2][8];
    u32x4 vraw[2];
    {
        float lbv[8];
#pragma unroll
        for (int j = 0; j < 8; ++j) lbv[j] = hg_lb(p, l, chn + j);
#pragma unroll
        for (int u = 0; u < 2; ++u) { const int t = t0 + 32 * u;
            float zq[8], zf[8]; unpack8(in.zq[u], zq); unpack8(in.zf[u], zf); vraw[u] = in.zi[u];
            float g[8];
#pragma unroll
            for (int j = 0; j < 8; ++j) { const float f = lbv[j] + (1.0f - lbv[j]) * sigm(zf[j]); q[u][j] = zq[j] * sigm(zq[j]); kf[u][j] = 1.0f - f; g[j] = __logf(f); }
            *(LAS f32x4*)(CS + t * HCL + 8 * cg) = (f32x4){g[0], g[1], g[2], g[3]}; *(LAS f32x4*)(CS + t * HCL + 8 * cg + 4) = (f32x4){g[4], g[5], g[6], g[7]}; }
    }
    const H1In nin = h1_load(ws, next_task, tid);
    lds_barrier();
    {   const int j = tid & 127, sg = tid >> 7; float s = 0.f;
#pragma unroll
        for (int i = 0; i < 16; ++i) s += CS[(16 * sg + i) * HCL + j];
        SEG[sg * 128 + j] = s;
        lds_barrier();
        float off = 0.f;
        for (int s2 = 0; s2 < sg; ++s2) off += SEG[s2 * 128 + j];
#pragma unroll
        for (int i = 0; i < 16; ++i) { off += CS[(16 * sg + i) * HCL + j]; CS[(16 * sg + i) * HCL + j] = off; }
    }
    lds_barrier();
    {
        const f32x4 rA = *(const LAS f32x4*)(CS + 31 * HCL + 8 * cg), rB = *(const LAS f32x4*)(CS + 31 * HCL + 8 * cg + 4);
        const f32x4 eA = *(const LAS f32x4*)(CS + 63 * HCL + 8 * cg), eB = *(const LAS f32x4*)(CS + 63 * HCL + 8 * cg + 4);
        const float cr[8] = {rA.x, rA.y, rA.z, rA.w, rB.x, rB.y, rB.z, rB.w}, ce[8] = {eA.x, eA.y, eA.z, eA.w, eB.x, eB.y, eB.z, eB.w};
#pragma unroll
        for (int u = 0; u < 2; ++u) { const int t = t0 + 32 * u;
            const f32x4 cA = *(const LAS f32x4*)(CS + t * HCL + 8 * cg), cB = *(const LAS f32x4*)(CS + t * HCL + 8 * cg + 4);
            const float cs[8] = {cA.x, cA.y, cA.z, cA.w, cB.x, cB.y, cB.z, cB.w};
            float qh[8], qt[8], kt[8], kp[8];
#pragma unroll
            for (int j = 0; j < 8; ++j) { qh[j] = q[u][j] * __expf(cs[j]); qt[j] = q[u][j] * __expf(cs[j] - cr[j]); kt[j] = kf[u][j] * __expf(cr[j] - cs[j]); kp[j] = kf[u][j] * __expf(ce[j] - cs[j]); }
            *(LAS u32x4*)(QTs + t * HL + 8 * cg) = pack8(qt); *(LAS u32x4*)(KTs + t * HL + 8 * cg) = pack8(kt); *(LAS u32x4*)(KPs + t * HL + 8 * cg) = pack8(kp); *(LAS u32x4*)(Vs + t * HL + 8 * cg) = vraw[u];
            *(u32x4*)((bf16_t*)(ws + WS_QH) + (size_t)(m0 + t) * 1024 + chn) = pack8(qh);
            if (t == 63) { float* DC = (float*)(ws + WS_DC) + (size_t)task * 128 + 8 * cg; *(f32x4*)DC = (f32x4){__expf(ce[0]), __expf(ce[1]), __expf(ce[2]), __expf(ce[3])}; *(f32x4*)(DC + 4) = (f32x4){__expf(ce[4]), __expf(ce[5]), __expf(ce[6]), __expf(ce[7])}; } }
    }
    lds_barrier();
    {
        const int p0 = 16 * (w >> 1), prow = p0 + fr;
#pragma unroll
        for (int i = 0; i < 2; ++i) { const int q0 = 16 * (2 * (w & 1) + i), qc = q0 + 4 * fq;
            f32x4 sc = mm16<false, false, 4, HL, HL>(QTs, KTs, p0, q0, lane, F4Z);
#pragma unroll
            for (int rr = 0; rr < 4; ++rr) if (qc + rr > prow) sc[rr] = 0.f;
            st4_bf16(SC + prow * SCL + qc, sc); }
        TrFrag xv[2]; tr_issue2<HL>(xv, Vs, 16 * w, lane);
#pragma unroll
        for (int dp = 0; dp < 4; ++dp) { TrFrag yk[2][2]; tr_issue4<HL>(yk, KPs, 32 * dp, lane);
            if (dp == 0) tr_wait42(yk, xv); else tr_wait4(yk);
            const bf16x8 x0 = tr_get(xv[0]), x1 = tr_get(xv[1]);
            const f32x4 na = mma2(x0, x1, tr_get(yk[0][0]), tr_get(yk[0][1]), F4Z), nb = mma2(x0, x1, tr_get(yk[1][0]), tr_get(yk[1][1]), F4Z);
            st4_bf16(NTS + (16 * w + fr) * HL + 32 * dp + 4 * fq, na); st4_bf16(NTS + (16 * w + fr) * HL + 32 * dp + 16 + 4 * fq, nb); }
    }
    lds_barrier();
    {
        bf16_t* OI = (bf16_t*)(ws + WS_OI);
        TrFrag yv[2]; tr_issue2<HL>(yv, Vs, 16 * w, lane); tr_wait2(yv);
        const bf16x8 y0 = tr_get(yv[0]), y1 = tr_get(yv[1]);
#pragma unroll
        for (int pt = 0; pt < 4; ++pt) { const f32x4 o = mma2(frag_n<SCL>(SC, 16 * pt, 0, lane), frag_n<SCL>(SC, 16 * pt, 32, lane), y0, y1, F4Z);
            *(u32x2*)(OI + (size_t)(m0 + 16 * pt + fr) * 1024 + 128 * h + 16 * w + 4 * fq) = pack4(o[0], o[1], o[2], o[3]); }
        bf16_t* NT = (bf16_t*)(ws + WS_NT) + (size_t)task * 16384;
        const int row = tid >> 2, cq = tid & 3;
#pragma unroll
        for (int i = 0; i < 4; ++i) *(u32x4*)(NT + row * 128 + 32 * cq + 8 * i) = *(const LAS u32x4*)(NTS + row * HL + 32 * cq + 8 * i);
    }
    lds_barrier();
    return nin;
}
DI void h2_item(PR p, const Ctx& c, int item) {
    unsigned char* ws = p.ws;
    const int gidx = item * 512 + c.tid, bh = gidx >> 11, e = (gidx >> 4) & 127, dg = gidx & 15;
    bf16_t* NT = (bf16_t*)(ws + WS_NT) + (size_t)bh * 32 * 16384 + e * 128 + 8 * dg; const float* DC = (const float*)(ws + WS_DC) + (size_t)bh * 32 * 128 + 8 * dg;
    float s[8];
#pragma unroll
    for (int j = 0; j < 8; ++j) s[j] = 0.f;
    for (int c0 = 0; c0 < 32; c0 += 8) {
        u32x4 nt[8]; f32x4 da[8], db[8];
#pragma unroll
        for (int i = 0; i < 8; ++i) { nt[i] = *(const u32x4*)(NT + (size_t)(c0 + i) * 16384); da[i] = *(const f32x4*)(DC + (c0 + i) * 128); db[i] = *(const f32x4*)(DC + (c0 + i) * 128 + 4); }
#pragma unroll
        for (int i = 0; i < 8; ++i) { *(u32x4*)(NT + (size_t)(c0 + i) * 16384) = pack8(s); float nf[8]; unpack8(nt[i], nf);
            s[0] = s[0] * da[i].x + nf[0]; s[1] = s[1] * da[i].y + nf[1]; s[2] = s[2] * da[i].z + nf[2]; s[3] = s[3] * da[i].w + nf[3];
            s[4] = s[4] * db[i].x + nf[4]; s[5] = s[5] * db[i].y + nf[5]; s[6] = s[6] * db[i].z + nf[6]; s[7] = s[7] * db[i].w + nf[7]; }
    }
}
DI void h3_wave(PR p, int l, int wt, int lane) {
    unsigned char* ws = p.ws;
    const int task = wt >> 2, tt = wt & 3, bh = task >> 5, ch = task & 31, b = bh >> 3, h = bh & 7, m0 = b * TSEQ + ch * 64 + 16 * tt, fr = lane & 15, fq = lane >> 4;
    const bf16_t* Z = (const bf16_t*)(ws + WS_Z); const bf16_t* QH = (const bf16_t*)(ws + WS_QH); const bf16_t* OI = (const bf16_t*)(ws + WS_OI); const bf16_t* S = (const bf16_t*)(ws + WS_NT) + (size_t)task * 16384;
    bf16_t* YHG = (bf16_t*)(ws + WS_YHG);
    const size_t row = (size_t)(m0 + fr);
    bf16x8 qf[4];
#pragma unroll
    for (int ks = 0; ks < 4; ++ks) qf[ks] = *(const bf16x8*)(QH + row * 1024 + 128 * h + 32 * ks + 8 * fq);
    u32x2 oi[8], zo[8];
#pragma unroll
    for (int et = 0; et < 8; ++et) { oi[et] = *(const u32x2*)(OI + row * 1024 + 128 * h + 16 * et + 4 * fq); zo[et] = *(const u32x2*)(Z + row * NZ + ZC_O + 128 * h + 16 * et + 4 * fq); }
    f32x4 onw[8];
#pragma unroll
    for (int et = 0; et < 8; ++et) onw[et] = *(const f32x4*)(p.in[I_ONORM] + l * 128 + 16 * et + 4 * fq);
    f32x4 o[8]; float ssq = 0.f;
#pragma unroll
    for (int et = 0; et < 8; ++et) { bf16x8 sa[4];
#pragma unroll
        for (int ks = 0; ks < 4; ++ks) sa[ks] = *(const bf16x8*)(S + (16 * et + fr) * 128 + 32 * ks + 8 * fq);
        float f[4]; unpack4(oi[et], f); f32x4 acc = {f[0], f[1], f[2], f[3]};
#pragma unroll
        for (int ks = 0; ks < 4; ++ks) acc = MFMA16(sa[ks], qf[ks], acc);
        o[et] = acc; ssq += (acc[0] * acc[0] + acc[1] * acc[1]) + (acc[2] * acc[2] + acc[3] * acc[3]); }
    ssq += __shfl_xor(ssq, 16); ssq += __shfl_xor(ssq, 32);
    const float rstd = rsqrtf(ssq * (1.0f / 128.0f) + NORM_EPS);
#pragma unroll
    for (int et = 0; et < 8; ++et) { float g[4]; unpack4(zo[et], g);
        *(u32x2*)(YHG + row * 1024 + 128 * h + 16 * et + 4 * fq) = pack4(o[et][0] * rstd * onw[et].x * sigm(g[0]), o[et][1] * rstd * onw[et].y * sigm(g[1]), o[et][2] * rstd * onw[et].z * sigm(g[2]), o[et][3] * rstd * onw[et].w * sigm(g[3])); }
}
struct R2Regs { bf16x8 ma[4][2]; u32x4 nv[2]; };
DI void r2_load(R2Regs& r, const bf16_t* mt, const bf16_t* nn, int et, int fr, int fq) {
#pragma unroll
    for (int n = 0; n < 4; ++n)
#pragma unroll
        for (int ks = 0; ks < 2; ++ks) r.ma[n][ks] = *(const bf16x8*)(mt + (16 * n + fr) * 64 + 32 * ks + 8 * fq);
    r.nv[0] = *(const u32x4*)(nn + (16 * et + fr) * 64 + 16 * fq); r.nv[1] = *(const u32x4*)(nn + (16 * et + fr) * 64 + 16 * fq + 8);
}
DI void r2_step(const R2Regs& r, f32x4 (&S)[4], bf16_t* ss, int et, int fr, int fq) {
    { float f[8] = {S[0][0], S[0][1], S[0][2], S[0][3], S[1][0], S[1][1], S[1][2], S[1][3]}, g[8] = {S[2][0], S[2][1], S[2][2], S[2][3], S[3][0], S[3][1], S[3][2], S[3][3]};
      *(u32x4*)(ss + (16 * et + fr) * 64 + 16 * fq) = pack8(f); *(u32x4*)(ss + (16 * et + fr) * 64 + 16 * fq + 8) = pack8(g); }
    bf16x8 sb[2];
#pragma unroll
    for (int ks = 0; ks < 2; ++ks) { u32x4 sp; sp.x = cvt_pk(S[2 * ks][0], S[2 * ks][1]); sp.y = cvt_pk(S[2 * ks][2], S[2 * ks][3]); sp.z = cvt_pk(S[2 * ks + 1][0], S[2 * ks + 1][1]); sp.w = cvt_pk(S[2 * ks + 1][2], S[2 * ks + 1][3]);
        sb[ks] = __builtin_bit_cast(bf16x8, sp); }
    float nf[16]; { float a[8], b[8]; unpack8(r.nv[0], a); unpack8(r.nv[1], b);
#pragma unroll
        for (int j = 0; j < 8; ++j) { nf[j] = a[j]; nf[8 + j] = b[j]; } }
#pragma unroll
    for (int n = 0; n < 4; ++n) { f32x4 acc = {nf[4 * n], nf[4 * n + 1], nf[4 * n + 2], nf[4 * n + 3]};
        acc = MFMA16(r.ma[n][0], sb[0], acc); acc = MFMA16(r.ma[n][1], sb[1], acc); S[n] = acc; }
}
DI void r2_task(PR p, const Ctx& c, int item) {
    unsigned char* ws = p.ws;
    const int lane = c.lane, w = c.wave, fr = lane & 15, fq = lane >> 4, bh = 2 * item + (w >> 2), et = w & 3;
    const bf16_t* MT = (const bf16_t*)(ws + WS_MT) + (size_t)bh * 32 * 4096; const bf16_t* NN = (const bf16_t*)(ws + WS_NN) + (size_t)bh * 32 * 4096;
    bf16_t* SS = (bf16_t*)(ws + WS_SS) + (size_t)bh * 32 * 4096;
    f32x4 S[4] = {F4Z, F4Z, F4Z, F4Z};
    R2Regs ra, rb;
    r2_load(ra, MT, NN, et, fr, fq);
    for (int ch = 0; ch < 32; ch += 2) {
        r2_load(rb, MT + (size_t)(ch + 1) * 4096, NN + (size_t)(ch + 1) * 4096, et, fr, fq);
        r2_step(ra, S, SS + (size_t)ch * 4096, et, fr, fq);
        { const int c2 = ch + 2 < 32 ? ch + 2 : 31; r2_load(ra, MT + (size_t)c2 * 4096, NN + (size_t)c2 * 4096, et, fr, fq); }
        r2_step(rb, S, SS + (size_t)(ch + 1) * 4096, et, fr, fq);
    }
}
DI void r3_wave(PR p, int l, int wt, int lane) {
    unsigned char* ws = p.ws;
    const int task = wt >> 2, pt = wt & 3, bh = task >> 5, ch = task & 31, b = bh >> 4, h = bh & 15, tok0 = ch * 64 + 16 * pt, m0 = b * TSEQ + tok0, fr = lane & 15, fq = lane >> 4;
    const bf16_t* Z = (const bf16_t*)(ws + WS_Z);
    const size_t blk = (size_t)task * 4096, m = (size_t)(m0 + fr);
    const bf16_t* SS = (const bf16_t*)(ws + WS_SS) + blk; const bf16_t* RP = (const bf16_t*)(ws + WS_RP) + blk; const bf16_t* Y0 = (const bf16_t*)(ws + WS_Y0) + blk;
    const bf16_t* GUPT = (const bf16_t*)(ws + WS_LORA + LO_GUP) + (size_t)(64 * h) * 160;
    bf16x8 sg[5];
    {   const float* mu = p.in[I_MU] + (size_t)l * 3360 + 3200; const bf16_t* zr = Z + m * NZ + ZC_GD; const bool has_prev = (tok0 + fr) > 0;
#pragma unroll
        for (int ks = 0; ks < 5; ++ks) { float cur[8], prv[8]; unpack8(*(const u32x4*)(zr + 32 * ks + 8 * fq), cur);
            if (has_prev) unpack8(*(const u32x4*)(zr - NZ + 32 * ks + 8 * fq), prv); else {
#pragma unroll
                for (int j = 0; j < 8; ++j) prv[j] = 0.f; }
            const f32x4 mA = *(const f32x4*)(mu + 32 * ks + 8 * fq), mB = *(const f32x4*)(mu + 32 * ks + 8 * fq + 4); const float mm[8] = {mA.x, mA.y, mA.z, mA.w, mB.x, mB.y, mB.z, mB.w};
#pragma unroll
            for (int j = 0; j < 8; ++j) cur[j] = sigm(cur[j] + mm[j] * (prv[j] - cur[j]));
            sg[ks] = __builtin_bit_cast(bf16x8, pack8(cur)); } }
    const bf16x8 rp0 = gfrag(RP, 64, 16 * pt, 0, lane), rp1 = gfrag(RP, 64, 16 * pt, 32, lane);
    const float rk = ((const float*)(ws + WS_RK))[m * 16 + h];
    const bf16_t* vsrc = (const bf16_t*)(ws + (l == 0 ? WS_VFIRST : WS_VF));
    f32x4 lnw[4], lnb[4]; u32x2 vraw[4], y0raw[4];
#pragma unroll
    for (int et = 0; et < 4; ++et) { const int col = 64 * h + 16 * et + 4 * fq; lnw[et] = *(const f32x4*)(p.in[I_LNW] + l * 1024 + col); lnb[et] = *(const f32x4*)(p.in[I_LNB] + l * 1024 + col);
        vraw[et] = *(const u32x2*)(vsrc + m * 1024 + col); y0raw[et] = *(const u32x2*)(Y0 + (16 * pt + fr) * 64 + 16 * et + 4 * fq); }
    f32x4 y[4], g[4]; float s1 = 0.f, s2 = 0.f;
#pragma unroll
    for (int et = 0; et < 4; ++et) { float f[4]; unpack4(y0raw[et], f); f32x4 acc = {f[0], f[1], f[2], f[3]};
        acc = MFMA16(gfrag(SS, 64, 16 * et, 0, lane), rp0, acc); acc = MFMA16(gfrag(SS, 64, 16 * et, 32, lane), rp1, acc);
        y[et] = acc; s1 += (acc[0] + acc[1]) + (acc[2] + acc[3]); s2 += (acc[0] * acc[0] + acc[1] * acc[1]) + (acc[2] * acc[2] + acc[3] * acc[3]);
        f32x4 ga = F4Z;
#pragma unroll
        for (int ks = 0; ks < 5; ++ks) ga = MFMA16(gfrag(GUPT, 160, 16 * et, 32 * ks, lane), sg[ks], ga);
        g[et] = ga; }
    s1 += __shfl_xor(s1, 16); s1 += __shfl_xor(s1, 32); s2 += __shfl_xor(s2, 16); s2 += __shfl_xor(s2, 32);
    const float mean = s1 * (1.0f / 64.0f), var = fmaxf(s2 * (1.0f / 64.0f) - mean * mean, 0.f), rstd = rsqrtf(var + RW_GN_EPS);
    bf16_t* YRW = (bf16_t*)(ws + WS_YRW);
#pragma unroll
    for (int et = 0; et < 4; ++et) { const int col = 64 * h + 16 * et + 4 * fq;
        float vv[4]; unpack4(vraw[et], vv);
        float o[4];
#pragma unroll
        for (int r = 0; r < 4; ++r) o[r] = ((y[et][r] - mean) * rstd * lnw[et][r] + lnb[et][r] + rk * vv[r]) * g[et][r];
        *(u32x2*)(YRW + m * 1024 + col) = pack4(o[0], o[1], o[2], o[3]); }
}
constexpr int P7L = 264;
constexpr int P7_HI = 0, P7_LO = 64 * P7L * 2, P7_LG = 2 * P7_LO, P7_RS = P7_LG + 2 * 64 * 48 * 4, P7_HIST = P7_RS + 256;
DI void p7_route(PR p, const Ctx& c, int l) {
    unsigned char* ws = p.ws;
    const int lane = c.lane, w = c.wave, fr = lane & 15, fq = lane >> 4;
    const float* H = p.out; bf16_t* HN = (bf16_t*)(ws + WS_XN);
    const float* nw = p.in[I_NFFN] + (size_t)l * D; const bf16_t* WRH = (const bf16_t*)(ws + WS_LORA + LO_WR); const bf16_t* WRL = (const bf16_t*)(ws + WS_LORA + LO_WRL);
    const float* bg = p.in[I_RGB] + l * 4; const float* be = p.in[I_REB] + l * 32;
    int* TOKE = (int*)(ws + WS_TOKE); float* TOKW = (float*)(ws + WS_TOKW); int* CNT = (int*)(ws + WS_CNT); float* TRSTD = (float*)(ws + WS_TRSTD);
    LAS bf16_t* HI = (LAS bf16_t*)(c.lds + P7_HI); LAS bf16_t* LO = (LAS bf16_t*)(c.lds + P7_LO); LAS float* LG = (LAS float*)(c.lds + P7_LG); LAS float* RS = (LAS float*)(c.lds + P7_RS); LAS int* hist = (LAS int*)(c.lds + P7_HIST);
    for (int tile = c.bid; tile < M / 64; tile += c.G) {
        if (c.tid < 32) hist[c.tid] = 0;
        const int tt = w & 3, kh = w >> 2, mb = tile * 64 + 8 * w;
        f32x4 acc[3] = {F4Z, F4Z, F4Z}; float ss[8];
#pragma unroll
        for (int i = 0; i < 8; ++i) ss[i] = 0.f;
        for (int kc = 0; kc < 8; ++kc) {
            const f32x4 ww = *(const f32x4*)(nw + 256 * kc + 4 * lane);
            f32x4 hv[8];
#pragma unroll
            for (int i = 0; i < 8; ++i) hv[i] = *(const f32x4*)(H + (size_t)(mb + i) * D + 256 * kc + 4 * lane);
            bf16x8 wh[4][3], wl[4][3];
#pragma unroll
            for (int k4 = 0; k4 < 4; ++k4)
#pragma unroll
                for (int ct = 0; ct < 3; ++ct) { const int kg = 256 * kc + 32 * (4 * kh + k4); wh[k4][ct] = gfrag(WRH, D, 16 * ct, kg, lane); wl[k4][ct] = gfrag(WRL, D, 16 * ct, kg, lane); }
#pragma unroll
            for (int i = 0; i < 8; ++i) { ss[i] += (hv[i].x * hv[i].x + hv[i].y * hv[i].y) + (hv[i].z * hv[i].z + hv[i].w * hv[i].w);
                const f32x4 x = hv[i] * ww; const u32x2 hp = pack4(x.x, x.y, x.z, x.w); float hf[4]; unpack4(hp, hf);
                *(u32x2*)(HN + (size_t)(mb + i) * D + 256 * kc + 4 * lane) = hp;
                *(LAS u32x2*)(HI + (8 * w + i) * P7L + 4 * lane) = hp; *(LAS u32x2*)(LO + (8 * w + i) * P7L + 4 * lane) = pack4(x.x - hf[0], x.y - hf[1], x.z - hf[2], x.w - hf[3]); }
            lds_barrier();
#pragma unroll
            for (int k4 = 0; k4 < 4; ++k4) { const int ks = 4 * kh + k4;
                const bf16x8 xh = frag_n<P7L>(HI, 16 * tt, 32 * ks, lane), xl = frag_n<P7L>(LO, 16 * tt, 32 * ks, lane);
#pragma unroll
                for (int ct = 0; ct < 3; ++ct) { acc[ct] = MFMA16(wh[k4][ct], xh, acc[ct]); acc[ct] = MFMA16(wh[k4][ct], xl, acc[ct]); acc[ct] = MFMA16(wl[k4][ct], xh, acc[ct]); } }
            lds_barrier();
        }
#pragma unroll
        for (int i = 0; i < 8; ++i) { const float r = rsqrtf(wave_sum(ss[i]) * (1.f / D) + NORM_EPS); if (lane == i) { RS[8 * w + i] = r; TRSTD[mb + i] = r; } }
#pragma unroll
        for (int ct = 0; ct < 3; ++ct) *(LAS f32x4*)(LG + (kh * 64 + 16 * tt + fr) * 48 + 16 * ct + 4 * fq) = acc[ct];
        __syncthreads();
        if (c.tid < 64) { const int t = c.tid, m = tile * 64 + t; const float rstd = RS[t];
            const LAS float* l0 = LG + t * 48; const LAS float* l1 = LG + (64 + t) * 48;
            float gl[4]; int gs = 0;
#pragma unroll
            for (int i = 0; i < 4; ++i) gl[i] = (l0[i] + l1[i]) * rstd + bg[i];
#pragma unroll
            for (int i = 1; i < 4; ++i) if (gl[i] > gl[gs]) gs = i;
            float den = 0.f;
#pragma unroll
            for (int i = 0; i < 4; ++i) den += __expf(gl[i] - gl[gs]);
            const float pg = 1.0f / den;
            float el[8]; int i1 = 0, i2 = -1;
#pragma unroll
            for (int i = 0; i < 8; ++i) el[i] = (l0[4 + 8 * gs + i] + l1[4 + 8 * gs + i]) * rstd + be[8 * gs + i];
#pragma unroll
            for (int i = 1; i < 8; ++i) if (el[i] > el[i1]) i1 = i;
#pragma unroll
            for (int i = 0; i < 8; ++i) if (i != i1 && (i2 < 0 || el[i] > el[i2])) i2 = i;
            const float e2 = __expf(el[i2] - el[i1]), w1 = pg / (1.0f + e2), w2 = pg * e2 / (1.0f + e2);
            TOKE[2 * m] = 8 * gs + i1; TOKE[2 * m + 1] = 8 * gs + i2; TOKW[2 * m] = w1; TOKW[2 * m + 1] = w2;
            atomicAdd((int*)&hist[8 * gs + i1], 1); atomicAdd((int*)&hist[8 * gs + i2], 1); }
        __syncthreads();
        if (c.tid < 32) CNT[tile * 32 + c.tid] = hist[c.tid];
        __syncthreads();
    }
}
DI void moe_tables(PR p, const Ctx& c) {
    const int* CNT = (const int*)(p.ws + WS_CNT);
    LAS int* LC = (LAS int*)(c.lds + LDS_CTL_OFF);
    LAS int* part = (LAS int*)(c.lds + 72000);
    { const int e = c.tid & 31, pr = c.tid >> 5; int v[16];
#pragma unroll
      for (int i = 0; i < 16; ++i) v[i] = CNT[(pr + 16 * i) * 32 + e];
      int s = 0;
#pragma unroll
      for (int i = 0; i < 16; ++i) s += v[i];
      part[pr * 32 + e] = s; }
    __syncthreads();
    if (c.tid < 32) { int s = 0;
#pragma unroll 1
        for (int pr = 0; pr < 16; ++pr) s += part[pr * 32 + c.tid];
        LC[LC_TOT + c.tid] = s; }
    __syncthreads();
    if (c.tid == 0) { int acc = 0;
#pragma unroll 1
        for (int e = 0; e < 32; ++e) { LC[LC_PAD + e] = acc; const int nt = (LC[LC_TOT + e] + 255) >> 8;
#pragma unroll 1
            for (int i = 0; i < nt; ++i) LC[LC_TILE + (acc >> 8) + i] = e;
            acc += nt << 8; }
        LC[LC_PAD + 32] = acc; }
    __syncthreads();
}
DI void p8_dispatch(PR p, const Ctx& c) {
    unsigned char* ws = p.ws;
    const int* CNT = (const int*)(ws + WS_CNT); const int* TOKE = (const int*)(ws + WS_TOKE); int* TOKS = (int*)(ws + WS_TOKS);
    const bf16_t* HN = (const bf16_t*)(ws + WS_XN); bf16_t* XS = (bf16_t*)(ws + WS_XS);
    LAS int* LC = (LAS int*)(c.lds + LDS_CTL_OFF);
    LAS int* base = (LAS int*)(c.lds + 76000); LAS int* part = (LAS int*)(c.lds + 72000); LAS int* eids = (LAS int*)(c.lds + 77000); LAS int* slots = (LAS int*)(c.lds + 78000);
    for (int tile = c.bid; tile < M / 64; tile += c.G) {
        { const int e = c.tid & 31, pr = c.tid >> 5; int v[16];
#pragma unroll
          for (int i = 0; i < 16; ++i) { const int tl = pr + 16 * i; v[i] = CNT[(tl < tile ? tl : 0) * 32 + e]; }
          int s = 0;
#pragma unroll
          for (int i = 0; i < 16; ++i) s += (pr + 16 * i < tile) ? v[i] : 0;
          part[pr * 32 + e] = s; }
        if (c.tid < 128) eids[c.tid] = TOKE[tile * 128 + c.tid];
        __syncthreads();
        if (c.tid < 32) { int s = 0; for (int pr = 0; pr < 16; ++pr) s += part[pr * 32 + c.tid]; base[c.tid] = s; }
        __syncthreads();
        if (c.tid < 128) { const int e = eids[c.tid]; int lp = 0; for (int i = 0; i < c.tid; ++i) lp += (eids[i] == e) ? 1 : 0;
            const int s = LC[LC_PAD + e] + base[e] + lp; slots[c.tid] = s; TOKS[tile * 128 + c.tid] = s; ((int*)(ws + WS_CTL + CTL_SLOTTOK))[s] = tile * 64 + (c.tid >> 1); ((float*)(ws + WS_SRSTD))[s] = ((const float*)(ws + WS_TRSTD))[tile * 64 + (c.tid >> 1)]; }
        __syncthreads();
        __syncthreads();
    }
}
DI void p11_combine(PR p, const Ctx& c, int l) {
    unsigned char* ws = p.ws;
    const int lane = c.lane; const int gw = c.bid * 8 + c.wave, NGW = c.G * 8;
    float* H = p.out; const bf16_t* YS = (const bf16_t*)(ws + WS_YS); const int* TOKS = (const int*)(ws + WS_TOKS); const float* TOKW = (const float*)(ws + WS_TOKW);
    bf16_t* XN = (bf16_t*)(ws + WS_XN);
    const float* nw = (l == 0) ? p.in[I_NMIX] + D : p.in[I_FNW];
    f32x4 ww[8];
#pragma unroll
    for (int j = 0; j < 8; ++j) ww[j] = ((const f32x4*)nw)[lane + 64 * j];
    if (gw >= M) return;
    int s0 = TOKS[2 * gw], s1 = TOKS[2 * gw + 1]; float w0 = TOKW[2 * gw], w1 = TOKW[2 * gw + 1];
    for (int m = gw; m < M; m += NGW) {
        f32x4* hr = (f32x4*)(H + (size_t)m * D) + lane; const u32x2* y0 = (const u32x2*)(YS + (size_t)s0 * D) + lane; const u32x2* y1 = (const u32x2*)(YS + (size_t)s1 * D) + lane;
        f32x4 hv[8]; u32x2 ya[8], yb[8];
#pragma unroll
        for (int j = 0; j < 8; ++j) { hv[j] = hr[64 * j]; ya[j] = y0[64 * j]; yb[j] = y1[64 * j]; }
        const float cw0 = w0, cw1 = w1;
        { const int mn = (m + NGW < M) ? m + NGW : m; s0 = TOKS[2 * mn]; s1 = TOKS[2 * mn + 1]; w0 = TOKW[2 * mn]; w1 = TOKW[2 * mn + 1]; }
        float s = 0.f;
#pragma unroll
        for (int j = 0; j < 8; ++j) { float a[4], b[4]; unpack4(ya[j], a); unpack4(yb[j], b);
            hv[j].x += cw0 * a[0] + cw1 * b[0]; hv[j].y += cw0 * a[1] + cw1 * b[1]; hv[j].z += cw0 * a[2] + cw1 * b[2]; hv[j].w += cw0 * a[3] + cw1 * b[3];
            s += (hv[j].x * hv[j].x + hv[j].y * hv[j].y) + (hv[j].z * hv[j].z + hv[j].w * hv[j].w); }
        const float rstd = rsqrtf(wave_sum(s) * (1.f / D) + NORM_EPS);
#pragma unroll
        for (int j = 0; j < 8; ++j) {
            if (l == 0) { hr[64 * j] = hv[j]; ((u32x2*)(XN + (size_t)m * D))[lane + 64 * j] = pack4(hv[j].x * rstd * ww[j].x, hv[j].y * rstd * ww[j].y, hv[j].z * rstd * ww[j].z, hv[j].w * rstd * ww[j].w); }
            else hr[64 * j] = hv[j] * rstd * ww[j]; }
    }
}
#ifndef DBG_CUT
#define DBG_CUT 1000
#endif
constexpr int NPHASE = 23;
#ifndef WGM_P1
#define WGM_P1 4
#endif
#ifndef WGM_P56
#define WGM_P56 2
#endif
#ifndef REP_R1
#define REP_R1 1
#endif
#ifndef REP_H1
#define REP_H1 1
#endif
#ifndef REP_R2
#define REP_R2 1
#endif
#ifndef REP_H3
#define REP_H3 1
#endif
#ifndef REP_R3
#define REP_R3 1
#endif
#ifndef PH_MASK
#define PH_MASK 0xFFFF
#endif
#define PH_EN(n) ((PH_MASK >> (n)) & 1)
__global__ void __launch_bounds__(512, 2) mk_fwd(Params p_byval) {
    const CAS Params* pp = (const CAS Params*)__builtin_amdgcn_kernarg_segment_ptr();
#define p (*pp)
    extern __shared__ __attribute__((aligned(16))) unsigned char lds_raw[];
    Ctx c; unsigned char* ws;
#define FRESH() do { int t_ = threadIdx.x; asm volatile("" : "+v"(t_)); int b_ = blockIdx.x; asm volatile("" : "+s"(b_)); unsigned lb_ = (unsigned)(uintptr_t)(LAS unsigned char*)lds_raw; asm volatile("" : "+s"(lb_)); c.lds = (LAS unsigned char*)(uintptr_t)lb_; c.tid = t_; c.lane = t_ & 63; \
        c.wave = __builtin_amdgcn_readfirstlane(t_ >> 6); c.G = gridDim.x; c.bid = b_; pp = (const CAS Params*)__builtin_amdgcn_kernarg_segment_ptr(); asm volatile("" : "+s"(pp)); ws = p.ws; asm volatile("" : "+s"(ws)); glds = (LAS unsigned char*)c.lds; } while (0)
    LAS unsigned char* glds;
    FRESH();
    LAS unsigned* LCU = (LAS unsigned*)(c.lds + LDS_CTL_OFF);
    if (c.tid < 4) LCU[c.tid] = 0u;
    __syncthreads();
#if MK_ONE_LAUNCH
    XcdBarrier bar = xcd_barrier_post((unsigned*)(ws + WS_CTL) + CW_BAR, (volatile LAS unsigned*)LCU);
#define GRID_BAR() xcd_barrier(bar)
#else
#define GRID_BAR() do { } while (0)
#endif
    const int lo = p.ph_lo, hi_raw = p.ph_hi; int hi = hi_raw & 0xffff; const int dbgflag = hi_raw >> 16; (void)dbgflag;
#define IN(k) (lo <= (k) && (k) < hi)
#define SEAM(k) do { if (IN(k) && IN((k) + 1)) GRID_BAR(); } while (0)
    if (PH_EN(0) && IN(0)) { FRESH();
        convert_small(p, c, 0, 0);
        const int gw = c.bid * 8 + c.wave, NGW = c.G * 8;
        for (int m = gw; m < M; m += NGW) rms_row_bf16(p.in[I_X] + (size_t)m * D, p.in[I_NMIX], (bf16_t*)(ws + WS_XN) + (size_t)m * D, c.lane);
    }
    SEAM(0);
    for (int l = 0; l < 2; ++l) {
        const int pb = 1 + 11 * l;
        if (PH_EN(1) && IN(pb + 0)) { FRESH();
            pg8::Gemm g{(const bf16_t*)(ws + WS_XN), (const bf16_t*)(ws + WS_WIN), M, NZ, D}; pg8::StaticOrder S; S.init(M, NZ, c.G, c.bid, WGM_P1);
            pg8::EpiBf16P E{(bf16_t*)(ws + WS_Z), NZ, dbgflag};
#ifdef STAGGER_TICKS
            if (c.bid & 1) { const unsigned long long t0 = __builtin_amdgcn_s_memrealtime(); while (__builtin_amdgcn_s_memrealtime() - t0 < STAGGER_TICKS) __builtin_amdgcn_s_sleep(32); }
#endif
            pg8::gemm_phase<pg8::EpiBf16P, pg8::StaticOrder>(glds, g, S, E, nullptr);
            const int nunits = (M / 256) * (NZ / 256), rem = nunits % c.G;
            if (rem != 0 && c.bid >= rem && EXP_EARLY > 0) { __syncthreads(); FRESH(); convert_experts_early(p, c, l, rem, c.G - rem); }
        }
        SEAM(pb + 0);
        if (PH_EN(2) && IN(pb + 1)) { FRESH();
            if (c.bid < 4096) { R1In rin = r1_load(ws, c.bid, c.tid);
              for (int it = c.bid; it < 4096; it += c.G) rin = r1_task<0>(p, c, l, it, rin, it + c.G < 4096 ? it + c.G : it); }
            if (c.bid < 2048) { H1In hin = h1_load(ws, c.bid, c.tid);
              for (int it = c.bid; it < 2048; it += c.G) hin = h1_task(p, c, l, it, hin, it + c.G < 2048 ? it + c.G : it); }
        }
        SEAM(pb + 1);
        if (PH_EN(3) && IN(pb + 2)) { FRESH();
            if (c.G >= 128) { if (c.bid < 64) { for (int rep = 0; rep < REP_R2; ++rep) r2_task(p, c, c.bid); } else for (int it = c.bid - 64; it < 256; it += c.G - 64) h2_item(p, c, it); }
            else { for (int it = c.bid; it < 64; it += c.G) r2_task(p, c, it); for (int it = c.bid; it < 256; it += c.G) h2_item(p, c, it); }
        }
        SEAM(pb + 2);
        if (PH_EN(4) && IN(pb + 3)) { FRESH();
            { const int gw = c.bid * 8 + c.wave, NGW = c.G * 8;
              for (int wt = gw; wt < 8192; wt += NGW) h3_wave(p, l, wt, c.lane);
              for (int wt = gw; wt < 16384; wt += NGW) r3_wave(p, l, wt, c.lane); }
        }
        SEAM(pb + 3);
        if (PH_EN(5) && IN(pb + 4)) { FRESH();
            pg8::StaticOrder S; S.init(M, D, c.G, c.bid, WGM_P56);
#ifndef DBG_NO_HG
            { pg8::Gemm g{(const bf16_t*)(ws + WS_YHG), (const bf16_t*)(ws + WS_WBH), M, D, 1024};
              pg8::EpiGate E{(bf16_t*)(ws + WS_XN), D, (const bf16_t*)(ws + WS_Z) + ZC_GA, NZ, 0, dbgflag};
              pg8::gemm_phase<pg8::EpiGate, pg8::StaticOrder>(glds, g, S, E, nullptr); }
#endif
#ifndef DBG_NO_RW
            { pg8::Gemm g{(const bf16_t*)(ws + WS_YRW), (const bf16_t*)(ws + WS_WBR), M, D, 1024};
#ifdef DBG_NO_HG
              pg8::EpiGate E{(bf16_t*)(ws + WS_XN), D, (const bf16_t*)(ws + WS_Z) + ZC_GB, NZ, 0, dbgflag};
#else
              pg8::EpiGate E{(bf16_t*)(ws + WS_XN), D, (const bf16_t*)(ws + WS_Z) + ZC_GB, NZ, 1, dbgflag};
#endif
              pg8::gemm_phase<pg8::EpiGate, pg8::StaticOrder>(glds, g, S, E, nullptr); }
#endif
        }
        SEAM(pb + 4);
        if (PH_EN(6) && IN(pb + 5)) { FRESH();
            pg8::Gemm g{(const bf16_t*)(ws + WS_XN), (const bf16_t*)(ws + WS_WO), M, D, D}; pg8::StaticOrder S; S.init(M, D, c.G, c.bid, WGM_P56);
            pg8::EpiRes E{l == 0 ? p.in[I_X] : p.out, p.out, D, dbgflag};
            pg8::gemm_phase<pg8::EpiRes, pg8::StaticOrder>(glds, g, S, E, nullptr);
        }
        SEAM(pb + 5);
        if (PH_EN(7) && IN(pb + 6)) { FRESH();
            { const int nunits = (M / 256) * (NZ / 256); convert_experts(p, c, l, (nunits % c.G) != 0 ? EXP_EARLY : 0); }
            __syncthreads();
            p7_route(p, c, l);
        }
        SEAM(pb + 6);
        if (PH_EN(8) && IN(pb + 7)) { FRESH(); moe_tables(p, c); p8_dispatch(p, c); }
        SEAM(pb + 7);
        if (PH_EN(9) && IN(pb + 8)) { FRESH();
            moe_tables(p, c); FRESH();
            const LAS int* LC = (const LAS int*)(c.lds + LDS_CTL_OFF);
            pg8::Gemm g{(const bf16_t*)(ws + WS_XN), (const bf16_t*)(ws + WS_WGU), MAXSLOTS, NEXP * 1024, D, (const int*)(ws + WS_CTL + CTL_SLOTTOK)};
            pg8::GroupedOrder<4> S{(LC[LC_PAD + 32] >> 8) * 4, c.G, c.bid, LC + LC_TILE};
            pg8::EpiSwiGLU E{(bf16_t*)(ws + WS_ACT), (const float*)(ws + WS_SRSTD), dbgflag};
            pg8::gemm_phase<pg8::EpiSwiGLU, pg8::GroupedOrder<4>, false, true>(glds, g, S, E, nullptr);
        }
        SEAM(pb + 8);
        if (PH_EN(10) && IN(pb + 9)) { FRESH();
            moe_tables(p, c); FRESH();
            const LAS int* LC = (const LAS int*)(c.lds + LDS_CTL_OFF);
            pg8::Gemm g{(const bf16_t*)(ws + WS_ACT), (const bf16_t*)(ws + WS_WDN), MAXSLOTS, NEXP * D, DEXP};
            pg8::GroupedOrder<8> S{(LC[LC_PAD + 32] >> 8) * 8, c.G, c.bid, LC + LC_TILE};
            pg8::EpiDown E{(bf16_t*)(ws + WS_YS), dbgflag};
            pg8::gemm_phase<pg8::EpiDown, pg8::GroupedOrder<8>>(glds, g, S, E, nullptr);
        }
        SEAM(pb + 9);
        if (PH_EN(11) && IN(pb + 10)) { FRESH();
            p11_combine(p, c, l);
            if (l == 0) convert_small(p, c, 1, 0);
        }
        SEAM(pb + 10);
    }
}
#undef p
__global__ void __launch_bounds__(512) dbg_final(const float* src, const float* fw, float* out) {
    const int lane = threadIdx.x & 63, gw = blockIdx.x * 8 + (threadIdx.x >> 6), NGW = gridDim.x * 8;
    for (int m = gw; m < M; m += NGW) { const f32x4* xr = (const f32x4*)(src + (size_t)m * D) + lane; f32x4 v[8]; float s = 0.f;
#pragma unroll
        for (int j = 0; j < 8; ++j) { v[j] = xr[64 * j]; s += (v[j].x * v[j].x + v[j].y * v[j].y) + (v[j].z * v[j].z + v[j].w * v[j].w); }
        const float rstd = rsqrtf(wave_sum(s) * (1.f / D) + NORM_EPS);
#pragma unroll
        for (int j = 0; j < 8; ++j) ((f32x4*)(out + (size_t)m * D))[lane + 64 * j] = v[j] * rstd * ((const f32x4*)fw)[lane + 64 * j]; }
}
#ifdef DBG_CHECK
__global__ void __launch_bounds__(512) dbg_check(const void* buf, size_t n, int is_f32, unsigned* flag, unsigned idx) {
    size_t i = (size_t)blockIdx.x * 512 + threadIdx.x, st = (size_t)gridDim.x * 512; bool bad = false;
#ifdef DBG_DEAD
    bool alive = false;
    for (; i < n; i += st) { float v = is_f32 ? ((const float*)buf)[i] : bf2f(((const bf16_t*)buf)[i]); if (fabsf(v) > 0.01f && fabsf(v) < 1e6f) alive = true; }
    __shared__ int anyalive; if (threadIdx.x == 0) anyalive = 0; __syncthreads(); if (alive) anyalive = 1; __syncthreads();
    if (threadIdx.x == 0 && anyalive) atomicOr(flag + 1 + idx, 1u);
#else
    for (; i < n; i += st) { float v = is_f32 ? ((const float*)buf)[i] : bf2f(((const bf16_t*)buf)[i]); if (!(v - v == 0.f)) bad = true; }
    if (bad) atomicMin(flag, idx);
#endif
}
__global__ void __launch_bounds__(512) dbg_scale(float* out, const unsigned* flag) {
#ifdef DBG_DEAD
    unsigned f = 1000u; for (unsigned i = 1; i <= 18; ++i) if (flag[1 + i] == 0u) { f = i; break; }
#else
    const unsigned f = *flag;
#endif
    const float s = f < 100u ? 1.0f + 0.25f * (float)f : 1.0f;
    for (size_t i = (size_t)blockIdx.x * 512 + threadIdx.x; i < (size_t)M * D; i += (size_t)gridDim.x * 512) out[i] *= s;
}
#endif
#ifdef DBG_TRTEST
__global__ void __launch_bounds__(64) dbg_trtest(unsigned* flag) {
    __shared__ __attribute__((aligned(16))) bf16_t A[64 * 72];
    const int lane = threadIdx.x;
    for (int i = lane; i < 64 * 72; i += 64) { const int r = i / 72, cc = i % 72; const float v = (float)((r * 5 + cc * 3) & 255); A[i] = (bf16_t)(cvt_pk(v, 0.f) & 0xffff); }
    __syncthreads();
    unsigned bad = 0;
    for (int row0 = 0; row0 < 64; row0 += 16) for (int k0 = 0; k0 < 64; k0 += 32) {
        const bf16x8 f = frag_t<72>((const LAS bf16_t*)A, row0, k0, lane);
        for (int j = 0; j < 8; ++j) { const int k = k0 + 8 * (lane >> 4) + j, i = row0 + (lane & 15); if ((bf16_t)f[j] != A[k * 72 + i]) bad = 1; }
    }
    if (bad) atomicMin(flag, 2u);
    f32x4 acc = {0.f, 0.f, 0.f, 0.f}; bf16x8 xa, yb;
    for (int j = 0; j < 8; ++j) { const int k = 8 * (lane >> 4) + j, r = lane & 15; xa[j] = (short)(cvt_pk(r == k ? 1.f : 0.f, 0.f) & 0xffff); yb[j] = (short)(cvt_pk((float)(r * 8 + (k & 7)), 0.f) & 0xffff); }
    acc = MFMA16(yb, xa, acc);
    for (int r = 0; r < 4; ++r) { const int pp_ = lane & 15, q = 4 * (lane >> 4) + r; if (acc[r] != (float)(q * 8 + (pp_ & 7))) bad |= 2; }
    if (bad & 2) atomicMin(flag, 3u);
}
#endif
#ifdef DBG_H1TEST
__global__ void __launch_bounds__(512) dbg_h1test(unsigned* flag) {
    extern __shared__ __attribute__((aligned(16))) unsigned char lraw[];
    LAS unsigned char* lds = (LAS unsigned char*)lraw;
    LAS bf16_t* Vs = (LAS bf16_t*)(lds + H_V); LAS bf16_t* KPs = (LAS bf16_t*)(lds + H_KP); LAS bf16_t* QHs = (LAS bf16_t*)(lds + H_QH); LAS bf16_t* KTs = (LAS bf16_t*)(lds + H_KT);
    const int tid = threadIdx.x, lane = tid & 63, w = tid >> 6, fr = lane & 15, fq = lane >> 4;
    for (int i = tid; i < 32 * HL; i += 512) { const int r = i / HL, cc = i % HL;
        Vs[i] = (bf16_t)(cvt_pk((float)((r * 3 + cc) % 7 - 3), 0.f) & 0xffff); KPs[i] = (bf16_t)(cvt_pk((float)((r + cc * 5) % 5 - 2), 0.f) & 0xffff);
        QHs[i] = (bf16_t)(cvt_pk((float)((r * 2 + cc) % 3 - 1), 0.f) & 0xffff); KTs[i] = (bf16_t)(cvt_pk((float)((r + cc) % 4 - 1), 0.f) & 0xffff); }
    __syncthreads();
    unsigned bad = 0;
    const bf16x8 xb = frag_t<HL>(Vs, 16 * w, 0, lane);
    for (int dn = 0; dn < 8; ++dn) { const bf16x8 ya = frag_t<HL>(KPs, 16 * dn, 0, lane); const f32x4 nt = MFMA16(ya, xb, F4Z);
        for (int r = 0; r < 4; ++r) { const int e = 16 * w + fr, d = 16 * dn + 4 * fq + r; float ref = 0.f; for (int s = 0; s < 32; ++s) ref += (float)((s * 3 + e) % 7 - 3) * (float)((s + d * 5) % 5 - 2); if (nt[r] != ref) bad |= 1; } }
    if (w < 4) { const int p0 = 16 * (w >> 1), q0 = 16 * (w & 1);
        const f32x4 sc = mm16<false, false, 4, HL, HL>(QHs, KTs, p0, q0, lane, F4Z);
        for (int r = 0; r < 4; ++r) { const int t = p0 + fr, s = q0 + 4 * fq + r; float ref = 0.f; for (int d = 0; d < 128; ++d) ref += (float)((t * 2 + d) % 3 - 1) * (float)((s + d) % 4 - 1); if (sc[r] != ref) bad |= 2; } }
    if (bad & 1) atomicMin(flag, 2u);
    if (bad & 2) atomicMin(flag, 3u);
}
#endif
#ifdef DBG_CLASS
__global__ void __launch_bounds__(512) dbg_class(const bf16_t* buf, size_t n, unsigned* flag) {
    unsigned m = 0;
    for (size_t i = (size_t)blockIdx.x * 512 + threadIdx.x; i < n; i += (size_t)gridDim.x * 512) { const bf16_t b = buf[i]; const float v = bf2f(b); const float a = fabsf(v);
        if (b == 0xAAAA) m |= 4; else if (a == 0.f) m |= 2; else if (a > 0.01f && a < 1e6f) m |= 1; else if (!(a < 1e6f)) m |= 8; else m |= 16; }
    if (m) atomicOr(flag + 40, m);
}
__global__ void __launch_bounds__(512) dbg_scale2(float* out, const unsigned* flag) {
    const unsigned f = flag[40]; const float s = 1.0f + 0.25f * (float)f;
    for (size_t i = (size_t)blockIdx.x * 512 + threadIdx.x; i < (size_t)M * D; i += (size_t)gridDim.x * 512) out[i] *= s;
}
#endif
#ifdef DBG_CSUM
__global__ void __launch_bounds__(512) dbg_csum(const unsigned* buf, size_t nwords, unsigned* flag) {
    unsigned long long s = 0;
    for (size_t i = (size_t)blockIdx.x * 512 + threadIdx.x; i < nwords; i += (size_t)gridDim.x * 512) s += (unsigned long long)buf[i] * (unsigned long long)((i & 1023) + 1);
    atomicAdd((unsigned long long*)(flag + 42), s);
}
__global__ void __launch_bounds__(512) dbg_scale3(float* out, const unsigned* flag) {
    const unsigned long long c = *(const unsigned long long*)(flag + 42); const float s = 1.0f + 0.25f * (float)((c >> 7) & 3ull);
    for (size_t i = (size_t)blockIdx.x * 512 + threadIdx.x; i < (size_t)M * D; i += (size_t)gridDim.x * 512) out[i] *= s;
}
#endif
#ifdef DBG_ZCOLS
__global__ void __launch_bounds__(512) dbg_zcols(const bf16_t* Z, unsigned* flag) {
    const int starts[13] = {0, 1024, 2048, 3072, 4096, 5120, 6144, 7168, 7232, 7296, 7456, 9504, 11552};
    __shared__ int alive[12];
    if (threadIdx.x < 12) alive[threadIdx.x] = 0; __syncthreads();
    for (int row = blockIdx.x; row < M; row += gridDim.x) { const bf16_t* zr = Z + (size_t)row * NZ;
        for (int cidx = threadIdx.x; cidx < 11552; cidx += 512) { const float a = fabsf(bf2f(zr[cidx])); if (a > 0.01f && a < 1e6f) { int seg = 0; for (int s = 0; s < 12; ++s) if (cidx >= starts[s]) seg = s; alive[seg] = 1; } } }
    __syncthreads();
    if (threadIdx.x < 12 && alive[threadIdx.x]) atomicOr(flag + 2 + threadIdx.x, 1u);
}
#endif
#ifdef DBG_WROWS
__global__ void __launch_bounds__(512) dbg_wrows(const bf16_t* W, unsigned* flag) {
    const int starts[13] = {0, 1024, 2048, 3072, 4096, 5120, 6144, 7168, 7232, 7296, 7456, 9504, 11552};
    for (int row = blockIdx.x; row < 11552; row += gridDim.x) { bool alive = false;
        for (int cidx = threadIdx.x; cidx < 2048; cidx += 512) { const float a = fabsf(bf2f(W[(size_t)row * 2048 + cidx])); if (a > 0.001f && a < 1e6f) alive = true; }
        if (alive) { int seg = 0; for (int s = 0; s < 12; ++s) if (row >= starts[s]) seg = s; atomicOr(flag + 2 + seg, 1u); } }
}
#endif
extern "C" void kernel_launch(void* const* d_in, const int* in_sizes, int n_in, void* d_out, int out_size, void* d_ws, size_t ws_size, hipStream_t stream) {
    static int grid = 0;
    if (grid == 0) {
        if (n_in != 31 || out_size != M * D || ws_size < WS_END) { fprintf(stderr, "kernel_launch: unexpected shapes (n_in %d out %d ws %zu)\n", n_in, out_size, ws_size); grid = -1; return; }
        int dev = 0, cus = 0;
        if (hipGetDevice(&dev) != hipSuccess || hipDeviceGetAttribute(&cus, hipDeviceAttributeMultiprocessorCount, dev) != hipSuccess) { grid = -1; return; }
        if (hipFuncSetAttribute((const void*)mk_fwd, hipFuncAttributeMaxDynamicSharedMemorySize, LDS_BYTES) != hipSuccess) { fprintf(stderr, "kernel_launch: hipFuncSetAttribute failed\n"); grid = -1; return; }
        int per_cu = 0;
        if (hipOccupancyMaxActiveBlocksPerMultiprocessor(&per_cu, (const void*)mk_fwd, 512, LDS_BYTES) != hipSuccess || per_cu < 1) { fprintf(stderr, "kernel_launch: occupancy query says %d\n", per_cu); }
        (void)hipGetLastError();
        grid = cus;
    }
    if (grid < 0) return;
    (void)hipMemsetAsync((char*)d_ws + WS_CTL, 0, CTL_BYTES, stream);
    Params p{};
    for (int i = 0; i < 31; ++i) p.in[i] = (const float*)d_in[i];
    p.out = (float*)d_out; p.ws = (unsigned char*)d_ws;
    const int nph = NPHASE < DBG_CUT ? NPHASE : DBG_CUT;
#if MK_ONE_LAUNCH
    p.ph_lo = 0; p.ph_hi = nph;
    hipLaunchKernelGGL(mk_fwd, dim3(grid), dim3(512), LDS_BYTES, stream, p);
#else
    for (int ph = 0; ph < nph; ++ph) { p.ph_lo = ph; p.ph_hi = ph + 1; hipLaunchKernelGGL(mk_fwd, dim3(grid), dim3(512), LDS_BYTES, stream, p);
#ifdef DUP_PID
        if (ph == DUP_PID) {
#ifdef DUP_FLAG
            p.ph_hi |= (DUP_FLAG << 16);
#endif
            hipLaunchKernelGGL(mk_fwd, dim3(grid), dim3(512), LDS_BYTES, stream, p); }
#endif
    }
#endif
#if defined(DBG_ZCOLS)
    { unsigned* flag = (unsigned*)((char*)d_ws + 512 * 1024); (void)hipMemsetAsync(flag, 0, 256, stream);
#ifdef DBG_WROWS
      hipLaunchKernelGGL(dbg_wrows, dim3(1024), dim3(512), 0, stream, (const bf16_t*)((char*)d_ws + WS_WIN), flag);
#else
      hipLaunchKernelGGL(dbg_zcols, dim3(1024), dim3(512), 0, stream, (const bf16_t*)((char*)d_ws + WS_Z), flag);
#endif
      for (int i = 13; i <= 18; ++i) (void)hipMemsetAsync(flag + 1 + i, 1, 4, stream);
      hipLaunchKernelGGL(dbg_final, dim3(grid), dim3(512), 0, stream, (const float*)d_in[0], (const float*)d_in[30], (float*)d_out);
      hipLaunchKernelGGL(dbg_scale, dim3(1024), dim3(512), 0, stream, (float*)d_out, (const unsigned*)flag); }
#elif defined(DBG_CSUM)
    { unsigned* flag = (unsigned*)((char*)d_ws + 512 * 1024); (void)hipMemsetAsync(flag, 0, 256, stream);
      hipLaunchKernelGGL(dbg_csum, dim3(1024), dim3(512), 0, stream, (const unsigned*)((char*)d_ws + DBG_CSUM_OFF), (size_t)DBG_CSUM_WORDS, flag);
      hipLaunchKernelGGL(dbg_final, dim3(grid), dim3(512), 0, stream, (const float*)d_in[0], (const float*)d_in[30], (float*)d_out);
      hipLaunchKernelGGL(dbg_scale3, dim3(1024), dim3(512), 0, stream, (float*)d_out, (const unsigned*)flag); }
#elif defined(DBG_CLASS)
    { unsigned* flag = (unsigned*)((char*)d_ws + 512 * 1024); (void)hipMemsetAsync(flag, 0, 256, stream);
      hipLaunchKernelGGL(dbg_class, dim3(1024), dim3(512), 0, stream, (const bf16_t*)((char*)d_ws + DBG_CLASS_OFF), (size_t)DBG_CLASS_N, flag);
      hipLaunchKernelGGL(dbg_final, dim3(grid), dim3(512), 0, stream, (const float*)d_in[0], (const float*)d_in[30], (float*)d_out);
      hipLaunchKernelGGL(dbg_scale2, dim3(1024), dim3(512), 0, stream, (float*)d_out, (const unsigned*)flag); }
#elif defined(DBG_CHECK)
    { unsigned* flag = (unsigned*)((char*)d_ws + 512 * 1024); (void)hipMemsetAsync(flag, 0x7f, 4, stream); (void)hipMemsetAsync(flag + 1, 0, 128, stream);
      struct B { size_t off, n; int f32; }; const B bl[] = {
#ifdef DBG_DEAD
        {WS_WIN, (size_t)IN_WIDTH * D, 0}, {WS_XN, (size_t)M * D, 0},
#endif
        {WS_Z, (size_t)M * NZ, 0}, {WS_QH, (size_t)M * 1024, 0}, {WS_QH, (size_t)M * 1024, 0}, {WS_NT, (size_t)64 * 64 * 16384, 0}, {WS_DC, (size_t)64 * 64 * 128, 1},
        {WS_RP, (size_t)M * 1024, 0}, {WS_Y0, (size_t)M * 1024, 0}, {WS_MT, (size_t)M * 1024, 0}, {WS_NN, (size_t)M * 1024, 0}, {WS_RK, (size_t)M * 16, 1}, {WS_VFIRST, (size_t)M * 1024, 0},
        {WS_YHG, (size_t)M * 1024, 0}, {WS_SS, (size_t)M * 1024, 0}, {WS_YRW, (size_t)M * 1024, 0}, {WS_XN, (size_t)M * D, 0} };
#ifdef DBG_TRTEST
      hipLaunchKernelGGL(dbg_trtest, dim3(1), dim3(64), 0, stream, flag);
#endif
#ifdef DBG_H1TEST
      hipLaunchKernelGGL(dbg_h1test, dim3(1), dim3(512), 65536, stream, flag);
#endif
      for (unsigned i = 0; i < sizeof(bl) / sizeof(bl[0]); ++i) hipLaunchKernelGGL(dbg_check, dim3(1024), dim3(512), 0, stream, (const void*)((char*)d_ws + bl[i].off), bl[i].n, bl[i].f32, flag, i + 1);
      hipLaunchKernelGGL(dbg_check, dim3(1024), dim3(512), 0, stream, (const void*)d_out, (size_t)M * D, 1, flag, 18u);
      hipLaunchKernelGGL(dbg_final, dim3(grid), dim3(512), 0, stream, (const float*)d_in[0], (const float*)d_in[30], (float*)d_out);
      hipLaunchKernelGGL(dbg_scale, dim3(1024), dim3(512), 0, stream, (float*)d_out, (const unsigned*)flag); }
#elif DBG_CUT < 1000
    hipLaunchKernelGGL(dbg_final, dim3(grid), dim3(512), 0, stream, (const float*)(DBG_CUT <= 6 ? d_in[0] : d_out), (const float*)d_in[30], (float*)d_out);
#endif
}
```

```cpp
#define MK_ONE_LAUNCH 1
#include <hip/hip_runtime.h>
#include <stdint.h>
#include <stdio.h>
#ifndef MK_ONE_LAUNCH
#define MK_ONE_LAUNCH 0
#endif
#define DI __device__ __forceinline__
#define LAS __attribute__((address_space(3)))
typedef unsigned short bf16_t;
typedef short bf16x8 __attribute__((ext_vector_type(8)));
typedef short s16x4 __attribute__((ext_vector_type(4)));
typedef float f32x4 __attribute__((ext_vector_type(4)));
typedef float f32x2 __attribute__((ext_vector_type(2)));
typedef unsigned u32x4 __attribute__((ext_vector_type(4)));
typedef unsigned u32x2 __attribute__((ext_vector_type(2)));

constexpr int M = 16384, D = 2048, TSEQ = 2048, NBATCH = 8;
constexpr int NZ = 11776;
constexpr int ZC_Q = 0, ZC_F = 1024, ZC_I = 2048, ZC_O = 3072, ZC_R = 4096, ZC_K = 5120, ZC_V = 6144, ZC_WD = 7168, ZC_AD = 7232, ZC_GD = 7296,
              ZC_GA = 7456, ZC_GB = 9504, ZC_VDA = 11552, ZC_VDB = 11584;
constexpr int IN_WIDTH = 11552;
constexpr int NEXP = 32, DEXP = 512, MAXSLOTS = 40960;
constexpr float NORM_EPS = 1e-6f, RW_GN_EPS = 64e-5f;
constexpr size_t MiB = 1u << 20;
constexpr size_t WS_CTL = 0, CTL_BYTES = 1 * MiB;
constexpr size_t WS_TOKE = 1 * MiB, WS_TOKW = WS_TOKE + 128 * 1024, WS_TOKS = WS_TOKW + 128 * 1024, WS_CNT = WS_TOKS + 128 * 1024, WS_SRSTD = WS_CNT + 64 * 1024, WS_TRSTD = WS_SRSTD + 192 * 1024;
constexpr size_t WS_LORA = 2 * MiB;
constexpr size_t LO_WUP = 0, LO_AUP = 128 * 1024, LO_GUP = 256 * 1024, LO_VUP = 576 * 1024, LO_WR = 640 * 1024, LO_WRL = 832 * 1024;
constexpr size_t WS_WIN = 4 * MiB, WS_WBH = 50 * MiB, WS_WBR = 54 * MiB, WS_WO = 58 * MiB;
constexpr size_t WS_Z = 66 * MiB;
constexpr size_t WS_XS = WS_Z, WS_ACT = WS_Z + 160 * MiB, WS_YS = WS_Z + 200 * MiB;
constexpr size_t WS_XN = 434 * MiB;
constexpr size_t WS_YHG = 498 * MiB, WS_YRW = 530 * MiB, WS_VFIRST = 562 * MiB;
constexpr size_t WS_X = 594 * MiB;
constexpr size_t WS_NT = WS_X, WS_DC = WS_X + 128 * MiB, WS_QH = WS_X + 130 * MiB, WS_OI = WS_X + 162 * MiB;
constexpr size_t WS_MT = WS_X + 194 * MiB, WS_NN = WS_X + 226 * MiB, WS_RP = WS_X + 258 * MiB, WS_Y0 = WS_X + 290 * MiB, WS_SS = WS_X + 322 * MiB,
                 WS_RK = WS_X + 354 * MiB, WS_VF = WS_X + 355 * MiB;
constexpr size_t WS_WGU = 981 * MiB, WS_WDN = WS_X + 64 * MiB;
constexpr size_t WS_END = 1109 * MiB;
constexpr int CW_BAR = 4096;
constexpr size_t CTL_SLOTTOK = 256 * 1024;
constexpr int LDS_CTL_OFF = 148 * 1024, LDS_BYTES = 152 * 1024;
constexpr int LC_TOT = 16, LC_PAD = 48, LC_TILE = 96, LC_MISC = 256;

DI float bf2f(unsigned short b) { return __uint_as_float(((unsigned)b) << 16); }
typedef __bf16 nbf16x2 __attribute__((ext_vector_type(2)));
DI unsigned cvt_pk(float lo, float hi) { const f32x2 f = {lo, hi}; const nbf16x2 v = __builtin_convertvector(f, nbf16x2); return __builtin_bit_cast(unsigned, v); }
DI void unpack8(const u32x4 v, float (&f)[8]) {
    f[0] = __uint_as_float(v.x << 16); f[1] = __uint_as_float(v.x & 0xffff0000u); f[2] = __uint_as_float(v.y << 16); f[3] = __uint_as_float(v.y & 0xffff0000u);
    f[4] = __uint_as_float(v.z << 16); f[5] = __uint_as_float(v.z & 0xffff0000u); f[6] = __uint_as_float(v.w << 16); f[7] = __uint_as_float(v.w & 0xffff0000u); }
DI u32x4 pack8(const float (&f)[8]) { u32x4 v; v.x = cvt_pk(f[0], f[1]); v.y = cvt_pk(f[2], f[3]); v.z = cvt_pk(f[4], f[5]); v.w = cvt_pk(f[6], f[7]); return v; }
DI void unpack4(const u32x2 v, float (&f)[4]) { f[0] = __uint_as_float(v.x << 16); f[1] = __uint_as_float(v.x & 0xffff0000u); f[2] = __uint_as_float(v.y << 16); f[3] = __uint_as_float(v.y & 0xffff0000u); }
DI u32x2 pack4(float a, float b, float c, float d) { u32x2 v; v.x = cvt_pk(a, b); v.y = cvt_pk(c, d); return v; }
DI float sigm(float x) { return 1.0f / (1.0f + __expf(-x)); }
DI float wave_sum(float v) {
#pragma unroll
    for (int o = 1; o < 64; o <<= 1) v += __shfl_xor(v, o);
    return v;
}

DI void lds_barrier() { asm volatile("s_waitcnt lgkmcnt(0)\n\ts_barrier" ::: "memory"); }
namespace pg8 {
#define PG8_LAS __attribute__((address_space(3)))
typedef unsigned short bf16_t;
typedef short bf16x8 __attribute__((ext_vector_type(8)));
typedef float f32x4 __attribute__((ext_vector_type(4)));
typedef unsigned u32x4 __attribute__((ext_vector_type(4)));
constexpr int BM = 256, BK = 64, HALF = 128, HTB = HALF * BK * 2  , STAGE_BYTES = 8 * HTB, NXCD = 8, WGM = 8;

__host__ __device__ __forceinline__ int lds_byte(int r, int c) { const int st = (r >> 4) * 2 + (c >> 5), rr = r & 15, cc = c & 31, ob = rr * 64 + cc * 2; return st * 1024 + (ob ^ (((ob >> 9) & 1) << 5)); }
__host__ __device__ __forceinline__ void stage_rc(int b, int& R, int& C) { const int st = b / 1024, sb = b % 1024, swz = sb ^ (((sb >> 9) & 1) << 5); R = (st >> 1) * 16 + swz / 64; C = (st & 1) * 32 + (swz % 64) / 2; }
__host__ __device__ __forceinline__ int perm32(int rho) { const int n = rho >> 4, i = rho & 15; return 8 * (i >> 2) + 4 * n + (i & 3); }

struct Unit { int pm, pn; };
struct Gemm { const bf16_t* A; const bf16_t* Bt; int M, N, K; const int* amap = nullptr; };

struct StaticOrder {
    int nM, nN, nwg, G, c, wgm, hot = 0;
    __host__ __device__ void init(int M, int N, int G_, int c_, int wgm_ = WGM) { nM = M / BM; nN = N / BM; nwg = nM * nN; G = G_; c = c_; wgm = wgm_; }
    __host__ __device__ bool next(int i, Unit& u) const {
        const long L = (long)i * G + c; if (L >= nwg) return false;
        int wgid = (int)L; { const int q = nwg / NXCD, r = nwg % NXCD, xcd = wgid % NXCD, off = wgid / NXCD; wgid = (xcd < r ? xcd * (q + 1) : r * (q + 1) + (xcd - r) * q) + off; }
        const int nig = wgm * nN, gid = wgid / nig, fm = gid * wgm, gsz = (nM - fm) < wgm ? (nM - fm) : wgm;
        if (hot) { u.pm = 0; u.pn = 0; return true; }
        u.pm = fm + ((wgid % nig) % gsz); u.pn = (wgid % nig) / gsz; return true;
    }
    __device__ __forceinline__ void a_ready(const Unit&) const {}
    __device__ __forceinline__ void done(const Unit&) const {}
};
__device__ __forceinline__ unsigned cvt_pk_bf16(float lo, float hi) { return ::cvt_pk(lo, hi); }
typedef float f32x2 __attribute__((ext_vector_type(2)));
struct EpiBf16P {
    static constexpr bool PERM = true, AFTER_DRAIN = false;
    bf16_t* O; int ldc; int dbg;
    __device__ __forceinline__ void operator()(const f32x4 (&acc)[2][2][4][2], const Unit& u, int wr, int wc, int fr, int fq) const {
        if (dbg == 1) { float s = 0.f; _Pragma("unroll") for (int ai = 0; ai < 2; ++ai) _Pragma("unroll") for (int bj = 0; bj < 2; ++bj) _Pragma("unroll") for (int m = 0; m < 4; ++m) _Pragma("unroll") for (int n = 0; n < 2; ++n) s += acc[ai][bj][m][n][0] + acc[ai][bj][m][n][3]; asm volatile("" :: "v"(s)); return; }
        const int row0 = u.pm * BM + wr * 64 + fr, col0 = u.pn * BM + wc * 32 + 8 * fq;
#pragma unroll
        for (int ai = 0; ai < 2; ++ai)
#pragma unroll
            for (int m = 0; m < 4; ++m) { bf16_t* rowp = (dbg == 2 ? O + (size_t)(658 * 1024 * 1024 / 2) : O) + (size_t)(dbg == 2 ? (int)(blockIdx.x * 16 + fr) : row0 + ai * HALF + m * 16) * ldc + col0;
#pragma unroll
                for (int bj = 0; bj < 2; ++bj) { const f32x4 v0 = acc[ai][bj][m][0], v1 = acc[ai][bj][m][1];
                    u32x4 w; w.x = cvt_pk_bf16(v0[0], v0[1]); w.y = cvt_pk_bf16(v0[2], v0[3]); w.z = cvt_pk_bf16(v1[0], v1[1]); w.w = cvt_pk_bf16(v1[2], v1[3]);
                    *(u32x4*)(rowp + bj * HALF) = w; } asm volatile("" ::: "memory"); }
    }
};
struct EpiGate {
    static constexpr bool PERM = true, AFTER_DRAIN = false;
    bf16_t* O; int ldo; const bf16_t* Zg; int ldz; int accum; int dbg;
    __device__ __forceinline__ void operator()(const f32x4 (&acc)[2][2][4][2], const Unit& u, int wr, int wc, int fr, int fq) const {
        if (dbg) { float s = 0.f; _Pragma("unroll") for (int ai = 0; ai < 2; ++ai) _Pragma("unroll") for (int bj = 0; bj < 2; ++bj) _Pragma("unroll") for (int m = 0; m < 4; ++m) _Pragma("unroll") for (int n = 0; n < 2; ++n) s += acc[ai][bj][m][n][0] + acc[ai][bj][m][n][3]; asm volatile("" :: "v"(s)); return; }
        const int row0 = u.pm * BM + wr * 64 + fr, col0 = u.pn * BM + wc * 32 + 8 * fq;
#pragma unroll
        for (int ai = 0; ai < 2; ++ai) {
            u32x4 zg[4][2], pv[4][2];
#pragma unroll
            for (int m = 0; m < 4; ++m)
#pragma unroll
                for (int bj = 0; bj < 2; ++bj) { const size_t row = (size_t)(row0 + ai * HALF + m * 16); zg[m][bj] = *(const u32x4*)(Zg + row * ldz + col0 + bj * HALF);
                    if (accum) pv[m][bj] = *(const u32x4*)(O + row * ldo + col0 + bj * HALF); else pv[m][bj] = (u32x4){0u, 0u, 0u, 0u}; }
#pragma unroll
            for (int m = 0; m < 4; ++m)
#pragma unroll
                for (int bj = 0; bj < 2; ++bj) { const size_t row = (size_t)(row0 + ai * HALF + m * 16); const f32x4 v0 = acc[ai][bj][m][0], v1 = acc[ai][bj][m][1];
                    const unsigned zw[4] = {zg[m][bj].x, zg[m][bj].y, zg[m][bj].z, zg[m][bj].w}, pw[4] = {pv[m][bj].x, pv[m][bj].y, pv[m][bj].z, pv[m][bj].w};
                    float o[8];
#pragma unroll
                    for (int j = 0; j < 4; ++j) { const float z0 = __uint_as_float(zw[j] << 16), z1 = __uint_as_float(zw[j] & 0xffff0000u); const float a0 = j < 2 ? v0[2 * j] : v1[2 * j - 4], a1 = j < 2 ? v0[2 * j + 1] : v1[2 * j - 3];
                        o[2 * j] = a0 / (1.0f + __expf(-z0)) + __uint_as_float(pw[j] << 16); o[2 * j + 1] = a1 / (1.0f + __expf(-z1)) + __uint_as_float(pw[j] & 0xffff0000u); }
                    u32x4 w; w.x = cvt_pk_bf16(o[0], o[1]); w.y = cvt_pk_bf16(o[2], o[3]); w.z = cvt_pk_bf16(o[4], o[5]); w.w = cvt_pk_bf16(o[6], o[7]);
                    *(u32x4*)(O + row * ldo + col0 + bj * HALF) = w; }
            asm volatile("" ::: "memory");
        }
    }
};
struct EpiRes {
    static constexpr bool PERM = false, AFTER_DRAIN = false;
    const float* base; float* out; int ldc; int dbg;
    __device__ __forceinline__ void operator()(const f32x4 (&acc)[2][2][4][2], const Unit& u, int wr, int wc, int fr, int fq) const {
        if (dbg) { float s = 0.f; _Pragma("unroll") for (int ai = 0; ai < 2; ++ai) _Pragma("unroll") for (int bj = 0; bj < 2; ++bj) _Pragma("unroll") for (int m = 0; m < 4; ++m) _Pragma("unroll") for (int n = 0; n < 2; ++n) s += acc[ai][bj][m][n][0] + acc[ai][bj][m][n][3]; asm volatile("" :: "v"(s)); return; }
        const int row0 = u.pm * BM + wr * 64 + fr, col0 = u.pn * BM + wc * 32 + 4 * fq;
#pragma unroll
        for (int ai = 0; ai < 2; ++ai) {
            f32x4 bs[4][2][2];
#pragma unroll
            for (int m = 0; m < 4; ++m) { const size_t off = (size_t)(row0 + ai * HALF + m * 16) * ldc + col0;
#pragma unroll
                for (int bj = 0; bj < 2; ++bj)
#pragma unroll
                    for (int n = 0; n < 2; ++n) bs[m][bj][n] = *(const f32x4*)(base + off + bj * HALF + n * 16); }
#pragma unroll
            for (int m = 0; m < 4; ++m) { const size_t off = (size_t)(row0 + ai * HALF + m * 16) * ldc + col0;
#pragma unroll
                for (int bj = 0; bj < 2; ++bj)
#pragma unroll
                    for (int n = 0; n < 2; ++n) *(f32x4*)(out + off + bj * HALF + n * 16) = bs[m][bj][n] + acc[ai][bj][m][n]; }
            asm volatile("" ::: "memory");
        }
    }
};
struct EpiSwiGLU {
    static constexpr bool PERM = true, AFTER_DRAIN = false;
    bf16_t* O; const float* rstd; int dbg;
    __device__ __forceinline__ void operator()(const f32x4 (&acc)[2][2][4][2], const Unit& u, int wr, int wc, int fr, int fq) const {
        if (dbg) { float s = 0.f; _Pragma("unroll") for (int ai = 0; ai < 2; ++ai) _Pragma("unroll") for (int bj = 0; bj < 2; ++bj) _Pragma("unroll") for (int m = 0; m < 4; ++m) _Pragma("unroll") for (int n = 0; n < 2; ++n) s += acc[ai][bj][m][n][0] + acc[ai][bj][m][n][3]; asm volatile("" :: "v"(s)); return; }
        const int row0 = u.pm * BM + wr * 64 + fr, col0 = (u.pn & 3) * 128 + wc * 32 + 8 * fq;
        float rsv[2][4];
#pragma unroll
        for (int ai = 0; ai < 2; ++ai)
#pragma unroll
            for (int m = 0; m < 4; ++m) rsv[ai][m] = rstd[row0 + ai * HALF + m * 16];
#pragma unroll
        for (int ai = 0; ai < 2; ++ai)
#pragma unroll
            for (int m = 0; m < 4; ++m) { bf16_t* rowp = O + (size_t)(row0 + ai * HALF + m * 16) * 512 + col0; const float rs = rsv[ai][m];
                float o[8];
#pragma unroll
                for (int n = 0; n < 2; ++n)
#pragma unroll
                    for (int j = 0; j < 4; ++j) { const float g = acc[ai][0][m][n][j] * rs, up = acc[ai][1][m][n][j] * rs; o[4 * n + j] = g / (1.0f + __expf(-g)) * up; }
                u32x4 w; w.x = cvt_pk_bf16(o[0], o[1]); w.y = cvt_pk_bf16(o[2], o[3]); w.z = cvt_pk_bf16(o[4], o[5]); w.w = cvt_pk_bf16(o[6], o[7]);
                *(u32x4*)rowp = w; asm volatile("" ::: "memory"); }
    }
};
struct EpiDown {
    static constexpr bool PERM = true, AFTER_DRAIN = false;
    bf16_t* O; int dbg;
    __device__ __forceinline__ void operator()(const f32x4 (&acc)[2][2][4][2], const Unit& u, int wr, int wc, int fr, int fq) const {
        if (dbg) { float s = 0.f; _Pragma("unroll") for (int ai = 0; ai < 2; ++ai) _Pragma("unroll") for (int bj = 0; bj < 2; ++bj) _Pragma("unroll") for (int m = 0; m < 4; ++m) _Pragma("unroll") for (int n = 0; n < 2; ++n) s += acc[ai][bj][m][n][0] + acc[ai][bj][m][n][3]; asm volatile("" :: "v"(s)); return; }
        const int row0 = u.pm * BM + wr * 64 + fr, col0 = (u.pn & 7) * BM + wc * 32 + 8 * fq;
#pragma unroll
        for (int ai = 0; ai < 2; ++ai)
#pragma unroll
            for (int m = 0; m < 4; ++m) { bf16_t* rowp = O + (size_t)(row0 + ai * HALF + m * 16) * 2048 + col0;
#pragma unroll
                for (int bj = 0; bj < 2; ++bj) { const f32x4 v0 = acc[ai][bj][m][0], v1 = acc[ai][bj][m][1];
                    u32x4 w; w.x = cvt_pk_bf16(v0[0], v0[1]); w.y = cvt_pk_bf16(v0[2], v0[3]); w.z = cvt_pk_bf16(v1[0], v1[1]); w.w = cvt_pk_bf16(v1[2], v1[3]);
                    *(u32x4*)(rowp + bj * HALF) = w; } asm volatile("" ::: "memory"); }
    }
};
template <int NTN> struct GroupedOrder {
    static constexpr int ntn = NTN; int nunits, G, c; const PG8_LAS int* tile_e;
    __device__ __forceinline__ bool next(int i, Unit& u) const { const long L = (long)i * G + c; if (L >= nunits) return false; const int rt = (int)L / ntn, pl = (int)L % ntn; u.pm = rt; u.pn = tile_e[rt] * ntn + pl; return true; }
    __device__ __forceinline__ void a_ready(const Unit&) const {}
    __device__ __forceinline__ void done(const Unit&) const {}
};
template <class Epi, class Sched, bool STAMP = false, bool GATHER = false>
__device__ __forceinline__ void gemm_phase(PG8_LAS unsigned char* lds, const Gemm g, const Sched& S, const Epi& E, unsigned long long* stamps) {
    int tid_ = threadIdx.x; asm volatile("" : "+v"(tid_));
    const int tid = tid_, wid = __builtin_amdgcn_readfirstlane(tid >> 6), lane = tid & 63, wr = wid >> 2, wc = wid & 3, fr = lane & 15, fq = lane >> 4;
    const int K = g.K, nt = K / BK;
    int ts_lo = 0, ts_hi = 0, nts = 0; const unsigned long long rt_entry = STAMP ? (unsigned long long)wall_clock64() : 0ull;
#define PG8_STAMP() do { if (STAMP && wid == 0 && nts < 64) { const unsigned long long _c = (unsigned long long)clock64(); \
        ts_lo = (lane == nts) ? (int)(unsigned)_c : ts_lo; ts_hi = (lane == nts) ? (int)(unsigned)(_c >> 32) : ts_hi; ++nts; } } while (0)
    PG8_STAMP();
    unsigned voffA[2], voffB[2]; int gR[2]; unsigned gC[2];
#pragma unroll
    for (int i = 0; i < 2; ++i) { int R, C; stage_rc(tid * 16 + i * 8192, R, C); const int Rb = Epi::PERM ? ((R & ~31) + perm32(R & 31)) : R;
        voffA[i] = (unsigned)(R * K + C) * 2u; voffB[i] = (unsigned)(Rb * K + C) * 2u; gR[i] = R; gC[i] = (unsigned)C * 2u; }
    const size_t kstep = (size_t)(BK * 2);
    const size_t hstep = (size_t)HALF * K * 2;
    const size_t tstep = 2 * hstep;
    const unsigned ldsw = (unsigned)wid * 1024u;
    const int aoff = lds_byte(wr * 64 + fr, fq * 8), boff = lds_byte(wc * 32 + fr, fq * 8);
#define PG8_SA(b, h) (((b) * 2 + (h)) * HTB)
#define PG8_SB(b, h) ((4 + (b) * 2 + (h)) * HTB)
#define PG8_STAGE(bufoff, gbase, voff) do { _Pragma("unroll") for (int _i = 0; _i < 2; ++_i) \
        __builtin_amdgcn_global_load_lds((const unsigned*)((const char*)(gbase) + (voff)[_i]), (PG8_LAS unsigned*)(lds + (bufoff) + ldsw + _i * 8192), 16, 0, 0); } while (0)
#define PG8_LDA(dst, b, h) do { _Pragma("unroll") for (int m = 0; m < 4; ++m) _Pragma("unroll") for (int k = 0; k < 2; ++k) dst[m][k] = *(const PG8_LAS bf16x8*)(lds + PG8_SA(b, h) + aoff + m * 2048 + k * 1024); } while (0)
#define PG8_LDB(dst, b, h) do { _Pragma("unroll") for (int n = 0; n < 2; ++n) _Pragma("unroll") for (int k = 0; k < 2; ++k) dst[n][k] = *(const PG8_LAS bf16x8*)(lds + PG8_SB(b, h) + boff + n * 2048 + k * 1024); } while (0)
#define PG8_MMA(ai, bj, At, Bt) do { __builtin_amdgcn_s_setprio(1); _Pragma("unroll") for (int m = 0; m < 4; ++m) _Pragma("unroll") for (int n = 0; n < 2; ++n) _Pragma("unroll") for (int k = 0; k < 2; ++k) \
        acc[ai][bj][m][n] = __builtin_amdgcn_mfma_f32_16x16x32_bf16(Bt[n][k], At[m][k], acc[ai][bj][m][n], 0, 0, 0); __builtin_amdgcn_s_setprio(0); } while (0)
#define PG8_WAIT_V(n) asm volatile("s_waitcnt vmcnt(" #n ")" ::: "memory")
#define PG8_WAIT_L(n) asm volatile("s_waitcnt lgkmcnt(" #n ")" ::: "memory")
#define PG8_BAR __builtin_amdgcn_s_barrier()
#define PG8_SCHED __builtin_amdgcn_sched_barrier(0)
    Unit cur, nxt; int ui = 0;
    if (!S.next(0, cur)) return;
    f32x4 acc[2][2][4][2];
#pragma unroll
    for (int a = 0; a < 2; ++a)
#pragma unroll
        for (int b = 0; b < 2; ++b)
#pragma unroll
            for (int m = 0; m < 4; ++m)
#pragma unroll
                for (int n = 0; n < 2; ++n) acc[a][b][m][n] = (f32x4){0.f, 0.f, 0.f, 0.f};
    bf16x8 At[4][2], B0[2][2], B1[2][2];
    const char* cA = (const char*)g.A + (size_t)cur.pm * tstep; const char* cB = (const char*)g.Bt + (size_t)cur.pn * tstep;
    const char* gA = (const char*)g.A; unsigned voC[2][2], voN[2][2];
#define PG8_GATH(vo, u) do { _Pragma("unroll") for (int _h = 0; _h < 2; ++_h) _Pragma("unroll") for (int _i = 0; _i < 2; ++_i) \
        vo[_h][_i] = (unsigned)g.amap[(u).pm * BM + _h * HALF + gR[_i]] * (unsigned)(K * 2) + gC[_i]; } while (0)
    if constexpr (GATHER) { PG8_GATH(voC, cur); }
    S.a_ready(cur);
    PG8_STAGE(PG8_SB(0, 0), cB, voffB); if constexpr (GATHER) PG8_STAGE(PG8_SA(0, 0), gA, voC[0]); else PG8_STAGE(PG8_SA(0, 0), cA, voffA);
    PG8_STAGE(PG8_SB(0, 1), cB + hstep, voffB); if constexpr (GATHER) PG8_STAGE(PG8_SA(0, 1), gA, voC[1]); else PG8_STAGE(PG8_SA(0, 1), cA + hstep, voffA);
    if (wr == 1) PG8_BAR;
    PG8_WAIT_V(4); PG8_BAR;
    PG8_STAGE(PG8_SB(1, 0), cB + kstep, voffB); if constexpr (GATHER) PG8_STAGE(PG8_SA(1, 0), gA + kstep, voC[0]); else PG8_STAGE(PG8_SA(1, 0), cA + kstep, voffA);
    PG8_STAGE(PG8_SB(1, 1), cB + hstep + kstep, voffB);
    PG8_WAIT_V(6); PG8_BAR;
    PG8_STAMP();
    for (;;) {
        const bool has_next = S.next(ui + 1, nxt);
        if constexpr (GATHER) { if (has_next) { PG8_GATH(voN, nxt); } else { _Pragma("unroll") for (int _h = 0; _h < 2; ++_h) _Pragma("unroll") for (int _i = 0; _i < 2; ++_i) voN[_h][_i] = voC[_h][_i]; } }
        const char* nA = has_next ? (const char*)g.A + (size_t)nxt.pm * tstep : cA; const char* nB = has_next ? (const char*)g.Bt + (size_t)nxt.pn * tstep : cB;
        for (int t = 0; t < nt; t += 2) {
            const bool last = (t == nt - 2);
            const char* a1 = cA + (size_t)(t + 1) * kstep;
            const char* a2 = last ? nA : cA + (size_t)(t + 2) * kstep; const char* b2 = last ? nB : cB + (size_t)(t + 2) * kstep;
            const char* a3 = a2 + kstep; const char* b3 = b2 + kstep;
            const char* g1 = gA + (size_t)(t + 1) * kstep; const char* g2 = last ? gA : gA + (size_t)(t + 2) * kstep; const char* g3 = g2 + kstep; unsigned v2[2][2];
            if constexpr (GATHER) { _Pragma("unroll") for (int _h = 0; _h < 2; ++_h) _Pragma("unroll") for (int _i = 0; _i < 2; ++_i) v2[_h][_i] = last ? voN[_h][_i] : voC[_h][_i]; }
            if (last && has_next) S.a_ready(nxt);
            PG8_LDB(B0, 0, 0); PG8_SCHED; PG8_LDA(At, 0, 0); if constexpr (GATHER) PG8_STAGE(PG8_SA(1, 1), g1, voC[1]); else PG8_STAGE(PG8_SA(1, 1), a1 + hstep, voffA);
            PG8_WAIT_L(8); PG8_BAR; PG8_WAIT_L(0); PG8_MMA(0, 0, At, B0); PG8_BAR; PG8_SCHED;
            PG8_LDB(B1, 0, 1); PG8_STAGE(PG8_SB(0, 0), b2, voffB);
            PG8_BAR; PG8_WAIT_L(0); PG8_MMA(0, 1, At, B1); PG8_BAR;
            PG8_LDA(At, 0, 1); if constexpr (GATHER) PG8_STAGE(PG8_SA(0, 0), g2, v2[0]); else PG8_STAGE(PG8_SA(0, 0), a2, voffA);
            PG8_BAR; PG8_WAIT_L(0); PG8_MMA(1, 0, At, B0); PG8_BAR; PG8_SCHED;
            PG8_STAGE(PG8_SB(0, 1), b2 + hstep, voffB);
            PG8_WAIT_V(6); PG8_BAR; PG8_MMA(1, 1, At, B1); PG8_BAR;
            PG8_LDB(B0, 1, 0); PG8_SCHED; PG8_LDA(At, 1, 0); if constexpr (GATHER) PG8_STAGE(PG8_SA(0, 1), g2, v2[1]); else PG8_STAGE(PG8_SA(0, 1), a2 + hstep, voffA);
            PG8_WAIT_L(8); PG8_BAR; PG8_WAIT_L(0); PG8_MMA(0, 0, At, B0); PG8_BAR; PG8_SCHED;
            PG8_LDB(B1, 1, 1); PG8_STAGE(PG8_SB(1, 0), b3, voffB);
            PG8_BAR; PG8_WAIT_L(0); PG8_MMA(0, 1, At, B1); PG8_BAR;
            PG8_LDA(At, 1, 1); if constexpr (GATHER) PG8_STAGE(PG8_SA(1, 0), g3, v2[0]); else PG8_STAGE(PG8_SA(1, 0), a3, voffA);
            PG8_BAR; PG8_WAIT_L(0); PG8_MMA(1, 0, At, B0); PG8_BAR; PG8_SCHED;
            PG8_STAGE(PG8_SB(1, 1), b3 + hstep, voffB);
            PG8_WAIT_V(6); PG8_BAR; PG8_MMA(1, 1, At, B1); PG8_BAR;
        }
        PG8_STAMP();
        if constexpr (!Epi::AFTER_DRAIN) { E(acc, cur, wr, wc, fr, fq); S.done(cur); }
        PG8_STAMP();
        if (!has_next) break;
#pragma unroll
        for (int a = 0; a < 2; ++a)
#pragma unroll
            for (int b = 0; b < 2; ++b)
#pragma unroll
                for (int m = 0; m < 4; ++m)
#pragma unroll
                    for (int n = 0; n < 2; ++n) acc[a][b][m][n] = (f32x4){0.f, 0.f, 0.f, 0.f};
        cur = nxt; cA = nA; cB = nB; ++ui;
        if constexpr (GATHER) { _Pragma("unroll") for (int _h = 0; _h < 2; ++_h) _Pragma("unroll") for (int _i = 0; _i < 2; ++_i) voC[_h][_i] = voN[_h][_i]; }
    }
    PG8_WAIT_V(0);
    if (wr == 0) PG8_BAR;
    PG8_BAR;
    if constexpr (Epi::AFTER_DRAIN) { E.fused(acc, cur, wr, wc, fr, fq, lds, wid, lane); S.done(cur); }
    PG8_STAMP();
    if (STAMP && wid == 0) { stamps[lane] = lane < nts ? (((unsigned long long)(unsigned)ts_hi << 32) | (unsigned)ts_lo) : 0ull;
        if (lane == 62) stamps[62] = rt_entry; if (lane == 63) stamps[63] = (unsigned long long)wall_clock64(); }
#undef PG8_STAMP
#undef PG8_SA
#undef PG8_SB
#undef PG8_STAGE
#undef PG8_GATH
#undef PG8_LDA
#undef PG8_LDB
#undef PG8_MMA
#undef PG8_WAIT_V
#undef PG8_WAIT_L
#undef PG8_BAR
#undef PG8_SCHED
}
}
#define XB_TMO      128
#define XB_XCNT(j)  (256  + 64 * (j))
#define XB_XSUB(j)  (1280 + 64 * (j))
#define XB_XGEN(j)  (2304 + 64 * (j))
#define XB_TOP      3328
#define XB_TOPGEN   3392
#define XCD_BAR_WORDS 3456
#define XB_SPIN_CAP (1u << 18)

__device__ __forceinline__ unsigned xb_ld(unsigned* p)              { return __hip_atomic_load(p, __ATOMIC_RELAXED, __HIP_MEMORY_SCOPE_AGENT); }
__device__ __forceinline__ unsigned xb_add(unsigned* p, unsigned v) { return __hip_atomic_fetch_add(p, v, __ATOMIC_RELAXED, __HIP_MEMORY_SCOPE_AGENT); }
__device__ __forceinline__ unsigned xb_xcc_id() { return (unsigned)__builtin_amdgcn_s_getreg((3 << 11) | 20) & 0xFu; }
#define XB_SPIN(cond, bar) do { unsigned _sp = 0; while (cond) { __builtin_amdgcn_s_sleep(1); \
    if ((++_sp & 255u) == 0u) { if (xb_ld(&(bar)[XB_TMO])) break; if (_sp > XB_SPIN_CAP) { atomicAdd(&(bar)[XB_TMO], 1u); break; } } } } while (0)

struct XcdBarrier {
    unsigned* bar; unsigned x;
    volatile LAS unsigned* st;
};

__device__ __forceinline__ XcdBarrier xcd_barrier_post(unsigned* bar, volatile LAS unsigned* st) {
    XcdBarrier b; b.bar = bar; b.x = xb_xcc_id(); b.st = st;
    if (threadIdx.x == 0) (void)xb_add(&bar[XB_XCNT(b.x)], 1u);
    return b;
}
__device__ __forceinline__ void xcd_barrier_complete(unsigned* bar, unsigned x, unsigned& nloc, unsigned& nx) {
    const unsigned G = gridDim.x * gridDim.y * gridDim.z;
    unsigned sum, cnt, mine, sp = 0u;
    for (;;) {
        sum = 0u; cnt = 0u; mine = 0u;
#pragma unroll
        for (unsigned j = 0; j < 16; ++j) { const unsigned c = xb_ld(&bar[XB_XCNT(j)]); sum += c; cnt += (c > 0u) ? 1u : 0u; mine = (j == x) ? c : mine; }
        if (sum == G) break;
        __builtin_amdgcn_s_sleep(1);
        if ((++sp & 255u) == 0u) { if (xb_ld(&bar[XB_TMO])) break; if (sp > XB_SPIN_CAP) { atomicAdd(&bar[XB_TMO], 1u); break; } }
    }
    nloc = mine > 0u ? mine : 1u; nx = cnt > 0u ? cnt : 1u;
}

__device__ __forceinline__ void xcd_barrier(const XcdBarrier& b) {
    asm volatile("s_waitcnt vmcnt(0)" ::: "memory");
    __syncthreads();
    if (threadIdx.x == 0) {
        unsigned* bar = b.bar;
        __builtin_amdgcn_s_waitcnt(0);
        unsigned nloc = b.st[0], nx = b.st[1];
        if (nloc == 0u) { xcd_barrier_complete(bar, b.x, nloc, nx); b.st[0] = nloc; b.st[1] = nx; }
        const unsigned old = xb_add(&bar[XB_XSUB(b.x)], 1u);
        const unsigned gen = old / nloc;
        if (old + 1u == (gen + 1u) * nloc) {
            __builtin_amdgcn_fence(__ATOMIC_RELEASE, "agent");
            asm volatile("s_waitcnt vmcnt(0)" ::: "memory");
            const unsigned og = xb_add(&bar[XB_TOP], 1u);
            const unsigned tg = og / nx;
            if (og + 1u == (tg + 1u) * nx) xb_add(&bar[XB_TOPGEN], 1u);
            else XB_SPIN(xb_ld(&bar[XB_TOPGEN]) == tg, bar);
            __builtin_amdgcn_fence(__ATOMIC_ACQUIRE, "agent");
            xb_add(&bar[XB_XGEN(b.x)], 1u);
            asm volatile("s_waitcnt vmcnt(0)" ::: "memory");
        } else {
            XB_SPIN(xb_ld(&bar[XB_XGEN(b.x)]) == gen, bar);
            __builtin_amdgcn_fence(__ATOMIC_ACQUIRE, "agent");
            asm volatile("s_waitcnt vmcnt(0)" ::: "memory");
        }
    }
    __syncthreads();
}
template <int LD> DI bf16x8 frag_n(const LAS bf16_t* A, int row0, int k0, int lane) {
    return *(const LAS bf16x8*)(A + (row0 + (lane & 15)) * LD + k0 + 8 * (lane >> 4));
}
template <int LD> DI bf16x8 frag_t(const LAS bf16_t* A, int row0, int k0, int lane) {
    const int l = lane & 15, g = lane >> 4;
    const unsigned addr = (unsigned)(uintptr_t)(A + (k0 + 8 * g + (l >> 2)) * LD + row0 + 4 * (l & 3));
    s16x4 lo, hi;
    asm volatile("ds_read_b64_tr_b16 %0, %2\n\tds_read_b64_tr_b16 %1, %2 offset:%3\n\ts_waitcnt lgkmcnt(0)" : "=&v"(lo), "=&v"(hi) : "v"(addr), "n"(4 * LD * 2) : "memory");
    bf16x8 r; r[0] = lo[0]; r[1] = lo[1]; r[2] = lo[2]; r[3] = lo[3]; r[4] = hi[0]; r[5] = hi[1]; r[6] = hi[2]; r[7] = hi[3];
    return r;
}
DI bf16x8 gfrag(const bf16_t* A, int ld, int row0, int k0, int lane) {
    return *(const bf16x8*)(A + (size_t)(row0 + (lane & 15)) * ld + k0 + 8 * (lane >> 4));
}
#define MFMA16(a, b, c) __builtin_amdgcn_mfma_f32_16x16x32_bf16((a), (b), (c), 0, 0, 0)
template <bool XT, bool YT, int KS, int LDX, int LDY>
DI f32x4 mm16(const LAS bf16_t* X, const LAS bf16_t* Y, int p0, int q0, int lane, f32x4 acc) {
#pragma unroll
    for (int ks = 0; ks < KS; ++ks) {
        const bf16x8 xb = XT ? frag_t<LDX>(X, p0, 32 * ks, lane) : frag_n<LDX>(X, p0, 32 * ks, lane);
        const bf16x8 ya = YT ? frag_t<LDY>(Y, q0, 32 * ks, lane) : frag_n<LDY>(Y, q0, 32 * ks, lane);
        acc = MFMA16(ya, xb, acc);
    }
    return acc;
}
DI void st4_bf16(LAS bf16_t* p, const f32x4 v) { *(LAS u32x2*)p = pack4(v[0], v[1], v[2], v[3]); }
DI f32x4 ld4_bf16(const LAS bf16_t* p) { const u32x2 w = *(const LAS u32x2*)p; float f[4]; unpack4(w, f); return (f32x4){f[0], f[1], f[2], f[3]}; }
constexpr f32x4 F4Z = {0.f, 0.f, 0.f, 0.f};

struct TrFrag { s16x4 lo, hi; };
template <int LD> DI void tr_issue(TrFrag& f, const LAS bf16_t* A, int row0, int k0, int lane) {
    const int l = lane & 15, g = lane >> 4;
    const unsigned addr = (unsigned)(uintptr_t)(A + (k0 + 8 * g + (l >> 2)) * LD + row0 + 4 * (l & 3));
    asm volatile("ds_read_b64_tr_b16 %0, %2\n\tds_read_b64_tr_b16 %1, %2 offset:%3" : "=&v"(f.lo), "=&v"(f.hi) : "v"(addr), "n"(4 * LD * 2) : "memory");
}
DI bf16x8 tr_get(const TrFrag& f) { bf16x8 r; r[0] = f.lo[0]; r[1] = f.lo[1]; r[2] = f.lo[2]; r[3] = f.lo[3]; r[4] = f.hi[0]; r[5] = f.hi[1]; r[6] = f.hi[2]; r[7] = f.hi[3]; return r; }
template <int LD> DI void tr_issue4(TrFrag (&f)[2][2], const LAS bf16_t* A, int r0, int lane) {
    tr_issue<LD>(f[0][0], A, r0, 0, lane); tr_issue<LD>(f[0][1], A, r0, 32, lane); tr_issue<LD>(f[1][0], A, r0 + 16, 0, lane); tr_issue<LD>(f[1][1], A, r0 + 16, 32, lane); }
template <int LD> DI void tr_issue2(TrFrag (&f)[2], const LAS bf16_t* A, int r0, int lane) { tr_issue<LD>(f[0], A, r0, 0, lane); tr_issue<LD>(f[1], A, r0, 32, lane); }
#define TRW(f) "+v"((f).lo), "+v"((f).hi)
DI void tr_wait4(TrFrag (&a)[2][2]) { asm volatile("s_waitcnt lgkmcnt(0)" : TRW(a[0][0]), TRW(a[0][1]), TRW(a[1][0]), TRW(a[1][1]) :: "memory"); }
DI void tr_wait8(TrFrag (&a)[2][2], TrFrag (&b)[2][2]) { asm volatile("s_waitcnt lgkmcnt(0)" : TRW(a[0][0]), TRW(a[0][1]), TRW(a[1][0]), TRW(a[1][1]), TRW(b[0][0]), TRW(b[0][1]), TRW(b[1][0]), TRW(b[1][1]) :: "memory"); }
DI void tr_wait2(TrFrag (&a)[2]) { asm volatile("s_waitcnt lgkmcnt(0)" : TRW(a[0]), TRW(a[1]) :: "memory"); }
DI void tr_wait42(TrFrag (&a)[2][2], TrFrag (&b)[2]) { asm volatile("s_waitcnt lgkmcnt(0)" : TRW(a[0][0]), TRW(a[0][1]), TRW(a[1][0]), TRW(a[1][1]), TRW(b[0]), TRW(b[1]) :: "memory"); }
DI f32x4 mma2(const bf16x8 x0, const bf16x8 x1, const bf16x8 y0, const bf16x8 y1, f32x4 acc) { acc = MFMA16(y0, x0, acc); return MFMA16(y1, x1, acc); }
struct Params { const float* in[31]; float* out; unsigned char* ws; int ph_lo, ph_hi; };
#define CAS __attribute__((address_space(4)))
typedef const CAS Params& PR;
enum { I_X = 0, I_NMIX, I_WIN, I_LBRAW, I_ONORM, I_MU, I_W0, I_WUP, I_A0, I_AUP, I_GUP, I_KK, I_KA, I_RK, I_LNW, I_LNB, I_V0, I_VDOWN, I_VUP, I_WBH, I_WBR, I_WOUT, I_NFFN,
       I_RGW, I_RGB, I_REW, I_REB, I_EWG, I_EWU, I_EWD, I_FNW };
struct Ctx { LAS unsigned char* lds; int tid, lane, wave, G, bid; };

struct TItem { const float* W; bf16_t* WT; int ldw, ldt; };
DI void titem_load(const TItem& t, f32x4 (&v)[8], int lane) {
#pragma unroll
    for (int i = 0; i < 8; ++i) v[i] = __builtin_nontemporal_load((const f32x4*)(t.W + (size_t)(8 * i + (lane >> 3)) * t.ldw + 4 * (lane & 7)));
}
DI void titem_store(const TItem& t, const f32x4 (&v)[8], LAS float* scr, int lane) {
#pragma unroll
    for (int i = 0; i < 8; ++i) { LAS float* d = scr + (8 * i + (lane >> 3)) * 33 + 4 * (lane & 7); d[0] = v[i].x; d[1] = v[i].y; d[2] = v[i].z; d[3] = v[i].w; }
    asm volatile("s_waitcnt lgkmcnt(0)" ::: "memory");
    const int c = lane & 7;
#pragma unroll
    for (int j = 0; j < 4; ++j) { const int n = (lane >> 3) + 8 * j; const LAS float* s = scr + (8 * c) * 33 + n;
        u32x4 o; o.x = cvt_pk(s[0 * 33], s[1 * 33]); o.y = cvt_pk(s[2 * 33], s[3 * 33]); o.z = cvt_pk(s[4 * 33], s[5 * 33]); o.w = cvt_pk(s[6 * 33], s[7 * 33]);
        *(u32x4*)(t.WT + (size_t)n * t.ldt + 8 * c) = o; }
    asm volatile("s_waitcnt lgkmcnt(0)" ::: "memory");
}
DI TItem mk_titem(const float* W, int ldw, int k0, int n0, bf16_t* WT, int ldt, int drow0) { TItem t; t.W = W + (size_t)k0 * ldw + n0; t.WT = WT + (size_t)drow0 * ldt + k0; t.ldw = ldw; t.ldt = ldt; return t; }
DI TItem small_item(PR p, int l, int it) {
    unsigned char* ws = p.ws;
    constexpr int I_IN = 32 * 361, I_B = 16 * 64;
    int r = it;
    if (r < I_IN) return mk_titem(p.in[I_WIN] + (size_t)l * D * IN_WIDTH, IN_WIDTH, 64 * (r / 361), 32 * (r % 361), (bf16_t*)(ws + WS_WIN), D, 32 * (r % 361)); r -= I_IN;
    if (r < I_B) return mk_titem(p.in[I_WBH] + (size_t)l * 1024 * D, D, 64 * (r / 64), 32 * (r % 64), (bf16_t*)(ws + WS_WBH), 1024, 32 * (r % 64)); r -= I_B;
    if (r < I_B) return mk_titem(p.in[I_WBR] + (size_t)l * 1024 * D, D, 64 * (r / 64), 32 * (r % 64), (bf16_t*)(ws + WS_WBR), 1024, 32 * (r % 64)); r -= I_B;
    return mk_titem(p.in[I_WOUT] + (size_t)l * D * D, D, 64 * (r / 64), 32 * (r % 64), (bf16_t*)(ws + WS_WO), D, 32 * (r % 64));
}
DI TItem expert_item(PR p, int l, int it) {
    unsigned char* ws = p.ws;
    constexpr int PER_GU = 32 * 16, PER_D = 8 * 64;
    const int e = it / (2 * PER_GU + PER_D); int r = it % (2 * PER_GU + PER_D);
    if (r < 2 * PER_GU) { const int up = r >= PER_GU; if (up) r -= PER_GU; const int kb = r / 16, nb = r % 16, j0 = 32 * nb;
        return mk_titem((up ? p.in[I_EWU] : p.in[I_EWG]) + ((size_t)l * NEXP + e) * D * DEXP, DEXP, 64 * kb, j0, (bf16_t*)(ws + WS_WGU) + (size_t)e * 1024 * D, D, 256 * (j0 >> 7) + (j0 & 127) + (up ? 128 : 0)); }
    r -= 2 * PER_GU; const int kb = r / 64, nb = r % 64;
    return mk_titem(p.in[I_EWD] + ((size_t)l * NEXP + e) * DEXP * D, D, 64 * kb, 32 * nb, (bf16_t*)(ws + WS_WDN) + (size_t)e * D * DEXP, DEXP, 32 * nb);
}
template <bool EXPERT> DI void run_titems(PR p, const Ctx& c, int l, int lo, int hi, int wg0, int nwg) {
    LAS float* scr = (LAS float*)(c.lds + c.wave * 8448);
    const int gw = (c.bid - wg0) * 8 + c.wave, NGW = nwg * 8;
    for (int it = lo + gw; it < hi; it += 2 * NGW) {
        const int it2 = it + NGW; const bool has2 = it2 < hi;
        const TItem a = EXPERT ? expert_item(p, l, it) : small_item(p, l, it), b = EXPERT ? expert_item(p, l, has2 ? it2 : it) : small_item(p, l, has2 ? it2 : it);
        f32x4 va[8], vb[8]; titem_load(a, va, c.lane); titem_load(b, vb, c.lane);
        titem_store(a, va, scr, c.lane); if (has2) titem_store(b, vb, scr, c.lane);
    }
}
constexpr int SMALL_ITEMS = 32 * 361 + 2 * 16 * 64 + 32 * 64;
DI void convert_small(PR p, const Ctx& c, int l, int lo) {
    unsigned char* ws = p.ws;
    const int gw = c.bid * 8 + c.wave, NGW = c.G * 8;
    bf16_t* WIN = (bf16_t*)(ws + WS_WIN);
    const float* w_in = p.in[I_WIN] + (size_t)l * D * IN_WIDTH;
    run_titems<false>(p, c, l, lo, SMALL_ITEMS, 0, c.G);
    const int gt = c.bid * 512 + c.tid, NT = c.G * 512;
    bf16_t* WUPT = (bf16_t*)(ws + WS_LORA + LO_WUP); bf16_t* AUPT = (bf16_t*)(ws + WS_LORA + LO_AUP); bf16_t* GUPT = (bf16_t*)(ws + WS_LORA + LO_GUP); bf16_t* VUPT = (bf16_t*)(ws + WS_LORA + LO_VUP);
    bf16_t* WRH = (bf16_t*)(ws + WS_LORA + LO_WR); bf16_t* WRL = (bf16_t*)(ws + WS_LORA + LO_WRL);
    const float* wup = p.in[I_WUP] + (size_t)l * 64 * 1024; const float* aup = p.in[I_AUP] + (size_t)l * 64 * 1024; const float* gup = p.in[I_GUP] + (size_t)l * 160 * 1024;
    for (int i = gt; i < 1024 * 64; i += NT) { const int n = i >> 6, k = i & 63; WUPT[i] = (bf16_t)(cvt_pk(wup[k * 1024 + n], 0.f) & 0xffff); AUPT[i] = (bf16_t)(cvt_pk(aup[k * 1024 + n], 0.f) & 0xffff); }
    for (int i = gt; i < 1024 * 160; i += NT) { const int n = i / 160, k = i % 160; GUPT[i] = (bf16_t)(cvt_pk(gup[k * 1024 + n], 0.f) & 0xffff); }
    if (l == 1) { const float* vup = p.in[I_VUP]; for (int i = gt; i < 1024 * 32; i += NT) { const int n = i >> 5, k = i & 31; VUPT[i] = (bf16_t)(cvt_pk(vup[k * 1024 + n], 0.f) & 0xffff); } }
    const float* rgw = p.in[I_RGW] + (size_t)l * D * 4; const float* rew = p.in[I_REW] + (size_t)l * D * 32;
    for (int i = gt; i < 48 * 2048; i += NT) { const int cc = i >> 11, k = i & 2047; const float v = cc < 4 ? rgw[k * 4 + cc] : (cc < 36 ? rew[k * 32 + (cc - 4)] : 0.f);
        const unsigned hb = cvt_pk(v, 0.f) & 0xffffu; WRH[i] = (bf16_t)hb; WRL[i] = (bf16_t)(cvt_pk(v - __uint_as_float(hb << 16), 0.f) & 0xffffu); }
    if (l == 1) {
        const float* mu = p.in[I_MU] + 3360 + 2048; const float* vd = p.in[I_VDOWN];
        for (int k = gw; k < D; k += NGW) {
            float wv[16], wm[16];
#pragma unroll
            for (int j = 0; j < 16; ++j) { const int cc = c.lane + 64 * j; const float w = w_in[(size_t)k * IN_WIDTH + 6144 + cc], m = mu[cc]; wv[j] = w * (1.f - m); wm[j] = w * m; }
            float ra = 0.f, rb = 0.f;
            for (int n = 0; n < 32; ++n) { float sa = 0.f, sb = 0.f;
#pragma unroll
                for (int j = 0; j < 16; ++j) { const float v = vd[(size_t)(c.lane + 64 * j) * 32 + n]; sa += wv[j] * v; sb += wm[j] * v; }
                sa = wave_sum(sa); sb = wave_sum(sb); if (c.lane == n) { ra = sa; rb = sb; } }
            if (c.lane < 32) { WIN[(size_t)(ZC_VDA + c.lane) * D + k] = (bf16_t)(cvt_pk(ra, 0.f) & 0xffff); WIN[(size_t)(ZC_VDB + c.lane) * D + k] = (bf16_t)(cvt_pk(rb, 0.f) & 0xffff); }
        }
    }
}
constexpr int EXP_ITEMS = NEXP * (2 * 32 * 16 + 8 * 64);
#ifndef EXP_EARLY
#define EXP_EARLY 36864
#endif
DI void convert_experts_early(PR p, const Ctx& c, int l, int wg0, int nwg) { run_titems<true>(p, c, l, 0, EXP_EARLY, wg0, nwg); }
DI void convert_experts(PR p, const Ctx& c, int l, int lo) { run_titems<true>(p, c, l, lo, EXP_ITEMS, 0, c.G); }
DI void rms_row_bf16(const float* xrow, const float* w, bf16_t* orow, int lane) {
    const f32x4* xr = (const f32x4*)xrow + lane; const f32x4* wr = (const f32x4*)w + lane; f32x4 v[8], ww[8]; float s = 0.f;
#pragma unroll
    for (int j = 0; j < 8; ++j) { v[j] = xr[64 * j]; ww[j] = wr[64 * j]; }
#pragma unroll
    for (int j = 0; j < 8; ++j) s += (v[j].x * v[j].x + v[j].y * v[j].y) + (v[j].z * v[j].z + v[j].w * v[j].w);
    const float rstd = rsqrtf(wave_sum(s) * (1.f / D) + NORM_EPS);
    u32x2* o8 = (u32x2*)orow + lane;
#pragma unroll
    for (int j = 0; j < 8; ++j) o8[64 * j] = pack4(v[j].x * rstd * ww[j].x, v[j].y * rstd * ww[j].y, v[j].z * rstd * ww[j].z, v[j].w * rstd * ww[j].w);
}
constexpr int RL = 72;
constexpr int R_SLOT = 64 * RL * 2;
constexpr int R_EXTRA = 12 * R_SLOT;
constexpr int FL = 68;
#define RSLOT(i) ((LAS bf16_t*)(c.lds + (i) * R_SLOT))
struct R1In { u32x4 cur[5], prv[5]; };
DI R1In r1_load(const unsigned char* ws, int task, int tid) {
    R1In in;
    const int bh = task >> 5, ch = task & 31, b = bh >> 4, h = bh & 15, tok0 = ch * 64, m0 = b * TSEQ + tok0, t = tid >> 3, cg = tid & 7, ch0 = 64 * h + 8 * cg;
    const bf16_t* zr = (const bf16_t*)(ws + WS_Z) + (size_t)(m0 + t) * NZ; const bf16_t* zp = (tok0 + t) > 0 ? zr - NZ : zr;
    in.cur[0] = *(const u32x4*)(zr + ZC_R + ch0); in.prv[0] = *(const u32x4*)(zp + ZC_R + ch0); in.cur[1] = *(const u32x4*)(zr + ZC_K + ch0); in.prv[1] = *(const u32x4*)(zp + ZC_K + ch0);
    in.cur[2] = *(const u32x4*)(zr + ZC_V + ch0); in.prv[2] = *(const u32x4*)(zp + ZC_V + ch0); in.cur[3] = *(const u32x4*)(zr + ZC_WD + 8 * cg); in.prv[3] = *(const u32x4*)(zp + ZC_WD + 8 * cg);
    in.cur[4] = *(const u32x4*)(zr + ZC_AD + 8 * cg); in.prv[4] = *(const u32x4*)(zp + ZC_AD + 8 * cg);
    return in;
}
template <int PROF> DI R1In r1_task(PR p, const Ctx& c0, int l, int task, const R1In in, int next_task) {
    R1In nin;
#define SEC(b) (!(PROF & (b)))
#define GST(T, addr, val) do { const T v_ = (val); if (SEC(1)) *(T*)(addr) = v_; else asm volatile("" :: "v"(v_)); } while (0)
    Ctx c = c0; { int t_ = c0.tid; asm volatile("" : "+v"(t_)); c.tid = t_; c.lane = t_ & 63; unsigned lb_ = (unsigned)(uintptr_t)c0.lds; asm volatile("" : "+s"(lb_)); c.lds = (LAS unsigned char*)(uintptr_t)lb_; }
    unsigned char* ws = p.ws;
    const int bh = task >> 5, ch = task & 31, b = bh >> 4, h = bh & 15, tok0 = ch * 64, m0 = b * TSEQ + tok0;
    const int tid = c.tid, lane = c.lane, w = c.wave;
    const bf16_t* Z = (const bf16_t*)(ws + WS_Z);
    const int t = tid >> 3, cg = tid & 7, ch0 = 64 * h + 8 * cg;
    LAS float* LW = (LAS float*)(c.lds + R_EXTRA); LAS float* LA = LW + 64 * FL; LAS float* SEG = LA + 64 * FL;
    LAS float* LV = (LAS float*)(c.lds + 1 * R_SLOT);
    float r[8], k[8], v[8];
    const f32x4 w0A = *(const f32x4*)(p.in[I_W0] + l * 1024 + ch0), w0B = *(const f32x4*)(p.in[I_W0] + l * 1024 + ch0 + 4);
    const f32x4 a0A = *(const f32x4*)(p.in[I_A0] + l * 1024 + ch0), a0B = *(const f32x4*)(p.in[I_A0] + l * 1024 + ch0 + 4);
    const f32x4 kkA = *(const f32x4*)(p.in[I_KK] + l * 1024 + ch0), kkB = *(const f32x4*)(p.in[I_KK] + l * 1024 + ch0 + 4);
    const f32x4 kaA = *(const f32x4*)(p.in[I_KA] + l * 1024 + ch0), kaB = *(const f32x4*)(p.in[I_KA] + l * 1024 + ch0 + 4);
    const f32x4 rkA = *(const f32x4*)(p.in[I_RK] + l * 1024 + ch0), rkB = *(const f32x4*)(p.in[I_RK] + l * 1024 + ch0 + 4);
    if (!SEC(2)) {
#pragma unroll
        for (int j = 0; j < 8; ++j) { r[j] = 0.5f + 1e-3f * tid; k[j] = 0.25f + 1e-3f * lane; v[j] = 0.1f * w + 0.01f * j; } }
    if (SEC(2))
    {
        const bf16_t* zr = Z + (size_t)(m0 + t) * NZ; const bool has_prev = (tok0 + t) > 0; const bf16_t* zp = zr - NZ;
        const float* mu = p.in[I_MU] + (size_t)l * 3360;
        float cur[8], prv[8], wd[8], ad[8];
#define LERP_IN(dst, idx, mucol) do { unpack8(in.cur[idx], cur); if (has_prev) unpack8(in.prv[idx], prv); else { _Pragma("unroll") for (int j = 0; j < 8; ++j) prv[j] = 0.f; } \
            const f32x4 mA = *(const f32x4*)(mu + (mucol)), mB = *(const f32x4*)(mu + (mucol) + 4); const float mm[8] = {mA.x, mA.y, mA.z, mA.w, mB.x, mB.y, mB.z, mB.w}; \
            _Pragma("unroll") for (int j = 0; j < 8; ++j) dst[j] = cur[j] + mm[j] * (prv[j] - cur[j]); } while (0)
        LERP_IN(r, 0, ch0); LERP_IN(k, 1, 1024 + ch0); LERP_IN(v, 2, 2048 + ch0);
        LERP_IN(wd, 3, 3072 + 8 * cg); LERP_IN(ad, 4, 3136 + 8 * cg);
#pragma unroll
        for (int j = 0; j < 8; ++j) wd[j] = 1.0f - 2.0f / (1.0f + __expf(2.0f * wd[j]));
        *(LAS u32x4*)(RSLOT(7) + t * RL + 8 * cg) = pack8(wd);
        *(LAS u32x4*)(RSLOT(8) + t * RL + 8 * cg) = pack8(ad);
        const bf16_t* WUPT = (const bf16_t*)(ws + WS_LORA + LO_WUP) + (size_t)(64 * h) * 64; const bf16_t* AUPT = (const bf16_t*)(ws + WS_LORA + LO_AUP) + (size_t)(64 * h) * 64;
        *(LAS u32x4*)(RSLOT(9) + t * RL + 8 * cg) = *(const u32x4*)(WUPT + t * 64 + 8 * cg);
        *(LAS u32x4*)(RSLOT(10) + t * RL + 8 * cg) = *(const u32x4*)(AUPT + t * 64 + 8 * cg);
        if (l == 1) {
            if (cg < 4) { float a8[8], b8[8]; unpack8(*(const u32x4*)(zr + ZC_VDA + 8 * cg), a8); if (has_prev) unpack8(*(const u32x4*)(zp + ZC_VDB + 8 * cg), b8); else {
#pragma unroll
                    for (int j = 0; j < 8; ++j) b8[j] = 0.f; }
#pragma unroll
                for (int j = 0; j < 8; ++j) a8[j] += b8[j];
                *(LAS u32x4*)(RSLOT(11) + t * 40 + 8 * cg) = pack8(a8);
                const bf16_t* VUPT = (const bf16_t*)(ws + WS_LORA + LO_VUP) + (size_t)(64 * h) * 32;
                *(LAS u32x4*)(RSLOT(0) + t * 40 + 8 * cg) = *(const u32x4*)(VUPT + t * 32 + 8 * cg); }
        }
    }
    lds_barrier();
    const int pt = w >> 1, qb = 2 * (w & 1), fr = lane & 15, fq = lane >> 4;
    if (SEC(4)) {
#pragma unroll
        for (int i = 0; i < 2; ++i) { const int qt = qb + i;
            const f32x4 aw = mm16<false, false, 2, RL, RL>(RSLOT(7), RSLOT(9), 16 * pt, 16 * qt, lane, F4Z);
            const f32x4 aa = mm16<false, false, 2, RL, RL>(RSLOT(8), RSLOT(10), 16 * pt, 16 * qt, lane, F4Z);
            *(LAS f32x4*)(LW + (16 * pt + fr) * FL + 16 * qt + 4 * fq) = aw; *(LAS f32x4*)(LA + (16 * pt + fr) * FL + 16 * qt + 4 * fq) = aa;
            if (l == 1) { const f32x4 av = mm16<false, false, 1, 40, 40>(RSLOT(11), RSLOT(0), 16 * pt, 16 * qt, lane, F4Z); *(LAS f32x4*)(LV + (16 * pt + fr) * FL + 16 * qt + 4 * fq) = av; }
        }
    }
    lds_barrier();
    float lw[8], a[8], kk[8], kp[8];
    {
        const float w0[8] = {w0A.x, w0A.y, w0A.z, w0A.w, w0B.x, w0B.y, w0B.z, w0B.w}, a0[8] = {a0A.x, a0A.y, a0A.z, a0A.w, a0B.x, a0B.y, a0B.z, a0B.w};
        const float k_k[8] = {kkA.x, kkA.y, kkA.z, kkA.w, kkB.x, kkB.y, kkB.z, kkB.w}, k_a[8] = {kaA.x, kaA.y, kaA.z, kaA.w, kaB.x, kaB.y, kaB.z, kaB.w};
        const float r_k[8] = {rkA.x, rkA.y, rkA.z, rkA.w, rkB.x, rkB.y, rkB.z, rkB.w};
        const f32x4 lwA = *(const LAS f32x4*)(LW + t * FL + 8 * cg), lwB = *(const LAS f32x4*)(LW + t * FL + 8 * cg + 4);
        const f32x4 laA = *(const LAS f32x4*)(LA + t * FL + 8 * cg), laB = *(const LAS f32x4*)(LA + t * FL + 8 * cg + 4);
        const float lwr[8] = {lwA.x, lwA.y, lwA.z, lwA.w, lwB.x, lwB.y, lwB.z, lwB.w}, lar[8] = {laA.x, laA.y, laA.z, laA.w, laB.x, laB.y, laB.z, laB.w};
        bf16_t* VFIRST = (bf16_t*)(ws + WS_VFIRST) + (size_t)(m0 + t) * 1024 + ch0;
        if (l == 1) {
            const f32x4 lvA = *(const LAS f32x4*)(LV + t * FL + 8 * cg), lvB = *(const LAS f32x4*)(LV + t * FL + 8 * cg + 4);
            const float lvr[8] = {lvA.x, lvA.y, lvA.z, lvA.w, lvB.x, lvB.y, lvB.z, lvB.w};
            const f32x4 v0A = *(const f32x4*)(p.in[I_V0] + ch0), v0B = *(const f32x4*)(p.in[I_V0] + ch0 + 4); const float v0[8] = {v0A.x, v0A.y, v0A.z, v0A.w, v0B.x, v0B.y, v0B.z, v0B.w};
            float vf[8]; unpack8(*(const u32x4*)VFIRST, vf);
#pragma unroll
            for (int j = 0; j < 8; ++j) v[j] = v[j] + (vf[j] - v[j]) * sigm(v0[j] + lvr[j]);
            GST(u32x4, (bf16_t*)(ws + WS_VF) + (size_t)(m0 + t) * 1024 + ch0, pack8(v));
        } else { GST(u32x4, VFIRST, pack8(v)); }
        float ss = 0.f, rks = 0.f;
#pragma unroll
        for (int j = 0; j < 8; ++j) { lw[j] = -0.60653066f * sigm(w0[j] + lwr[j]); a[j] = sigm(a0[j] + lar[j]); kk[j] = k[j] * k_k[j]; ss += kk[j] * kk[j];
            kp[j] = k[j] * (1.0f + (a[j] - 1.0f) * k_a[j]); rks += r[j] * kp[j] * r_k[j]; }
        ss += __shfl_xor(ss, 1); ss += __shfl_xor(ss, 2); ss += __shfl_xor(ss, 4);
        rks += __shfl_xor(rks, 1); rks += __shfl_xor(rks, 2); rks += __shfl_xor(rks, 4);
        const float inv = rsqrtf(fmaxf(ss, 1e-12f));
#pragma unroll
        for (int j = 0; j < 8; ++j) kk[j] *= inv;
        if (SEC(1) && cg == 0) ((float*)(ws + WS_RK))[(size_t)(m0 + t) * 16 + h] = rks;
    }
    nin = r1_load(ws, next_task, tid);
    lds_barrier();
    *(LAS f32x4*)(LW + t * FL + 8 * cg) = (f32x4){lw[0], lw[1], lw[2], lw[3]}; *(LAS f32x4*)(LW + t * FL + 8 * cg + 4) = (f32x4){lw[4], lw[5], lw[6], lw[7]};
    lds_barrier();
    if (SEC(8)) {
        const int j = tid & 63, sg = tid >> 6; float s = 0.f;
#pragma unroll
        for (int i = 0; i < 8; ++i) s += LW[(8 * sg + i) * FL + j];
        SEG[sg * 64 + j] = s;
        lds_barrier();
        float off = 0.f;
        for (int s2 = 0; s2 < sg; ++s2) off += SEG[s2 * 64 + j];
#pragma unroll
        for (int i = 0; i < 8; ++i) { off += LW[(8 * sg + i) * FL + j]; LW[(8 * sg + i) * FL + j] = off; }
    }
    lds_barrier();
    {
        const f32x4 cA = *(const LAS f32x4*)(LW + t * FL + 8 * cg), cB = *(const LAS f32x4*)(LW + t * FL + 8 * cg + 4);
        const f32x4 eA = *(const LAS f32x4*)(LW + 63 * FL + 8 * cg), eB = *(const LAS f32x4*)(LW + 63 * FL + 8 * cg + 4);
        const float cs[8] = {cA.x, cA.y, cA.z, cA.w, cB.x, cB.y, cB.z, cB.w}, ce[8] = {eA.x, eA.y, eA.z, eA.w, eB.x, eB.y, eB.z, eB.w};
        float Rt[8], At[8], Bt[8], Kt[8], Bp[8], Kp[8];
#pragma unroll
        for (int j = 0; j < 8; ++j) { const float ep = __expf(cs[j]), em = __expf(-cs[j]), el = __expf(ce[j] - cs[j]), ex = __expf(cs[j] - lw[j]); const float bv = kk[j] * a[j];
            Rt[j] = r[j] * ep; At[j] = -kk[j] * ex; Bt[j] = bv * em; Kt[j] = kp[j] * em; Bp[j] = bv * el; Kp[j] = kp[j] * el; }
        *(LAS u32x4*)(RSLOT(0) + t * RL + 8 * cg) = pack8(Rt); *(LAS u32x4*)(RSLOT(1) + t * RL + 8 * cg) = pack8(At); *(LAS u32x4*)(RSLOT(2) + t * RL + 8 * cg) = pack8(Bt);
        *(LAS u32x4*)(RSLOT(3) + t * RL + 8 * cg) = pack8(Kt); *(LAS u32x4*)(RSLOT(4) + t * RL + 8 * cg) = pack8(Bp); *(LAS u32x4*)(RSLOT(5) + t * RL + 8 * cg) = pack8(Kp);
        *(LAS u32x4*)(RSLOT(6) + t * RL + 8 * cg) = pack8(v);
    }
    lds_barrier();
    const int p0 = 16 * pt, prow = p0 + fr;
    if (SEC(16)) {
#pragma unroll
        for (int i = 0; i < 2; ++i) { const int q0 = 16 * (qb + i), qc = q0 + 4 * fq;
            f32x4 ab = mm16<false, false, 2, RL, RL>(RSLOT(1), RSLOT(2), p0, q0, lane, F4Z);
            f32x4 ak = mm16<false, false, 2, RL, RL>(RSLOT(1), RSLOT(3), p0, q0, lane, F4Z);
            f32x4 rb = mm16<false, false, 2, RL, RL>(RSLOT(0), RSLOT(2), p0, q0, lane, F4Z);
            f32x4 rk = mm16<false, false, 2, RL, RL>(RSLOT(0), RSLOT(3), p0, q0, lane, F4Z);
#pragma unroll
            for (int rr = 0; rr < 4; ++rr) { const int s = qc + rr; if (s >= prow) { ab[rr] = 0.f; ak[rr] = 0.f; } if (s > prow) { rb[rr] = 0.f; rk[rr] = 0.f; } }
            st4_bf16(RSLOT(7) + prow * RL + qc, ab); st4_bf16(RSLOT(9) + prow * RL + qc, ak); st4_bf16(RSLOT(10) + prow * RL + qc, rb); st4_bf16(RSLOT(11) + prow * RL + qc, rk); }
    }
    lds_barrier();
    const int qa = 16 * qb, qca = qa + 4 * fq, qcb = qca + 16;
    if (SEC(32)) {
        TrFrag yl[2][2]; tr_issue4<RL>(yl, RSLOT(7), qa, lane);
        const bf16x8 xl0 = frag_n<RL>(RSLOT(7), p0, 0, lane), xl1 = frag_n<RL>(RSLOT(7), p0, 32, lane);
        f32x4 t1a = ld4_bf16(RSLOT(7) + prow * RL + qca), t1b = ld4_bf16(RSLOT(7) + prow * RL + qcb);
        tr_wait4(yl);
        const f32x4 la = mma2(xl0, xl1, tr_get(yl[0][0]), tr_get(yl[0][1]), F4Z), lb = mma2(xl0, xl1, tr_get(yl[1][0]), tr_get(yl[1][1]), F4Z);
#pragma unroll
        for (int rr = 0; rr < 4; ++rr) { if (qca + rr == prow) t1a[rr] += 1.0f; if (qcb + rr == prow) t1b[rr] += 1.0f; }
        st4_bf16(RSLOT(8) + prow * RL + qca, la); st4_bf16(RSLOT(8) + prow * RL + qcb, lb); st4_bf16(RSLOT(2) + prow * RL + qca, t1a); st4_bf16(RSLOT(2) + prow * RL + qcb, t1b);
    }
    lds_barrier();
#define NSTEP(LS, LD_, TS, TD, SQ) do { TrFrag yl[2][2]; tr_issue4<RL>(yl, RSLOT(LS), qa, lane); \
        const bf16x8 xt0 = frag_n<RL>(RSLOT(TS), p0, 0, lane), xt1 = frag_n<RL>(RSLOT(TS), p0, 32, lane), xl0 = frag_n<RL>(RSLOT(LS), p0, 0, lane), xl1 = frag_n<RL>(RSLOT(LS), p0, 32, lane); \
        const f32x4 ta0 = ld4_bf16(RSLOT(TS) + prow * RL + qca), tb0 = ld4_bf16(RSLOT(TS) + prow * RL + qcb); \
        tr_wait4(yl); const bf16x8 y00 = tr_get(yl[0][0]), y01 = tr_get(yl[0][1]), y10 = tr_get(yl[1][0]), y11 = tr_get(yl[1][1]); \
        const f32x4 tna = mma2(xt0, xt1, y00, y01, ta0), tnb = mma2(xt0, xt1, y10, y11, tb0); \
        if (SQ) { const f32x4 la = mma2(xl0, xl1, y00, y01, F4Z), lb = mma2(xl0, xl1, y10, y11, F4Z); st4_bf16(RSLOT(LD_) + prow * RL + qca, la); st4_bf16(RSLOT(LD_) + prow * RL + qcb, lb); } \
        st4_bf16(RSLOT(TD) + prow * RL + qca, tna); st4_bf16(RSLOT(TD) + prow * RL + qcb, tnb); lds_barrier(); } while (0)
    if (SEC(32)) NSTEP(8, 7, 2, 3, 1);
    if (SEC(32)) NSTEP(7, 8, 3, 2, 1);
    if (SEC(32)) NSTEP(8, 7, 2, 3, 1);
    if (SEC(32)) NSTEP(7, 8, 3, 2, 1);
    if (SEC(32)) NSTEP(8, 7, 2, 3, 0);
#undef NSTEP
    if (SEC(64)) {
        TrFrag ya[2][2], yv[2][2]; tr_issue4<RL>(ya, RSLOT(1), qa, lane); tr_issue4<RL>(yv, RSLOT(6), qa, lane);
        const bf16x8 xt0 = frag_n<RL>(RSLOT(3), p0, 0, lane), xt1 = frag_n<RL>(RSLOT(3), p0, 32, lane), xk0 = frag_n<RL>(RSLOT(9), p0, 0, lane), xk1 = frag_n<RL>(RSLOT(9), p0, 32, lane);
        tr_wait8(ya, yv);
        const f32x4 pa = mma2(xt0, xt1, tr_get(ya[0][0]), tr_get(ya[0][1]), F4Z), pb2 = mma2(xt0, xt1, tr_get(ya[1][0]), tr_get(ya[1][1]), F4Z);
        const f32x4 ga = mma2(xk0, xk1, tr_get(yv[0][0]), tr_get(yv[0][1]), F4Z), gb = mma2(xk0, xk1, tr_get(yv[1][0]), tr_get(yv[1][1]), F4Z);
        st4_bf16(RSLOT(7) + prow * RL + qca, pa); st4_bf16(RSLOT(7) + prow * RL + qcb, pb2); st4_bf16(RSLOT(8) + prow * RL + qca, ga); st4_bf16(RSLOT(8) + prow * RL + qcb, gb);
    }
    lds_barrier();
    if (SEC(64)) {
        TrFrag yg[2][2]; tr_issue4<RL>(yg, RSLOT(8), qa, lane);
        const bf16x8 xt0 = frag_n<RL>(RSLOT(3), p0, 0, lane), xt1 = frag_n<RL>(RSLOT(3), p0, 32, lane);
        tr_wait4(yg);
        const f32x4 q0v = mma2(xt0, xt1, tr_get(yg[0][0]), tr_get(yg[0][1]), F4Z), q1v = mma2(xt0, xt1, tr_get(yg[1][0]), tr_get(yg[1][1]), F4Z);
        st4_bf16(RSLOT(9) + prow * RL + qca, q0v); st4_bf16(RSLOT(9) + prow * RL + qcb, q1v);
    }
    lds_barrier();
    if (SEC(64)) {
        const size_t blk = (size_t)task * 4096;
        const int pia = 16 * fq + 4 * qb, pib = pia + 4, mka = 32 * (qb >> 1) + 8 * fq, mkb = mka + 4;
        bf16_t* RP = (bf16_t*)(ws + WS_RP) + blk; bf16_t* Y0 = (bf16_t*)(ws + WS_Y0) + blk; bf16_t* MT = (bf16_t*)(ws + WS_MT) + blk; bf16_t* NN = (bf16_t*)(ws + WS_NN) + blk;
        {
            TrFrag yp[2][2], yq[2][2]; tr_issue4<RL>(yp, RSLOT(7), qa, lane); tr_issue4<RL>(yq, RSLOT(9), qa, lane);
            const bf16x8 xb0 = frag_n<RL>(RSLOT(10), p0, 0, lane), xb1 = frag_n<RL>(RSLOT(10), p0, 32, lane), xk0 = frag_n<RL>(RSLOT(11), p0, 0, lane), xk1 = frag_n<RL>(RSLOT(11), p0, 32, lane);
            const f32x4 r0a = ld4_bf16(RSLOT(0) + prow * RL + qca), r0b = ld4_bf16(RSLOT(0) + prow * RL + qcb);
            tr_wait8(yp, yq);
            const f32x4 rpa = mma2(xb0, xb1, tr_get(yp[0][0]), tr_get(yp[0][1]), r0a), rpb = mma2(xb0, xb1, tr_get(yp[1][0]), tr_get(yp[1][1]), r0b);
            f32x4 y0a = mma2(xb0, xb1, tr_get(yq[0][0]), tr_get(yq[0][1]), F4Z), y0b = mma2(xb0, xb1, tr_get(yq[1][0]), tr_get(yq[1][1]), F4Z);
            TrFrag yv[2][2]; tr_issue4<RL>(yv, RSLOT(6), qa, lane); tr_wait4(yv);
            y0a = mma2(xk0, xk1, tr_get(yv[0][0]), tr_get(yv[0][1]), y0a); y0b = mma2(xk0, xk1, tr_get(yv[1][0]), tr_get(yv[1][1]), y0b);
            GST(u32x2, RP + prow * 64 + pia, pack4(rpa[0], rpa[1], rpa[2], rpa[3])); GST(u32x2, RP + prow * 64 + pib, pack4(rpb[0], rpb[1], rpb[2], rpb[3]));
            GST(u32x2, Y0 + prow * 64 + qca, pack4(y0a[0], y0a[1], y0a[2], y0a[3])); GST(u32x2, Y0 + prow * 64 + qcb, pack4(y0b[0], y0b[1], y0b[2], y0b[3]));
        }
        {
            TrFrag xbp[2], yp[2][2]; tr_issue2<RL>(xbp, RSLOT(4), p0, lane); tr_issue4<RL>(yp, RSLOT(7), qa, lane); tr_wait42(yp, xbp);
            const bf16x8 xb0 = tr_get(xbp[0]), xb1 = tr_get(xbp[1]);
            f32x4 mta = mma2(xb0, xb1, tr_get(yp[0][0]), tr_get(yp[0][1]), F4Z), mtb = mma2(xb0, xb1, tr_get(yp[1][0]), tr_get(yp[1][1]), F4Z);
            const float dg = __expf(LW[63 * FL + prow]);
#pragma unroll
            for (int rr = 0; rr < 4; ++rr) { if (qca + rr == prow) mta[rr] += dg; if (qcb + rr == prow) mtb[rr] += dg; }
            GST(u32x2, MT + prow * 64 + mka, pack4(mta[0], mta[1], mta[2], mta[3])); GST(u32x2, MT + prow * 64 + mkb, pack4(mtb[0], mtb[1], mtb[2], mtb[3]));
            TrFrag xq[2], ybp[2][2]; tr_issue2<RL>(xq, RSLOT(9), p0, lane); tr_issue4<RL>(ybp, RSLOT(4), qa, lane); tr_wait42(ybp, xq);
            f32x4 nna = mma2(tr_get(xq[0]), tr_get(xq[1]), tr_get(ybp[0][0]), tr_get(ybp[0][1]), F4Z), nnb = mma2(tr_get(xq[0]), tr_get(xq[1]), tr_get(ybp[1][0]), tr_get(ybp[1][1]), F4Z);
            TrFrag xv[2], ykp[2][2]; tr_issue2<RL>(xv, RSLOT(6), p0, lane); tr_issue4<RL>(ykp, RSLOT(5), qa, lane); tr_wait42(ykp, xv);
            nna = mma2(tr_get(xv[0]), tr_get(xv[1]), tr_get(ykp[0][0]), tr_get(ykp[0][1]), nna); nnb = mma2(tr_get(xv[0]), tr_get(xv[1]), tr_get(ykp[1][0]), tr_get(ykp[1][1]), nnb);
            GST(u32x2, NN + prow * 64 + pia, pack4(nna[0], nna[1], nna[2], nna[3])); GST(u32x2, NN + prow * 64 + pib, pack4(nnb[0], nnb[1], nnb[2], nnb[3]));
        }
    }
    lds_barrier();
    return nin;
}
#undef SEC
#undef GST
constexpr int HL = 136, HCL = 132, SCL = 72, HC = 64;
constexpr int H_QT = 0, H_KT = HC * HL * 2  , H_KP = 2 * H_KT, H_V = 3 * H_KT, H_CS = 4 * H_KT  , H_SEG = H_CS + HC * HCL * 4  , H_SC = H_SEG + 4 * 128 * 4  ,
              H_NTS = H_CS;
DI float hg_lb(PR p, int l, int chn) { if (l == 0) return 0.f; const float* raw = p.in[I_LBRAW]; return sigm(raw[1024 + chn] - raw[chn]); }
struct H1In { u32x4 zq[2], zf[2], zi[2]; };
DI H1In h1_load(const unsigned char* ws, int task, int tid) {
    const int bh = task >> 5, ch = task & 31, b = bh >> 3, h = bh & 7, m0 = b * TSEQ + ch * HC, t0 = tid >> 4, cg = tid & 15, chn = 128 * h + 8 * cg;
    H1In in;
#pragma unroll
    for (int u = 0; u < 2; ++u) { const bf16_t* zr = (const bf16_t*)(ws + WS_Z) + (size_t)(m0 + t0 + 32 * u) * NZ;
        in.zq[u] = *(const u32x4*)(zr + ZC_Q + chn); in.zf[u] = *(const u32x4*)(zr + ZC_F + chn); in.zi[u] = *(const u32x4*)(zr + ZC_I + chn); }
    return in;
}
DI H1In h1_task(PR p, const Ctx& c0, int l, int task, const H1In in, int next_task) {
    Ctx c = c0; { int t_ = c0.tid; asm volatile("" : "+v"(t_)); c.tid = t_; c.lane = t_ & 63; unsigned lb_ = (unsigned)(uintptr_t)c0.lds; asm volatile("" : "+s"(lb_)); c.lds = (LAS unsigned char*)(uintptr_t)lb_; }
    unsigned char* ws = p.ws;
    const int bh = task >> 5, ch = task & 31, b = bh >> 3, h = bh & 7, m0 = b * TSEQ + ch * HC;
    const int tid = c.tid, lane = c.lane, w = c.wave, fr = lane & 15, fq = lane >> 4;
    const bf16_t* Z = (const bf16_t*)(ws + WS_Z);
    LAS bf16_t* QTs = (LAS bf16_t*)(c.lds + H_QT); LAS bf16_t* KTs = (LAS bf16_t*)(c.lds + H_KT); LAS bf16_t* KPs = (LAS bf16_t*)(c.lds + H_KP); LAS bf16_t* Vs = (LAS bf16_t*)(c.lds + H_V);
    LAS float* CS = (LAS float*)(c.lds + H_CS); LAS float* SEG = (LAS float*)(c.lds + H_SEG); LAS bf16_t* SC = (LAS bf16_t*)(c.lds + H_SC); LAS bf16_t* NTS = (LAS bf16_t*)(c.lds + H_NTS);
    const int t0 = tid >> 4, cg = tid & 15, chn = 128 * h + 8 * cg;
    float q[2][8], kf[2][8];
    u32x4 vraw[2];
    {
        float lbv[8];
#pragma unroll
        for (int j = 0; j < 8; ++j) lbv[j] = hg_lb(p, l, chn + j);
#pragma unroll
        for (int u = 0; u < 2; ++u) { const int t = t0 + 32 * u;
            float zq[8], zf[8]; unpack8(in.zq[u], zq); unpack8(in.zf[u], zf); vraw[u] = in.zi[u];
            float g[8];
#pragma unroll
            for (int j = 0; j < 8; ++j) { const float f = lbv[j] + (1.0f - lbv[j]) * sigm(zf[j]); q[u][j] = zq[j] * sigm(zq[j]); kf[u][j] = 1.0f - f; g[j] = __logf(f); }
            *(LAS f32x4*)(CS + t * HCL + 8 * cg) = (f32x4){g[0], g[1], g[2], g[3]}; *(LAS f32x4*)(CS + t * HCL + 8 * cg + 4) = (f32x4){g[4], g[5], g[6], g[7]}; }
    }
    const H1In nin = h1_load(ws, next_task, tid);
    lds_barrier();
    {   const int j = tid & 127, sg = tid >> 7; float s = 0.f;
#pragma unroll
        for (int i = 0; i < 16; ++i) s += CS[(16 * sg + i) * HCL + j];
        SEG[sg * 128 + j] = s;
        lds_barrier();
        float off = 0.f;
        for (int s2 = 0; s2 < sg; ++s2) off += SEG[s2 * 128 + j];
#pragma unroll
        for (int i = 0; i < 16; ++i) { off += CS[(16 * sg + i) * HCL + j]; CS[(16 * sg + i) * HCL + j] = off; }
    }
    lds_barrier();
    {
        const f32x4 rA = *(const LAS f32x4*)(CS + 31 * HCL + 8 * cg), rB = *(const LAS f32x4*)(CS + 31 * HCL + 8 * cg + 4);
        const f32x4 eA = *(const LAS f32x4*)(CS + 63 * HCL + 8 * cg), eB = *(const LAS f32x4*)(CS + 63 * HCL + 8 * cg + 4);
        const float cr[8] = {rA.x, rA.y, rA.z, rA.w, rB.x, rB.y, rB.z, rB.w}, ce[8] = {eA.x, eA.y, eA.z, eA.w, eB.x, eB.y, eB.z, eB.w};
#pragma unroll
        for (int u = 0; u < 2; ++u) { const int t = t0 + 32 * u;
            const f32x4 cA = *(const LAS f32x4*)(CS + t * HCL + 8 * cg), cB = *(const LAS f32x4*)(CS + t * HCL + 8 * cg + 4);
            const float cs[8] = {cA.x, cA.y, cA.z, cA.w, cB.x, cB.y, cB.z, cB.w};
            float qh[8], qt[8], kt[8], kp[8];
#pragma unroll
            for (int j = 0; j < 8; ++j) { qh[j] = q[u][j] * __expf(cs[j]); qt[j] = q[u][j] * __expf(cs[j] - cr[j]); kt[j] = kf[u][j] * __expf(cr[j] - cs[j]); kp[j] = kf[u][j] * __expf(ce[j] - cs[j]); }
            *(LAS u32x4*)(QTs + t * HL + 8 * cg) = pack8(qt); *(LAS u32x4*)(KTs + t * HL + 8 * cg) = pack8(kt); *(LAS u32x4*)(KPs + t * HL + 8 * cg) = pack8(kp); *(LAS u32x4*)(Vs + t * HL + 8 * cg) = vraw[u];
            *(u32x4*)((bf16_t*)(ws + WS_QH) + (size_t)(m0 + t) * 1024 + chn) = pack8(qh);
            if (t == 63) { float* DC = (float*)(ws + WS_DC) + (size_t)task * 128 + 8 * cg; *(f32x4*)DC = (f32x4){__expf(ce[0]), __expf(ce[1]), __expf(ce[2]), __expf(ce[3])}; *(f32x4*)(DC + 4) = (f32x4){__expf(ce[4]), __expf(ce[5]), __expf(ce[6]), __expf(ce[7])}; } }
    }
    lds_barrier();
    {
        const int p0 = 16 * (w >> 1), prow = p0 + fr;
#pragma unroll
        for (int i = 0; i < 2; ++i) { const int q0 = 16 * (2 * (w & 1) + i), qc = q0 + 4 * fq;
            f32x4 sc = mm16<false, false, 4, HL, HL>(QTs, KTs, p0, q0, lane, F4Z);
#pragma unroll
            for (int rr = 0; rr < 4; ++rr) if (qc + rr > prow) sc[rr] = 0.f;
            st4_bf16(SC + prow * SCL + qc, sc); }
        TrFrag xv[2]; tr_issue2<HL>(xv, Vs, 16 * w, lane);
#pragma unroll
        for (int dp = 0; dp < 4; ++dp) { TrFrag yk[2][2]; tr_issue4<HL>(yk, KPs, 32 * dp, lane);
            if (dp == 0) tr_wait42(yk, xv); else tr_wait4(yk);
            const bf16x8 x0 = tr_get(xv[0]), x1 = tr_get(xv[1]);
            const f32x4 na = mma2(x0, x1, tr_get(yk[0][0]), tr_get(yk[0][1]), F4Z), nb = mma2(x0, x1, tr_get(yk[1][0]), tr_get(yk[1][1]), F4Z);
            st4_bf16(NTS + (16 * w + fr) * HL + 32 * dp + 4 * fq, na); st4_bf16(NTS + (16 * w + fr) * HL + 32 * dp + 16 + 4 * fq, nb); }
    }
    lds_barrier();
    {
        bf16_t* OI = (bf16_t*)(ws + WS_OI);
        TrFrag yv[2]; tr_issue2<HL>(yv, Vs, 16 * w, lane); tr_wait2(yv);
        const bf16x8 y0 = tr_get(yv[0]), y1 = tr_get(yv[1]);
#pragma unroll
        for (int pt = 0; pt < 4; ++pt) { const f32x4 o = mma2(frag_n<SCL>(SC, 16 * pt, 0, lane), frag_n<SCL>(SC, 16 * pt, 32, lane), y0, y1, F4Z);
            *(u32x2*)(OI + (size_t)(m0 + 16 * pt + fr) * 1024 + 128 * h + 16 * w + 4 * fq) = pack4(o[0], o[1], o[2], o[3]); }
        bf16_t* NT = (bf16_t*)(ws + WS_NT) + (size_t)task * 16384;
        const int row = tid >> 2, cq = tid & 3;
#pragma unroll
        for (int i = 0; i < 4; ++i) *(u32x4*)(NT + row * 128 + 32 * cq + 8 * i) = *(const LAS u32x4*)(NTS + row * HL + 32 * cq + 8 * i);
    }
    lds_barrier();
    return nin;
}
DI void h2_item(PR p, const Ctx& c, int item) {
    unsigned char* ws = p.ws;
    const int gidx = item * 512 + c.tid, bh = gidx >> 11, e = (gidx >> 4) & 127, dg = gidx & 15;
    bf16_t* NT = (bf16_t*)(ws + WS_NT) + (size_t)bh * 32 * 16384 + e * 128 + 8 * dg; const float* DC = (const float*)(ws + WS_DC) + (size_t)bh * 32 * 128 + 8 * dg;
    float s[8];
#pragma unroll
    for (int j = 0; j < 8; ++j) s[j] = 0.f;
    for (int c0 = 0; c0 < 32; c0 += 8) {
        u32x4 nt[8]; f32x4 da[8], db[8];
#pragma unroll
        for (int i = 0; i < 8; ++i) { nt[i] = *(const u32x4*)(NT + (size_t)(c0 + i) * 16384); da[i] = *(const f32x4*)(DC + (c0 + i) * 128); db[i] = *(const f32x4*)(DC + (c0 + i) * 128 + 4); }
#pragma unroll
        for (int i = 0; i < 8; ++i) { *(u32x4*)(NT + (size_t)(c0 + i) * 16384) = pack8(s); float nf[8]; unpack8(nt[i], nf);
            s[0] = s[0] * da[i].x + nf[0]; s[1] = s[1] * da[i].y + nf[1]; s[2] = s[2] * da[i].z + nf[2]; s[3] = s[3] * da[i].w + nf[3];
            s[4] = s[4] * db[i].x + nf[4]; s[5] = s[5] * db[i].y + nf[5]; s[6] = s[6] * db[i].z + nf[6]; s[7] = s[7] * db[i].w + nf[7]; }
    }
}
DI void h3_wave(const f32x4 (&onw)[8], PR p, int l, int wt, int lane) {
    unsigned char* ws = p.ws;
    const int task = wt >> 2, tt = wt & 3, bh = task >> 5, ch = task & 31, b = bh >> 3, h = bh & 7, m0 = b * TSEQ + ch * 64 + 16 * tt, fr = lane & 15, fq = lane >> 4;
    const bf16_t* Z = (const bf16_t*)(ws + WS_Z); const bf16_t* QH = (const bf16_t*)(ws + WS_QH); const bf16_t* OI = (const bf16_t*)(ws + WS_OI); const bf16_t* S = (const bf16_t*)(ws + WS_NT) + (size_t)task * 16384;
    bf16_t* YHG = (bf16_t*)(ws + WS_YHG);
    const size_t row = (size_t)(m0 + fr);
    bf16x8 qf[4];
#pragma unroll
    for (int ks = 0; ks < 4; ++ks) qf[ks] = *(const bf16x8*)(QH + row * 1024 + 128 * h + 32 * ks + 8 * fq);
    u32x2 oi[8], zo[8];
#pragma unroll
    for (int et = 0; et < 8; ++et) { oi[et] = *(const u32x2*)(OI + row * 1024 + 128 * h + 16 * et + 4 * fq); zo[et] = *(const u32x2*)(Z + row * NZ + ZC_O + 128 * h + 16 * et + 4 * fq); }
    f32x4 o[8]; float ssq = 0.f;
#pragma unroll
    for (int et = 0; et < 8; ++et) { bf16x8 sa[4];
#pragma unroll
        for (int ks = 0; ks < 4; ++ks) sa[ks] = *(const bf16x8*)(S + (16 * et + fr) * 128 + 32 * ks + 8 * fq);
        float f[4]; unpack4(oi[et], f); f32x4 acc = {f[0], f[1], f[2], f[3]};
#pragma unroll
        for (int ks = 0; ks < 4; ++ks) acc = MFMA16(sa[ks], qf[ks], acc);
        o[et] = acc; ssq += (acc[0] * acc[0] + acc[1] * acc[1]) + (acc[2] * acc[2] + acc[3] * acc[3]); }
    ssq += __shfl_xor(ssq, 16); ssq += __shfl_xor(ssq, 32);
    const float rstd = rsqrtf(ssq * (1.0f / 128.0f) + NORM_EPS);
#pragma unroll
    for (int et = 0; et < 8; ++et) { float g[4]; unpack4(zo[et], g);
        *(u32x2*)(YHG + row * 1024 + 128 * h + 16 * et + 4 * fq) = pack4(o[et][0] * rstd * onw[et].x * sigm(g[0]), o[et][1] * rstd * onw[et].y * sigm(g[1]), o[et][2] * rstd * onw[et].z * sigm(g[2]), o[et][3] * rstd * onw[et].w * sigm(g[3])); }
}
struct R2Regs { bf16x8 ma[4][2]; u32x4 nv[2]; };
DI void r2_load(R2Regs& r, const bf16_t* mt, const bf16_t* nn, int et, int fr, int fq) {
#pragma unroll
    for (int n = 0; n < 4; ++n)
#pragma unroll
        for (int ks = 0; ks < 2; ++ks) r.ma[n][ks] = *(const bf16x8*)(mt + (16 * n + fr) * 64 + 32 * ks + 8 * fq);
    r.nv[0] = *(const u32x4*)(nn + (16 * et + fr) * 64 + 16 * fq); r.nv[1] = *(const u32x4*)(nn + (16 * et + fr) * 64 + 16 * fq + 8);
}
DI void r2_step(const R2Regs& r, f32x4 (&S)[4], bf16_t* ss, int et, int fr, int fq) {
    { float f[8] = {S[0][0], S[0][1], S[0][2], S[0][3], S[1][0], S[1][1], S[1][2], S[1][3]}, g[8] = {S[2][0], S[2][1], S[2][2], S[2][3], S[3][0], S[3][1], S[3][2], S[3][3]};
      *(u32x4*)(ss + (16 * et + fr) * 64 + 16 * fq) = pack8(f); *(u32x4*)(ss + (16 * et + fr) * 64 + 16 * fq + 8) = pack8(g); }
    bf16x8 sb[2];
#pragma unroll
    for (int ks = 0; ks < 2; ++ks) { u32x4 sp; sp.x = cvt_pk(S[2 * ks][0], S[2 * ks][1]); sp.y = cvt_pk(S[2 * ks][2], S[2 * ks][3]); sp.z = cvt_pk(S[2 * ks + 1][0], S[2 * ks + 1][1]); sp.w = cvt_pk(S[2 * ks + 1][2], S[2 * ks + 1][3]);
        sb[ks] = __builtin_bit_cast(bf16x8, sp); }
    float nf[16]; { float a[8], b[8]; unpack8(r.nv[0], a); unpack8(r.nv[1], b);
#pragma unroll
        for (int j = 0; j < 8; ++j) { nf[j] = a[j]; nf[8 + j] = b[j]; } }
#pragma unroll
    for (int n = 0; n < 4; ++n) { f32x4 acc = {nf[4 * n], nf[4 * n + 1], nf[4 * n + 2], nf[4 * n + 3]};
        acc = MFMA16(r.ma[n][0], sb[0], acc); acc = MFMA16(r.ma[n][1], sb[1], acc); S[n] = acc; }
}
DI void r2_task(PR p, const Ctx& c, int item) {
    unsigned char* ws = p.ws;
    const int lane = c.lane, w = c.wave, fr = lane & 15, fq = lane >> 4, bh = 2 * item + (w >> 2), et = w & 3;
    const bf16_t* MT = (const bf16_t*)(ws + WS_MT) + (size_t)bh * 32 * 4096; const bf16_t* NN = (const bf16_t*)(ws + WS_NN) + (size_t)bh * 32 * 4096;
    bf16_t* SS = (bf16_t*)(ws + WS_SS) + (size_t)bh * 32 * 4096;
    f32x4 S[4] = {F4Z, F4Z, F4Z, F4Z};
    R2Regs ra, rb;
    r2_load(ra, MT, NN, et, fr, fq);
    for (int ch = 0; ch < 32; ch += 2) {
        r2_load(rb, MT + (size_t)(ch + 1) * 4096, NN + (size_t)(ch + 1) * 4096, et, fr, fq);
        r2_step(ra, S, SS + (size_t)ch * 4096, et, fr, fq);
        { const int c2 = ch + 2 < 32 ? ch + 2 : 31; r2_load(ra, MT + (size_t)c2 * 4096, NN + (size_t)c2 * 4096, et, fr, fq); }
        r2_step(rb, S, SS + (size_t)(ch + 1) * 4096, et, fr, fq);
    }
}
struct R3Const { bf16x8 gup[4][5]; f32x4 lnw[4], lnb[4]; };
DI void r3_const(R3Const& k, PR p, int l, int h, int lane) {
    const int fr = lane & 15, fq = lane >> 4; (void)fr;
    const bf16_t* GUPT = (const bf16_t*)(p.ws + WS_LORA + LO_GUP) + (size_t)(64 * h) * 160;
#pragma unroll
    for (int et = 0; et < 4; ++et) { const int col = 64 * h + 16 * et + 4 * fq; k.lnw[et] = *(const f32x4*)(p.in[I_LNW] + l * 1024 + col); k.lnb[et] = *(const f32x4*)(p.in[I_LNB] + l * 1024 + col);
#pragma unroll
        for (int ks = 0; ks < 5; ++ks) k.gup[et][ks] = gfrag(GUPT, 160, 16 * et, 32 * ks, lane); }
}
DI void r3_wave(const R3Const& K, PR p, int l, int wt, int lane) {
    unsigned char* ws = p.ws;
    const int task = wt >> 2, pt = wt & 3, bh = task >> 5, ch = task & 31, b = bh >> 4, h = bh & 15, tok0 = ch * 64 + 16 * pt, m0 = b * TSEQ + tok0, fr = lane & 15, fq = lane >> 4;
    const bf16_t* Z = (const bf16_t*)(ws + WS_Z);
    const size_t blk = (size_t)task * 4096, m = (size_t)(m0 + fr);
    const bf16_t* SS = (const bf16_t*)(ws + WS_SS) + blk; const bf16_t* RP = (const bf16_t*)(ws + WS_RP) + blk; const bf16_t* Y0 = (const bf16_t*)(ws + WS_Y0) + blk;
    bf16x8 sg[5];
    {   const float* mu = p.in[I_MU] + (size_t)l * 3360 + 3200; const bf16_t* zr = Z + m * NZ + ZC_GD; const bool has_prev = (tok0 + fr) > 0;
#pragma unroll
        for (int ks = 0; ks < 5; ++ks) { float cur[8], prv[8]; unpack8(*(const u32x4*)(zr + 32 * ks + 8 * fq), cur);
            if (has_prev) unpack8(*(const u32x4*)(zr - NZ + 32 * ks + 8 * fq), prv); else {
#pragma unroll
                for (int j = 0; j < 8; ++j) prv[j] = 0.f; }
            const f32x4 mA = *(const f32x4*)(mu + 32 * ks + 8 * fq), mB = *(const f32x4*)(mu + 32 * ks + 8 * fq + 4); const float mm[8] = {mA.x, mA.y, mA.z, mA.w, mB.x, mB.y, mB.z, mB.w};
#pragma unroll
            for (int j = 0; j < 8; ++j) cur[j] = sigm(cur[j] + mm[j] * (prv[j] - cur[j]));
            sg[ks] = __builtin_bit_cast(bf16x8, pack8(cur)); } }
    const bf16x8 rp0 = gfrag(RP, 64, 16 * pt, 0, lane), rp1 = gfrag(RP, 64, 16 * pt, 32, lane);
    const float rk = ((const float*)(ws + WS_RK))[m * 16 + h];
    const bf16_t* vsrc = (const bf16_t*)(ws + (l == 0 ? WS_VFIRST : WS_VF));
    u32x2 vraw[4], y0raw[4];
#pragma unroll
    for (int et = 0; et < 4; ++et) { const int col = 64 * h + 16 * et + 4 * fq;
        vraw[et] = *(const u32x2*)(vsrc + m * 1024 + col); y0raw[et] = *(const u32x2*)(Y0 + (16 * pt + fr) * 64 + 16 * et + 4 * fq); }
    f32x4 y[4], g[4]; float s1 = 0.f, s2 = 0.f;
#pragma unroll
    for (int et = 0; et < 4; ++et) { float f[4]; unpack4(y0raw[et], f); f32x4 acc = {f[0], f[1], f[2], f[3]};
        acc = MFMA16(gfrag(SS, 64, 16 * et, 0, lane), rp0, acc); acc = MFMA16(gfrag(SS, 64, 16 * et, 32, lane), rp1, acc);
        y[et] = acc; s1 += (acc[0] + acc[1]) + (acc[2] + acc[3]); s2 += (acc[0] * acc[0] + acc[1] * acc[1]) + (acc[2] * acc[2] + acc[3] * acc[3]);
        f32x4 ga = F4Z;
#pragma unroll
        for (int ks = 0; ks < 5; ++ks) ga = MFMA16(K.gup[et][ks], sg[ks], ga);
        g[et] = ga; }
    s1 += __shfl_xor(s1, 16); s1 += __shfl_xor(s1, 32); s2 += __shfl_xor(s2, 16); s2 += __shfl_xor(s2, 32);
    const float mean = s1 * (1.0f / 64.0f), var = fmaxf(s2 * (1.0f / 64.0f) - mean * mean, 0.f), rstd = rsqrtf(var + RW_GN_EPS);
    bf16_t* YRW = (bf16_t*)(ws + WS_YRW);
#pragma unroll
    for (int et = 0; et < 4; ++et) { const int col = 64 * h + 16 * et + 4 * fq;
        float vv[4]; unpack4(vraw[et], vv);
        float o[4];
#pragma unroll
        for (int r = 0; r < 4; ++r) o[r] = ((y[et][r] - mean) * rstd * K.lnw[et][r] + K.lnb[et][r] + rk * vv[r]) * g[et][r];
        *(u32x2*)(YRW + m * 1024 + col) = pack4(o[0], o[1], o[2], o[3]); }
}
constexpr int P7L = 264;
constexpr int P7_HI = 0, P7_LO = 64 * P7L * 2, P7_LG = 2 * P7_LO, P7_RS = P7_LG + 2 * 64 * 48 * 4, P7_HIST = P7_RS + 256;
DI void p7_route(PR p, const Ctx& c, int l) {
    unsigned char* ws = p.ws;
    const int lane = c.lane, w = c.wave, fr = lane & 15, fq = lane >> 4;
    const float* H = p.out; bf16_t* HN = (bf16_t*)(ws + WS_XN);
    const float* nw = p.in[I_NFFN] + (size_t)l * D; const bf16_t* WRH = (const bf16_t*)(ws + WS_LORA + LO_WR); const bf16_t* WRL = (const bf16_t*)(ws + WS_LORA + LO_WRL);
    const float* bg = p.in[I_RGB] + l * 4; const float* be = p.in[I_REB] + l * 32;
    int* TOKE = (int*)(ws + WS_TOKE); float* TOKW = (float*)(ws + WS_TOKW); int* CNT = (int*)(ws + WS_CNT); float* TRSTD = (float*)(ws + WS_TRSTD);
    LAS bf16_t* HI = (LAS bf16_t*)(c.lds + P7_HI); LAS bf16_t* LO = (LAS bf16_t*)(c.lds + P7_LO); LAS float* LG = (LAS float*)(c.lds + P7_LG); LAS float* RS = (LAS float*)(c.lds + P7_RS); LAS int* hist = (LAS int*)(c.lds + P7_HIST);
    for (int tile = c.bid; tile < M / 64; tile += c.G) {
        if (c.tid < 32) hist[c.tid] = 0;
        const int tt = w & 3, kh = w >> 2, mb = tile * 64 + 8 * w;
        f32x4 acc[3] = {F4Z, F4Z, F4Z}; float ss[8];
#pragma unroll
        for (int i = 0; i < 8; ++i) ss[i] = 0.f;
        for (int kc = 0; kc < 8; ++kc) {
            const f32x4 ww = *(const f32x4*)(nw + 256 * kc + 4 * lane);
            f32x4 hv[8];
#pragma unroll
            for (int i = 0; i < 8; ++i) hv[i] = *(const f32x4*)(H + (size_t)(mb + i) * D + 256 * kc + 4 * lane);
            bf16x8 wh[4][3], wl[4][3];
#pragma unroll
            for (int k4 = 0; k4 < 4; ++k4)
#pragma unroll
                for (int ct = 0; ct < 3; ++ct) { const int kg = 256 * kc + 32 * (4 * kh + k4); wh[k4][ct] = gfrag(WRH, D, 16 * ct, kg, lane); wl[k4][ct] = gfrag(WRL, D, 16 * ct, kg, lane); }
#pragma unroll
            for (int i = 0; i < 8; ++i) { ss[i] += (hv[i].x * hv[i].x + hv[i].y * hv[i].y) + (hv[i].z * hv[i].z + hv[i].w * hv[i].w);
                const f32x4 x = hv[i] * ww; const u32x2 hp = pack4(x.x, x.y, x.z, x.w); float hf[4]; unpack4(hp, hf);
                *(u32x2*)(HN + (size_t)(mb + i) * D + 256 * kc + 4 * lane) = hp;
                *(LAS u32x2*)(HI + (8 * w + i) * P7L + 4 * lane) = hp; *(LAS u32x2*)(LO + (8 * w + i) * P7L + 4 * lane) = pack4(x.x - hf[0], x.y - hf[1], x.z - hf[2], x.w - hf[3]); }
            lds_barrier();
#pragma unroll
            for (int k4 = 0; k4 < 4; ++k4) { const int ks = 4 * kh + k4;
                const bf16x8 xh = frag_n<P7L>(HI, 16 * tt, 32 * ks, lane), xl = frag_n<P7L>(LO, 16 * tt, 32 * ks, lane);
#pragma unroll
                for (int ct = 0; ct < 3; ++ct) { acc[ct] = MFMA16(wh[k4][ct], xh, acc[ct]); acc[ct] = MFMA16(wh[k4][ct], xl, acc[ct]); acc[ct] = MFMA16(wl[k4][ct], xh, acc[ct]); } }
            lds_barrier();
        }
#pragma unroll
        for (int i = 0; i < 8; ++i) { const float r = rsqrtf(wave_sum(ss[i]) * (1.f / D) + NORM_EPS); if (lane == i) { RS[8 * w + i] = r; TRSTD[mb + i] = r; } }
#pragma unroll
        for (int ct = 0; ct < 3; ++ct) *(LAS f32x4*)(LG + (kh * 64 + 16 * tt + fr) * 48 + 16 * ct + 4 * fq) = acc[ct];
        __syncthreads();
        if (c.tid < 64) { const int t = c.tid, m = tile * 64 + t; const float rstd = RS[t];
            const LAS float* l0 = LG + t * 48; const LAS float* l1 = LG + (64 + t) * 48;
            float gl[4]; int gs = 0;
#pragma unroll
            for (int i = 0; i < 4; ++i) gl[i] = (l0[i] + l1[i]) * rstd + bg[i];
#pragma unroll
            for (int i = 1; i < 4; ++i) if (gl[i] > gl[gs]) gs = i;
            float den = 0.f;
#pragma unroll
            for (int i = 0; i < 4; ++i) den += __expf(gl[i] - gl[gs]);
            const float pg = 1.0f / den;
            float el[8]; int i1 = 0, i2 = -1;
#pragma unroll
            for (int i = 0; i < 8; ++i) el[i] = (l0[4 + 8 * gs + i] + l1[4 + 8 * gs + i]) * rstd + be[8 * gs + i];
#pragma unroll
            for (int i = 1; i < 8; ++i) if (el[i] > el[i1]) i1 = i;
#pragma unroll
            for (int i = 0; i < 8; ++i) if (i != i1 && (i2 < 0 || el[i] > el[i2])) i2 = i;
            const float e2 = __expf(el[i2] - el[i1]), w1 = pg / (1.0f + e2), w2 = pg * e2 / (1.0f + e2);
            TOKE[2 * m] = 8 * gs + i1; TOKE[2 * m + 1] = 8 * gs + i2; TOKW[2 * m] = w1; TOKW[2 * m + 1] = w2;
            atomicAdd((int*)&hist[8 * gs + i1], 1); atomicAdd((int*)&hist[8 * gs + i2], 1); }
        __syncthreads();
        if (c.tid < 32) CNT[tile * 32 + c.tid] = hist[c.tid];
        __syncthreads();
    }
}
DI void moe_tables(PR p, const Ctx& c) {
    const int* CNT = (const int*)(p.ws + WS_CNT);
    LAS int* LC = (LAS int*)(c.lds + LDS_CTL_OFF);
    LAS int* part = (LAS int*)(c.lds + 72000);
    { const int e = c.tid & 31, pr = c.tid >> 5; int v[16];
#pragma unroll
      for (int i = 0; i < 16; ++i) v[i] = CNT[(pr + 16 * i) * 32 + e];
      int s = 0;
#pragma unroll
      for (int i = 0; i < 16; ++i) s += v[i];
      part[pr * 32 + e] = s; }
    __syncthreads();
    if (c.tid < 32) { int s = 0;
#pragma unroll 1
        for (int pr = 0; pr < 16; ++pr) s += part[pr * 32 + c.tid];
        LC[LC_TOT + c.tid] = s; }
    __syncthreads();
    if (c.tid == 0) { int acc = 0;
#pragma unroll 1
        for (int e = 0; e < 32; ++e) { LC[LC_PAD + e] = acc; const int nt = (LC[LC_TOT + e] + 255) >> 8;
#pragma unroll 1
            for (int i = 0; i < nt; ++i) LC[LC_TILE + (acc >> 8) + i] = e;
            acc += nt << 8; }
        LC[LC_PAD + 32] = acc; }
    __syncthreads();
}
DI void p8_dispatch(PR p, const Ctx& c) {
    unsigned char* ws = p.ws;
    const int* CNT = (const int*)(ws + WS_CNT); const int* TOKE = (const int*)(ws + WS_TOKE); int* TOKS = (int*)(ws + WS_TOKS);
    const bf16_t* HN = (const bf16_t*)(ws + WS_XN); bf16_t* XS = (bf16_t*)(ws + WS_XS);
    LAS int* LC = (LAS int*)(c.lds + LDS_CTL_OFF);
    LAS int* base = (LAS int*)(c.lds + 76000); LAS int* part = (LAS int*)(c.lds + 72000); LAS int* eids = (LAS int*)(c.lds + 77000); LAS int* slots = (LAS int*)(c.lds + 78000);
    for (int tile = c.bid; tile < M / 64; tile += c.G) {
        { const int e = c.tid & 31, pr = c.tid >> 5; int v[16];
#pragma unroll
          for (int i = 0; i < 16; ++i) { const int tl = pr + 16 * i; v[i] = CNT[(tl < tile ? tl : 0) * 32 + e]; }
          int s = 0;
#pragma unroll
          for (int i = 0; i < 16; ++i) s += (pr + 16 * i < tile) ? v[i] : 0;
          part[pr * 32 + e] = s; }
        if (c.tid < 128) eids[c.tid] = TOKE[tile * 128 + c.tid];
        __syncthreads();
        if (c.tid < 32) { int s = 0; for (int pr = 0; pr < 16; ++pr) s += part[pr * 32 + c.tid]; base[c.tid] = s; }
        __syncthreads();
        if (c.tid < 128) { const int e = eids[c.tid]; int lp = 0; for (int i = 0; i < c.tid; ++i) lp += (eids[i] == e) ? 1 : 0;
            const int s = LC[LC_PAD + e] + base[e] + lp; slots[c.tid] = s; TOKS[tile * 128 + c.tid] = s; ((int*)(ws + WS_CTL + CTL_SLOTTOK))[s] = tile * 64 + (c.tid >> 1); ((float*)(ws + WS_SRSTD))[s] = ((const float*)(ws + WS_TRSTD))[tile * 64 + (c.tid >> 1)]; }
        __syncthreads();
        __syncthreads();
    }
}
DI void p11_combine(PR p, const Ctx& c, int l) {
    unsigned char* ws = p.ws;
    const int lane = c.lane; const int gw = c.bid * 8 + c.wave, NGW = c.G * 8;
    float* H = p.out; const bf16_t* YS = (const bf16_t*)(ws + WS_YS); const int* TOKS = (const int*)(ws + WS_TOKS); const float* TOKW = (const float*)(ws + WS_TOKW);
    bf16_t* XN = (bf16_t*)(ws + WS_XN);
    const float* nw = (l == 0) ? p.in[I_NMIX] + D : p.in[I_FNW];
    f32x4 ww[8];
#pragma unroll
    for (int j = 0; j < 8; ++j) ww[j] = ((const f32x4*)nw)[lane + 64 * j];
    if (gw >= M) return;
    int s0 = TOKS[2 * gw], s1 = TOKS[2 * gw + 1]; float w0 = TOKW[2 * gw], w1 = TOKW[2 * gw + 1];
    for (int m = gw; m < M; m += NGW) {
        f32x4* hr = (f32x4*)(H + (size_t)m * D) + lane; const u32x2* y0 = (const u32x2*)(YS + (size_t)s0 * D) + lane; const u32x2* y1 = (const u32x2*)(YS + (size_t)s1 * D) + lane;
        f32x4 hv[8]; u32x2 ya[8], yb[8];
#pragma unroll
        for (int j = 0; j < 8; ++j) { hv[j] = hr[64 * j]; ya[j] = y0[64 * j]; yb[j] = y1[64 * j]; }
        const float cw0 = w0, cw1 = w1;
        { const int mn = (m + NGW < M) ? m + NGW : m; s0 = TOKS[2 * mn]; s1 = TOKS[2 * mn + 1]; w0 = TOKW[2 * mn]; w1 = TOKW[2 * mn + 1]; }
        float s = 0.f;
#pragma unroll
        for (int j = 0; j < 8; ++j) { float a[4], b[4]; unpack4(ya[j], a); unpack4(yb[j], b);
            hv[j].x += cw0 * a[0] + cw1 * b[0]; hv[j].y += cw0 * a[1] + cw1 * b[1]; hv[j].z += cw0 * a[2] + cw1 * b[2]; hv[j].w += cw0 * a[3] + cw1 * b[3];
            s += (hv[j].x * hv[j].x + hv[j].y * hv[j].y) + (hv[j].z * hv[j].z + hv[j].w * hv[j].w); }
        const float rstd = rsqrtf(wave_sum(s) * (1.f / D) + NORM_EPS);
#pragma unroll
        for (int j = 0; j < 8; ++j) {
            if (l == 0) { hr[64 * j] = hv[j]; ((u32x2*)(XN + (size_t)m * D))[lane + 64 * j] = pack4(hv[j].x * rstd * ww[j].x, hv[j].y * rstd * ww[j].y, hv[j].z * rstd * ww[j].z, hv[j].w * rstd * ww[j].w); }
            else hr[64 * j] = hv[j] * rstd * ww[j]; }
    }
}
#ifndef DBG_CUT
#define DBG_CUT 1000
#endif
constexpr int NPHASE = 23;
#ifndef WGM_P1
#define WGM_P1 4
#endif
#ifndef WGM_P56
#define WGM_P56 2
#endif
#ifndef REP_R1
#define REP_R1 1
#endif
#ifndef REP_H1
#define REP_H1 1
#endif
#ifndef REP_R2
#define REP_R2 1
#endif
#ifndef REP_H3
#define REP_H3 1
#endif
#ifndef REP_R3
#define REP_R3 1
#endif
#ifndef PH_MASK
#define PH_MASK 0xFFFF
#endif
#define PH_EN(n) ((PH_MASK >> (n)) & 1)
__global__ void __launch_bounds__(512, 2) mk_fwd(Params p_byval) {
    const CAS Params* pp = (const CAS Params*)__builtin_amdgcn_kernarg_segment_ptr();
#define p (*pp)
    extern __shared__ __attribute__((aligned(16))) unsigned char lds_raw[];
    Ctx c; unsigned char* ws;
#define FRESH() do { int t_ = threadIdx.x; asm volatile("" : "+v"(t_)); int b_ = blockIdx.x; asm volatile("" : "+s"(b_)); unsigned lb_ = (unsigned)(uintptr_t)(LAS unsigned char*)lds_raw; asm volatile("" : "+s"(lb_)); c.lds = (LAS unsigned char*)(uintptr_t)lb_; c.tid = t_; c.lane = t_ & 63; \
        c.wave = __builtin_amdgcn_readfirstlane(t_ >> 6); c.G = gridDim.x; c.bid = b_; pp = (const CAS Params*)__builtin_amdgcn_kernarg_segment_ptr(); asm volatile("" : "+s"(pp)); ws = p.ws; asm volatile("" : "+s"(ws)); glds = (LAS unsigned char*)c.lds; } while (0)
    LAS unsigned char* glds;
    FRESH();
    LAS unsigned* LCU = (LAS unsigned*)(c.lds + LDS_CTL_OFF);
    if (c.tid < 4) LCU[c.tid] = 0u;
    __syncthreads();
#if MK_ONE_LAUNCH
    XcdBarrier bar = xcd_barrier_post((unsigned*)(ws + WS_CTL) + CW_BAR, (volatile LAS unsigned*)LCU);
#define GRID_BAR() xcd_barrier(bar)
#else
#define GRID_BAR() do { } while (0)
#endif
    const int lo = p.ph_lo, hi_raw = p.ph_hi; int hi = hi_raw & 0xffff; const int dbgflag = hi_raw >> 16; (void)dbgflag;
#define IN(k) (lo <= (k) && (k) < hi)
#define SEAM(k) do { if (IN(k) && IN((k) + 1)) GRID_BAR(); } while (0)
    if (PH_EN(0) && IN(0)) { FRESH();
        convert_small(p, c, 0, 0);
        const int gw = c.bid * 8 + c.wave, NGW = c.G * 8;
        for (int m = gw; m < M; m += NGW) rms_row_bf16(p.in[I_X] + (size_t)m * D, p.in[I_NMIX], (bf16_t*)(ws + WS_XN) + (size_t)m * D, c.lane);
    }
    SEAM(0);
    for (int l = 0; l < 2; ++l) {
        const int pb = 1 + 11 * l;
        if (PH_EN(1) && IN(pb + 0)) { FRESH();
            pg8::Gemm g{(const bf16_t*)(ws + WS_XN), (const bf16_t*)(ws + WS_WIN), M, NZ, D}; pg8::StaticOrder S; S.init(M, NZ, c.G, c.bid, WGM_P1);
            if (dbgflag == 3) { S.nM = 1; S.nN = 1; S.hot = 1; }
            pg8::EpiBf16P E{(bf16_t*)(ws + WS_Z), NZ, dbgflag == 3 ? 1 : dbgflag};
#ifdef STAGGER_TICKS
            if (c.bid & 1) { const unsigned long long t0 = __builtin_amdgcn_s_memrealtime(); while (__builtin_amdgcn_s_memrealtime() - t0 < STAGGER_TICKS) __builtin_amdgcn_s_sleep(32); }
#endif
            pg8::gemm_phase<pg8::EpiBf16P, pg8::StaticOrder>(glds, g, S, E, nullptr);
            const int nunits = (M / 256) * (NZ / 256), rem = nunits % c.G;
            if (rem != 0 && c.bid >= rem && EXP_EARLY > 0) { __syncthreads(); FRESH(); convert_experts_early(p, c, l, rem, c.G - rem); }
        }
        SEAM(pb + 0);
        if (PH_EN(2) && IN(pb + 1)) { FRESH();
            if (c.bid < 4096) { R1In rin = r1_load(ws, c.bid, c.tid);
              for (int it = c.bid; it < 4096; it += c.G) rin = r1_task<0>(p, c, l, it, rin, it + c.G < 4096 ? it + c.G : it); }
            if (c.bid < 2048) { H1In hin = h1_load(ws, c.bid, c.tid);
              for (int it = c.bid; it < 2048; it += c.G) hin = h1_task(p, c, l, it, hin, it + c.G < 2048 ? it + c.G : it); }
        }
        SEAM(pb + 1);
        if (PH_EN(3) && IN(pb + 2)) { FRESH();
            if (c.G >= 128) { if (c.bid < 64) { for (int rep = 0; rep < REP_R2; ++rep) r2_task(p, c, c.bid); } else for (int it = c.bid - 64; it < 256; it += c.G - 64) h2_item(p, c, it); }
            else { for (int it = c.bid; it < 64; it += c.G) r2_task(p, c, it); for (int it = c.bid; it < 256; it += c.G) h2_item(p, c, it); }
        }
        SEAM(pb + 2);
        if (PH_EN(4) && IN(pb + 3)) { FRESH();
            { const int gw = c.bid * 8 + c.wave, NGW = c.G * 8;
              { f32x4 onw[8];
#pragma unroll
                for (int et = 0; et < 8; ++et) onw[et] = *(const f32x4*)(p.in[I_ONORM] + l * 128 + 16 * et + 4 * (c.lane >> 4));
                for (int wt = gw; wt < 8192; wt += NGW) h3_wave(onw, p, l, wt, c.lane); }
              if (gw < 16384) { R3Const K3; const bool inv = (NGW % 2048) == 0;
                r3_const(K3, p, l, ((gw >> 2) >> 5) & 15, c.lane);
                for (int wt = gw; wt < 16384; wt += NGW) { if (!inv) r3_const(K3, p, l, ((wt >> 2) >> 5) & 15, c.lane); r3_wave(K3, p, l, wt, c.lane); } } }
        }
        SEAM(pb + 3);
        if (PH_EN(5) && IN(pb + 4)) { FRESH();
            pg8::StaticOrder S; S.init(M, D, c.G, c.bid, WGM_P56);
#ifndef DBG_NO_HG
            { pg8::Gemm g{(const bf16_t*)(ws + WS_YHG), (const bf16_t*)(ws + WS_WBH), M, D, 1024};
              pg8::EpiGate E{(bf16_t*)(ws + WS_XN), D, (const bf16_t*)(ws + WS_Z) + ZC_GA, NZ, 0, dbgflag};
              pg8::gemm_phase<pg8::EpiGate, pg8::StaticOrder>(glds, g, S, E, nullptr); }
#endif
#ifndef DBG_NO_RW
            { pg8::Gemm g{(const bf16_t*)(ws + WS_YRW), (const bf16_t*)(ws + WS_WBR), M, D, 1024};
#ifdef DBG_NO_HG
              pg8::EpiGate E{(bf16_t*)(ws + WS_XN), D, (const bf16_t*)(ws + WS_Z) + ZC_GB, NZ, 0, dbgflag};
#else
              pg8::EpiGate E{(bf16_t*)(ws + WS_XN), D, (const bf16_t*)(ws + WS_Z) + ZC_GB, NZ, 1, dbgflag};
#endif
              pg8::gemm_phase<pg8::EpiGate, pg8::StaticOrder>(glds, g, S, E, nullptr); }
#endif
        }
        SEAM(pb + 4);
        if (PH_EN(6) && IN(pb + 5)) { FRESH();
            pg8::Gemm g{(const bf16_t*)(ws + WS_XN), (const bf16_t*)(ws + WS_WO), M, D, D}; pg8::StaticOrder S; S.init(M, D, c.G, c.bid, WGM_P56);
            pg8::EpiRes E{l == 0 ? p.in[I_X] : p.out, p.out, D, dbgflag};
            pg8::gemm_phase<pg8::EpiRes, pg8::StaticOrder>(glds, g, S, E, nullptr);
        }
        SEAM(pb + 5);
        if (PH_EN(7) && IN(pb + 6)) { FRESH();
            { const int nunits = (M / 256) * (NZ / 256); convert_experts(p, c, l, (nunits % c.G) != 0 ? EXP_EARLY : 0); }
            __syncthreads();
            p7_route(p, c, l);
        }
        SEAM(pb + 6);
        if (PH_EN(8) && IN(pb + 7)) { FRESH(); moe_tables(p, c); p8_dispatch(p, c); }
        SEAM(pb + 7);
        if (PH_EN(9) && IN(pb + 8)) { FRESH();
            moe_tables(p, c); FRESH();
            const LAS int* LC = (const LAS int*)(c.lds + LDS_CTL_OFF);
            pg8::Gemm g{(const bf16_t*)(ws + WS_XN), (const bf16_t*)(ws + WS_WGU), MAXSLOTS, NEXP * 1024, D, (const int*)(ws + WS_CTL + CTL_SLOTTOK)};
            pg8::GroupedOrder<4> S{(LC[LC_PAD + 32] >> 8) * 4, c.G, c.bid, LC + LC_TILE};
            pg8::EpiSwiGLU E{(bf16_t*)(ws + WS_ACT), (const float*)(ws + WS_SRSTD), dbgflag};
            pg8::gemm_phase<pg8::EpiSwiGLU, pg8::GroupedOrder<4>, false, true>(glds, g, S, E, nullptr);
        }
        SEAM(pb + 8);
        if (PH_EN(10) && IN(pb + 9)) { FRESH();
            moe_tables(p, c); FRESH();
            const LAS int* LC = (const LAS int*)(c.lds + LDS_CTL_OFF);
            pg8::Gemm g{(const bf16_t*)(ws + WS_ACT), (const bf16_t*)(ws + WS_WDN), MAXSLOTS, NEXP * D, DEXP};
            pg8::GroupedOrder<8> S{(LC[LC_PAD + 32] >> 8) * 8, c.G, c.bid, LC + LC_TILE};
            pg8::EpiDown E{(bf16_t*)(ws + WS_YS), dbgflag};
            pg8::gemm_phase<pg8::EpiDown, pg8::GroupedOrder<8>>(glds, g, S, E, nullptr);
        }
        SEAM(pb + 9);
        if (PH_EN(11) && IN(pb + 10)) { FRESH();
            p11_combine(p, c, l);
            if (l == 0) convert_small(p, c, 1, 0);
        }
        SEAM(pb + 10);
    }
}
#undef p
__global__ void __launch_bounds__(512) dbg_final(const float* src, const float* fw, float* out) {
    const int lane = threadIdx.x & 63, gw = blockIdx.x * 8 + (threadIdx.x >> 6), NGW = gridDim.x * 8;
    for (int m = gw; m < M; m += NGW) { const f32x4* xr = (const f32x4*)(src + (size_t)m * D) + lane; f32x4 v[8]; float s = 0.f;
#pragma unroll
        for (int j = 0; j < 8; ++j) { v[j] = xr[64 * j]; s += (v[j].x * v[j].x + v[j].y * v[j].y) + (v[j].z * v[j].z + v[j].w * v[j].w); }
        const float rstd = rsqrtf(wave_sum(s) * (1.f / D) + NORM_EPS);
#pragma unroll
        for (int j = 0; j < 8; ++j) ((f32x4*)(out + (size_t)m * D))[lane + 64 * j] = v[j] * rstd * ((const f32x4*)fw)[lane + 64 * j]; }
}
#ifdef DBG_CHECK
__global__ void __launch_bounds__(512) dbg_check(const void* buf, size_t n, int is_f32, unsigned* flag, unsigned idx) {
    size_t i = (size_t)blockIdx.x * 512 + threadIdx.x, st = (size_t)gridDim.x * 512; bool bad = false;
#ifdef DBG_DEAD
    bool alive = false;
    for (; i < n; i += st) { float v = is_f32 ? ((const float*)buf)[i] : bf2f(((const bf16_t*)buf)[i]); if (fabsf(v) > 0.01f && fabsf(v) < 1e6f) alive = true; }
    __shared__ int anyalive; if (threadIdx.x == 0) anyalive = 0; __syncthreads(); if (alive) anyalive = 1; __syncthreads();
    if (threadIdx.x == 0 && anyalive) atomicOr(flag + 1 + idx, 1u);
#else
    for (; i < n; i += st) { float v = is_f32 ? ((const float*)buf)[i] : bf2f(((const bf16_t*)buf)[i]); if (!(v - v == 0.f)) bad = true; }
    if (bad) atomicMin(flag, idx);
#endif
}
__global__ void __launch_bounds__(512) dbg_scale(float* out, const unsigned* flag) {
#ifdef DBG_DEAD
    unsigned f = 1000u; for (unsigned i = 1; i <= 18; ++i) if (flag[1 + i] == 0u) { f = i; break; }
#else
    const unsigned f = *flag;
#endif
    const float s = f < 100u ? 1.0f + 0.25f * (float)f : 1.0f;
    for (size_t i = (size_t)blockIdx.x * 512 + threadIdx.x; i < (size_t)M * D; i += (size_t)gridDim.x * 512) out[i] *= s;
}
#endif
#ifdef DBG_TRTEST
__global__ void __launch_bounds__(64) dbg_trtest(unsigned* flag) {
    __shared__ __attribute__((aligned(16))) bf16_t A[64 * 72];
    const int lane = threadIdx.x;
    for (int i = lane; i < 64 * 72; i += 64) { const int r = i / 72, cc = i % 72; const float v = (float)((r * 5 + cc * 3) & 255); A[i] = (bf16_t)(cvt_pk(v, 0.f) & 0xffff); }
    __syncthreads();
    unsigned bad = 0;
    for (int row0 = 0; row0 < 64; row0 += 16) for (int k0 = 0; k0 < 64; k0 += 32) {
        const bf16x8 f = frag_t<72>((const LAS bf16_t*)A, row0, k0, lane);
        for (int j = 0; j < 8; ++j) { const int k = k0 + 8 * (lane >> 4) + j, i = row0 + (lane & 15); if ((bf16_t)f[j] != A[k * 72 + i]) bad = 1; }
    }
    if (bad) atomicMin(flag, 2u);
    f32x4 acc = {0.f, 0.f, 0.f, 0.f}; bf16x8 xa, yb;
    for (int j = 0; j < 8; ++j) { const int k = 8 * (lane >> 4) + j, r = lane & 15; xa[j] = (short)(cvt_pk(r == k ? 1.f : 0.f, 0.f) & 0xffff); yb[j] = (short)(cvt_pk((float)(r * 8 + (k & 7)), 0.f) & 0xffff); }
    acc = MFMA16(yb, xa, acc);
    for (int r = 0; r < 4; ++r) { const int pp_ = lane & 15, q = 4 * (lane >> 4) + r; if (acc[r] != (float)(q * 8 + (pp_ & 7))) bad |= 2; }
    if (bad & 2) atomicMin(flag, 3u);
}
#endif
#ifdef DBG_H1TEST
__global__ void __launch_bounds__(512) dbg_h1test(unsigned* flag) {
    extern __shared__ __attribute__((aligned(16))) unsigned char lraw[];
    LAS unsigned char* lds = (LAS unsigned char*)lraw;
    LAS bf16_t* Vs = (LAS bf16_t*)(lds + H_V); LAS bf16_t* KPs = (LAS bf16_t*)(lds + H_KP); LAS bf16_t* QHs = (LAS bf16_t*)(lds + H_QH); LAS bf16_t* KTs = (LAS bf16_t*)(lds + H_KT);
    const int tid = threadIdx.x, lane = tid & 63, w = tid >> 6, fr = lane & 15, fq = lane >> 4;
    for (int i = tid; i < 32 * HL; i += 512) { const int r = i / HL, cc = i % HL;
        Vs[i] = (bf16_t)(cvt_pk((float)((r * 3 + cc) % 7 - 3), 0.f) & 0xffff); KPs[i] = (bf16_t)(cvt_pk((float)((r + cc * 5) % 5 - 2), 0.f) & 0xffff);
        QHs[i] = (bf16_t)(cvt_pk((float)((r * 2 + cc) % 3 - 1), 0.f) & 0xffff); KTs[i] = (bf16_t)(cvt_pk((float)((r + cc) % 4 - 1), 0.f) & 0xffff); }
    __syncthreads();
    unsigned bad = 0;
    const bf16x8 xb = frag_t<HL>(Vs, 16 * w, 0, lane);
    for (int dn = 0; dn < 8; ++dn) { const bf16x8 ya = frag_t<HL>(KPs, 16 * dn, 0, lane); const f32x4 nt = MFMA16(ya, xb, F4Z);
        for (int r = 0; r < 4; ++r) { const int e = 16 * w + fr, d = 16 * dn + 4 * fq + r; float ref = 0.f; for (int s = 0; s < 32; ++s) ref += (float)((s * 3 + e) % 7 - 3) * (float)((s + d * 5) % 5 - 2); if (nt[r] != ref) bad |= 1; } }
    if (w < 4) { const int p0 = 16 * (w >> 1), q0 = 16 * (w & 1);
        const f32x4 sc = mm16<false, false, 4, HL, HL>(QHs, KTs, p0, q0, lane, F4Z);
        for (int r = 0; r < 4; ++r) { const int t = p0 + fr, s = q0 + 4 * fq + r; float ref = 0.f; for (int d = 0; d < 128; ++d) ref += (float)((t * 2 + d) % 3 - 1) * (float)((s + d) % 4 - 1); if (sc[r] != ref) bad |= 2; } }
    if (bad & 1) atomicMin(flag, 2u);
    if (bad & 2) atomicMin(flag, 3u);
}
#endif
#ifdef DBG_CLASS
__global__ void __launch_bounds__(512) dbg_class(const bf16_t* buf, size_t n, unsigned* flag) {
    unsigned m = 0;
    for (size_t i = (size_t)blockIdx.x * 512 + threadIdx.x; i < n; i += (size_t)gridDim.x * 512) { const bf16_t b = buf[i]; const float v = bf2f(b); const float a = fabsf(v);
        if (b == 0xAAAA) m |= 4; else if (a == 0.f) m |= 2; else if (a > 0.01f && a < 1e6f) m |= 1; else if (!(a < 1e6f)) m |= 8; else m |= 16; }
    if (m) atomicOr(flag + 40, m);
}
__global__ void __launch_bounds__(512) dbg_scale2(float* out, const unsigned* flag) {
    const unsigned f = flag[40]; const float s = 1.0f + 0.25f * (float)f;
    for (size_t i = (size_t)blockIdx.x * 512 + threadIdx.x; i < (size_t)M * D; i += (size_t)gridDim.x * 512) out[i] *= s;
}
#endif
#ifdef DBG_CSUM
__global__ void __launch_bounds__(512) dbg_csum(const unsigned* buf, size_t nwords, unsigned* flag) {
    unsigned long long s = 0;
    for (size_t i = (size_t)blockIdx.x * 512 + threadIdx.x; i < nwords; i += (size_t)gridDim.x * 512) s += (unsigned long long)buf[i] * (unsigned long long)((i & 1023) + 1);
    atomicAdd((unsigned long long*)(flag + 42), s);
}
__global__ void __launch_bounds__(512) dbg_scale3(float* out, const unsigned* flag) {
    const unsigned long long c = *(const unsigned long long*)(flag + 42); const float s = 1.0f + 0.25f * (float)((c >> 7) & 3ull);
    for (size_t i = (size_t)blockIdx.x * 512 + threadIdx.x; i < (size_t)M * D; i += (size_t)gridDim.x * 512) out[i] *= s;
}
#endif
#ifdef DBG_ZCOLS
__global__ void __launch_bounds__(512) dbg_zcols(const bf16_t* Z, unsigned* flag) {
    const int starts[13] = {0, 1024, 2048, 3072, 4096, 5120, 6144, 7168, 7232, 7296, 7456, 9504, 11552};
    __shared__ int alive[12];
    if (threadIdx.x < 12) alive[threadIdx.x] = 0; __syncthreads();
    for (int row = blockIdx.x; row < M; row += gridDim.x) { const bf16_t* zr = Z + (size_t)row * NZ;
        for (int cidx = threadIdx.x; cidx < 11552; cidx += 512) { const float a = fabsf(bf2f(zr[cidx])); if (a > 0.01f && a < 1e6f) { int seg = 0; for (int s = 0; s < 12; ++s) if (cidx >= starts[s]) seg = s; alive[seg] = 1; } } }
    __syncthreads();
    if (threadIdx.x < 12 && alive[threadIdx.x]) atomicOr(flag + 2 + threadIdx.x, 1u);
}
#endif
#ifdef DBG_WROWS
__global__ void __launch_bounds__(512) dbg_wrows(const bf16_t* W, unsigned* flag) {
    const int starts[13] = {0, 1024, 2048, 3072, 4096, 5120, 6144, 7168, 7232, 7296, 7456, 9504, 11552};
    for (int row = blockIdx.x; row < 11552; row += gridDim.x) { bool alive = false;
        for (int cidx = threadIdx.x; cidx < 2048; cidx += 512) { const float a = fabsf(bf2f(W[(size_t)row * 2048 + cidx])); if (a > 0.001f && a < 1e6f) alive = true; }
        if (alive) { int seg = 0; for (int s = 0; s < 12; ++s) if (row >= starts[s]) seg = s; atomicOr(flag + 2 + seg, 1u); } }
}
#endif
extern "C" void kernel_launch(void* const* d_in, const int* in_sizes, int n_in, void* d_out, int out_size, void* d_ws, size_t ws_size, hipStream_t stream) {
    static int grid = 0;
    if (grid == 0) {
        if (n_in != 31 || out_size != M * D || ws_size < WS_END) { fprintf(stderr, "kernel_launch: unexpected shapes (n_in %d out %d ws %zu)\n", n_in, out_size, ws_size); grid = -1; return; }
        int dev = 0, cus = 0;
        if (hipGetDevice(&dev) != hipSuccess || hipDeviceGetAttribute(&cus, hipDeviceAttributeMultiprocessorCount, dev) != hipSuccess) { grid = -1; return; }
        if (hipFuncSetAttribute((const void*)mk_fwd, hipFuncAttributeMaxDynamicSharedMemorySize, LDS_BYTES) != hipSuccess) { fprintf(stderr, "kernel_launch: hipFuncSetAttribute failed\n"); grid = -1; return; }
        int per_cu = 0;
        if (hipOccupancyMaxActiveBlocksPerMultiprocessor(&per_cu, (const void*)mk_fwd, 512, LDS_BYTES) != hipSuccess || per_cu < 1) { fprintf(stderr, "kernel_launch: occupancy query says %d\n", per_cu); }
        (void)hipGetLastError();
        grid = cus;
    }
    if (grid < 0) return;
    (void)hipMemsetAsync((char*)d_ws + WS_CTL, 0, CTL_BYTES, stream);
    Params p{};
    for (int i = 0; i < 31; ++i) p.in[i] = (const float*)d_in[i];
    p.out = (float*)d_out; p.ws = (unsigned char*)d_ws;
    const int nph = NPHASE < DBG_CUT ? NPHASE : DBG_CUT;
#if MK_ONE_LAUNCH
    p.ph_lo = 0; p.ph_hi = nph;
    hipLaunchKernelGGL(mk_fwd, dim3(grid), dim3(512), LDS_BYTES, stream, p);
#else
    for (int ph = 0; ph < nph; ++ph) { p.ph_lo = ph; p.ph_hi = ph + 1; hipLaunchKernelGGL(mk_fwd, dim3(grid), dim3(512), LDS_BYTES, stream, p);
#ifdef DUP_PID
        if (ph == DUP_PID) {
#ifdef DUP_FLAG
            p.ph_hi |= (DUP_FLAG << 16);
#endif
            hipLaunchKernelGGL(mk_fwd, dim3(grid), dim3(512), LDS_BYTES, stream, p); }
#endif
    }
#endif
#if defined(DBG_ZCOLS)
    { unsigned* flag = (unsigned*)((char*)d_ws + 512 * 1024); (void)hipMemsetAsync(flag, 0, 256, stream);
#ifdef DBG_WROWS
      hipLaunchKernelGGL(dbg_wrows, dim3(1024), dim3(512), 0, stream, (const bf16_t*)((char*)d_ws + WS_WIN), flag);
#else
      hipLaunchKernelGGL(dbg_zcols, dim3(1024), dim3(512), 0, stream, (const bf16_t*)((char*)d_ws + WS_Z), flag);
#endif
      for (int i = 13; i <= 18; ++i) (void)hipMemsetAsync(flag + 1 + i, 1, 4, stream);
      hipLaunchKernelGGL(dbg_final, dim3(grid), dim3(512), 0, stream, (const float*)d_in[0], (const float*)d_in[30], (float*)d_out);
      hipLaunchKernelGGL(dbg_scale, dim3(1024), dim3(512), 0, stream, (float*)d_out, (const unsigned*)flag); }
#elif defined(DBG_CSUM)
    { unsigned* flag = (unsigned*)((char*)d_ws + 512 * 1024); (void)hipMemsetAsync(flag, 0, 256, stream);
      hipLaunchKernelGGL(dbg_csum, dim3(1024), dim3(512), 0, stream, (const unsigned*)((char*)d_ws + DBG_CSUM_OFF), (size_t)DBG_CSUM_WORDS, flag);
      hipLaunchKernelGGL(dbg_final, dim3(grid), dim3(512), 0, stream, (const float*)d_in[0], (const float*)d_in[30], (float*)d_out);
      hipLaunchKernelGGL(dbg_scale3, dim3(1024), dim3(512), 0, stream, (float*)d_out, (const unsigned*)flag); }
#elif defined(DBG_CLASS)
    { unsigned* flag = (unsigned*)((char*)d_ws + 512 * 1024); (void)hipMemsetAsync(flag, 0, 256, stream);
      hipLaunchKernelGGL(dbg_class, dim3(1024), dim3(512), 0, stream, (const bf16_t*)((char*)d_ws + DBG_CLASS_OFF), (size_t)DBG_CLASS_N, flag);
      hipLaunchKernelGGL(dbg_final, dim3(grid), dim3(512), 0, stream, (const float*)d_in[0], (const float*)d_in[30], (float*)d_out);
      hipLaunchKernelGGL(dbg_scale2, dim3(1024), dim3(512), 0, stream, (float*)d_out, (const unsigned*)flag); }
#elif defined(DBG_CHECK)
    { unsigned* flag = (unsigned*)((char*)d_ws + 512 * 1024); (void)hipMemsetAsync(flag, 0x7f, 4, stream); (void)hipMemsetAsync(flag + 1, 0, 128, stream);
      struct B { size_t off, n; int f32; }; const B bl[] = {
#ifdef DBG_DEAD
        {WS_WIN, (size_t)IN_WIDTH * D, 0}, {WS_XN, (size_t)M * D, 0},
#endif
        {WS_Z, (size_t)M * NZ, 0}, {WS_QH, (size_t)M * 1024, 0}, {WS_QH, (size_t)M * 1024, 0}, {WS_NT, (size_t)64 * 64 * 16384, 0}, {WS_DC, (size_t)64 * 64 * 128, 1},
        {WS_RP, (size_t)M * 1024, 0}, {WS_Y0, (size_t)M * 1024, 0}, {WS_MT, (size_t)M * 1024, 0}, {WS_NN, (size_t)M * 1024, 0}, {WS_RK, (size_t)M * 16, 1}, {WS_VFIRST, (size_t)M * 1024, 0},
        {WS_YHG, (size_t)M * 1024, 0}, {WS_SS, (size_t)M * 1024, 0}, {WS_YRW, (size_t)M * 1024, 0}, {WS_XN, (size_t)M * D, 0} };
#ifdef DBG_TRTEST
      hipLaunchKernelGGL(dbg_trtest, dim3(1), dim3(64), 0, stream, flag);
#endif
#ifdef DBG_H1TEST
      hipLaunchKernelGGL(dbg_h1test, dim3(1), dim3(512), 65536, stream, flag);
#endif
      for (unsigned i = 0; i < sizeof(bl) / sizeof(bl[0]); ++i) hipLaunchKernelGGL(dbg_check, dim3(1024), dim3(512), 0, stream, (const void*)((char*)d_ws + bl[i].off), bl[i].n, bl[i].f32, flag, i + 1);
      hipLaunchKernelGGL(dbg_check, dim3(1024), dim3(512), 0, stream, (const void*)d_out, (size_t)M * D, 1, flag, 18u);
      hipLaunchKernelGGL(dbg_final, dim3(grid), dim3(512), 0, stream, (const float*)d_in[0], (const float*)d_in[30], (float*)d_out);
      hipLaunchKernelGGL(dbg_scale, dim3(1024), dim3(512), 0, stream, (float*)d_out, (const unsigned*)flag); }
#elif DBG_CUT < 1000
    hipLaunchKernelGGL(dbg_final, dim3(grid), dim3(512), 0, stream, (const float*)(DBG_CUT <= 6 ? d_in[0] : d_out), (const float*)d_in[30], (float*)d_out);
#endif
}
```

```cpp
#define MK_ONE_LAUNCH 1
#include <hip/hip_runtime.h>
#include <stdint.h>
#include <stdio.h>
#ifndef MK_ONE_LAUNCH
#define MK_ONE_LAUNCH 0
#endif
#define DI __device__ __forceinline__
#define LAS __attribute__((address_space(3)))
typedef unsigned short bf16_t;
typedef short bf16x8 __attribute__((ext_vector_type(8)));
typedef short s16x4 __attribute__((ext_vector_type(4)));
typedef float f32x4 __attribute__((ext_vector_type(4)));
typedef float f32x2 __attribute__((ext_vector_type(2)));
typedef unsigned u32x4 __attribute__((ext_vector_type(4)));
typedef unsigned u32x2 __attribute__((ext_vector_type(2)));

constexpr int M = 16384, D = 2048, TSEQ = 2048, NBATCH = 8;
constexpr int NZ = 11776;
constexpr int ZC_Q = 0, ZC_F = 1024, ZC_I = 2048, ZC_O = 3072, ZC_R = 4096, ZC_K = 5120, ZC_V = 6144, ZC_WD = 7168, ZC_AD = 7232, ZC_GD = 7296,
              ZC_GA = 7456, ZC_GB = 9504, ZC_VDA = 11552, ZC_VDB = 11584;
constexpr int IN_WIDTH = 11552;
constexpr int NEXP = 32, DEXP = 512, MAXSLOTS = 40960;
constexpr float NORM_EPS = 1e-6f, RW_GN_EPS = 64e-5f;
constexpr size_t MiB = 1u << 20;
constexpr size_t WS_CTL = 0, CTL_BYTES = 1 * MiB;
constexpr size_t WS_TOKE = 1 * MiB, WS_TOKW = WS_TOKE + 128 * 1024, WS_TOKS = WS_TOKW + 128 * 1024, WS_CNT = WS_TOKS + 128 * 1024, WS_SRSTD = WS_CNT + 64 * 1024, WS_TRSTD = WS_SRSTD + 192 * 1024;
constexpr size_t WS_LORA = 2 * MiB;
constexpr size_t LO_WUP = 0, LO_AUP = 128 * 1024, LO_GUP = 256 * 1024, LO_VUP = 576 * 1024, LO_WR = 640 * 1024, LO_WRL = 832 * 1024;
constexpr size_t WS_WIN = 4 * MiB, WS_WBH = 50 * MiB, WS_WBR = 54 * MiB, WS_WO = 58 * MiB;
constexpr size_t WS_Z = 66 * MiB;
constexpr size_t WS_XS = WS_Z, WS_ACT = WS_Z + 160 * MiB, WS_YS = WS_Z + 200 * MiB;
constexpr size_t WS_XN = 434 * MiB;
constexpr size_t WS_YHG = 498 * MiB, WS_YRW = 530 * MiB, WS_VFIRST = 562 * MiB;
constexpr size_t WS_X = 594 * MiB;
constexpr size_t WS_NT = WS_X, WS_DC = WS_X + 128 * MiB, WS_QH = WS_X + 130 * MiB, WS_OI = WS_X + 162 * MiB;
constexpr size_t WS_MT = WS_X + 194 * MiB, WS_NN = WS_X + 226 * MiB, WS_RP = WS_X + 258 * MiB, WS_Y0 = WS_X + 290 * MiB, WS_SS = WS_X + 322 * MiB,
                 WS_RK = WS_X + 354 * MiB, WS_VF = WS_X + 355 * MiB;
constexpr size_t WS_WGU = 981 * MiB, WS_WDN = WS_X + 64 * MiB;
constexpr size_t WS_END = 1109 * MiB;
constexpr int CW_BAR = 4096;
constexpr size_t CTL_SLOTTOK = 256 * 1024;
constexpr int LDS_CTL_OFF = 148 * 1024, LDS_BYTES = 152 * 1024;
constexpr int LC_TOT = 16, LC_PAD = 48, LC_TILE = 96, LC_MISC = 256;

DI float bf2f(unsigned short b) { return __uint_as_float(((unsigned)b) << 16); }
typedef __bf16 nbf16x2 __attribute__((ext_vector_type(2)));
DI unsigned cvt_pk(float lo, float hi) { const f32x2 f = {lo, hi}; const nbf16x2 v = __builtin_convertvector(f, nbf16x2); return __builtin_bit_cast(unsigned, v); }
DI void unpack8(const u32x4 v, float (&f)[8]) {
    f[0] = __uint_as_float(v.x << 16); f[1] = __uint_as_float(v.x & 0xffff0000u); f[2] = __uint_as_float(v.y << 16); f[3] = __uint_as_float(v.y & 0xffff0000u);
    f[4] = __uint_as_float(v.z << 16); f[5] = __uint_as_float(v.z & 0xffff0000u); f[6] = __uint_as_float(v.w << 16); f[7] = __uint_as_float(v.w & 0xffff0000u); }
DI u32x4 pack8(const float (&f)[8]) { u32x4 v; v.x = cvt_pk(f[0], f[1]); v.y = cvt_pk(f[2], f[3]); v.z = cvt_pk(f[4], f[5]); v.w = cvt_pk(f[6], f[7]); return v; }
DI void unpack4(const u32x2 v, float (&f)[4]) { f[0] = __uint_as_float(v.x << 16); f[1] = __uint_as_float(v.x & 0xffff0000u); f[2] = __uint_as_float(v.y << 16); f[3] = __uint_as_float(v.y & 0xffff0000u); }
DI u32x2 pack4(float a, float b, float c, float d) { u32x2 v; v.x = cvt_pk(a, b); v.y = cvt_pk(c, d); return v; }
DI float sigm(float x) { return 1.0f / (1.0f + __expf(-x)); }
DI float wave_sum(float v) {
#pragma unroll
    for (int o = 1; o < 64; o <<= 1) v += __shfl_xor(v, o);
    return v;
}

DI void lds_barrier() { asm volatile("s_waitcnt lgkmcnt(0)\n\ts_barrier" ::: "memory"); }
namespace pg8 {
#define PG8_LAS __attribute__((address_space(3)))
typedef unsigned short bf16_t;
typedef short bf16x8 __attribute__((ext_vector_type(8)));
typedef float f32x4 __attribute__((ext_vector_type(4)));
typedef unsigned u32x4 __attribute__((ext_vector_type(4)));
constexpr int BM = 256, BK = 64, HALF = 128, HTB = HALF * BK * 2  , STAGE_BYTES = 8 * HTB, NXCD = 8, WGM = 8;

__host__ __device__ __forceinline__ int lds_byte(int r, int c) { const int st = (r >> 4) * 2 + (c >> 5), rr = r & 15, cc = c & 31, ob = rr * 64 + cc * 2; return st * 1024 + (ob ^ (((ob >> 9) & 1) << 5)); }
__host__ __device__ __forceinline__ void stage_rc(int b, int& R, int& C) { const int st = b / 1024, sb = b % 1024, swz = sb ^ (((sb >> 9) & 1) << 5); R = (st >> 1) * 16 + swz / 64; C = (st & 1) * 32 + (swz % 64) / 2; }
__host__ __device__ __forceinline__ int perm32(int rho) { const int n = rho >> 4, i = rho & 15; return 8 * (i >> 2) + 4 * n + (i & 3); }

struct Unit { int pm, pn; };
struct Gemm { const bf16_t* A; const bf16_t* Bt; int M, N, K; const int* amap = nullptr; };

struct StaticOrder {
    int nM, nN, nwg, G, c, wgm, hot = 0;
    __host__ __device__ void init(int M, int N, int G_, int c_, int wgm_ = WGM) { nM = M / BM; nN = N / BM; nwg = nM * nN; G = G_; c = c_; wgm = wgm_; }
    __host__ __device__ bool next(int i, Unit& u) const {
        const long L = (long)i * G + c; if (L >= nwg) return false;
        int wgid = (int)L; { const int q = nwg / NXCD, r = nwg % NXCD, xcd = wgid % NXCD, off = wgid / NXCD; wgid = (xcd < r ? xcd * (q + 1) : r * (q + 1) + (xcd - r) * q) + off; }
        const int nig = wgm * nN, gid = wgid / nig, fm = gid * wgm, gsz = (nM - fm) < wgm ? (nM - fm) : wgm;
        if (hot) { u.pm = 0; u.pn = 0; return true; }
        u.pm = fm + ((wgid % nig) % gsz); u.pn = (wgid % nig) / gsz; return true;
    }
    __device__ __forceinline__ void a_ready(const Unit&) const {}
    __device__ __forceinline__ void done(const Unit&) const {}
};
__device__ __forceinline__ unsigned cvt_pk_bf16(float lo, float hi) { return ::cvt_pk(lo, hi); }
typedef float f32x2 __attribute__((ext_vector_type(2)));
struct EpiBf16P {
    static constexpr bool PERM = true, AFTER_DRAIN = false;
    bf16_t* O; int ldc; int dbg;
    __device__ __forceinline__ void operator()(const f32x4 (&acc)[2][2][4][2], const Unit& u, int wr, int wc, int fr, int fq) const {
        if (dbg == 1) { float s = 0.f; _Pragma("unroll") for (int ai = 0; ai < 2; ++ai) _Pragma("unroll") for (int bj = 0; bj < 2; ++bj) _Pragma("unroll") for (int m = 0; m < 4; ++m) _Pragma("unroll") for (int n = 0; n < 2; ++n) s += acc[ai][bj][m][n][0] + acc[ai][bj][m][n][3]; asm volatile("" :: "v"(s)); return; }
        const int row0 = u.pm * BM + wr * 64 + fr, col0 = u.pn * BM + wc * 32 + 8 * fq;
#pragma unroll
        for (int ai = 0; ai < 2; ++ai)
#pragma unroll
            for (int m = 0; m < 4; ++m) { bf16_t* rowp = (dbg == 2 ? O + (size_t)(658 * 1024 * 1024 / 2) : O) + (size_t)(dbg == 2 ? (int)(blockIdx.x * 16 + fr) : row0 + ai * HALF + m * 16) * ldc + col0;
#pragma unroll
                for (int bj = 0; bj < 2; ++bj) { const f32x4 v0 = acc[ai][bj][m][0], v1 = acc[ai][bj][m][1];
                    u32x4 w; w.x = cvt_pk_bf16(v0[0], v0[1]); w.y = cvt_pk_bf16(v0[2], v0[3]); w.z = cvt_pk_bf16(v1[0], v1[1]); w.w = cvt_pk_bf16(v1[2], v1[3]);
                    *(u32x4*)(rowp + bj * HALF) = w; } asm volatile("" ::: "memory"); }
    }
};
struct EpiGate {
    static constexpr bool PERM = true, AFTER_DRAIN = false;
    bf16_t* O; int ldo; const bf16_t* Zg; int ldz; int accum; int dbg;
    __device__ __forceinline__ void operator()(const f32x4 (&acc)[2][2][4][2], const Unit& u, int wr, int wc, int fr, int fq) const {
        if (dbg) { float s = 0.f; _Pragma("unroll") for (int ai = 0; ai < 2; ++ai) _Pragma("unroll") for (int bj = 0; bj < 2; ++bj) _Pragma("unroll") for (int m = 0; m < 4; ++m) _Pragma("unroll") for (int n = 0; n < 2; ++n) s += acc[ai][bj][m][n][0] + acc[ai][bj][m][n][3]; asm volatile("" :: "v"(s)); return; }
        const int row0 = u.pm * BM + wr * 64 + fr, col0 = u.pn * BM + wc * 32 + 8 * fq;
#pragma unroll
        for (int ai = 0; ai < 2; ++ai) {
            u32x4 zg[4][2], pv[4][2];
#pragma unroll
            for (int m = 0; m < 4; ++m)
#pragma unroll
                for (int bj = 0; bj < 2; ++bj) { const size_t row = (size_t)(row0 + ai * HALF + m * 16); zg[m][bj] = *(const u32x4*)(Zg + row * ldz + col0 + bj * HALF);
                    if (accum) pv[m][bj] = *(const u32x4*)(O + row * ldo + col0 + bj * HALF); else pv[m][bj] = (u32x4){0u, 0u, 0u, 0u}; }
#pragma unroll
            for (int m = 0; m < 4; ++m)
#pragma unroll
                for (int bj = 0; bj < 2; ++bj) { const size_t row = (size_t)(row0 + ai * HALF + m * 16); const f32x4 v0 = acc[ai][bj][m][0], v1 = acc[ai][bj][m][1];
                    const unsigned zw[4] = {zg[m][bj].x, zg[m][bj].y, zg[m][bj].z, zg[m][bj].w}, pw[4] = {pv[m][bj].x, pv[m][bj].y, pv[m][bj].z, pv[m][bj].w};
                    float o[8];
#pragma unroll
                    for (int j = 0; j < 4; ++j) { const float z0 = __uint_as_float(zw[j] << 16), z1 = __uint_as_float(zw[j] & 0xffff0000u); const float a0 = j < 2 ? v0[2 * j] : v1[2 * j - 4], a1 = j < 2 ? v0[2 * j + 1] : v1[2 * j - 3];
                        o[2 * j] = a0 / (1.0f + __expf(-z0)) + __uint_as_float(pw[j] << 16); o[2 * j + 1] = a1 / (1.0f + __expf(-z1)) + __uint_as_float(pw[j] & 0xffff0000u); }
                    u32x4 w; w.x = cvt_pk_bf16(o[0], o[1]); w.y = cvt_pk_bf16(o[2], o[3]); w.z = cvt_pk_bf16(o[4], o[5]); w.w = cvt_pk_bf16(o[6], o[7]);
                    *(u32x4*)(O + row * ldo + col0 + bj * HALF) = w; }
            asm volatile("" ::: "memory");
        }
    }
};
struct EpiRes {
    static constexpr bool PERM = false, AFTER_DRAIN = false;
    const float* base; float* out; int ldc; int dbg;
    __device__ __forceinline__ void operator()(const f32x4 (&acc)[2][2][4][2], const Unit& u, int wr, int wc, int fr, int fq) const {
        if (dbg) { float s = 0.f; _Pragma("unroll") for (int ai = 0; ai < 2; ++ai) _Pragma("unroll") for (int bj = 0; bj < 2; ++bj) _Pragma("unroll") for (int m = 0; m < 4; ++m) _Pragma("unroll") for (int n = 0; n < 2; ++n) s += acc[ai][bj][m][n][0] + acc[ai][bj][m][n][3]; asm volatile("" :: "v"(s)); return; }
        const int row0 = u.pm * BM + wr * 64 + fr, col0 = u.pn * BM + wc * 32 + 4 * fq;
#pragma unroll
        for (int ai = 0; ai < 2; ++ai) {
            f32x4 bs[4][2][2];
#pragma unroll
            for (int m = 0; m < 4; ++m) { const size_t off = (size_t)(row0 + ai * HALF + m * 16) * ldc + col0;
#pragma unroll
                for (int bj = 0; bj < 2; ++bj)
#pragma unroll
                    for (int n = 0; n < 2; ++n) bs[m][bj][n] = *(const f32x4*)(base + off + bj * HALF + n * 16); }
#pragma unroll
            for (int m = 0; m < 4; ++m) { const size_t off = (size_t)(row0 + ai * HALF + m * 16) * ldc + col0;
#pragma unroll
                for (int bj = 0; bj < 2; ++bj)
#pragma unroll
                    for (int n = 0; n < 2; ++n) *(f32x4*)(out + off + bj * HALF + n * 16) = bs[m][bj][n] + acc[ai][bj][m][n]; }
            asm volatile("" ::: "memory");
        }
    }
};
struct EpiSwiGLU {
    static constexpr bool PERM = true, AFTER_DRAIN = false;
    bf16_t* O; const float* rstd; int dbg;
    __device__ __forceinline__ void operator()(const f32x4 (&acc)[2][2][4][2], const Unit& u, int wr, int wc, int fr, int fq) const {
        if (dbg) { float s = 0.f; _Pragma("unroll") for (int ai = 0; ai < 2; ++ai) _Pragma("unroll") for (int bj = 0; bj < 2; ++bj) _Pragma("unroll") for (int m = 0; m < 4; ++m) _Pragma("unroll") for (int n = 0; n < 2; ++n) s += acc[ai][bj][m][n][0] + acc[ai][bj][m][n][3]; asm volatile("" :: "v"(s)); return; }
        const int row0 = u.pm * BM + wr * 64 + fr, col0 = (u.pn & 3) * 128 + wc * 32 + 8 * fq;
        float rsv[2][4];
#pragma unroll
        for (int ai = 0; ai < 2; ++ai)
#pragma unroll
            for (int m = 0; m < 4; ++m) rsv[ai][m] = rstd[row0 + ai * HALF + m * 16];
#pragma unroll
        for (int ai = 0; ai < 2; ++ai)
#pragma unroll
            for (int m = 0; m < 4; ++m) { bf16_t* rowp = O + (size_t)(row0 + ai * HALF + m * 16) * 512 + col0; const float rs = rsv[ai][m];
                float o[8];
#pragma unroll
                for (int n = 0; n < 2; ++n)
#pragma unroll
                    for (int j = 0; j < 4; ++j) { const float g = acc[ai][0][m][n][j] * rs, up = acc[ai][1][m][n][j] * rs; o[4 * n + j] = g / (1.0f + __expf(-g)) * up; }
                u32x4 w; w.x = cvt_pk_bf16(o[0], o[1]); w.y = cvt_pk_bf16(o[2], o[3]); w.z = cvt_pk_bf16(o[4], o[5]); w.w = cvt_pk_bf16(o[6], o[7]);
                *(u32x4*)rowp = w; asm volatile("" ::: "memory"); }
    }
};
struct EpiDown {
    static constexpr bool PERM = true, AFTER_DRAIN = false;
    bf16_t* O; int dbg;
    __device__ __forceinline__ void operator()(const f32x4 (&acc)[2][2][4][2], const Unit& u, int wr, int wc, int fr, int fq) const {
        if (dbg) { float s = 0.f; _Pragma("unroll") for (int ai = 0; ai < 2; ++ai) _Pragma("unroll") for (int bj = 0; bj < 2; ++bj) _Pragma("unroll") for (int m = 0; m < 4; ++m) _Pragma("unroll") for (int n = 0; n < 2; ++n) s += acc[ai][bj][m][n][0] + acc[ai][bj][m][n][3]; asm volatile("" :: "v"(s)); return; }
        const int row0 = u.pm * BM + wr * 64 + fr, col0 = (u.pn & 7) * BM + wc * 32 + 8 * fq;
#pragma unroll
        for (int ai = 0; ai < 2; ++ai)
#pragma unroll
            for (int m = 0; m < 4; ++m) { bf16_t* rowp = O + (size_t)(row0 + ai * HALF + m * 16) * 2048 + col0;
#pragma unroll
                for (int bj = 0; bj < 2; ++bj) { const f32x4 v0 = acc[ai][bj][m][0], v1 = acc[ai][bj][m][1];
                    u32x4 w; w.x = cvt_pk_bf16(v0[0], v0[1]); w.y = cvt_pk_bf16(v0[2], v0[3]); w.z = cvt_pk_bf16(v1[0], v1[1]); w.w = cvt_pk_bf16(v1[2], v1[3]);
                    *(u32x4*)(rowp + bj * HALF) = w; } asm volatile("" ::: "memory"); }
    }
};
template <int NTN> struct GroupedOrder {
    static constexpr int ntn = NTN; int nunits, G, c; const PG8_LAS int* tile_e;
    __device__ __forceinline__ bool next(int i, Unit& u) const { const long L = (long)i * G + c; if (L >= nunits) return false; const int rt = (int)L / ntn, pl = (int)L % ntn; u.pm = rt; u.pn = tile_e[rt] * ntn + pl; return true; }
    __device__ __forceinline__ void a_ready(const Unit&) const {}
    __device__ __forceinline__ void done(const Unit&) const {}
};
template <class Epi, class Sched, bool STAMP = false, bool GATHER = false>
__device__ __forceinline__ void gemm_phase(PG8_LAS unsigned char* lds, const Gemm g, const Sched& S, const Epi& E, unsigned long long* stamps) {
    int tid_ = threadIdx.x; asm volatile("" : "+v"(tid_));
    const int tid = tid_, wid = __builtin_amdgcn_readfirstlane(tid >> 6), lane = tid & 63, wr = wid >> 2, wc = wid & 3, fr = lane & 15, fq = lane >> 4;
    const int K = g.K, nt = K / BK;
    int ts_lo = 0, ts_hi = 0, nts = 0; const unsigned long long rt_entry = STAMP ? (unsigned long long)wall_clock64() : 0ull;
#define PG8_STAMP() do { if (STAMP && wid == 0 && nts < 64) { const unsigned long long _c = (unsigned long long)clock64(); \
        ts_lo = (lane == nts) ? (int)(unsigned)_c : ts_lo; ts_hi = (lane == nts) ? (int)(unsigned)(_c >> 32) : ts_hi; ++nts; } } while (0)
    PG8_STAMP();
    unsigned voffA[2], voffB[2]; int gR[2]; unsigned gC[2];
#pragma unroll
    for (int i = 0; i < 2; ++i) { int R, C; stage_rc(tid * 16 + i * 8192, R, C); const int Rb = Epi::PERM ? ((R & ~31) + perm32(R & 31)) : R;
        voffA[i] = (unsigned)(R * K + C) * 2u; voffB[i] = (unsigned)(Rb * K + C) * 2u; gR[i] = R; gC[i] = (unsigned)C * 2u; }
    const size_t kstep = (size_t)(BK * 2);
    const size_t hstep = (size_t)HALF * K * 2;
    const size_t tstep = 2 * hstep;
    const unsigned ldsw = (unsigned)wid * 1024u;
    const int aoff = lds_byte(wr * 64 + fr, fq * 8), boff = lds_byte(wc * 32 + fr, fq * 8);
#define PG8_SA(b, h) (((b) * 2 + (h)) * HTB)
#define PG8_SB(b, h) ((4 + (b) * 2 + (h)) * HTB)
#define PG8_STAGE(bufoff, gbase, voff) do { _Pragma("unroll") for (int _i = 0; _i < 2; ++_i) \
        __builtin_amdgcn_global_load_lds((const unsigned*)((const char*)(gbase) + (voff)[_i]), (PG8_LAS unsigned*)(lds + (bufoff) + ldsw + _i * 8192), 16, 0, 0); } while (0)
#define PG8_LDA(dst, b, h) do { _Pragma("unroll") for (int m = 0; m < 4; ++m) _Pragma("unroll") for (int k = 0; k < 2; ++k) dst[m][k] = *(const PG8_LAS bf16x8*)(lds + PG8_SA(b, h) + aoff + m * 2048 + k * 1024); } while (0)
#define PG8_LDB(dst, b, h) do { _Pragma("unroll") for (int n = 0; n < 2; ++n) _Pragma("unroll") for (int k = 0; k < 2; ++k) dst[n][k] = *(const PG8_LAS bf16x8*)(lds + PG8_SB(b, h) + boff + n * 2048 + k * 1024); } while (0)
#define PG8_MMA(ai, bj, At, Bt) do { __builtin_amdgcn_s_setprio(1); _Pragma("unroll") for (int m = 0; m < 4; ++m) _Pragma("unroll") for (int n = 0; n < 2; ++n) _Pragma("unroll") for (int k = 0; k < 2; ++k) \
        acc[ai][bj][m][n] = __builtin_amdgcn_mfma_f32_16x16x32_bf16(Bt[n][k], At[m][k], acc[ai][bj][m][n], 0, 0, 0); __builtin_amdgcn_s_setprio(0); } while (0)
#define PG8_WAIT_V(n) asm volatile("s_waitcnt vmcnt(" #n ")" ::: "memory")
#define PG8_WAIT_L(n) asm volatile("s_waitcnt lgkmcnt(" #n ")" ::: "memory")
#define PG8_BAR __builtin_amdgcn_s_barrier()
#define PG8_SCHED __builtin_amdgcn_sched_barrier(0)
    Unit cur, nxt; int ui = 0;
    if (!S.next(0, cur)) return;
    f32x4 acc[2][2][4][2];
#pragma unroll
    for (int a = 0; a < 2; ++a)
#pragma unroll
        for (int b = 0; b < 2; ++b)
#pragma unroll
            for (int m = 0; m < 4; ++m)
#pragma unroll
                for (int n = 0; n < 2; ++n) acc[a][b][m][n] = (f32x4){0.f, 0.f, 0.f, 0.f};
    bf16x8 At[4][2], B0[2][2], B1[2][2];
    const char* cA = (const char*)g.A + (size_t)cur.pm * tstep; const char* cB = (const char*)g.Bt + (size_t)cur.pn * tstep;
    const char* gA = (const char*)g.A; unsigned voC[2][2], voN[2][2];
#define PG8_GATH(vo, u) do { _Pragma("unroll") for (int _h = 0; _h < 2; ++_h) _Pragma("unroll") for (int _i = 0; _i < 2; ++_i) \
        vo[_h][_i] = (unsigned)g.amap[(u).pm * BM + _h * HALF + gR[_i]] * (unsigned)(K * 2) + gC[_i]; } while (0)
    if constexpr (GATHER) { PG8_GATH(voC, cur); }
    S.a_ready(cur);
    PG8_STAGE(PG8_SB(0, 0), cB, voffB); if constexpr (GATHER) PG8_STAGE(PG8_SA(0, 0), gA, voC[0]); else PG8_STAGE(PG8_SA(0, 0), cA, voffA);
    PG8_STAGE(PG8_SB(0, 1), cB + hstep, voffB); if constexpr (GATHER) PG8_STAGE(PG8_SA(0, 1), gA, voC[1]); else PG8_STAGE(PG8_SA(0, 1), cA + hstep, voffA);
    if (wr == 1) PG8_BAR;
    PG8_WAIT_V(4); PG8_BAR;
    PG8_STAGE(PG8_SB(1, 0), cB + kstep, voffB); if constexpr (GATHER) PG8_STAGE(PG8_SA(1, 0), gA + kstep, voC[0]); else PG8_STAGE(PG8_SA(1, 0), cA + kstep, voffA);
    PG8_STAGE(PG8_SB(1, 1), cB + hstep + kstep, voffB);
    PG8_WAIT_V(6); PG8_BAR;
    PG8_STAMP();
    for (;;) {
        const bool has_next = S.next(ui + 1, nxt);
        if constexpr (GATHER) { if (has_next) { PG8_GATH(voN, nxt); } else { _Pragma("unroll") for (int _h = 0; _h < 2; ++_h) _Pragma("unroll") for (int _i = 0; _i < 2; ++_i) voN[_h][_i] = voC[_h][_i]; } }
        const char* nA = has_next ? (const char*)g.A + (size_t)nxt.pm * tstep : cA; const char* nB = has_next ? (const char*)g.Bt + (size_t)nxt.pn * tstep : cB;
        for (int t = 0; t < nt; t += 2) {
            const bool last = (t == nt - 2);
            const char* a1 = cA + (size_t)(t + 1) * kstep;
            const char* a2 = last ? nA : cA + (size_t)(t + 2) * kstep; const char* b2 = last ? nB : cB + (size_t)(t + 2) * kstep;
            const char* a3 = a2 + kstep; const char* b3 = b2 + kstep;
            const char* g1 = gA + (size_t)(t + 1) * kstep; const char* g2 = last ? gA : gA + (size_t)(t + 2) * kstep; const char* g3 = g2 + kstep; unsigned v2[2][2];
            if constexpr (GATHER) { _Pragma("unroll") for (int _h = 0; _h < 2; ++_h) _Pragma("unroll") for (int _i = 0; _i < 2; ++_i) v2[_h][_i] = last ? voN[_h][_i] : voC[_h][_i]; }
            if (last && has_next) S.a_ready(nxt);
            PG8_LDB(B0, 0, 0); PG8_SCHED; PG8_LDA(At, 0, 0); if constexpr (GATHER) PG8_STAGE(PG8_SA(1, 1), g1, voC[1]); else PG8_STAGE(PG8_SA(1, 1), a1 + hstep, voffA);
            PG8_WAIT_L(8); PG8_BAR; PG8_WAIT_L(0); PG8_MMA(0, 0, At, B0); PG8_BAR; PG8_SCHED;
            PG8_LDB(B1, 0, 1); PG8_STAGE(PG8_SB(0, 0), b2, voffB);
            PG8_BAR; PG8_WAIT_L(0); PG8_MMA(0, 1, At, B1); PG8_BAR;
            PG8_LDA(At, 0, 1); if constexpr (GATHER) PG8_STAGE(PG8_SA(0, 0), g2, v2[0]); else PG8_STAGE(PG8_SA(0, 0), a2, voffA);
            PG8_BAR; PG8_WAIT_L(0); PG8_MMA(1, 0, At, B0); PG8_BAR; PG8_SCHED;
            PG8_STAGE(PG8_SB(0, 1), b2 + hstep, voffB);
            PG8_WAIT_V(6); PG8_BAR; PG8_MMA(1, 1, At, B1); PG8_BAR;
            PG8_LDB(B0, 1, 0); PG8_SCHED; PG8_LDA(At, 1, 0); if constexpr (GATHER) PG8_STAGE(PG8_SA(0, 1), g2, v2[1]); else PG8_STAGE(PG8_SA(0, 1), a2 + hstep, voffA);
            PG8_WAIT_L(8); PG8_BAR; PG8_WAIT_L(0); PG8_MMA(0, 0, At, B0); PG8_BAR; PG8_SCHED;
            PG8_LDB(B1, 1, 1); PG8_STAGE(PG8_SB(1, 0), b3, voffB);
            PG8_BAR; PG8_WAIT_L(0); PG8_MMA(0, 1, At, B1); PG8_BAR;
            PG8_LDA(At, 1, 1); if constexpr (GATHER) PG8_STAGE(PG8_SA(1, 0), g3, v2[0]); else PG8_STAGE(PG8_SA(1, 0), a3, voffA);
            PG8_BAR; PG8_WAIT_L(0); PG8_MMA(1, 0, At, B0); PG8_BAR; PG8_SCHED;
            PG8_STAGE(PG8_SB(1, 1), b3 + hstep, voffB);
            PG8_WAIT_V(6); PG8_BAR; PG8_MMA(1, 1, At, B1); PG8_BAR;
        }
        PG8_STAMP();
        if constexpr (!Epi::AFTER_DRAIN) { E(acc, cur, wr, wc, fr, fq); S.done(cur); }
        PG8_STAMP();
        if (!has_next) break;
#pragma unroll
        for (int a = 0; a < 2; ++a)
#pragma unroll
            for (int b = 0; b < 2; ++b)
#pragma unroll
                for (int m = 0; m < 4; ++m)
#pragma unroll
                    for (int n = 0; n < 2; ++n) acc[a][b][m][n] = (f32x4){0.f, 0.f, 0.f, 0.f};
        cur = nxt; cA = nA; cB = nB; ++ui;
        if constexpr (GATHER) { _Pragma("unroll") for (int _h = 0; _h < 2; ++_h) _Pragma("unroll") for (int _i = 0; _i < 2; ++_i) voC[_h][_i] = voN[_h][_i]; }
    }
    PG8_WAIT_V(0);
    if (wr == 0) PG8_BAR;
    PG8_BAR;
    if constexpr (Epi::AFTER_DRAIN) { E.fused(acc, cur, wr, wc, fr, fq, lds, wid, lane); S.done(cur); }
    PG8_STAMP();
    if (STAMP && wid == 0) { stamps[lane] = lane < nts ? (((unsigned long long)(unsigned)ts_hi << 32) | (unsigned)ts_lo) : 0ull;
        if (lane == 62) stamps[62] = rt_entry; if (lane == 63) stamps[63] = (unsigned long long)wall_clock64(); }
#undef PG8_STAMP
#undef PG8_SA
#undef PG8_SB
#undef PG8_STAGE
#undef PG8_GATH
#undef PG8_LDA
#undef PG8_LDB
#undef PG8_MMA
#undef PG8_WAIT_V
#undef PG8_WAIT_L
#undef PG8_BAR
#undef PG8_SCHED
}
}
#define XB_TMO      128
#define XB_XCNT(j)  (256  + 64 * (j))
#define XB_XSUB(j)  (1280 + 64 * (j))
#define XB_XGEN(j)  (2304 + 64 * (j))
#define XB_TOP      3328
#define XB_TOPGEN   3392
#define XCD_BAR_WORDS 3456
#define XB_SPIN_CAP (1u << 18)

__device__ __forceinline__ unsigned xb_ld(unsigned* p)              { return __hip_atomic_load(p, __ATOMIC_RELAXED, __HIP_MEMORY_SCOPE_AGENT); }
__device__ __forceinline__ unsigned xb_add(unsigned* p, unsigned v) { return __hip_atomic_fetch_add(p, v, __ATOMIC_RELAXED, __HIP_MEMORY_SCOPE_AGENT); }
__device__ __forceinline__ unsigned xb_xcc_id() { return (unsigned)__builtin_amdgcn_s_getreg((3 << 11) | 20) & 0xFu; }
#define XB_SPIN(cond, bar) do { unsigned _sp = 0; while (cond) { __builtin_amdgcn_s_sleep(1); \
    if ((++_sp & 255u) == 0u) { if (xb_ld(&(bar)[XB_TMO])) break; if (_sp > XB_SPIN_CAP) { atomicAdd(&(bar)[XB_TMO], 1u); break; } } } } while (0)

struct XcdBarrier {
    unsigned* bar; unsigned x;
    volatile LAS unsigned* st;
};

__device__ __forceinline__ XcdBarrier xcd_barrier_post(unsigned* bar, volatile LAS unsigned* st) {
    XcdBarrier b; b.bar = bar; b.x = xb_xcc_id(); b.st = st;
    if (threadIdx.x == 0) (void)xb_add(&bar[XB_XCNT(b.x)], 1u);
    return b;
}
__device__ __forceinline__ void xcd_barrier_complete(unsigned* bar, unsigned x, unsigned& nloc, unsigned& nx) {
    const unsigned G = gridDim.x * gridDim.y * gridDim.z;
    unsigned sum, cnt, mine, sp = 0u;
    for (;;) {
        sum = 0u; cnt = 0u; mine = 0u;
#pragma unroll
        for (unsigned j = 0; j < 16; ++j) { const unsigned c = xb_ld(&bar[XB_XCNT(j)]); sum += c; cnt += (c > 0u) ? 1u : 0u; mine = (j == x) ? c : mine; }
        if (sum == G) break;
        __builtin_amdgcn_s_sleep(1);
        if ((++sp & 255u) == 0u) { if (xb_ld(&bar[XB_TMO])) break; if (sp > XB_SPIN_CAP) { atomicAdd(&bar[XB_TMO], 1u); break; } }
    }
    nloc = mine > 0u ? mine : 1u; nx = cnt > 0u ? cnt : 1u;
}

__device__ __forceinline__ void xcd_barrier(const XcdBarrier& b) {
    asm volatile("s_waitcnt vmcnt(0)" ::: "memory");
    __syncthreads();
    if (threadIdx.x == 0) {
        unsigned* bar = b.bar;
        __builtin_amdgcn_s_waitcnt(0);
        unsigned nloc = b.st[0], nx = b.st[1];
        if (nloc == 0u) { xcd_barrier_complete(bar, b.x, nloc, nx); b.st[0] = nloc; b.st[1] = nx; }
        const unsigned old = xb_add(&bar[XB_XSUB(b.x)], 1u);
        const unsigned gen = old / nloc;
        if (old + 1u == (gen + 1u) * nloc) {
            __builtin_amdgcn_fence(__ATOMIC_RELEASE, "agent");
            asm volatile("s_waitcnt vmcnt(0)" ::: "memory");
            const unsigned og = xb_add(&bar[XB_TOP], 1u);
            const unsigned tg = og / nx;
            if (og + 1u == (tg + 1u) * nx) xb_add(&bar[XB_TOPGEN], 1u);
            else XB_SPIN(xb_ld(&bar[XB_TOPGEN]) == tg, bar);
            __builtin_amdgcn_fence(__ATOMIC_ACQUIRE, "agent");
            xb_add(&bar[XB_XGEN(b.x)], 1u);
            asm volatile("s_waitcnt vmcnt(0)" ::: "memory");
        } else {
            XB_SPIN(xb_ld(&bar[XB_XGEN(b.x)]) == gen, bar);
            __builtin_amdgcn_fence(__ATOMIC_ACQUIRE, "agent");
            asm volatile("s_waitcnt vmcnt(0)" ::: "memory");
        }
    }
    __syncthreads();
}
template <int LD> DI bf16x8 frag_n(const LAS bf16_t* A, int row0, int k0, int lane) {
    return *(const LAS bf16x8*)(A + (row0 + (lane & 15)) * LD + k0 + 8 * (lane >> 4));
}
template <int LD> DI bf16x8 frag_t(const LAS bf16_t* A, int row0, int k0, int lane) {
    const int l = lane & 15, g = lane >> 4;
    const unsigned addr = (unsigned)(uintptr_t)(A + (k0 + 8 * g + (l >> 2)) * LD + row0 + 4 * (l & 3));
    s16x4 lo, hi;
    asm volatile("ds_read_b64_tr_b16 %0, %2\n\tds_read_b64_tr_b16 %1, %2 offset:%3\n\ts_waitcnt lgkmcnt(0)" : "=&v"(lo), "=&v"(hi) : "v"(addr), "n"(4 * LD * 2) : "memory");
    bf16x8 r; r[0] = lo[0]; r[1] = lo[1]; r[2] = lo[2]; r[3] = lo[3]; r[4] = hi[0]; r[5] = hi[1]; r[6] = hi[2]; r[7] = hi[3];
    return r;
}
DI bf16x8 gfrag(const bf16_t* A, int ld, int row0, int k0, int lane) {
    return *(const bf16x8*)(A + (size_t)(row0 + (lane & 15)) * ld + k0 + 8 * (lane >> 4));
}
#define MFMA16(a, b, c) __builtin_amdgcn_mfma_f32_16x16x32_bf16((a), (b), (c), 0, 0, 0)
template <bool XT, bool YT, int KS, int LDX, int LDY>
DI f32x4 mm16(const LAS bf16_t* X, const LAS bf16_t* Y, int p0, int q0, int lane, f32x4 acc) {
#pragma unroll
    for (int ks = 0; ks < KS; ++ks) {
        const bf16x8 xb = XT ? frag_t<LDX>(X, p0, 32 * ks, lane) : frag_n<LDX>(X, p0, 32 * ks, lane);
        const bf16x8 ya = YT ? frag_t<LDY>(Y, q0, 32 * ks, lane) : frag_n<LDY>(Y, q0, 32 * ks, lane);
        acc = MFMA16(ya, xb, acc);
    }
    return acc;
}
DI void st4_bf16(LAS bf16_t* p, const f32x4 v) { *(LAS u32x2*)p = pack4(v[0], v[1], v[2], v[3]); }
DI f32x4 ld4_bf16(const LAS bf16_t* p) { const u32x2 w = *(const LAS u32x2*)p; float f[4]; unpack4(w, f); return (f32x4){f[0], f[1], f[2], f[3]}; }
constexpr f32x4 F4Z = {0.f, 0.f, 0.f, 0.f};

struct TrFrag { s16x4 lo, hi; };
template <int LD> DI void tr_issue(TrFrag& f, const LAS bf16_t* A, int row0, int k0, int lane) {
    const int l = lane & 15, g = lane >> 4;
    const unsigned addr = (unsigned)(uintptr_t)(A + (k0 + 8 * g + (l >> 2)) * LD + row0 + 4 * (l & 3));
    asm volatile("ds_read_b64_tr_b16 %0, %2\n\tds_read_b64_tr_b16 %1, %2 offset:%3" : "=&v"(f.lo), "=&v"(f.hi) : "v"(addr), "n"(4 * LD * 2) : "memory");
}
DI bf16x8 tr_get(const TrFrag& f) { bf16x8 r; r[0] = f.lo[0]; r[1] = f.lo[1]; r[2] = f.lo[2]; r[3] = f.lo[3]; r[4] = f.hi[0]; r[5] = f.hi[1]; r[6] = f.hi[2]; r[7] = f.hi[3]; return r; }
template <int LD> DI void tr_issue4(TrFrag (&f)[2][2], const LAS bf16_t* A, int r0, int lane) {
    tr_issue<LD>(f[0][0], A, r0, 0, lane); tr_issue<LD>(f[0][1], A, r0, 32, lane); tr_issue<LD>(f[1][0], A, r0 + 16, 0, lane); tr_issue<LD>(f[1][1], A, r0 + 16, 32, lane); }
template <int LD> DI void tr_issue2(TrFrag (&f)[2], const LAS bf16_t* A, int r0, int lane) { tr_issue<LD>(f[0], A, r0, 0, lane); tr_issue<LD>(f[1], A, r0, 32, lane); }
#define TRW(f) "+v"((f).lo), "+v"((f).hi)
DI void tr_wait4(TrFrag (&a)[2][2]) { asm volatile("s_waitcnt lgkmcnt(0)" : TRW(a[0][0]), TRW(a[0][1]), TRW(a[1][0]), TRW(a[1][1]) :: "memory"); }
DI void tr_wait8(TrFrag (&a)[2][2], TrFrag (&b)[2][2]) { asm volatile("s_waitcnt lgkmcnt(0)" : TRW(a[0][0]), TRW(a[0][1]), TRW(a[1][0]), TRW(a[1][1]), TRW(b[0][0]), TRW(b[0][1]), TRW(b[1][0]), TRW(b[1][1]) :: "memory"); }
DI void tr_wait2(TrFrag (&a)[2]) { asm volatile("s_waitcnt lgkmcnt(0)" : TRW(a[0]), TRW(a[1]) :: "memory"); }
DI void tr_wait42(TrFrag (&a)[2][2], TrFrag (&b)[2]) { asm volatile("s_waitcnt lgkmcnt(0)" : TRW(a[0][0]), TRW(a[0][1]), TRW(a[1][0]), TRW(a[1][1]), TRW(b[0]), TRW(b[1]) :: "memory"); }
DI f32x4 mma2(const bf16x8 x0, const bf16x8 x1, const bf16x8 y0, const bf16x8 y1, f32x4 acc) { acc = MFMA16(y0, x0, acc); return MFMA16(y1, x1, acc); }
struct Params { const float* in[31]; float* out; unsigned char* ws; int ph_lo, ph_hi; };
#define CAS __attribute__((address_space(4)))
typedef const CAS Params& PR;
enum { I_X = 0, I_NMIX, I_WIN, I_LBRAW, I_ONORM, I_MU, I_W0, I_WUP, I_A0, I_AUP, I_GUP, I_KK, I_KA, I_RK, I_LNW, I_LNB, I_V0, I_VDOWN, I_VUP, I_WBH, I_WBR, I_WOUT, I_NFFN,
       I_RGW, I_RGB, I_REW, I_REB, I_EWG, I_EWU, I_EWD, I_FNW };
struct Ctx { LAS unsigned char* lds; int tid, lane, wave, G, bid; };

struct TItem { const float* W; bf16_t* WT; int ldw, ldt; };
DI void titem_load(const TItem& t, f32x4 (&v)[8], int lane) {
#pragma unroll
    for (int i = 0; i < 8; ++i) v[i] = __builtin_nontemporal_load((const f32x4*)(t.W + (size_t)(8 * i + (lane >> 3)) * t.ldw + 4 * (lane & 7)));
}
DI void titem_store(const TItem& t, const f32x4 (&v)[8], LAS float* scr, int lane) {
#pragma unroll
    for (int i = 0; i < 8; ++i) { LAS float* d = scr + (8 * i + (lane >> 3)) * 33 + 4 * (lane & 7); d[0] = v[i].x; d[1] = v[i].y; d[2] = v[i].z; d[3] = v[i].w; }
    asm volatile("s_waitcnt lgkmcnt(0)" ::: "memory");
    const int c = lane & 7;
#pragma unroll
    for (int j = 0; j < 4; ++j) { const int n = (lane >> 3) + 8 * j; const LAS float* s = scr + (8 * c) * 33 + n;
        u32x4 o; o.x = cvt_pk(s[0 * 33], s[1 * 33]); o.y = cvt_pk(s[2 * 33], s[3 * 33]); o.z = cvt_pk(s[4 * 33], s[5 * 33]); o.w = cvt_pk(s[6 * 33], s[7 * 33]);
        *(u32x4*)(t.WT + (size_t)n * t.ldt + 8 * c) = o; }
    asm volatile("s_waitcnt lgkmcnt(0)" ::: "memory");
}
DI TItem mk_titem(const float* W, int ldw, int k0, int n0, bf16_t* WT, int ldt, int drow0) { TItem t; t.W = W + (size_t)k0 * ldw + n0; t.WT = WT + (size_t)drow0 * ldt + k0; t.ldw = ldw; t.ldt = ldt; return t; }
DI TItem small_item(PR p, int l, int it) {
    unsigned char* ws = p.ws;
    constexpr int I_IN = 32 * 361, I_B = 16 * 64;
    int r = it;
    if (r < I_IN) return mk_titem(p.in[I_WIN] + (size_t)l * D * IN_WIDTH, IN_WIDTH, 64 * (r / 361), 32 * (r % 361), (bf16_t*)(ws + WS_WIN), D, 32 * (r % 361)); r -= I_IN;
    if (r < I_B) return mk_titem(p.in[I_WBH] + (size_t)l * 1024 * D, D, 64 * (r / 64), 32 * (r % 64), (bf16_t*)(ws + WS_WBH), 1024, 32 * (r % 64)); r -= I_B;
    if (r < I_B) return mk_titem(p.in[I_WBR] + (size_t)l * 1024 * D, D, 64 * (r / 64), 32 * (r % 64), (bf16_t*)(ws + WS_WBR), 1024, 32 * (r % 64)); r -= I_B;
    return mk_titem(p.in[I_WOUT] + (size_t)l * D * D, D, 64 * (r / 64), 32 * (r % 64), (bf16_t*)(ws + WS_WO), D, 32 * (r % 64));
}
DI TItem expert_item(PR p, int l, int it) {
    unsigned char* ws = p.ws;
    constexpr int PER_GU = 32 * 16, PER_D = 8 * 64;
    const int e = it / (2 * PER_GU + PER_D); int r = it % (2 * PER_GU + PER_D);
    if (r < 2 * PER_GU) { const int up = r >= PER_GU; if (up) r -= PER_GU; const int kb = r / 16, nb = r % 16, j0 = 32 * nb;
        return mk_titem((up ? p.in[I_EWU] : p.in[I_EWG]) + ((size_t)l * NEXP + e) * D * DEXP, DEXP, 64 * kb, j0, (bf16_t*)(ws + WS_WGU) + (size_t)e * 1024 * D, D, 256 * (j0 >> 7) + (j0 & 127) + (up ? 128 : 0)); }
    r -= 2 * PER_GU; const int kb = r / 64, nb = r % 64;
    return mk_titem(p.in[I_EWD] + ((size_t)l * NEXP + e) * DEXP * D, D, 64 * kb, 32 * nb, (bf16_t*)(ws + WS_WDN) + (size_t)e * D * DEXP, DEXP, 32 * nb);
}
template <bool EXPERT> DI void run_titems(PR p, const Ctx& c, int l, int lo, int hi, int wg0, int nwg) {
    LAS float* scr = (LAS float*)(c.lds + c.wave * 8448);
    const int gw = (c.bid - wg0) * 8 + c.wave, NGW = nwg * 8;
    for (int it = lo + gw; it < hi; it += 2 * NGW) {
        const int it2 = it + NGW; const bool has2 = it2 < hi;
        const TItem a = EXPERT ? expert_item(p, l, it) : small_item(p, l, it), b = EXPERT ? expert_item(p, l, has2 ? it2 : it) : small_item(p, l, has2 ? it2 : it);
        f32x4 va[8], vb[8]; titem_load(a, va, c.lane); titem_load(b, vb, c.lane);
        titem_store(a, va, scr, c.lane); if (has2) titem_store(b, vb, scr, c.lane);
    }
}
constexpr int SMALL_ITEMS = 32 * 361 + 2 * 16 * 64 + 32 * 64;
DI void convert_small(PR p, const Ctx& c, int l, int lo) {
    unsigned char* ws = p.ws;
    const int gw = c.bid * 8 + c.wave, NGW = c.G * 8;
    bf16_t* WIN = (bf16_t*)(ws + WS_WIN);
    const float* w_in = p.in[I_WIN] + (size_t)l * D * IN_WIDTH;
    run_titems<false>(p, c, l, lo, SMALL_ITEMS, 0, c.G);
    const int gt = c.bid * 512 + c.tid, NT = c.G * 512;
    bf16_t* WUPT = (bf16_t*)(ws + WS_LORA + LO_WUP); bf16_t* AUPT = (bf16_t*)(ws + WS_LORA + LO_AUP); bf16_t* GUPT = (bf16_t*)(ws + WS_LORA + LO_GUP); bf16_t* VUPT = (bf16_t*)(ws + WS_LORA + LO_VUP);
    bf16_t* WRH = (bf16_t*)(ws + WS_LORA + LO_WR); bf16_t* WRL = (bf16_t*)(ws + WS_LORA + LO_WRL);
    const float* wup = p.in[I_WUP] + (size_t)l * 64 * 1024; const float* aup = p.in[I_AUP] + (size_t)l * 64 * 1024; const float* gup = p.in[I_GUP] + (size_t)l * 160 * 1024;
    for (int i = gt; i < 1024 * 64; i += NT) { const int n = i >> 6, k = i & 63; WUPT[i] = (bf16_t)(cvt_pk(wup[k * 1024 + n], 0.f) & 0xffff); AUPT[i] = (bf16_t)(cvt_pk(aup[k * 1024 + n], 0.f) & 0xffff); }
    for (int i = gt; i < 1024 * 160; i += NT) { const int n = i / 160, k = i % 160; GUPT[i] = (bf16_t)(cvt_pk(gup[k * 1024 + n], 0.f) & 0xffff); }
    if (l == 1) { const float* vup = p.in[I_VUP]; for (int i = gt; i < 1024 * 32; i += NT) { const int n = i >> 5, k = i & 31; VUPT[i] = (bf16_t)(cvt_pk(vup[k * 1024 + n], 0.f) & 0xffff); } }
    const float* rgw = p.in[I_RGW] + (size_t)l * D * 4; const float* rew = p.in[I_REW] + (size_t)l * D * 32;
    for (int i = gt; i < 48 * 2048; i += NT) { const int cc = i >> 11, k = i & 2047; const float v = cc < 4 ? rgw[k * 4 + cc] : (cc < 36 ? rew[k * 32 + (cc - 4)] : 0.f);
        const unsigned hb = cvt_pk(v, 0.f) & 0xffffu; WRH[i] = (bf16_t)hb; WRL[i] = (bf16_t)(cvt_pk(v - __uint_as_float(hb << 16), 0.f) & 0xffffu); }
    if (l == 1) {
        const float* mu = p.in[I_MU] + 3360 + 2048; const float* vd = p.in[I_VDOWN];
        for (int k = gw; k < D; k += NGW) {
            float wv[16], wm[16];
#pragma unroll
            for (int j = 0; j < 16; ++j) { const int cc = c.lane + 64 * j; const float w = w_in[(size_t)k * IN_WIDTH + 6144 + cc], m = mu[cc]; wv[j] = w * (1.f - m); wm[j] = w * m; }
            float ra = 0.f, rb = 0.f;
            for (int n = 0; n < 32; ++n) { float sa = 0.f, sb = 0.f;
#pragma unroll
                for (int j = 0; j < 16; ++j) { const float v = vd[(size_t)(c.lane + 64 * j) * 32 + n]; sa += wv[j] * v; sb += wm[j] * v; }
                sa = wave_sum(sa); sb = wave_sum(sb); if (c.lane == n) { ra = sa; rb = sb; } }
            if (c.lane < 32) { WIN[(size_t)(ZC_VDA + c.lane) * D + k] = (bf16_t)(cvt_pk(ra, 0.f) & 0xffff); WIN[(size_t)(ZC_VDB + c.lane) * D + k] = (bf16_t)(cvt_pk(rb, 0.f) & 0xffff); }
        }
    }
}
constexpr int EXP_ITEMS = NEXP * (2 * 32 * 16 + 8 * 64);
#ifndef EXP_EARLY
#define EXP_EARLY 36864
#endif
DI void convert_experts_early(PR p, const Ctx& c, int l, int wg0, int nwg) { run_titems<true>(p, c, l, 0, EXP_EARLY, wg0, nwg); }
DI void convert_experts(PR p, const Ctx& c, int l, int lo) { run_titems<true>(p, c, l, lo, EXP_ITEMS, 0, c.G); }
DI void rms_row_bf16(const float* xrow, const float* w, bf16_t* orow, int lane) {
    const f32x4* xr = (const f32x4*)xrow + lane; const f32x4* wr = (const f32x4*)w + lane; f32x4 v[8], ww[8]; float s = 0.f;
#pragma unroll
    for (int j = 0; j < 8; ++j) { v[j] = xr[64 * j]; ww[j] = wr[64 * j]; }
#pragma unroll
    for (int j = 0; j < 8; ++j) s += (v[j].x * v[j].x + v[j].y * v[j].y) + (v[j].z * v[j].z + v[j].w * v[j].w);
    const float rstd = rsqrtf(wave_sum(s) * (1.f / D) + NORM_EPS);
    u32x2* o8 = (u32x2*)orow + lane;
#pragma unroll
    for (int j = 0; j < 8; ++j) o8[64 * j] = pack4(v[j].x * rstd * ww[j].x, v[j].y * rstd * ww[j].y, v[j].z * rstd * ww[j].z, v[j].w * rstd * ww[j].w);
}
constexpr int RL = 72;
constexpr int R_SLOT = 64 * RL * 2;
constexpr int R_EXTRA = 12 * R_SLOT;
constexpr int FL = 68;
#define RSLOT(i) ((LAS bf16_t*)(c.lds + (i) * R_SLOT))
struct R1In { u32x4 cur[5], prv[5]; };
DI R1In r1_load(const unsigned char* ws, int task, int tid) {
    R1In in;
    const int bh = task >> 5, ch = task & 31, b = bh >> 4, h = bh & 15, tok0 = ch * 64, m0 = b * TSEQ + tok0, t = tid >> 3, cg = tid & 7, ch0 = 64 * h + 8 * cg;
    const bf16_t* zr = (const bf16_t*)(ws + WS_Z) + (size_t)(m0 + t) * NZ; const bf16_t* zp = (tok0 + t) > 0 ? zr - NZ : zr;
    in.cur[0] = *(const u32x4*)(zr + ZC_R + ch0); in.prv[0] = *(const u32x4*)(zp + ZC_R + ch0); in.cur[1] = *(const u32x4*)(zr + ZC_K + ch0); in.prv[1] = *(const u32x4*)(zp + ZC_K + ch0);
    in.cur[2] = *(const u32x4*)(zr + ZC_V + ch0); in.prv[2] = *(const u32x4*)(zp + ZC_V + ch0); in.cur[3] = *(const u32x4*)(zr + ZC_WD + 8 * cg); in.prv[3] = *(const u32x4*)(zp + ZC_WD + 8 * cg);
    in.cur[4] = *(const u32x4*)(zr + ZC_AD + 8 * cg); in.prv[4] = *(const u32x4*)(zp + ZC_AD + 8 * cg);
    return in;
}
template <int PROF> DI R1In r1_task(PR p, const Ctx& c0, int l, int task, const R1In in, int next_task) {
    R1In nin;
#define SEC(b) (!(PROF & (b)))
#define GST(T, addr, val) do { const T v_ = (val); if (SEC(1)) *(T*)(addr) = v_; else asm volatile("" :: "v"(v_)); } while (0)
    Ctx c = c0; { int t_ = c0.tid; asm volatile("" : "+v"(t_)); c.tid = t_; c.lane = t_ & 63; unsigned lb_ = (unsigned)(uintptr_t)c0.lds; asm volatile("" : "+s"(lb_)); c.lds = (LAS unsigned char*)(uintptr_t)lb_; }
    unsigned char* ws = p.ws;
    const int bh = task >> 5, ch = task & 31, b = bh >> 4, h = bh & 15, tok0 = ch * 64, m0 = b * TSEQ + tok0;
    const int tid = c.tid, lane = c.lane, w = c.wave;
    const bf16_t* Z = (const bf16_t*)(ws + WS_Z);
    const int t = tid >> 3, cg = tid & 7, ch0 = 64 * h + 8 * cg;
    LAS float* LW = (LAS float*)(c.lds + R_EXTRA); LAS float* LA = LW + 64 * FL; LAS float* SEG = LA + 64 * FL;
    LAS float* LV = (LAS float*)(c.lds + 1 * R_SLOT);
    float r[8], k[8], v[8];
    const f32x4 w0A = *(const f32x4*)(p.in[I_W0] + l * 1024 + ch0), w0B = *(const f32x4*)(p.in[I_W0] + l * 1024 + ch0 + 4);
    const f32x4 a0A = *(const f32x4*)(p.in[I_A0] + l * 1024 + ch0), a0B = *(const f32x4*)(p.in[I_A0] + l * 1024 + ch0 + 4);
    const f32x4 kkA = *(const f32x4*)(p.in[I_KK] + l * 1024 + ch0), kkB = *(const f32x4*)(p.in[I_KK] + l * 1024 + ch0 + 4);
    const f32x4 kaA = *(const f32x4*)(p.in[I_KA] + l * 1024 + ch0), kaB = *(const f32x4*)(p.in[I_KA] + l * 1024 + ch0 + 4);
    const f32x4 rkA = *(const f32x4*)(p.in[I_RK] + l * 1024 + ch0), rkB = *(const f32x4*)(p.in[I_RK] + l * 1024 + ch0 + 4);
    if (!SEC(2)) {
#pragma unroll
        for (int j = 0; j < 8; ++j) { r[j] = 0.5f + 1e-3f * tid; k[j] = 0.25f + 1e-3f * lane; v[j] = 0.1f * w + 0.01f * j; } }
    if (SEC(2))
    {
        const bf16_t* zr = Z + (size_t)(m0 + t) * NZ; const bool has_prev = (tok0 + t) > 0; const bf16_t* zp = zr - NZ;
        const float* mu = p.in[I_MU] + (size_t)l * 3360;
        float cur[8], prv[8], wd[8], ad[8];
#define LERP_IN(dst, idx, mucol) do { unpack8(in.cur[idx], cur); if (has_prev) unpack8(in.prv[idx], prv); else { _Pragma("unroll") for (int j = 0; j < 8; ++j) prv[j] = 0.f; } \
            const f32x4 mA = *(const f32x4*)(mu + (mucol)), mB = *(const f32x4*)(mu + (mucol) + 4); const float mm[8] = {mA.x, mA.y, mA.z, mA.w, mB.x, mB.y, mB.z, mB.w}; \
            _Pragma("unroll") for (int j = 0; j < 8; ++j) dst[j] = cur[j] + mm[j] * (prv[j] - cur[j]); } while (0)
        LERP_IN(r, 0, ch0); LERP_IN(k, 1, 1024 + ch0); LERP_IN(v, 2, 2048 + ch0);
        LERP_IN(wd, 3, 3072 + 8 * cg); LERP_IN(ad, 4, 3136 + 8 * cg);
#pragma unroll
        for (int j = 0; j < 8; ++j) wd[j] = 1.0f - 2.0f / (1.0f + __expf(2.0f * wd[j]));
        *(LAS u32x4*)(RSLOT(7) + t * RL + 8 * cg) = pack8(wd);
        *(LAS u32x4*)(RSLOT(8) + t * RL + 8 * cg) = pack8(ad);
        const bf16_t* WUPT = (const bf16_t*)(ws + WS_LORA + LO_WUP) + (size_t)(64 * h) * 64; const bf16_t* AUPT = (const bf16_t*)(ws + WS_LORA + LO_AUP) + (size_t)(64 * h) * 64;
        *(LAS u32x4*)(RSLOT(9) + t * RL + 8 * cg) = *(const u32x4*)(WUPT + t * 64 + 8 * cg);
        *(LAS u32x4*)(RSLOT(10) + t * RL + 8 * cg) = *(const u32x4*)(AUPT + t * 64 + 8 * cg);
        if (l == 1) {
            if (cg < 4) { float a8[8], b8[8]; unpack8(*(const u32x4*)(zr + ZC_VDA + 8 * cg), a8); if (has_prev) unpack8(*(const u32x4*)(zp + ZC_VDB + 8 * cg), b8); else {
#pragma unroll
                    for (int j = 0; j < 8; ++j) b8[j] = 0.f; }
#pragma unroll
                for (int j = 0; j < 8; ++j) a8[j] += b8[j];
                *(LAS u32x4*)(RSLOT(11) + t * 40 + 8 * cg) = pack8(a8);
                const bf16_t* VUPT = (const bf16_t*)(ws + WS_LORA + LO_VUP) + (size_t)(64 * h) * 32;
                *(LAS u32x4*)(RSLOT(0) + t * 40 + 8 * cg) = *(const u32x4*)(VUPT + t * 32 + 8 * cg); }
        }
    }
    lds_barrier();
    const int pt = w >> 1, qb = 2 * (w & 1), fr = lane & 15, fq = lane >> 4;
    if (SEC(4)) {
#pragma unroll
        for (int i = 0; i < 2; ++i) { const int qt = qb + i;
            const f32x4 aw = mm16<false, false, 2, RL, RL>(RSLOT(7), RSLOT(9), 16 * pt, 16 * qt, lane, F4Z);
            const f32x4 aa = mm16<false, false, 2, RL, RL>(RSLOT(8), RSLOT(10), 16 * pt, 16 * qt, lane, F4Z);
            *(LAS f32x4*)(LW + (16 * pt + fr) * FL + 16 * qt + 4 * fq) = aw; *(LAS f32x4*)(LA + (16 * pt + fr) * FL + 16 * qt + 4 * fq) = aa;
            if (l == 1) { const f32x4 av = mm16<false, false, 1, 40, 40>(RSLOT(11), RSLOT(0), 16 * pt, 16 * qt, lane, F4Z); *(LAS f32x4*)(LV + (16 * pt + fr) * FL + 16 * qt + 4 * fq) = av; }
        }
    }
    lds_barrier();
    float lw[8], a[8], kk[8], kp[8];
    {
        const float w0[8] = {w0A.x, w0A.y, w0A.z, w0A.w, w0B.x, w0B.y, w0B.z, w0B.w}, a0[8] = {a0A.x, a0A.y, a0A.z, a0A.w, a0B.x, a0B.y, a0B.z, a0B.w};
        const float k_k[8] = {kkA.x, kkA.y, kkA.z, kkA.w, kkB.x, kkB.y, kkB.z, kkB.w}, k_a[8] = {kaA.x, kaA.y, kaA.z, kaA.w, kaB.x, kaB.y, kaB.z, kaB.w};
        const float r_k[8] = {rkA.x, rkA.y, rkA.z, rkA.w, rkB.x, rkB.y, rkB.z, rkB.w};
        const f32x4 lwA = *(const LAS f32x4*)(LW + t * FL + 8 * cg), lwB = *(const LAS f32x4*)(LW + t * FL + 8 * cg + 4);
        const f32x4 laA = *(const LAS f32x4*)(LA + t * FL + 8 * cg), laB = *(const LAS f32x4*)(LA + t * FL + 8 * cg + 4);
        const float lwr[8] = {lwA.x, lwA.y, lwA.z, lwA.w, lwB.x, lwB.y, lwB.z, lwB.w}, lar[8] = {laA.x, laA.y, laA.z, laA.w, laB.x, laB.y, laB.z, laB.w};
        bf16_t* VFIRST = (bf16_t*)(ws + WS_VFIRST) + (size_t)(m0 + t) * 1024 + ch0;
        if (l == 1) {
            const f32x4 lvA = *(const LAS f32x4*)(LV + t * FL + 8 * cg), lvB = *(const LAS f32x4*)(LV + t * FL + 8 * cg + 4);
            const float lvr[8] = {lvA.x, lvA.y, lvA.z, lvA.w, lvB.x, lvB.y, lvB.z, lvB.w};
            const f32x4 v0A = *(const f32x4*)(p.in[I_V0] + ch0), v0B = *(const f32x4*)(p.in[I_V0] + ch0 + 4); const float v0[8] = {v0A.x, v0A.y, v0A.z, v0A.w, v0B.x, v0B.y, v0B.z, v0B.w};
            float vf[8]; unpack8(*(const u32x4*)VFIRST, vf);
#pragma unroll
            for (int j = 0; j < 8; ++j) v[j] = v[j] + (vf[j] - v[j]) * sigm(v0[j] + lvr[j]);
            GST(u32x4, (bf16_t*)(ws + WS_VF) + (size_t)(m0 + t) * 1024 + ch0, pack8(v));
        } else { GST(u32x4, VFIRST, pack8(v)); }
        float ss = 0.f, rks = 0.f;
#pragma unroll
        for (int j = 0; j < 8; ++j) { lw[j] = -0.60653066f * sigm(w0[j] + lwr[j]); a[j] = sigm(a0[j] + lar[j]); kk[j] = k[j] * k_k[j]; ss += kk[j] * kk[j];
            kp[j] = k[j] * (1.0f + (a[j] - 1.0f) * k_a[j]); rks += r[j] * kp[j] * r_k[j]; }
        ss += __shfl_xor(ss, 1); ss += __shfl_xor(ss, 2); ss += __shfl_xor(ss, 4);
        rks += __shfl_xor(rks, 1); rks += __shfl_xor(rks, 2); rks += __shfl_xor(rks, 4);
        const float inv = rsqrtf(fmaxf(ss, 1e-12f));
#pragma unroll
        for (int j = 0; j < 8; ++j) kk[j] *= inv;
        if (SEC(1) && cg == 0) ((float*)(ws + WS_RK))[(size_t)(m0 + t) * 16 + h] = rks;
    }
    nin = r1_load(ws, next_task, tid);
    lds_barrier();
    *(LAS f32x4*)(LW + t * FL + 8 * cg) = (f32x4){lw[0], lw[1], lw[2], lw[3]}; *(LAS f32x4*)(LW + t * FL + 8 * cg + 4) = (f32x4){lw[4], lw[5], lw[6], lw[7]};
    lds_barrier();
    if (SEC(8)) {
        const int j = tid & 63, sg = tid >> 6; float s = 0.f;
#pragma unroll
        for (int i = 0; i < 8; ++i) s += LW[(8 * sg + i) * FL + j];
        SEG[sg * 64 + j] = s;
        lds_barrier();
        float off = 0.f;
        for (int s2 = 0; s2 < sg; ++s2) off += SEG[s2 * 64 + j];
#pragma unroll
        for (int i = 0; i < 8; ++i) { off += LW[(8 * sg + i) * FL + j]; LW[(8 * sg + i) * FL + j] = off; }
    }
    lds_barrier();
    {
        const f32x4 cA = *(const LAS f32x4*)(LW + t * FL + 8 * cg), cB = *(const LAS f32x4*)(LW + t * FL + 8 * cg + 4);
        const f32x4 eA = *(const LAS f32x4*)(LW + 63 * FL + 8 * cg), eB = *(const LAS f32x4*)(LW + 63 * FL + 8 * cg + 4);
        const float cs[8] = {cA.x, cA.y, cA.z, cA.w, cB.x, cB.y, cB.z, cB.w}, ce[8] = {eA.x, eA.y, eA.z, eA.w, eB.x, eB.y, eB.z, eB.w};
        float Rt[8], At[8], Bt[8], Kt[8], Bp[8], Kp[8];
#pragma unroll
        for (int j = 0; j < 8; ++j) { const float ep = __expf(cs[j]), em = __expf(-cs[j]), el = __expf(ce[j] - cs[j]), ex = __expf(cs[j] - lw[j]); const float bv = kk[j] * a[j];
            Rt[j] = r[j] * ep; At[j] = -kk[j] * ex; Bt[j] = bv * em; Kt[j] = kp[j] * em; Bp[j] = bv * el; Kp[j] = kp[j] * el; }
        *(LAS u32x4*)(RSLOT(0) + t * RL + 8 * cg) = pack8(Rt); *(LAS u32x4*)(RSLOT(1) + t * RL + 8 * cg) = pack8(At); *(LAS u32x4*)(RSLOT(2) + t * RL + 8 * cg) = pack8(Bt);
        *(LAS u32x4*)(RSLOT(3) + t * RL + 8 * cg) = pack8(Kt); *(LAS u32x4*)(RSLOT(4) + t * RL + 8 * cg) = pack8(Bp); *(LAS u32x4*)(RSLOT(5) + t * RL + 8 * cg) = pack8(Kp);
        *(LAS u32x4*)(RSLOT(6) + t * RL + 8 * cg) = pack8(v);
    }
    lds_barrier();
    const int p0 = 16 * pt, prow = p0 + fr;
    if (SEC(16)) {
#pragma unroll
        for (int i = 0; i < 2; ++i) { const int q0 = 16 * (qb + i), qc = q0 + 4 * fq;
            f32x4 ab = mm16<false, false, 2, RL, RL>(RSLOT(1), RSLOT(2), p0, q0, lane, F4Z);
            f32x4 ak = mm16<false, false, 2, RL, RL>(RSLOT(1), RSLOT(3), p0, q0, lane, F4Z);
            f32x4 rb = mm16<false, false, 2, RL, RL>(RSLOT(0), RSLOT(2), p0, q0, lane, F4Z);
            f32x4 rk = mm16<false, false, 2, RL, RL>(RSLOT(0), RSLOT(3), p0, q0, lane, F4Z);
#pragma unroll
            for (int rr = 0; rr < 4; ++rr) { const int s = qc + rr; if (s >= prow) { ab[rr] = 0.f; ak[rr] = 0.f; } if (s > prow) { rb[rr] = 0.f; rk[rr] = 0.f; } }
            st4_bf16(RSLOT(7) + prow * RL + qc, ab); st4_bf16(RSLOT(9) + prow * RL + qc, ak); st4_bf16(RSLOT(10) + prow * RL + qc, rb); st4_bf16(RSLOT(11) + prow * RL + qc, rk); }
    }
    lds_barrier();
    const int qa = 16 * qb, qca = qa + 4 * fq, qcb = qca + 16;
    if (SEC(32)) {
        TrFrag yl[2][2]; tr_issue4<RL>(yl, RSLOT(7), qa, lane);
        const bf16x8 xl0 = frag_n<RL>(RSLOT(7), p0, 0, lane), xl1 = frag_n<RL>(RSLOT(7), p0, 32, lane);
        f32x4 t1a = ld4_bf16(RSLOT(7) + prow * RL + qca), t1b = ld4_bf16(RSLOT(7) + prow * RL + qcb);
        tr_wait4(yl);
        const f32x4 la = mma2(xl0, xl1, tr_get(yl[0][0]), tr_get(yl[0][1]), F4Z), lb = mma2(xl0, xl1, tr_get(yl[1][0]), tr_get(yl[1][1]), F4Z);
#pragma unroll
        for (int rr = 0; rr < 4; ++rr) { if (qca + rr == prow) t1a[rr] += 1.0f; if (qcb + rr == prow) t1b[rr] += 1.0f; }
        st4_bf16(RSLOT(8) + prow * RL + qca, la); st4_bf16(RSLOT(8) + prow * RL + qcb, lb); st4_bf16(RSLOT(2) + prow * RL + qca, t1a); st4_bf16(RSLOT(2) + prow * RL + qcb, t1b);
    }
    lds_barrier();
#define NSTEP(LS, LD_, TS, TD, SQ) do { TrFrag yl[2][2]; tr_issue4<RL>(yl, RSLOT(LS), qa, lane); \
        const bf16x8 xt0 = frag_n<RL>(RSLOT(TS), p0, 0, lane), xt1 = frag_n<RL>(RSLOT(TS), p0, 32, lane), xl0 = frag_n<RL>(RSLOT(LS), p0, 0, lane), xl1 = frag_n<RL>(RSLOT(LS), p0, 32, lane); \
        const f32x4 ta0 = ld4_bf16(RSLOT(TS) + prow * RL + qca), tb0 = ld4_bf16(RSLOT(TS) + prow * RL + qcb); \
        tr_wait4(yl); const bf16x8 y00 = tr_get(yl[0][0]), y01 = tr_get(yl[0][1]), y10 = tr_get(yl[1][0]), y11 = tr_get(yl[1][1]); \
        const f32x4 tna = mma2(xt0, xt1, y00, y01, ta0), tnb = mma2(xt0, xt1, y10, y11, tb0); \
        if (SQ) { const f32x4 la = mma2(xl0, xl1, y00, y01, F4Z), lb = mma2(xl0, xl1, y10, y11, F4Z); st4_bf16(RSLOT(LD_) + prow * RL + qca, la); st4_bf16(RSLOT(LD_) + prow * RL + qcb, lb); } \
        st4_bf16(RSLOT(TD) + prow * RL + qca, tna); st4_bf16(RSLOT(TD) + prow * RL + qcb, tnb); lds_barrier(); } while (0)
    if (SEC(32)) NSTEP(8, 7, 2, 3, 1);
    if (SEC(32)) NSTEP(7, 8, 3, 2, 1);
    if (SEC(32)) NSTEP(8, 7, 2, 3, 1);
    if (SEC(32)) NSTEP(7, 8, 3, 2, 1);
    if (SEC(32)) NSTEP(8, 7, 2, 3, 0);
#undef NSTEP
    if (SEC(64)) {
        TrFrag ya[2][2], yv[2][2]; tr_issue4<RL>(ya, RSLOT(1), qa, lane); tr_issue4<RL>(yv, RSLOT(6), qa, lane);
        const bf16x8 xt0 = frag_n<RL>(RSLOT(3), p0, 0, lane), xt1 = frag_n<RL>(RSLOT(3), p0, 32, lane), xk0 = frag_n<RL>(RSLOT(9), p0, 0, lane), xk1 = frag_n<RL>(RSLOT(9), p0, 32, lane);
        tr_wait8(ya, yv);
        const f32x4 pa = mma2(xt0, xt1, tr_get(ya[0][0]), tr_get(ya[0][1]), F4Z), pb2 = mma2(xt0, xt1, tr_get(ya[1][0]), tr_get(ya[1][1]), F4Z);
        const f32x4 ga = mma2(xk0, xk1, tr_get(yv[0][0]), tr_get(yv[0][1]), F4Z), gb = mma2(xk0, xk1, tr_get(yv[1][0]), tr_get(yv[1][1]), F4Z);
        st4_bf16(RSLOT(7) + prow * RL + qca, pa); st4_bf16(RSLOT(7) + prow * RL + qcb, pb2); st4_bf16(RSLOT(8) + prow * RL + qca, ga); st4_bf16(RSLOT(8) + prow * RL + qcb, gb);
    }
    lds_barrier();
    if (SEC(64)) {
        TrFrag yg[2][2]; tr_issue4<RL>(yg, RSLOT(8), qa, lane);
        const bf16x8 xt0 = frag_n<RL>(RSLOT(3), p0, 0, lane), xt1 = frag_n<RL>(RSLOT(3), p0, 32, lane);
        tr_wait4(yg);
        const f32x4 q0v = mma2(xt0, xt1, tr_get(yg[0][0]), tr_get(yg[0][1]), F4Z), q1v = mma2(xt0, xt1, tr_get(yg[1][0]), tr_get(yg[1][1]), F4Z);
        st4_bf16(RSLOT(9) + prow * RL + qca, q0v); st4_bf16(RSLOT(9) + prow * RL + qcb, q1v);
    }
    lds_barrier();
    if (SEC(64)) {
        const size_t blk = (size_t)task * 4096;
        const int pia = 16 * fq + 4 * qb, pib = pia + 4, mka = 32 * (qb >> 1) + 8 * fq, mkb = mka + 4;
        bf16_t* RP = (bf16_t*)(ws + WS_RP) + blk; bf16_t* Y0 = (bf16_t*)(ws + WS_Y0) + blk; bf16_t* MT = (bf16_t*)(ws + WS_MT) + blk; bf16_t* NN = (bf16_t*)(ws + WS_NN) + blk;
        {
            TrFrag yp[2][2], yq[2][2]; tr_issue4<RL>(yp, RSLOT(7), qa, lane); tr_issue4<RL>(yq, RSLOT(9), qa, lane);
            const bf16x8 xb0 = frag_n<RL>(RSLOT(10), p0, 0, lane), xb1 = frag_n<RL>(RSLOT(10), p0, 32, lane), xk0 = frag_n<RL>(RSLOT(11), p0, 0, lane), xk1 = frag_n<RL>(RSLOT(11), p0, 32, lane);
            const f32x4 r0a = ld4_bf16(RSLOT(0) + prow * RL + qca), r0b = ld4_bf16(RSLOT(0) + prow * RL + qcb);
            tr_wait8(yp, yq);
            const f32x4 rpa = mma2(xb0, xb1, tr_get(yp[0][0]), tr_get(yp[0][1]), r0a), rpb = mma2(xb0, xb1, tr_get(yp[1][0]), tr_get(yp[1][1]), r0b);
            f32x4 y0a = mma2(xb0, xb1, tr_get(yq[0][0]), tr_get(yq[0][1]), F4Z), y0b = mma2(xb0, xb1, tr_get(yq[1][0]), tr_get(yq[1][1]), F4Z);
            TrFrag yv[2][2]; tr_issue4<RL>(yv, RSLOT(6), qa, lane); tr_wait4(yv);
            y0a = mma2(xk0, xk1, tr_get(yv[0][0]), tr_get(yv[0][1]), y0a); y0b = mma2(xk0, xk1, tr_get(yv[1][0]), tr_get(yv[1][1]), y0b);
            GST(u32x2, RP + prow * 64 + pia, pack4(rpa[0], rpa[1], rpa[2], rpa[3])); GST(u32x2, RP + prow * 64 + pib, pack4(rpb[0], rpb[1], rpb[2], rpb[3]));
            GST(u32x2, Y0 + prow * 64 + qca, pack4(y0a[0], y0a[1], y0a[2], y0a[3])); GST(u32x2, Y0 + prow * 64 + qcb, pack4(y0b[0], y0b[1], y0b[2], y0b[3]));
        }
        {
            TrFrag xbp[2], yp[2][2]; tr_issue2<RL>(xbp, RSLOT(4), p0, lane); tr_issue4<RL>(yp, RSLOT(7), qa, lane); tr_wait42(yp, xbp);
            const bf16x8 xb0 = tr_get(xbp[0]), xb1 = tr_get(xbp[1]);
            f32x4 mta = mma2(xb0, xb1, tr_get(yp[0][0]), tr_get(yp[0][1]), F4Z), mtb = mma2(xb0, xb1, tr_get(yp[1][0]), tr_get(yp[1][1]), F4Z);
            const float dg = __expf(LW[63 * FL + prow]);
#pragma unroll
            for (int rr = 0; rr < 4; ++rr) { if (qca + rr == prow) mta[rr] += dg; if (qcb + rr == prow) mtb[rr] += dg; }
            GST(u32x2, MT + prow * 64 + mka, pack4(mta[0], mta[1], mta[2], mta[3])); GST(u32x2, MT + prow * 64 + mkb, pack4(mtb[0], mtb[1], mtb[2], mtb[3]));
            TrFrag xq[2], ybp[2][2]; tr_issue2<RL>(xq, RSLOT(9), p0, lane); tr_issue4<RL>(ybp, RSLOT(4), qa, lane); tr_wait42(ybp, xq);
            f32x4 nna = mma2(tr_get(xq[0]), tr_get(xq[1]), tr_get(ybp[0][0]), tr_get(ybp[0][1]), F4Z), nnb = mma2(tr_get(xq[0]), tr_get(xq[1]), tr_get(ybp[1][0]), tr_get(ybp[1][1]), F4Z);
            TrFrag xv[2], ykp[2][2]; tr_issue2<RL>(xv, RSLOT(6), p0, lane); tr_issue4<RL>(ykp, RSLOT(5), qa, lane); tr_wait42(ykp, xv);
            nna = mma2(tr_get(xv[0]), tr_get(xv[1]), tr_get(ykp[0][0]), tr_get(ykp[0][1]), nna); nnb = mma2(tr_get(xv[0]), tr_get(xv[1]), tr_get(ykp[1][0]), tr_get(ykp[1][1]), nnb);
            GST(u32x2, NN + prow * 64 + pia, pack4(nna[0], nna[1], nna[2], nna[3])); GST(u32x2, NN + prow * 64 + pib, pack4(nnb[0], nnb[1], nnb[2], nnb[3]));
        }
    }
    lds_barrier();
    return nin;
}
#undef SEC
#undef GST
constexpr int HL = 136, HCL = 132, SCL = 72, HC = 64;
constexpr int H_QT = 0, H_KT = HC * HL * 2  , H_KP = 2 * H_KT, H_V = 3 * H_KT, H_CS = 4 * H_KT  , H_SEG = H_CS + HC * HCL * 4  , H_SC = H_SEG + 4 * 128 * 4  ,
              H_NTS = H_CS;
DI float hg_lb(PR p, int l, int chn) { if (l == 0) return 0.f; const float* raw = p.in[I_LBRAW]; return sigm(raw[1024 + chn] - raw[chn]); }
struct H1In { u32x4 zq[2], zf[2], zi[2]; };
DI H1In h1_load(const unsigned char* ws, int task, int tid) {
    const int bh = task >> 5, ch = task & 31, b = bh >> 3, h = bh & 7, m0 = b * TSEQ + ch * HC, t0 = tid >> 4, cg = tid & 15, chn = 128 * h + 8 * cg;
    H1In in;
#pragma unroll
    for (int u = 0; u < 2; ++u) { const bf16_t* zr = (const bf16_t*)(ws + WS_Z) + (size_t)(m0 + t0 + 32 * u) * NZ;
        in.zq[u] = *(const u32x4*)(zr + ZC_Q + chn); in.zf[u] = *(const u32x4*)(zr + ZC_F + chn); in.zi[u] = *(const u32x4*)(zr + ZC_I + chn); }
    return in;
}
DI H1In h1_task(PR p, const Ctx& c0, int l, int task, const H1In in, int next_task) {
    Ctx c = c0; { int t_ = c0.tid; asm volatile("" : "+v"(t_)); c.tid = t_; c.lane = t_ & 63; unsigned lb_ = (unsigned)(uintptr_t)c0.lds; asm volatile("" : "+s"(lb_)); c.lds = (LAS unsigned char*)(uintptr_t)lb_; }
    unsigned char* ws = p.ws;
    const int bh = task >> 5, ch = task & 31, b = bh >> 3, h = bh & 7, m0 = b * TSEQ + ch * HC;
    const int tid = c.tid, lane = c.lane, w = c.wave, fr = lane & 15, fq = lane >> 4;
    const bf16_t* Z = (const bf16_t*)(ws + WS_Z);
    LAS bf16_t* QTs = (LAS bf16_t*)(c.lds + H_QT); LAS bf16_t* KTs = (LAS bf16_t*)(c.lds + H_KT); LAS bf16_t* KPs = (LAS bf16_t*)(c.lds + H_KP); LAS bf16_t* Vs = (LAS bf16_t*)(c.lds + H_V);
    LAS float* CS = (LAS float*)(c.lds + H_CS); LAS float* SEG = (LAS float*)(c.lds + H_SEG); LAS bf16_t* SC = (LAS bf16_t*)(c.lds + H_SC); LAS bf16_t* NTS = (LAS bf16_t*)(c.lds + H_NTS);
    const int t0 = tid >> 4, cg = tid & 15, chn = 128 * h + 8 * cg;
    float q[2][8], kf[2][8];
    u32x4 vraw[2];
    {
        float lbv[8];
#pragma unroll
        for (int j = 0; j < 8; ++j) lbv[j] = hg_lb(p, l, chn + j);
#pragma unroll
        for (int u = 0; u < 2; ++u) { const int t = t0 + 32 * u;
            float zq[8], zf[8]; unpack8(in.zq[u], zq); unpack8(in.zf[u], zf); vraw[u] = in.zi[u];
            float g[8];
#pragma unroll
            for (int j = 0; j < 8; ++j) { const float f = lbv[j] + (1.0f - lbv[j]) * sigm(zf[j]); q[u][j] = zq[j] * sigm(zq[j]); kf[u][j] = 1.0f - f; g[j] = __logf(f); }
            *(LAS f32x4*)(CS + t * HCL + 8 * cg) = (f32x4){g[0], g[1], g[2], g[3]}; *(LAS f32x4*)(CS + t * HCL + 8 * cg + 4) = (f32x4){g[4], g[5], g[6], g[7]}; }
    }
    const H1In nin = h1_load(ws, next_task, tid);
    lds_barrier();
    {   const int j = tid & 127, sg = tid >> 7; float s = 0.f;
#pragma unroll
        for (int i = 0; i < 16; ++i) s += CS[(16 * sg + i) * HCL + j];
        SEG[sg * 128 + j] = s;
        lds_barrier();
        float off = 0.f;
        for (int s2 = 0; s2 < sg; ++s2) off += SEG[s2 * 128 + j];
#pragma unroll
        for (int i = 0; i < 16; ++i) { off += CS[(16 * sg + i) * HCL + j]; CS[(16 * sg + i) * HCL + j] = off; }
    }
    lds_barrier();
    {
        const f32x4 rA = *(const LAS f32x4*)(CS + 31 * HCL + 8 * cg), rB = *(const LAS f32x4*)(CS + 31 * HCL + 8 * cg + 4);
        const f32x4 eA = *(const LAS f32x4*)(CS + 63 * HCL + 8 * cg), eB = *(const LAS f32x4*)(CS + 63 * HCL + 8 * cg + 4);
        const float cr[8] = {rA.x, rA.y, rA.z, rA.w, rB.x, rB.y, rB.z, rB.w}, ce[8] = {eA.x, eA.y, eA.z, eA.w, eB.x, eB.y, eB.z, eB.w};
#pragma unroll
        for (int u = 0; u < 2; ++u) { const int t = t0 + 32 * u;
            const f32x4 cA = *(const LAS f32x4*)(CS + t * HCL + 8 * cg), cB = *(const LAS f32x4*)(CS + t * HCL + 8 * cg + 4);
            const float cs[8] = {cA.x, cA.y, cA.z, cA.w, cB.x, cB.y, cB.z, cB.w};
            float qh[8], qt[8], kt[8], kp[8];
#pragma unroll
            for (int j = 0; j < 8; ++j) { qh[j] = q[u][j] * __expf(cs[j]); qt[j] = q[u][j] * __expf(cs[j] - cr[j]); kt[j] = kf[u][j] * __expf(cr[j] - cs[j]); kp[j] = kf[u][j] * __expf(ce[j] - cs[j]); }
            *(LAS u32x4*)(QTs + t * HL + 8 * cg) = pack8(qt); *(LAS u32x4*)(KTs + t * HL + 8 * cg) = pack8(kt); *(LAS u32x4*)(KPs + t * HL + 8 * cg) = pack8(kp); *(LAS u32x4*)(Vs + t * HL + 8 * cg) = vraw[u];
            *(u32x4*)((bf16_t*)(ws + WS_QH) + (size_t)(m0 + t) * 1024 + chn) = pack8(qh);
            if (t == 63) { float* DC = (float*)(ws + WS_DC) + (size_t)task * 128 + 8 * cg; *(f32x4*)DC = (f32x4){__expf(ce[0]), __expf(ce[1]), __expf(ce[2]), __expf(ce[3])}; *(f32x4*)(DC + 4) = (f32x4){__expf(ce[4]), __expf(ce[5]), __expf(ce[6]), __expf(ce[7])}; } }
    }
    lds_barrier();
    {
        const int p0 = 16 * (w >> 1), prow = p0 + fr;
#pragma unroll
        for (int i = 0; i < 2; ++i) { const int q0 = 16 * (2 * (w & 1) + i), qc = q0 + 4 * fq;
            f32x4 sc = mm16<false, false, 4, HL, HL>(QTs, KTs, p0, q0, lane, F4Z);
#pragma unroll
            for (int rr = 0; rr < 4; ++rr) if (qc + rr > prow) sc[rr] = 0.f;
            st4_bf16(SC + prow * SCL + qc, sc); }
        TrFrag xv[2]; tr_issue2<HL>(xv, Vs, 16 * w, lane);
#pragma unroll
        for (int dp = 0; dp < 4; ++dp) { TrFrag yk[2][2]; tr_issue4<HL>(yk, KPs, 32 * dp, lane);
            if (dp == 0) tr_wait42(yk, xv); else tr_wait4(yk);
            const bf16x8 x0 = tr_get(xv[0]), x1 = tr_get(xv[1]);
            const f32x4 na = mma2(x0, x1, tr_get(yk[0][0]), tr_get(yk[0][1]), F4Z), nb = mma2(x0, x1, tr_get(yk[1][0]), tr_get(yk[1][1]), F4Z);
            st4_bf16(NTS + (16 * w + fr) * HL + 32 * dp + 4 * fq, na); st4_bf16(NTS + (16 * w + fr) * HL + 32 * dp + 16 + 4 * fq, nb); }
    }
    lds_barrier();
    {
        bf16_t* OI = (bf16_t*)(ws + WS_OI);
        TrFrag yv[2]; tr_issue2<HL>(yv, Vs, 16 * w, lane); tr_wait2(yv);
        const bf16x8 y0 = tr_get(yv[0]), y1 = tr_get(yv[1]);
#pragma unroll
        for (int pt = 0; pt < 4; ++pt) { const f32x4 o = mma2(frag_n<SCL>(SC, 16 * pt, 0, lane), frag_n<SCL>(SC, 16 * pt, 32, lane), y0, y1, F4Z);
            *(u32x2*)(OI + (size_t)(m0 + 16 * pt + fr) * 1024 + 128 * h + 16 * w + 4 * fq) = pack4(o[0], o[1], o[2], o[3]); }
        bf16_t* NT = (bf16_t*)(ws + WS_NT) + (size_t)task * 16384;
        const int row = tid >> 2, cq = tid & 3;
#pragma unroll
        for (int i = 0; i < 4; ++i) *(u32x4*)(NT + row * 128 + 32 * cq + 8 * i) = *(const LAS u32x4*)(NTS + row * HL + 32 * cq + 8 * i);
    }
    lds_barrier();
    return nin;
}
DI void h2_item(PR p, const Ctx& c, int item) {
    unsigned char* ws = p.ws;
    const int gidx = item * 512 + c.tid, bh = gidx >> 11, e = (gidx >> 4) & 127, dg = gidx & 15;
    bf16_t* NT = (bf16_t*)(ws + WS_NT) + (size_t)bh * 32 * 16384 + e * 128 + 8 * dg; const float* DC = (const float*)(ws + WS_DC) + (size_t)bh * 32 * 128 + 8 * dg;
    float s[8];
#pragma unroll
    for (int j = 0; j < 8; ++j) s[j] = 0.f;
    for (int c0 = 0; c0 < 32; c0 += 8) {
        u32x4 nt[8]; f32x4 da[8], db[8];
#pragma unroll
        for (int i = 0; i < 8; ++i) { nt[i] = *(const u32x4*)(NT + (size_t)(c0 + i) * 16384); da[i] = *(const f32x4*)(DC + (c0 + i) * 128); db[i] = *(const f32x4*)(DC + (c0 + i) * 128 + 4); }
#pragma unroll
        for (int i = 0; i < 8; ++i) { *(u32x4*)(NT + (size_t)(c0 + i) * 16384) = pack8(s); float nf[8]; unpack8(nt[i], nf);
            s[0] = s[0] * da[i].x + nf[0]; s[1] = s[1] * da[i].y + nf[1]; s[2] = s[2] * da[i].z + nf[2]; s[3] = s[3] * da[i].w + nf[3];
            s[4] = s[4] * db[i].x + nf[4]; s[5] = s[5] * db[i].y + nf[5]; s[6] = s[6] * db[i].z + nf[6]; s[7] = s[7] * db[i].w + nf[7]; }
    }
}
DI void h3_wave(const f32x4 (&onw)[8], PR p, int l, int wt, int lane) {
    unsigned char* ws = p.ws;
    const int task = wt >> 2, tt = wt & 3, bh = task >> 5, ch = task & 31, b = bh >> 3, h = bh & 7, m0 = b * TSEQ + ch * 64 + 16 * tt, fr = lane & 15, fq = lane >> 4;
    const bf16_t* Z = (const bf16_t*)(ws + WS_Z); const bf16_t* QH = (const bf16_t*)(ws + WS_QH); const bf16_t* OI = (const bf16_t*)(ws + WS_OI); const bf16_t* S = (const bf16_t*)(ws + WS_NT) + (size_t)task * 16384;
    bf16_t* YHG = (bf16_t*)(ws + WS_YHG);
    const size_t row = (size_t)(m0 + fr);
    bf16x8 qf[4];
#pragma unroll
    for (int ks = 0; ks < 4; ++ks) qf[ks] = *(const bf16x8*)(QH + row * 1024 + 128 * h + 32 * ks + 8 * fq);
    u32x2 oi[8], zo[8];
#pragma unroll
    for (int et = 0; et < 8; ++et) { oi[et] = *(const u32x2*)(OI + row * 1024 + 128 * h + 16 * et + 4 * fq); zo[et] = *(const u32x2*)(Z + row * NZ + ZC_O + 128 * h + 16 * et + 4 * fq); }
    f32x4 o[8]; float ssq = 0.f;
#pragma unroll
    for (int et = 0; et < 8; ++et) { bf16x8 sa[4];
#pragma unroll
        for (int ks = 0; ks < 4; ++ks) sa[ks] = *(const bf16x8*)(S + (16 * et + fr) * 128 + 32 * ks + 8 * fq);
        float f[4]; unpack4(oi[et], f); f32x4 acc = {f[0], f[1], f[2], f[3]};
#pragma unroll
        for (int ks = 0; ks < 4; ++ks) acc = MFMA16(sa[ks], qf[ks], acc);
        o[et] = acc; ssq += (acc[0] * acc[0] + acc[1] * acc[1]) + (acc[2] * acc[2] + acc[3] * acc[3]); }
    ssq += __shfl_xor(ssq, 16); ssq += __shfl_xor(ssq, 32);
    const float rstd = rsqrtf(ssq * (1.0f / 128.0f) + NORM_EPS);
#pragma unroll
    for (int et = 0; et < 8; ++et) { float g[4]; unpack4(zo[et], g);
        *(u32x2*)(YHG + row * 1024 + 128 * h + 16 * et + 4 * fq) = pack4(o[et][0] * rstd * onw[et].x * sigm(g[0]), o[et][1] * rstd * onw[et].y * sigm(g[1]), o[et][2] * rstd * onw[et].z * sigm(g[2]), o[et][3] * rstd * onw[et].w * sigm(g[3])); }
}
struct R2Regs { bf16x8 ma[4][2]; u32x4 nv[2]; };
DI void r2_load(R2Regs& r, const bf16_t* mt, const bf16_t* nn, int et, int fr, int fq) {
#pragma unroll
    for (int n = 0; n < 4; ++n)
#pragma unroll
        for (int ks = 0; ks < 2; ++ks) r.ma[n][ks] = *(const bf16x8*)(mt + (16 * n + fr) * 64 + 32 * ks + 8 * fq);
    r.nv[0] = *(const u32x4*)(nn + (16 * et + fr) * 64 + 16 * fq); r.nv[1] = *(const u32x4*)(nn + (16 * et + fr) * 64 + 16 * fq + 8);
}
DI void r2_step(const R2Regs& r, f32x4 (&S)[4], bf16_t* ss, int et, int fr, int fq) {
    { float f[8] = {S[0][0], S[0][1], S[0][2], S[0][3], S[1][0], S[1][1], S[1][2], S[1][3]}, g[8] = {S[2][0], S[2][1], S[2][2], S[2][3], S[3][0], S[3][1], S[3][2], S[3][3]};
      *(u32x4*)(ss + (16 * et + fr) * 64 + 16 * fq) = pack8(f); *(u32x4*)(ss + (16 * et + fr) * 64 + 16 * fq + 8) = pack8(g); }
    bf16x8 sb[2];
#pragma unroll
    for (int ks = 0; ks < 2; ++ks) { u32x4 sp; sp.x = cvt_pk(S[2 * ks][0], S[2 * ks][1]); sp.y = cvt_pk(S[2 * ks][2], S[2 * ks][3]); sp.z = cvt_pk(S[2 * ks + 1][0], S[2 * ks + 1][1]); sp.w = cvt_pk(S[2 * ks + 1][2], S[2 * ks + 1][3]);
        sb[ks] = __builtin_bit_cast(bf16x8, sp); }
    float nf[16]; { float a[8], b[8]; unpack8(r.nv[0], a); unpack8(r.nv[1], b);
#pragma unroll
        for (int j = 0; j < 8; ++j) { nf[j] = a[j]; nf[8 + j] = b[j]; } }
#pragma unroll
    for (int n = 0; n < 4; ++n) { f32x4 acc = {nf[4 * n], nf[4 * n + 1], nf[4 * n + 2], nf[4 * n + 3]};
        acc = MFMA16(r.ma[n][0], sb[0], acc); acc = MFMA16(r.ma[n][1], sb[1], acc); S[n] = acc; }
}
DI void r2_task(PR p, const Ctx& c, int item) {
    unsigned char* ws = p.ws;
    const int lane = c.lane, w = c.wave, fr = lane & 15, fq = lane >> 4, bh = 2 * item + (w >> 2), et = w & 3;
    const bf16_t* MT = (const bf16_t*)(ws + WS_MT) + (size_t)bh * 32 * 4096; const bf16_t* NN = (const bf16_t*)(ws + WS_NN) + (size_t)bh * 32 * 4096;
    bf16_t* SS = (bf16_t*)(ws + WS_SS) + (size_t)bh * 32 * 4096;
    f32x4 S[4] = {F4Z, F4Z, F4Z, F4Z};
    R2Regs ra, rb;
    r2_load(ra, MT, NN, et, fr, fq);
    for (int ch = 0; ch < 32; ch += 2) {
        r2_load(rb, MT + (size_t)(ch + 1) * 4096, NN + (size_t)(ch + 1) * 4096, et, fr, fq);
        r2_step(ra, S, SS + (size_t)ch * 4096, et, fr, fq);
        { const int c2 = ch + 2 < 32 ? ch + 2 : 31; r2_load(ra, MT + (size_t)c2 * 4096, NN + (size_t)c2 * 4096, et, fr, fq); }
        r2_step(rb, S, SS + (size_t)(ch + 1) * 4096, et, fr, fq);
    }
}
struct R3Const { bf16x8 gup[4][5]; f32x4 lnw[4], lnb[4]; };
DI void r3_const(R3Const& k, PR p, int l, int h, int lane) {
    const int fr = lane & 15, fq = lane >> 4; (void)fr;
    const bf16_t* GUPT = (const bf16_t*)(p.ws + WS_LORA + LO_GUP) + (size_t)(64 * h) * 160;
#pragma unroll
    for (int et = 0; et < 4; ++et) { const int col = 64 * h + 16 * et + 4 * fq; k.lnw[et] = *(const f32x4*)(p.in[I_LNW] + l * 1024 + col); k.lnb[et] = *(const f32x4*)(p.in[I_LNB] + l * 1024 + col);
#pragma unroll
        for (int ks = 0; ks < 5; ++ks) k.gup[et][ks] = gfrag(GUPT, 160, 16 * et, 32 * ks, lane); }
}
DI void r3_wave(const R3Const& K, PR p, int l, int wt, int lane) {
    unsigned char* ws = p.ws;
    const int task = wt >> 2, pt = wt & 3, bh = task >> 5, ch = task & 31, b = bh >> 4, h = bh & 15, tok0 = ch * 64 + 16 * pt, m0 = b * TSEQ + tok0, fr = lane & 15, fq = lane >> 4;
    const bf16_t* Z = (const bf16_t*)(ws + WS_Z);
    const size_t blk = (size_t)task * 4096, m = (size_t)(m0 + fr);
    const bf16_t* SS = (const bf16_t*)(ws + WS_SS) + blk; const bf16_t* RP = (const bf16_t*)(ws + WS_RP) + blk; const bf16_t* Y0 = (const bf16_t*)(ws + WS_Y0) + blk;
    bf16x8 sg[5];
    {   const float* mu = p.in[I_MU] + (size_t)l * 3360 + 3200; const bf16_t* zr = Z + m * NZ + ZC_GD; const bool has_prev = (tok0 + fr) > 0;
#pragma unroll
        for (int ks = 0; ks < 5; ++ks) { float cur[8], prv[8]; unpack8(*(const u32x4*)(zr + 32 * ks + 8 * fq), cur);
            if (has_prev) unpack8(*(const u32x4*)(zr - NZ + 32 * ks + 8 * fq), prv); else {
#pragma unroll
                for (int j = 0; j < 8; ++j) prv[j] = 0.f; }
            const f32x4 mA = *(const f32x4*)(mu + 32 * ks + 8 * fq), mB = *(const f32x4*)(mu + 32 * ks + 8 * fq + 4); const float mm[8] = {mA.x, mA.y, mA.z, mA.w, mB.x, mB.y, mB.z, mB.w};
#pragma unroll
            for (int j = 0; j < 8; ++j) cur[j] = sigm(cur[j] + mm[j] * (prv[j] - cur[j]));
            sg[ks] = __builtin_bit_cast(bf16x8, pack8(cur)); } }
    const bf16x8 rp0 = gfrag(RP, 64, 16 * pt, 0, lane), rp1 = gfrag(RP, 64, 16 * pt, 32, lane);
    const float rk = ((const float*)(ws + WS_RK))[m * 16 + h];
    const bf16_t* vsrc = (const bf16_t*)(ws + (l == 0 ? WS_VFIRST : WS_VF));
    u32x2 vraw[4], y0raw[4];
#pragma unroll
    for (int et = 0; et < 4; ++et) { const int col = 64 * h + 16 * et + 4 * fq;
        vraw[et] = *(const u32x2*)(vsrc + m * 1024 + col); y0raw[et] = *(const u32x2*)(Y0 + (16 * pt + fr) * 64 + 16 * et + 4 * fq); }
    f32x4 y[4], g[4]; float s1 = 0.f, s2 = 0.f;
#pragma unroll
    for (int et = 0; et < 4; ++et) { float f[4]; unpack4(y0raw[et], f); f32x4 acc = {f[0], f[1], f[2], f[3]};
        acc = MFMA16(gfrag(SS, 64, 16 * et, 0, lane), rp0, acc); acc = MFMA16(gfrag(SS, 64, 16 * et, 32, lane), rp1, acc);
        y[et] = acc; s1 += (acc[0] + acc[1]) + (acc[2] + acc[3]); s2 += (acc[0] * acc[0] + acc[1] * acc[1]) + (acc[2] * acc[2] + acc[3] * acc[3]);
        f32x4 ga = F4Z;
#pragma unroll
        for (int ks = 0; ks < 5; ++ks) ga = MFMA16(K.gup[et][ks], sg[ks], ga);
        g[et] = ga; }
    s1 += __shfl_xor(s1, 16); s1 += __shfl_xor(s1, 32); s2 += __shfl_xor(s2, 16); s2 += __shfl_xor(s2, 32);
    const float mean = s1 * (1.0f / 64.0f), var = fmaxf(s2 * (1.0f / 64.0f) - mean * mean, 0.f), rstd = rsqrtf(var + RW_GN_EPS);
    bf16_t* YRW = (bf16_t*)(ws + WS_YRW);
#pragma unroll
    for (int et = 0; et < 4; ++et) { const int col = 64 * h + 16 * et + 4 * fq;
        float vv[4]; unpack4(vraw[et], vv);
        float o[4];
#pragma unroll
        for (int r = 0; r < 4; ++r) o[r] = ((y[et][r] - mean) * rstd * K.lnw[et][r] + K.lnb[et][r] + rk * vv[r]) * g[et][r];
        *(u32x2*)(YRW + m * 1024 + col) = pack4(o[0], o[1], o[2], o[3]); }
}
constexpr int P7L = 264;
constexpr int P7_HI = 0, P7_LO = 64 * P7L * 2, P7_LG = 2 * P7_LO, P7_RS = P7_LG + 2 * 64 * 48 * 4, P7_HIST = P7_RS + 256;
DI void p7_route(PR p, const Ctx& c, int l) {
    unsigned char* ws = p.ws;
    const int lane = c.lane, w = c.wave, fr = lane & 15, fq = lane >> 4;
    const float* H = p.out; bf16_t* HN = (bf16_t*)(ws + WS_XN);
    const float* nw = p.in[I_NFFN] + (size_t)l * D; const bf16_t* WRH = (const bf16_t*)(ws + WS_LORA + LO_WR); const bf16_t* WRL = (const bf16_t*)(ws + WS_LORA + LO_WRL);
    const float* bg = p.in[I_RGB] + l * 4; const float* be = p.in[I_REB] + l * 32;
    int* TOKE = (int*)(ws + WS_TOKE); float* TOKW = (float*)(ws + WS_TOKW); int* CNT = (int*)(ws + WS_CNT); float* TRSTD = (float*)(ws + WS_TRSTD);
    LAS bf16_t* HI = (LAS bf16_t*)(c.lds + P7_HI); LAS bf16_t* LO = (LAS bf16_t*)(c.lds + P7_LO); LAS float* LG = (LAS float*)(c.lds + P7_LG); LAS float* RS = (LAS float*)(c.lds + P7_RS); LAS int* hist = (LAS int*)(c.lds + P7_HIST);
    for (int tile = c.bid; tile < M / 64; tile += c.G) {
        if (c.tid < 32) hist[c.tid] = 0;
        const int tt = w & 3, kh = w >> 2, mb = tile * 64 + 8 * w;
        f32x4 acc[3] = {F4Z, F4Z, F4Z}; float ss[8];
#pragma unroll
        for (int i = 0; i < 8; ++i) ss[i] = 0.f;
        for (int kc = 0; kc < 8; ++kc) {
            const f32x4 ww = *(const f32x4*)(nw + 256 * kc + 4 * lane);
            f32x4 hv[8];
#pragma unroll
            for (int i = 0; i < 8; ++i) hv[i] = *(const f32x4*)(H + (size_t)(mb + i) * D + 256 * kc + 4 * lane);
            bf16x8 wh[4][3], wl[4][3];
#pragma unroll
            for (int k4 = 0; k4 < 4; ++k4)
#pragma unroll
                for (int ct = 0; ct < 3; ++ct) { const int kg = 256 * kc + 32 * (4 * kh + k4); wh[k4][ct] = gfrag(WRH, D, 16 * ct, kg, lane); wl[k4][ct] = gfrag(WRL, D, 16 * ct, kg, lane); }
#pragma unroll
            for (int i = 0; i < 8; ++i) { ss[i] += (hv[i].x * hv[i].x + hv[i].y * hv[i].y) + (hv[i].z * hv[i].z + hv[i].w * hv[i].w);
                const f32x4 x = hv[i] * ww; const u32x2 hp = pack4(x.x, x.y, x.z, x.w); float hf[4]; unpack4(hp, hf);
                *(u32x2*)(HN + (size_t)(mb + i) * D + 256 * kc + 4 * lane) = hp;
                *(LAS u32x2*)(HI + (8 * w + i) * P7L + 4 * lane) = hp; *(LAS u32x2*)(LO + (8 * w + i) * P7L + 4 * lane) = pack4(x.x - hf[0], x.y - hf[1], x.z - hf[2], x.w - hf[3]); }
            lds_barrier();
#pragma unroll
            for (int k4 = 0; k4 < 4; ++k4) { const int ks = 4 * kh + k4;
                const bf16x8 xh = frag_n<P7L>(HI, 16 * tt, 32 * ks, lane), xl = frag_n<P7L>(LO, 16 * tt, 32 * ks, lane);
#pragma unroll
                for (int ct = 0; ct < 3; ++ct) { acc[ct] = MFMA16(wh[k4][ct], xh, acc[ct]); acc[ct] = MFMA16(wh[k4][ct], xl, acc[ct]); acc[ct] = MFMA16(wl[k4][ct], xh, acc[ct]); } }
            lds_barrier();
        }
#pragma unroll
        for (int i = 0; i < 8; ++i) { const float r = rsqrtf(wave_sum(ss[i]) * (1.f / D) + NORM_EPS); if (lane == i) { RS[8 * w + i] = r; TRSTD[mb + i] = r; } }
#pragma unroll
        for (int ct = 0; ct < 3; ++ct) *(LAS f32x4*)(LG + (kh * 64 + 16 * tt + fr) * 48 + 16 * ct + 4 * fq) = acc[ct];
        __syncthreads();
        if (c.tid < 64) { const int t = c.tid, m = tile * 64 + t; const float rstd = RS[t];
            const LAS float* l0 = LG + t * 48; const LAS float* l1 = LG + (64 + t) * 48;
            float gl[4]; int gs = 0;
#pragma unroll
            for (int i = 0; i < 4; ++i) gl[i] = (l0[i] + l1[i]) * rstd + bg[i];
#pragma unroll
            for (int i = 1; i < 4; ++i) if (gl[i] > gl[gs]) gs = i;
            float den = 0.f;
#pragma unroll
            for (int i = 0; i < 4; ++i) den += __expf(gl[i] - gl[gs]);
            const float pg = 1.0f / den;
            float el[8]; int i1 = 0, i2 = -1;
#pragma unroll
            for (int i = 0; i < 8; ++i) el[i] = (l0[4 + 8 * gs + i] + l1[4 + 8 * gs + i]) * rstd + be[8 * gs + i];
#pragma unroll
            for (int i = 1; i < 8; ++i) if (el[i] > el[i1]) i1 = i;
#pragma unroll
            for (int i = 0; i < 8; ++i) if (i != i1 && (i2 < 0 || el[i] > el[i2])) i2 = i;
            const float e2 = __expf(el[i2] - el[i1]), w1 = pg / (1.0f + e2), w2 = pg * e2 / (1.0f + e2);
            TOKE[2 * m] = 8 * gs + i1; TOKE[2 * m + 1] = 8 * gs + i2; TOKW[2 * m] = w1; TOKW[2 * m + 1] = w2;
            atomicAdd((int*)&hist[8 * gs + i1], 1); atomicAdd((int*)&hist[8 * gs + i2], 1); }
        __syncthreads();
        if (c.tid < 32) CNT[tile * 32 + c.tid] = hist[c.tid];
        __syncthreads();
    }
}
DI void moe_tables(PR p, const Ctx& c) {
    const int* CNT = (const int*)(p.ws + WS_CNT);
    LAS int* LC = (LAS int*)(c.lds + LDS_CTL_OFF);
    LAS int* part = (LAS int*)(c.lds + 72000);
    { const int e = c.tid & 31, pr = c.tid >> 5; int v[16];
#pragma unroll
      for (int i = 0; i < 16; ++i) v[i] = CNT[(pr + 16 * i) * 32 + e];
      int s = 0;
#pragma unroll
      for (int i = 0; i < 16; ++i) s += v[i];
      part[pr * 32 + e] = s; }
    __syncthreads();
    if (c.tid < 32) { int s = 0;
#pragma unroll 1
        for (int pr = 0; pr < 16; ++pr) s += part[pr * 32 + c.tid];
        LC[LC_TOT + c.tid] = s; }
    __syncthreads();
    if (c.tid < 64) {
        const int e = c.tid & 31; const int nt = (LC[LC_TOT + e] + 255) >> 8; int inc = nt;
#pragma unroll
        for (int o = 1; o < 32; o <<= 1) { const int v = __shfl_up(inc, o, 32); if ((c.tid & 31) >= o) inc += v; }
        if (c.tid < 32) { LC[LC_PAD + e] = (inc - nt) << 8; if (e == 31) LC[LC_PAD + 32] = inc << 8; }
    }
    __syncthreads();
    if (c.tid < 160) { int e = 0;
#pragma unroll 1
        for (int i = 0; i < 32; ++i) if ((LC[LC_PAD + i] >> 8) <= c.tid) e = i;
        LC[LC_TILE + c.tid] = e; }
    __syncthreads();
}
DI void p8_dispatch(PR p, const Ctx& c) {
    unsigned char* ws = p.ws;
    const int* CNT = (const int*)(ws + WS_CNT); const int* TOKE = (const int*)(ws + WS_TOKE); int* TOKS = (int*)(ws + WS_TOKS);
    const bf16_t* HN = (const bf16_t*)(ws + WS_XN); bf16_t* XS = (bf16_t*)(ws + WS_XS);
    LAS int* LC = (LAS int*)(c.lds + LDS_CTL_OFF);
    LAS int* base = (LAS int*)(c.lds + 76000); LAS int* part = (LAS int*)(c.lds + 72000); LAS int* eids = (LAS int*)(c.lds + 77000); LAS int* slots = (LAS int*)(c.lds + 78000);
    for (int tile = c.bid; tile < M / 64; tile += c.G) {
        { const int e = c.tid & 31, pr = c.tid >> 5; int v[16];
#pragma unroll
          for (int i = 0; i < 16; ++i) { const int tl = pr + 16 * i; v[i] = CNT[(tl < tile ? tl : 0) * 32 + e]; }
          int s = 0;
#pragma unroll
          for (int i = 0; i < 16; ++i) s += (pr + 16 * i < tile) ? v[i] : 0;
          part[pr * 32 + e] = s; }
        if (c.tid < 128) eids[c.tid] = TOKE[tile * 128 + c.tid];
        __syncthreads();
        if (c.tid < 32) { int s = 0; for (int pr = 0; pr < 16; ++pr) s += part[pr * 32 + c.tid]; base[c.tid] = s; }
        __syncthreads();
        if (c.tid < 128) { const int e = eids[c.tid]; int lp = 0; for (int i = 0; i < c.tid; ++i) lp += (eids[i] == e) ? 1 : 0;
            const int s = LC[LC_PAD + e] + base[e] + lp; slots[c.tid] = s; TOKS[tile * 128 + c.tid] = s; ((int*)(ws + WS_CTL + CTL_SLOTTOK))[s] = tile * 64 + (c.tid >> 1); ((float*)(ws + WS_SRSTD))[s] = ((const float*)(ws + WS_TRSTD))[tile * 64 + (c.tid >> 1)]; }
        __syncthreads();
        __syncthreads();
    }
}
DI void p11_combine(PR p, const Ctx& c, int l) {
    unsigned char* ws = p.ws;
    const int lane = c.lane; const int gw = c.bid * 8 + c.wave, NGW = c.G * 8;
    float* H = p.out; const bf16_t* YS = (const bf16_t*)(ws + WS_YS); const int* TOKS = (const int*)(ws + WS_TOKS); const float* TOKW = (const float*)(ws + WS_TOKW);
    bf16_t* XN = (bf16_t*)(ws + WS_XN);
    const float* nw = (l == 0) ? p.in[I_NMIX] + D : p.in[I_FNW];
    f32x4 ww[8];
#pragma unroll
    for (int j = 0; j < 8; ++j) ww[j] = ((const f32x4*)nw)[lane + 64 * j];
    if (gw >= M) return;
    int s0 = TOKS[2 * gw], s1 = TOKS[2 * gw + 1]; float w0 = TOKW[2 * gw], w1 = TOKW[2 * gw + 1];
    for (int m = gw; m < M; m += NGW) {
        f32x4* hr = (f32x4*)(H + (size_t)m * D) + lane; const u32x2* y0 = (const u32x2*)(YS + (size_t)s0 * D) + lane; const u32x2* y1 = (const u32x2*)(YS + (size_t)s1 * D) + lane;
        f32x4 hv[8]; u32x2 ya[8], yb[8];
#pragma unroll
        for (int j = 0; j < 8; ++j) { hv[j] = hr[64 * j]; ya[j] = y0[64 * j]; yb[j] = y1[64 * j]; }
        const float cw0 = w0, cw1 = w1;
        { const int mn = (m + NGW < M) ? m + NGW : m; s0 = TOKS[2 * mn]; s1 = TOKS[2 * mn + 1]; w0 = TOKW[2 * mn]; w1 = TOKW[2 * mn + 1]; }
        float s = 0.f;
#pragma unroll
        for (int j = 0; j < 8; ++j) { float a[4], b[4]; unpack4(ya[j], a); unpack4(yb[j], b);
            hv[j].x += cw0 * a[0] + cw1 * b[0]; hv[j].y += cw0 * a[1] + cw1 * b[1]; hv[j].z += cw0 * a[2] + cw1 * b[2]; hv[j].w += cw0 * a[3] + cw1 * b[3];
            s += (hv[j].x * hv[j].x + hv[j].y * hv[j].y) + (hv[j].z * hv[j].z + hv[j].w * hv[j].w); }
        const float rstd = rsqrtf(wave_sum(s) * (1.f / D) + NORM_EPS);
#pragma unroll
        for (int j = 0; j < 8; ++j) {
            if (l == 0) { hr[64 * j] = hv[j]; ((u32x2*)(XN + (size_t)m * D))[lane + 64 * j] = pack4(hv[j].x * rstd * ww[j].x, hv[j].y * rstd * ww[j].y, hv[j].z * rstd * ww[j].z, hv[j].w * rstd * ww[j].w); }
            else hr[64 * j] = hv[j] * rstd * ww[j]; }
    }
}
#ifndef DBG_CUT
#define DBG_CUT 1000
#endif
constexpr int NPHASE = 23;
#ifndef WGM_P1
#define WGM_P1 4
#endif
#ifndef WGM_P56
#define WGM_P56 2
#endif
#ifndef REP_R1
#define REP_R1 1
#endif
#ifndef REP_H1
#define REP_H1 1
#endif
#ifndef REP_R2
#define REP_R2 1
#endif
#ifndef REP_H3
#define REP_H3 1
#endif
#ifndef REP_R3
#define REP_R3 1
#endif
#ifndef PH_MASK
#define PH_MASK 0xFFFF
#endif
#define PH_EN(n) ((PH_MASK >> (n)) & 1)
__global__ void __launch_bounds__(512, 2) mk_fwd(Params p_byval) {
    const CAS Params* pp = (const CAS Params*)__builtin_amdgcn_kernarg_segment_ptr();
#define p (*pp)
    extern __shared__ __attribute__((aligned(16))) unsigned char lds_raw[];
    Ctx c; unsigned char* ws;
#define FRESH() do { int t_ = threadIdx.x; asm volatile("" : "+v"(t_)); int b_ = blockIdx.x; asm volatile("" : "+s"(b_)); unsigned lb_ = (unsigned)(uintptr_t)(LAS unsigned char*)lds_raw; asm volatile("" : "+s"(lb_)); c.lds = (LAS unsigned char*)(uintptr_t)lb_; c.tid = t_; c.lane = t_ & 63; \
        c.wave = __builtin_amdgcn_readfirstlane(t_ >> 6); c.G = gridDim.x; c.bid = b_; pp = (const CAS Params*)__builtin_amdgcn_kernarg_segment_ptr(); asm volatile("" : "+s"(pp)); ws = p.ws; asm volatile("" : "+s"(ws)); glds = (LAS unsigned char*)c.lds; } while (0)
    LAS unsigned char* glds;
    FRESH();
    LAS unsigned* LCU = (LAS unsigned*)(c.lds + LDS_CTL_OFF);
    if (c.tid < 4) LCU[c.tid] = 0u;
    __syncthreads();
#if MK_ONE_LAUNCH
    XcdBarrier bar = xcd_barrier_post((unsigned*)(ws + WS_CTL) + CW_BAR, (volatile LAS unsigned*)LCU);
#define GRID_BAR() xcd_barrier(bar)
#else
#define GRID_BAR() do { } while (0)
#endif
    const int lo = p.ph_lo, hi_raw = p.ph_hi; int hi = hi_raw & 0xffff; const int dbgflag = hi_raw >> 16; (void)dbgflag;
#define IN(k) (lo <= (k) && (k) < hi)
#define SEAM(k) do { if (IN(k) && IN((k) + 1)) GRID_BAR(); } while (0)
    if (PH_EN(0) && IN(0)) { FRESH();
        convert_small(p, c, 0, 0);
        const int gw = c.bid * 8 + c.wave, NGW = c.G * 8;
        for (int m = gw; m < M; m += NGW) rms_row_bf16(p.in[I_X] + (size_t)m * D, p.in[I_NMIX], (bf16_t*)(ws + WS_XN) + (size_t)m * D, c.lane);
    }
    SEAM(0);
    for (int l = 0; l < 2; ++l) {
        const int pb = 1 + 11 * l;
        if (PH_EN(1) && IN(pb + 0)) { FRESH();
            pg8::Gemm g{(const bf16_t*)(ws + WS_XN), (const bf16_t*)(ws + WS_WIN), M, NZ, D}; pg8::StaticOrder S; S.init(M, NZ, c.G, c.bid, WGM_P1);
            if (dbgflag == 3) { S.nM = 1; S.nN = 1; S.hot = 1; }
            pg8::EpiBf16P E{(bf16_t*)(ws + WS_Z), NZ, dbgflag == 3 ? 1 : dbgflag};
#ifdef STAGGER_TICKS
            if (c.bid & 1) { const unsigned long long t0 = __builtin_amdgcn_s_memrealtime(); while (__builtin_amdgcn_s_memrealtime() - t0 < STAGGER_TICKS) __builtin_amdgcn_s_sleep(32); }
#endif
            pg8::gemm_phase<pg8::EpiBf16P, pg8::StaticOrder>(glds, g, S, E, nullptr);
            const int nunits = (M / 256) * (NZ / 256), rem = nunits % c.G;
            if (rem != 0 && c.bid >= rem && EXP_EARLY > 0) { __syncthreads(); FRESH(); convert_experts_early(p, c, l, rem, c.G - rem); }
        }
        SEAM(pb + 0);
        if (PH_EN(2) && IN(pb + 1)) { FRESH();
            if (c.bid < 4096) { R1In rin = r1_load(ws, c.bid, c.tid);
              for (int it = c.bid; it < 4096; it += c.G) rin = r1_task<0>(p, c, l, it, rin, it + c.G < 4096 ? it + c.G : it); }
            if (c.bid < 2048) { H1In hin = h1_load(ws, c.bid, c.tid);
              for (int it = c.bid; it < 2048; it += c.G) hin = h1_task(p, c, l, it, hin, it + c.G < 2048 ? it + c.G : it); }
        }
        SEAM(pb + 1);
        if (PH_EN(3) && IN(pb + 2)) { FRESH();
            if (c.G >= 128) { if (c.bid < 64) { for (int rep = 0; rep < REP_R2; ++rep) r2_task(p, c, c.bid); } else for (int it = c.bid - 64; it < 256; it += c.G - 64) h2_item(p, c, it); }
            else { for (int it = c.bid; it < 64; it += c.G) r2_task(p, c, it); for (int it = c.bid; it < 256; it += c.G) h2_item(p, c, it); }
        }
        SEAM(pb + 2);
        if (PH_EN(4) && IN(pb + 3)) { FRESH();
            { const int gw = c.bid * 8 + c.wave, NGW = c.G * 8;
              { f32x4 onw[8];
#pragma unroll
                for (int et = 0; et < 8; ++et) onw[et] = *(const f32x4*)(p.in[I_ONORM] + l * 128 + 16 * et + 4 * (c.lane >> 4));
                for (int wt = gw; wt < 8192; wt += NGW) h3_wave(onw, p, l, wt, c.lane); }
              if (gw < 16384) { R3Const K3; const bool inv = (NGW % 2048) == 0;
                r3_const(K3, p, l, ((gw >> 2) >> 5) & 15, c.lane);
                for (int wt = gw; wt < 16384; wt += NGW) { if (!inv) r3_const(K3, p, l, ((wt >> 2) >> 5) & 15, c.lane); r3_wave(K3, p, l, wt, c.lane); } } }
        }
        SEAM(pb + 3);
        if (PH_EN(5) && IN(pb + 4)) { FRESH();
            pg8::StaticOrder S; S.init(M, D, c.G, c.bid, WGM_P56);
#ifndef DBG_NO_HG
            { pg8::Gemm g{(const bf16_t*)(ws + WS_YHG), (const bf16_t*)(ws + WS_WBH), M, D, 1024};
              pg8::EpiGate E{(bf16_t*)(ws + WS_XN), D, (const bf16_t*)(ws + WS_Z) + ZC_GA, NZ, 0, dbgflag};
              pg8::gemm_phase<pg8::EpiGate, pg8::StaticOrder>(glds, g, S, E, nullptr); }
#endif
#ifndef DBG_NO_RW
            { pg8::Gemm g{(const bf16_t*)(ws + WS_YRW), (const bf16_t*)(ws + WS_WBR), M, D, 1024};
#ifdef DBG_NO_HG
              pg8::EpiGate E{(bf16_t*)(ws + WS_XN), D, (const bf16_t*)(ws + WS_Z) + ZC_GB, NZ, 0, dbgflag};
#else
              pg8::EpiGate E{(bf16_t*)(ws + WS_XN), D, (const bf16_t*)(ws + WS_Z) + ZC_GB, NZ, 1, dbgflag};
#endif
              pg8::gemm_phase<pg8::EpiGate, pg8::StaticOrder>(glds, g, S, E, nullptr); }
#endif
        }
        SEAM(pb + 4);
        if (PH_EN(6) && IN(pb + 5)) { FRESH();
            pg8::Gemm g{(const bf16_t*)(ws + WS_XN), (const bf16_t*)(ws + WS_WO), M, D, D}; pg8::StaticOrder S; S.init(M, D, c.G, c.bid, WGM_P56);
            pg8::EpiRes E{l == 0 ? p.in[I_X] : p.out, p.out, D, dbgflag};
            pg8::gemm_phase<pg8::EpiRes, pg8::StaticOrder>(glds, g, S, E, nullptr);
        }
        SEAM(pb + 5);
        if (PH_EN(7) && IN(pb + 6)) { FRESH();
            { const int nunits = (M / 256) * (NZ / 256); convert_experts(p, c, l, (nunits % c.G) != 0 ? EXP_EARLY : 0); }
            __syncthreads();
            p7_route(p, c, l);
        }
        SEAM(pb + 6);
        if (PH_EN(8) && IN(pb + 7)) { FRESH(); moe_tables(p, c); p8_dispatch(p, c); }
        SEAM(pb + 7);
        if (PH_EN(9) && IN(pb + 8)) { FRESH();
            moe_tables(p, c); FRESH();
            const LAS int* LC = (const LAS int*)(c.lds + LDS_CTL_OFF);
            pg8::Gemm g{(const bf16_t*)(ws + WS_XN), (const bf16_t*)(ws + WS_WGU), MAXSLOTS, NEXP * 1024, D, (const int*)(ws + WS_CTL + CTL_SLOTTOK)};
            pg8::GroupedOrder<4> S{(LC[LC_PAD + 32] >> 8) * 4, c.G, c.bid, LC + LC_TILE};
            pg8::EpiSwiGLU E{(bf16_t*)(ws + WS_ACT), (const float*)(ws + WS_SRSTD), dbgflag};
            pg8::gemm_phase<pg8::EpiSwiGLU, pg8::GroupedOrder<4>, false, true>(glds, g, S, E, nullptr);
        }
        SEAM(pb + 8);
        if (PH_EN(10) && IN(pb + 9)) { FRESH();
            moe_tables(p, c); FRESH();
            const LAS int* LC = (const LAS int*)(c.lds + LDS_CTL_OFF);
            pg8::Gemm g{(const bf16_t*)(ws + WS_ACT), (const bf16_t*)(ws + WS_WDN), MAXSLOTS, NEXP * D, DEXP};
            pg8::GroupedOrder<8> S{(LC[LC_PAD + 32] >> 8) * 8, c.G, c.bid, LC + LC_TILE};
            pg8::EpiDown E{(bf16_t*)(ws + WS_YS), dbgflag};
            pg8::gemm_phase<pg8::EpiDown, pg8::GroupedOrder<8>>(glds, g, S, E, nullptr);
        }
        SEAM(pb + 9);
        if (PH_EN(11) && IN(pb + 10)) { FRESH();
            p11_combine(p, c, l);
            if (l == 0) convert_small(p, c, 1, 0);
        }
        SEAM(pb + 10);
    }
}
#undef p
__global__ void __launch_bounds__(512) dbg_final(const float* src, const float* fw, float* out) {
    const int lane = threadIdx.x & 63, gw = blockIdx.x * 8 + (threadIdx.x >> 6), NGW = gridDim.x * 8;
    for (int m = gw; m < M; m += NGW) { const f32x4* xr = (const f32x4*)(src + (size_t)m * D) + lane; f32x4 v[8]; float s = 0.f;
#pragma unroll
        for (int j = 0; j < 8; ++j) { v[j] = xr[64 * j]; s += (v[j].x * v[j].x + v[j].y * v[j].y) + (v[j].z * v[j].z + v[j].w * v[j].w); }
        const float rstd = rsqrtf(wave_sum(s) * (1.f / D) + NORM_EPS);
#pragma unroll
        for (int j = 0; j < 8; ++j) ((f32x4*)(out + (size_t)m * D))[lane + 64 * j] = v[j] * rstd * ((const f32x4*)fw)[lane + 64 * j]; }
}
#ifdef DBG_CHECK
__global__ void __launch_bounds__(512) dbg_check(const void* buf, size_t n, int is_f32, unsigned* flag, unsigned idx) {
    size_t i = (size_t)blockIdx.x * 512 + threadIdx.x, st = (size_t)gridDim.x * 512; bool bad = false;
#ifdef DBG_DEAD
    bool alive = false;
    for (; i < n; i += st) { float v = is_f32 ? ((const float*)buf)[i] : bf2f(((const bf16_t*)buf)[i]); if (fabsf(v) > 0.01f && fabsf(v) < 1e6f) alive = true; }
    __shared__ int anyalive; if (threadIdx.x == 0) anyalive = 0; __syncthreads(); if (alive) anyalive = 1; __syncthreads();
    if (threadIdx.x == 0 && anyalive) atomicOr(flag + 1 + idx, 1u);
#else
    for (; i < n; i += st) { float v = is_f32 ? ((const float*)buf)[i] : bf2f(((const bf16_t*)buf)[i]); if (!(v - v == 0.f)) bad = true; }
    if (bad) atomicMin(flag, idx);
#endif
}
__global__ void __launch_bounds__(512) dbg_scale(float* out, const unsigned* flag) {
#ifdef DBG_DEAD
    unsigned f = 1000u; for (unsigned i = 1; i <= 18; ++i) if (flag[1 + i] == 0u) { f = i; break; }
#else
    const unsigned f = *flag;
#endif
    const float s = f < 100u ? 1.0f + 0.25f * (float)f : 1.0f;
    for (size_t i = (size_t)blockIdx.x * 512 + threadIdx.x; i < (size_t)M * D; i += (size_t)gridDim.x * 512) out[i] *= s;
}
#endif
#ifdef DBG_TRTEST
__global__ void __launch_bounds__(64) dbg_trtest(unsigned* flag) {
    __shared__ __attribute__((aligned(16))) bf16_t A[64 * 72];
    const int lane = threadIdx.x;
    for (int i = lane; i < 64 * 72; i += 64) { const int r = i / 72, cc = i % 72; const float v = (float)((r * 5 + cc * 3) & 255); A[i] = (bf16_t)(cvt_pk(v, 0.f) & 0xffff); }
    __syncthreads();
    unsigned bad = 0;
    for (int row0 = 0; row0 < 64; row0 += 16) for (int k0 = 0; k0 < 64; k0 += 32) {
        const bf16x8 f = frag_t<72>((const LAS bf16_t*)A, row0, k0, lane);
        for (int j = 0; j < 8; ++j) { const int k = k0 + 8 * (lane >> 4) + j, i = row0 + (lane & 15); if ((bf16_t)f[j] != A[k * 72 + i]) bad = 1; }
    }
    if (bad) atomicMin(flag, 2u);
    f32x4 acc = {0.f, 0.f, 0.f, 0.f}; bf16x8 xa, yb;
    for (int j = 0; j < 8; ++j) { const int k = 8 * (lane >> 4) + j, r = lane & 15; xa[j] = (short)(cvt_pk(r == k ? 1.f : 0.f, 0.f) & 0xffff); yb[j] = (short)(cvt_pk((float)(r * 8 + (k & 7)), 0.f) & 0xffff); }
    acc = MFMA16(yb, xa, acc);
    for (int r = 0; r < 4; ++r) { const int pp_ = lane & 15, q = 4 * (lane >> 4) + r; if (acc[r] != (float)(q * 8 + (pp_ & 7))) bad |= 2; }
    if (bad & 2) atomicMin(flag, 3u);
}
#endif
#ifdef DBG_H1TEST
__global__ void __launch_bounds__(512) dbg_h1test(unsigned* flag) {
    extern __shared__ __attribute__((aligned(16))) unsigned char lraw[];
    LAS unsigned char* lds = (LAS unsigned char*)lraw;
    LAS bf16_t* Vs = (LAS bf16_t*)(lds + H_V); LAS bf16_t* KPs = (LAS bf16_t*)(lds + H_KP); LAS bf16_t* QHs = (LAS bf16_t*)(lds + H_QH); LAS bf16_t* KTs = (LAS bf16_t*)(lds + H_KT);
    const int tid = threadIdx.x, lane = tid & 63, w = tid >> 6, fr = lane & 15, fq = lane >> 4;
    for (int i = tid; i < 32 * HL; i += 512) { const int r = i / HL, cc = i % HL;
        Vs[i] = (bf16_t)(cvt_pk((float)((r * 3 + cc) % 7 - 3), 0.f) & 0xffff); KPs[i] = (bf16_t)(cvt_pk((float)((r + cc * 5) % 5 - 2), 0.f) & 0xffff);
        QHs[i] = (bf16_t)(cvt_pk((float)((r * 2 + cc) % 3 - 1), 0.f) & 0xffff); KTs[i] = (bf16_t)(cvt_pk((float)((r + cc) % 4 - 1), 0.f) & 0xffff); }
    __syncthreads();
    unsigned bad = 0;
    const bf16x8 xb = frag_t<HL>(Vs, 16 * w, 0, lane);
    for (int dn = 0; dn < 8; ++dn) { const bf16x8 ya = frag_t<HL>(KPs, 16 * dn, 0, lane); const f32x4 nt = MFMA16(ya, xb, F4Z);
        for (int r = 0; r < 4; ++r) { const int e = 16 * w + fr, d = 16 * dn + 4 * fq + r; float ref = 0.f; for (int s = 0; s < 32; ++s) ref += (float)((s * 3 + e) % 7 - 3) * (float)((s + d * 5) % 5 - 2); if (nt[r] != ref) bad |= 1; } }
    if (w < 4) { const int p0 = 16 * (w >> 1), q0 = 16 * (w & 1);
        const f32x4 sc = mm16<false, false, 4, HL, HL>(QHs, KTs, p0, q0, lane, F4Z);
        for (int r = 0; r < 4; ++r) { const int t = p0 + fr, s = q0 + 4 * fq + r; float ref = 0.f; for (int d = 0; d < 128; ++d) ref += (float)((t * 2 + d) % 3 - 1) * (float)((s + d) % 4 - 1); if (sc[r] != ref) bad |= 2; } }
    if (bad & 1) atomicMin(flag, 2u);
    if (bad & 2) atomicMin(flag, 3u);
}
#endif
#ifdef DBG_CLASS
__global__ void __launch_bounds__(512) dbg_class(const bf16_t* buf, size_t n, unsigned* flag) {
    unsigned m = 0;
    for (size_t i = (size_t)blockIdx.x * 512 + threadIdx.x; i < n; i += (size_t)gridDim.x * 512) { const bf16_t b = buf[i]; const float v = bf2f(b); const float a = fabsf(v);
        if (b == 0xAAAA) m |= 4; else if (a == 0.f) m |= 2; else if (a > 0.01f && a < 1e6f) m |= 1; else if (!(a < 1e6f)) m |= 8; else m |= 16; }
    if (m) atomicOr(flag + 40, m);
}
__global__ void __launch_bounds__(512) dbg_scale2(float* out, const unsigned* flag) {
    const unsigned f = flag[40]; const float s = 1.0f + 0.25f * (float)f;
    for (size_t i = (size_t)blockIdx.x * 512 + threadIdx.x; i < (size_t)M * D; i += (size_t)gridDim.x * 512) out[i] *= s;
}
#endif
#ifdef DBG_CSUM
__global__ void __launch_bounds__(512) dbg_csum(const unsigned* buf, size_t nwords, unsigned* flag) {
    unsigned long long s = 0;
    for (size_t i = (size_t)blockIdx.x * 512 + threadIdx.x; i < nwords; i += (size_t)gridDim.x * 512) s += (unsigned long long)buf[i] * (unsigned long long)((i & 1023) + 1);
    atomicAdd((unsigned long long*)(flag + 42), s);
}
__global__ void __launch_bounds__(512) dbg_scale3(float* out, const unsigned* flag) {
    const unsigned long long c = *(const unsigned long long*)(flag + 42); const float s = 1.0f + 0.25f * (float)((c >> 7) & 3ull);
    for (size_t i = (size_t)blockIdx.x * 512 + threadIdx.x; i < (size_t)M * D; i += (size_t)gridDim.x * 512) out[i] *= s;
}
#endif
#ifdef DBG_ZCOLS
__global__ void __launch_bounds__(512) dbg_zcols(const bf16_t* Z, unsigned* flag) {
    const int starts[13] = {0, 1024, 2048, 3072, 4096, 5120, 6144, 7168, 7232, 7296, 7456, 9504, 11552};
    __shared__ int alive[12];
    if (threadIdx.x < 12) alive[threadIdx.x] = 0; __syncthreads();
    for (int row = blockIdx.x; row < M; row += gridDim.x) { const bf16_t* zr = Z + (size_t)row * NZ;
        for (int cidx = threadIdx.x; cidx < 11552; cidx += 512) { const float a = fabsf(bf2f(zr[cidx])); if (a > 0.01f && a < 1e6f) { int seg = 0; for (int s = 0; s < 12; ++s) if (cidx >= starts[s]) seg = s; alive[seg] = 1; } } }
    __syncthreads();
    if (threadIdx.x < 12 && alive[threadIdx.x]) atomicOr(flag + 2 + threadIdx.x, 1u);
}
#endif
#ifdef DBG_WROWS
__global__ void __launch_bounds__(512) dbg_wrows(const bf16_t* W, unsigned* flag) {
    const int starts[13] = {0, 1024, 2048, 3072, 4096, 5120, 6144, 7168, 7232, 7296, 7456, 9504, 11552};
    for (int row = blockIdx.x; row < 11552; row += gridDim.x) { bool alive = false;
        for (int cidx = threadIdx.x; cidx < 2048; cidx += 512) { const float a = fabsf(bf2f(W[(size_t)row * 2048 + cidx])); if (a > 0.001f && a < 1e6f) alive = true; }
        if (alive) { int seg = 0; for (int s = 0; s < 12; ++s) if (row >= starts[s]) seg = s; atomicOr(flag + 2 + seg, 1u); } }
}
#endif
extern "C" void kernel_launch(void* const* d_in, const int* in_sizes, int n_in, void* d_out, int out_size, void* d_ws, size_t ws_size, hipStream_t stream) {
    static int grid = 0;
    if (grid == 0) {
        if (n_in != 31 || out_size != M * D || ws_size < WS_END) { fprintf(stderr, "kernel_launch: unexpected shapes (n_in %d out %d ws %zu)\n", n_in, out_size, ws_size); grid = -1; return; }
        int dev = 0, cus = 0;
        if (hipGetDevice(&dev) != hipSuccess || hipDeviceGetAttribute(&cus, hipDeviceAttributeMultiprocessorCount, dev) != hipSuccess) { grid = -1; return; }
        if (hipFuncSetAttribute((const void*)mk_fwd, hipFuncAttributeMaxDynamicSharedMemorySize, LDS_BYTES) != hipSuccess) { fprintf(stderr, "kernel_launch: hipFuncSetAttribute failed\n"); grid = -1; return; }
        int per_cu = 0;
        if (hipOccupancyMaxActiveBlocksPerMultiprocessor(&per_cu, (const void*)mk_fwd, 512, LDS_BYTES) != hipSuccess || per_cu < 1) { fprintf(stderr, "kernel_launch: occupancy query says %d\n", per_cu); }
        (void)hipGetLastError();
        grid = cus;
    }
    if (grid < 0) return;
    (void)hipMemsetAsync((char*)d_ws + WS_CTL, 0, CTL_BYTES, stream);
    Params p{};
    for (int i = 0; i < 31; ++i) p.in[i] = (const float*)d_in[i];
    p.out = (float*)d_out; p.ws = (unsigned char*)d_ws;
    const int nph = NPHASE < DBG_CUT ? NPHASE : DBG_CUT;
#if MK_ONE_LAUNCH
    p.ph_lo = 0; p.ph_hi = nph;
    hipLaunchKernelGGL(mk_fwd, dim3(grid), dim3(512), LDS_BYTES, stream, p);
#else
    for (int ph = 0; ph < nph; ++ph) { p.ph_lo = ph; p.ph_hi = ph + 1; hipLaunchKernelGGL(mk_fwd, dim3(grid), dim3(512), LDS_BYTES, stream, p);
#ifdef DUP_PID
        if (ph == DUP_PID) {
#ifdef DUP_FLAG
            p.ph_hi |= (DUP_FLAG << 16);
#endif
            hipLaunchKernelGGL(mk_fwd, dim3(grid), dim3(512), LDS_BYTES, stream, p); }
#endif
    }
#endif
#if defined(DBG_ZCOLS)
    { unsigned* flag = (unsigned*)((char*)d_ws + 512 * 1024); (void)hipMemsetAsync(flag, 0, 256, stream);
#ifdef DBG_WROWS
      hipLaunchKernelGGL(dbg_wrows, dim3(1024), dim3(512), 0, stream, (const bf16_t*)((char*)d_ws + WS_WIN), flag);
#else
      hipLaunchKernelGGL(dbg_zcols, dim3(1024), dim3(512), 0, stream, (const bf16_t*)((char*)d_ws + WS_Z), flag);
#endif
      for (int i = 13; i <= 18; ++i) (void)hipMemsetAsync(flag + 1 + i, 1, 4, stream);
      hipLaunchKernelGGL(dbg_final, dim3(grid), dim3(512), 0, stream, (const float*)d_in[0], (const float*)d_in[30], (float*)d_out);
      hipLaunchKernelGGL(dbg_scale, dim3(1024), dim3(512), 0, stream, (float*)d_out, (const unsigned*)flag); }
#elif defined(DBG_CSUM)
    { unsigned* flag = (unsigned*)((char*)d_ws + 512 * 1024); (void)hipMemsetAsync(flag, 0, 256, stream);
      hipLaunchKernelGGL(dbg_csum, dim3(1024), dim3(512), 0, stream, (const unsigned*)((char*)d_ws + DBG_CSUM_OFF), (size_t)DBG_CSUM_WORDS, flag);
      hipLaunchKernelGGL(dbg_final, dim3(grid), dim3(512), 0, stream, (const float*)d_in[0], (const float*)d_in[30], (float*)d_out);
      hipLaunchKernelGGL(dbg_scale3, dim3(1024), dim3(512), 0, stream, (float*)d_out, (const unsigned*)flag); }
#elif defined(DBG_CLASS)
    { unsigned* flag = (unsigned*)((char*)d_ws + 512 * 1024); (void)hipMemsetAsync(flag, 0, 256, stream);
      hipLaunchKernelGGL(dbg_class, dim3(1024), dim3(512), 0, stream, (const bf16_t*)((char*)d_ws + DBG_CLASS_OFF), (size_t)DBG_CLASS_N, flag);
      hipLaunchKernelGGL(dbg_final, dim3(grid), dim3(512), 0, stream, (const float*)d_in[0], (const float*)d_in[30], (float*)d_out);
      hipLaunchKernelGGL(dbg_scale2, dim3(1024), dim3(512), 0, stream, (float*)d_out, (const unsigned*)flag); }
#elif defined(DBG_CHECK)
    { unsigned* flag = (unsigned*)((char*)d_ws + 512 * 1024); (void)hipMemsetAsync(flag, 0x7f, 4, stream); (void)hipMemsetAsync(flag + 1, 0, 128, stream);
      struct B { size_t off, n; int f32; }; const B bl[] = {
#ifdef DBG_DEAD
        {WS_WIN, (size_t)IN_WIDTH * D, 0}, {WS_XN, (size_t)M * D, 0},
#endif
        {WS_Z, (size_t)M * NZ, 0}, {WS_QH, (size_t)M * 1024, 0}, {WS_QH, (size_t)M * 1024, 0}, {WS_NT, (size_t)64 * 64 * 16384, 0}, {WS_DC, (size_t)64 * 64 * 128, 1},
        {WS_RP, (size_t)M * 1024, 0}, {WS_Y0, (size_t)M * 1024, 0}, {WS_MT, (size_t)M * 1024, 0}, {WS_NN, (size_t)M * 1024, 0}, {WS_RK, (size_t)M * 16, 1}, {WS_VFIRST, (size_t)M * 1024, 0},
        {WS_YHG, (size_t)M * 1024, 0}, {WS_SS, (size_t)M * 1024, 0}, {WS_YRW, (size_t)M * 1024, 0}, {WS_XN, (size_t)M * D, 0} };
#ifdef DBG_TRTEST
      hipLaunchKernelGGL(dbg_trtest, dim3(1), dim3(64), 0, stream, flag);
#endif
#ifdef DBG_H1TEST
      hipLaunchKernelGGL(dbg_h1test, dim3(1), dim3(512), 65536, stream, flag);
#endif
      for (unsigned i = 0; i < sizeof(bl) / sizeof(bl[0]); ++i) hipLaunchKernelGGL(dbg_check, dim3(1024), dim3(512), 0, stream, (const void*)((char*)d_ws + bl[i].off), bl[i].n, bl[i].f32, flag, i + 1);
      hipLaunchKernelGGL(dbg_check, dim3(1024), dim3(512), 0, stream, (const void*)d_out, (size_t)M * D, 1, flag, 18u);
      hipLaunchKernelGGL(dbg_final, dim3(grid), dim3(512), 0, stream, (const float*)d_in[0], (const float*)d_in[30], (float*)d_out);
      hipLaunchKernelGGL(dbg_scale, dim3(1024), dim3(512), 0, stream, (float*)d_out, (const unsigned*)flag); }
#elif DBG_CUT < 1000
    hipLaunchKernelGGL(dbg_final, dim3(grid), dim3(512), 0, stream, (const float*)(DBG_CUT <= 6 ? d_in[0] : d_out), (const float*)d_in[30], (float*)d_out);
#endif
}
```

```cpp
#define MK_ONE_LAUNCH 1
#include <hip/hip_runtime.h>
#include <stdint.h>
#include <stdio.h>
#ifndef MK_ONE_LAUNCH
#define MK_ONE_LAUNCH 0
#endif
#define DI __device__ __forceinline__
#define LAS __attribute__((address_space(3)))
typedef unsigned short bf16_t;
typedef short bf16x8 __attribute__((ext_vector_type(8)));
typedef short s16x4 __attribute__((ext_vector_type(4)));
typedef float f32x4 __attribute__((ext_vector_type(4)));
typedef float f32x2 __attribute__((ext_vector_type(2)));
typedef unsigned u32x4 __attribute__((ext_vector_type(4)));
typedef unsigned u32x2 __attribute__((ext_vector_type(2)));

constexpr int M = 16384, D = 2048, TSEQ = 2048, NBATCH = 8;
constexpr int NZ = 11776;
constexpr int ZC_Q = 0, ZC_F = 1024, ZC_I = 2048, ZC_O = 3072, ZC_R = 4096, ZC_K = 5120, ZC_V = 6144, ZC_WD = 7168, ZC_AD = 7232, ZC_GD = 7296,
              ZC_GA = 7456, ZC_GB = 9504, ZC_VDA = 11552, ZC_VDB = 11584;
constexpr int IN_WIDTH = 11552;
constexpr int NEXP = 32, DEXP = 512, MAXSLOTS = 40960;
constexpr float NORM_EPS = 1e-6f, RW_GN_EPS = 64e-5f;
constexpr size_t MiB = 1u << 20;
constexpr size_t WS_CTL = 0, CTL_BYTES = 1 * MiB;
constexpr size_t WS_TOKE = 1 * MiB, WS_TOKW = WS_TOKE + 128 * 1024, WS_TOKS = WS_TOKW + 128 * 1024, WS_CNT = WS_TOKS + 128 * 1024, WS_SRSTD = WS_CNT + 64 * 1024, WS_TRSTD = WS_SRSTD + 192 * 1024;
constexpr size_t WS_LORA = 2 * MiB;
constexpr size_t LO_WUP = 0, LO_AUP = 128 * 1024, LO_GUP = 256 * 1024, LO_VUP = 576 * 1024, LO_WR = 640 * 1024, LO_WRL = 832 * 1024;
constexpr size_t WS_WIN = 4 * MiB, WS_WBH = 50 * MiB, WS_WBR = 54 * MiB, WS_WO = 58 * MiB;
constexpr size_t WS_Z = 66 * MiB;
constexpr size_t WS_XS = WS_Z, WS_ACT = WS_Z + 160 * MiB, WS_YS = WS_Z + 200 * MiB;
constexpr size_t WS_XN = 434 * MiB;
constexpr size_t WS_YHG = 498 * MiB, WS_YRW = 530 * MiB, WS_VFIRST = 562 * MiB;
constexpr size_t WS_X = 594 * MiB;
constexpr size_t WS_NT = WS_X, WS_DC = WS_X + 128 * MiB, WS_QH = WS_X + 130 * MiB, WS_OI = WS_X + 162 * MiB;
constexpr size_t WS_MT = WS_X + 194 * MiB, WS_NN = WS_X + 226 * MiB, WS_RP = WS_X + 258 * MiB, WS_Y0 = WS_X + 290 * MiB, WS_SS = WS_X + 322 * MiB,
                 WS_RK = WS_X + 354 * MiB, WS_VF = WS_X + 355 * MiB;
constexpr size_t WS_WGU = 981 * MiB, WS_WDN = WS_X + 64 * MiB;
constexpr size_t WS_END = 1109 * MiB;
constexpr int CW_BAR = 4096;
constexpr size_t CTL_SLOTTOK = 256 * 1024;
constexpr int LDS_CTL_OFF = 148 * 1024, LDS_BYTES = 152 * 1024;
constexpr int LC_TOT = 16, LC_PAD = 48, LC_TILE = 96, LC_MISC = 256;

DI float bf2f(unsigned short b) { return __uint_as_float(((unsigned)b) << 16); }
typedef __bf16 nbf16x2 __attribute__((ext_vector_type(2)));
DI unsigned cvt_pk(float lo, float hi) { const f32x2 f = {lo, hi}; const nbf16x2 v = __builtin_convertvector(f, nbf16x2); return __builtin_bit_cast(unsigned, v); }
DI void unpack8(const u32x4 v, float (&f)[8]) {
    f[0] = __uint_as_float(v.x << 16); f[1] = __uint_as_float(v.x & 0xffff0000u); f[2] = __uint_as_float(v.y << 16); f[3] = __uint_as_float(v.y & 0xffff0000u);
    f[4] = __uint_as_float(v.z << 16); f[5] = __uint_as_float(v.z & 0xffff0000u); f[6] = __uint_as_float(v.w << 16); f[7] = __uint_as_float(v.w & 0xffff0000u); }
DI u32x4 pack8(const float (&f)[8]) { u32x4 v; v.x = cvt_pk(f[0], f[1]); v.y = cvt_pk(f[2], f[3]); v.z = cvt_pk(f[4], f[5]); v.w = cvt_pk(f[6], f[7]); return v; }
DI void unpack4(const u32x2 v, float (&f)[4]) { f[0] = __uint_as_float(v.x << 16); f[1] = __uint_as_float(v.x & 0xffff0000u); f[2] = __uint_as_float(v.y << 16); f[3] = __uint_as_float(v.y & 0xffff0000u); }
DI u32x2 pack4(float a, float b, float c, float d) { u32x2 v; v.x = cvt_pk(a, b); v.y = cvt_pk(c, d); return v; }
DI float sigm(float x) { return 1.0f / (1.0f + __expf(-x)); }
DI float wave_sum(float v) {
#pragma unroll
    for (int o = 1; o < 64; o <<= 1) v += __shfl_xor(v, o);
    return v;
}

DI void lds_barrier() { asm volatile("s_waitcnt lgkmcnt(0)\n\ts_barrier" ::: "memory"); }
namespace pg8 {
#define PG8_LAS __attribute__((address_space(3)))
typedef unsigned short bf16_t;
typedef short bf16x8 __attribute__((ext_vector_type(8)));
typedef float f32x4 __attribute__((ext_vector_type(4)));
typedef unsigned u32x4 __attribute__((ext_vector_type(4)));
constexpr int BM = 256, BK = 64, HALF = 128, HTB = HALF * BK * 2  , STAGE_BYTES = 8 * HTB, NXCD = 8, WGM = 8;

__host__ __device__ __forceinline__ int lds_byte(int r, int c) { const int st = (r >> 4) * 2 + (c >> 5), rr = r & 15, cc = c & 31, ob = rr * 64 + cc * 2; return st * 1024 + (ob ^ (((ob >> 9) & 1) << 5)); }
__host__ __device__ __forceinline__ void stage_rc(int b, int& R, int& C) { const int st = b / 1024, sb = b % 1024, swz = sb ^ (((sb >> 9) & 1) << 5); R = (st >> 1) * 16 + swz / 64; C = (st & 1) * 32 + (swz % 64) / 2; }
__host__ __device__ __forceinline__ int perm32(int rho) { const int n = rho >> 4, i = rho & 15; return 8 * (i >> 2) + 4 * n + (i & 3); }

struct Unit { int pm, pn; };
struct Gemm { const bf16_t* A; const bf16_t* Bt; int M, N, K; const int* amap = nullptr; };

struct StaticOrder {
    int nM, nN, nwg, G, c, wgm, hot = 0;
    __host__ __device__ void init(int M, int N, int G_, int c_, int wgm_ = WGM) { nM = M / BM; nN = N / BM; nwg = nM * nN; G = G_; c = c_; wgm = wgm_; }
    __host__ __device__ bool next(int i, Unit& u) const {
        const long L = (long)i * G + c; if (L >= nwg) return false;
        int wgid = (int)L; { const int q = nwg / NXCD, r = nwg % NXCD, xcd = wgid % NXCD, off = wgid / NXCD; wgid = (xcd < r ? xcd * (q + 1) : r * (q + 1) + (xcd - r) * q) + off; }
        const int nig = wgm * nN, gid = wgid / nig, fm = gid * wgm, gsz = (nM - fm) < wgm ? (nM - fm) : wgm;
        if (hot) { u.pm = 0; u.pn = 0; return true; }
        u.pm = fm + ((wgid % nig) % gsz); u.pn = (wgid % nig) / gsz; return true;
    }
    __device__ __forceinline__ void a_ready(const Unit&) const {}
    __device__ __forceinline__ void done(const Unit&) const {}
};
__device__ __forceinline__ unsigned cvt_pk_bf16(float lo, float hi) { return ::cvt_pk(lo, hi); }
typedef float f32x2 __attribute__((ext_vector_type(2)));
struct EpiBf16P {
    static constexpr bool PERM = true, AFTER_DRAIN = false;
    bf16_t* O; int ldc; int dbg;
    __device__ __forceinline__ void operator()(const f32x4 (&acc)[2][2][4][2], const Unit& u, int wr, int wc, int fr, int fq) const {
        if (dbg == 1) { float s = 0.f; _Pragma("unroll") for (int ai = 0; ai < 2; ++ai) _Pragma("unroll") for (int bj = 0; bj < 2; ++bj) _Pragma("unroll") for (int m = 0; m < 4; ++m) _Pragma("unroll") for (int n = 0; n < 2; ++n) s += acc[ai][bj][m][n][0] + acc[ai][bj][m][n][3]; asm volatile("" :: "v"(s)); return; }
        const int row0 = u.pm * BM + wr * 64 + fr, col0 = u.pn * BM + wc * 32 + 8 * fq;
#pragma unroll
        for (int ai = 0; ai < 2; ++ai)
#pragma unroll
            for (int m = 0; m < 4; ++m) { bf16_t* rowp = (dbg == 2 ? O + (size_t)(658 * 1024 * 1024 / 2) : O) + (size_t)(dbg == 2 ? (int)(blockIdx.x * 16 + fr) : row0 + ai * HALF + m * 16) * ldc + col0;
#pragma unroll
                for (int bj = 0; bj < 2; ++bj) { const f32x4 v0 = acc[ai][bj][m][0], v1 = acc[ai][bj][m][1];
                    u32x4 w; w.x = cvt_pk_bf16(v0[0], v0[1]); w.y = cvt_pk_bf16(v0[2], v0[3]); w.z = cvt_pk_bf16(v1[0], v1[1]); w.w = cvt_pk_bf16(v1[2], v1[3]);
                    *(u32x4*)(rowp + bj * HALF) = w; } asm volatile("" ::: "memory"); }
    }
};
struct EpiGate {
    static constexpr bool PERM = true, AFTER_DRAIN = false;
    bf16_t* O; int ldo; const bf16_t* Zg; int ldz; int accum; int dbg;
    __device__ __forceinline__ void operator()(const f32x4 (&acc)[2][2][4][2], const Unit& u, int wr, int wc, int fr, int fq) const {
        if (dbg) { float s = 0.f; _Pragma("unroll") for (int ai = 0; ai < 2; ++ai) _Pragma("unroll") for (int bj = 0; bj < 2; ++bj) _Pragma("unroll") for (int m = 0; m < 4; ++m) _Pragma("unroll") for (int n = 0; n < 2; ++n) s += acc[ai][bj][m][n][0] + acc[ai][bj][m][n][3]; asm volatile("" :: "v"(s)); return; }
        const int row0 = u.pm * BM + wr * 64 + fr, col0 = u.pn * BM + wc * 32 + 8 * fq;
#pragma unroll
        for (int ai = 0; ai < 2; ++ai) {
            u32x4 zg[4][2], pv[4][2];
#pragma unroll
            for (int m = 0; m < 4; ++m)
#pragma unroll
                for (int bj = 0; bj < 2; ++bj) { const size_t row = (size_t)(row0 + ai * HALF + m * 16); zg[m][bj] = *(const u32x4*)(Zg + row * ldz + col0 + bj * HALF);
                    if (accum) pv[m][bj] = *(const u32x4*)(O + row * ldo + col0 + bj * HALF); else pv[m][bj] = (u32x4){0u, 0u, 0u, 0u}; }
#pragma unroll
            for (int m = 0; m < 4; ++m)
#pragma unroll
                for (int bj = 0; bj < 2; ++bj) { const size_t row = (size_t)(row0 + ai * HALF + m * 16); const f32x4 v0 = acc[ai][bj][m][0], v1 = acc[ai][bj][m][1];
                    const unsigned zw[4] = {zg[m][bj].x, zg[m][bj].y, zg[m][bj].z, zg[m][bj].w}, pw[4] = {pv[m][bj].x, pv[m][bj].y, pv[m][bj].z, pv[m][bj].w};
                    float o[8];
#pragma unroll
                    for (int j = 0; j < 4; ++j) { const float z0 = __uint_as_float(zw[j] << 16), z1 = __uint_as_float(zw[j] & 0xffff0000u); const float a0 = j < 2 ? v0[2 * j] : v1[2 * j - 4], a1 = j < 2 ? v0[2 * j + 1] : v1[2 * j - 3];
                        o[2 * j] = a0 / (1.0f + __expf(-z0)) + __uint_as_float(pw[j] << 16); o[2 * j + 1] = a1 / (1.0f + __expf(-z1)) + __uint_as_float(pw[j] & 0xffff0000u); }
                    u32x4 w; w.x = cvt_pk_bf16(o[0], o[1]); w.y = cvt_pk_bf16(o[2], o[3]); w.z = cvt_pk_bf16(o[4], o[5]); w.w = cvt_pk_bf16(o[6], o[7]);
                    *(u32x4*)(O + row * ldo + col0 + bj * HALF) = w; }
            asm volatile("" ::: "memory");
        }
    }
};
struct EpiRes {
    static constexpr bool PERM = false, AFTER_DRAIN = false;
    const float* base; float* out; int ldc; int dbg;
    __device__ __forceinline__ void operator()(const f32x4 (&acc)[2][2][4][2], const Unit& u, int wr, int wc, int fr, int fq) const {
        if (dbg) { float s = 0.f; _Pragma("unroll") for (int ai = 0; ai < 2; ++ai) _Pragma("unroll") for (int bj = 0; bj < 2; ++bj) _Pragma("unroll") for (int m = 0; m < 4; ++m) _Pragma("unroll") for (int n = 0; n < 2; ++n) s += acc[ai][bj][m][n][0] + acc[ai][bj][m][n][3]; asm volatile("" :: "v"(s)); return; }
        const int row0 = u.pm * BM + wr * 64 + fr, col0 = u.pn * BM + wc * 32 + 4 * fq;
#pragma unroll
        for (int ai = 0; ai < 2; ++ai) {
            f32x4 bs[4][2][2];
#pragma unroll
            for (int m = 0; m < 4; ++m) { const size_t off = (size_t)(row0 + ai * HALF + m * 16) * ldc + col0;
#pragma unroll
                for (int bj = 0; bj < 2; ++bj)
#pragma unroll
                    for (int n = 0; n < 2; ++n) bs[m][bj][n] = *(const f32x4*)(base + off + bj * HALF + n * 16); }
#pragma unroll
            for (int m = 0; m < 4; ++m) { const size_t off = (size_t)(row0 + ai * HALF + m * 16) * ldc + col0;
#pragma unroll
                for (int bj = 0; bj < 2; ++bj)
#pragma unroll
                    for (int n = 0; n < 2; ++n) *(f32x4*)(out + off + bj * HALF + n * 16) = bs[m][bj][n] + acc[ai][bj][m][n]; }
            asm volatile("" ::: "memory");
        }
    }
};
struct EpiSwiGLU {
    static constexpr bool PERM = true, AFTER_DRAIN = false;
    bf16_t* O; const float* rstd; int dbg;
    __device__ __forceinline__ void operator()(const f32x4 (&acc)[2][2][4][2], const Unit& u, int wr, int wc, int fr, int fq) const {
        if (dbg) { float s = 0.f; _Pragma("unroll") for (int ai = 0; ai < 2; ++ai) _Pragma("unroll") for (int bj = 0; bj < 2; ++bj) _Pragma("unroll") for (int m = 0; m < 4; ++m) _Pragma("unroll") for (int n = 0; n < 2; ++n) s += acc[ai][bj][m][n][0] + acc[ai][bj][m][n][3]; asm volatile("" :: "v"(s)); return; }
        const int row0 = u.pm * BM + wr * 64 + fr, col0 = (u.pn & 3) * 128 + wc * 32 + 8 * fq;
        float rsv[2][4];
#pragma unroll
        for (int ai = 0; ai < 2; ++ai)
#pragma unroll
            for (int m = 0; m < 4; ++m) rsv[ai][m] = rstd[row0 + ai * HALF + m * 16];
#pragma unroll
        for (int ai = 0; ai < 2; ++ai)
#pragma unroll
            for (int m = 0; m < 4; ++m) { bf16_t* rowp = O + (size_t)(row0 + ai * HALF + m * 16) * 512 + col0; const float rs = rsv[ai][m];
                float o[8];
#pragma unroll
                for (int n = 0; n < 2; ++n)
#pragma unroll
                    for (int j = 0; j < 4; ++j) { const float g = acc[ai][0][m][n][j] * rs, up = acc[ai][1][m][n][j] * rs; o[4 * n + j] = g / (1.0f + __expf(-g)) * up; }
                u32x4 w; w.x = cvt_pk_bf16(o[0], o[1]); w.y = cvt_pk_bf16(o[2], o[3]); w.z = cvt_pk_bf16(o[4], o[5]); w.w = cvt_pk_bf16(o[6], o[7]);
                *(u32x4*)rowp = w; asm volatile("" ::: "memory"); }
    }
};
struct EpiDown {
    static constexpr bool PERM = true, AFTER_DRAIN = false;
    bf16_t* O; int dbg;
    __device__ __forceinline__ void operator()(const f32x4 (&acc)[2][2][4][2], const Unit& u, int wr, int wc, int fr, int fq) const {
        if (dbg) { float s = 0.f; _Pragma("unroll") for (int ai = 0; ai < 2; ++ai) _Pragma("unroll") for (int bj = 0; bj < 2; ++bj) _Pragma("unroll") for (int m = 0; m < 4; ++m) _Pragma("unroll") for (int n = 0; n < 2; ++n) s += acc[ai][bj][m][n][0] + acc[ai][bj][m][n][3]; asm volatile("" :: "v"(s)); return; }
        const int row0 = u.pm * BM + wr * 64 + fr, col0 = (u.pn & 7) * BM + wc * 32 + 8 * fq;
#pragma unroll
        for (int ai = 0; ai < 2; ++ai)
#pragma unroll
            for (int m = 0; m < 4; ++m) { bf16_t* rowp = O + (size_t)(row0 + ai * HALF + m * 16) * 2048 + col0;
#pragma unroll
                for (int bj = 0; bj < 2; ++bj) { const f32x4 v0 = acc[ai][bj][m][0], v1 = acc[ai][bj][m][1];
                    u32x4 w; w.x = cvt_pk_bf16(v0[0], v0[1]); w.y = cvt_pk_bf16(v0[2], v0[3]); w.z = cvt_pk_bf16(v1[0], v1[1]); w.w = cvt_pk_bf16(v1[2], v1[3]);
                    *(u32x4*)(rowp + bj * HALF) = w; } asm volatile("" ::: "memory"); }
    }
};
template <int NTN> struct GroupedOrder {
    static constexpr int ntn = NTN; int nunits, G, c; const PG8_LAS int* tile_e;
    __device__ __forceinline__ bool next(int i, Unit& u) const { const long L = (long)i * G + c; if (L >= nunits) return false; const int rt = (int)L / ntn, pl = (int)L % ntn; u.pm = rt; u.pn = tile_e[rt] * ntn + pl; return true; }
    __device__ __forceinline__ void a_ready(const Unit&) const {}
    __device__ __forceinline__ void done(const Unit&) const {}
};
template <class Epi, class Sched, bool STAMP = false, bool GATHER = false>
__device__ __forceinline__ void gemm_phase(PG8_LAS unsigned char* lds, const Gemm g, const Sched& S, const Epi& E, unsigned long long* stamps) {
    int tid_ = threadIdx.x; asm volatile("" : "+v"(tid_));
    const int tid = tid_, wid = __builtin_amdgcn_readfirstlane(tid >> 6), lane = tid & 63, wr = wid >> 2, wc = wid & 3, fr = lane & 15, fq = lane >> 4;
    const int K = g.K, nt = K / BK;
    int ts_lo = 0, ts_hi = 0, nts = 0; const unsigned long long rt_entry = STAMP ? (unsigned long long)wall_clock64() : 0ull;
#define PG8_STAMP() do { if (STAMP && wid == 0 && nts < 64) { const unsigned long long _c = (unsigned long long)clock64(); \
        ts_lo = (lane == nts) ? (int)(unsigned)_c : ts_lo; ts_hi = (lane == nts) ? (int)(unsigned)(_c >> 32) : ts_hi; ++nts; } } while (0)
    PG8_STAMP();
    unsigned voffA[2], voffB[2]; int gR[2]; unsigned gC[2];
#pragma unroll
    for (int i = 0; i < 2; ++i) { int R, C; stage_rc(tid * 16 + i * 8192, R, C); const int Rb = Epi::PERM ? ((R & ~31) + perm32(R & 31)) : R;
        voffA[i] = (unsigned)(R * K + C) * 2u; voffB[i] = (unsigned)(Rb * K + C) * 2u; gR[i] = R; gC[i] = (unsigned)C * 2u; }
    const size_t kstep = (size_t)(BK * 2);
    const size_t hstep = (size_t)HALF * K * 2;
    const size_t tstep = 2 * hstep;
    const unsigned ldsw = (unsigned)wid * 1024u;
    const int aoff = lds_byte(wr * 64 + fr, fq * 8), boff = lds_byte(wc * 32 + fr, fq * 8);
#define PG8_SA(b, h) (((b) * 2 + (h)) * HTB)
#define PG8_SB(b, h) ((4 + (b) * 2 + (h)) * HTB)
#define PG8_STAGE(bufoff, gbase, voff) do { _Pragma("unroll") for (int _i = 0; _i < 2; ++_i) \
        __builtin_amdgcn_global_load_lds((const unsigned*)((const char*)(gbase) + (voff)[_i]), (PG8_LAS unsigned*)(lds + (bufoff) + ldsw + _i * 8192), 16, 0, 0); } while (0)
#define PG8_LDA(dst, b, h) do { _Pragma("unroll") for (int m = 0; m < 4; ++m) _Pragma("unroll") for (int k = 0; k < 2; ++k) dst[m][k] = *(const PG8_LAS bf16x8*)(lds + PG8_SA(b, h) + aoff + m * 2048 + k * 1024); } while (0)
#define PG8_LDB(dst, b, h) do { _Pragma("unroll") for (int n = 0; n < 2; ++n) _Pragma("unroll") for (int k = 0; k < 2; ++k) dst[n][k] = *(const PG8_LAS bf16x8*)(lds + PG8_SB(b, h) + boff + n * 2048 + k * 1024); } while (0)
#define PG8_MMA(ai, bj, At, Bt) do { __builtin_amdgcn_s_setprio(1); _Pragma("unroll") for (int m = 0; m < 4; ++m) _Pragma("unroll") for (int n = 0; n < 2; ++n) _Pragma("unroll") for (int k = 0; k < 2; ++k) \
        acc[ai][bj][m][n] = __builtin_amdgcn_mfma_f32_16x16x32_bf16(Bt[n][k], At[m][k], acc[ai][bj][m][n], 0, 0, 0); __builtin_amdgcn_s_setprio(0); } while (0)
#define PG8_WAIT_V(n) asm volatile("s_waitcnt vmcnt(" #n ")" ::: "memory")
#define PG8_WAIT_L(n) asm volatile("s_waitcnt lgkmcnt(" #n ")" ::: "memory")
#define PG8_BAR __builtin_amdgcn_s_barrier()
#define PG8_SCHED __builtin_amdgcn_sched_barrier(0)
    Unit cur, nxt; int ui = 0;
    if (!S.next(0, cur)) return;
    f32x4 acc[2][2][4][2];
#pragma unroll
    for (int a = 0; a < 2; ++a)
#pragma unroll
        for (int b = 0; b < 2; ++b)
#pragma unroll
            for (int m = 0; m < 4; ++m)
#pragma unroll
                for (int n = 0; n < 2; ++n) acc[a][b][m][n] = (f32x4){0.f, 0.f, 0.f, 0.f};
    bf16x8 At[4][2], B0[2][2], B1[2][2];
    const char* cA = (const char*)g.A + (size_t)cur.pm * tstep; const char* cB = (const char*)g.Bt + (size_t)cur.pn * tstep;
    const char* gA = (const char*)g.A; unsigned voC[2][2], voN[2][2];
#define PG8_GATH(vo, u) do { _Pragma("unroll") for (int _h = 0; _h < 2; ++_h) _Pragma("unroll") for (int _i = 0; _i < 2; ++_i) \
        vo[_h][_i] = (unsigned)g.amap[(u).pm * BM + _h * HALF + gR[_i]] * (unsigned)(K * 2) + gC[_i]; } while (0)
    if constexpr (GATHER) { PG8_GATH(voC, cur); }
    S.a_ready(cur);
    PG8_STAGE(PG8_SB(0, 0), cB, voffB); if constexpr (GATHER) PG8_STAGE(PG8_SA(0, 0), gA, voC[0]); else PG8_STAGE(PG8_SA(0, 0), cA, voffA);
    PG8_STAGE(PG8_SB(0, 1), cB + hstep, voffB); if constexpr (GATHER) PG8_STAGE(PG8_SA(0, 1), gA, voC[1]); else PG8_STAGE(PG8_SA(0, 1), cA + hstep, voffA);
    if (wr == 1) PG8_BAR;
    PG8_WAIT_V(4); PG8_BAR;
    PG8_STAGE(PG8_SB(1, 0), cB + kstep, voffB); if constexpr (GATHER) PG8_STAGE(PG8_SA(1, 0), gA + kstep, voC[0]); else PG8_STAGE(PG8_SA(1, 0), cA + kstep, voffA);
    PG8_STAGE(PG8_SB(1, 1), cB + hstep + kstep, voffB);
    PG8_WAIT_V(6); PG8_BAR;
    PG8_STAMP();
    for (;;) {
        const bool has_next = S.next(ui + 1, nxt);
        if constexpr (GATHER) { if (has_next) { PG8_GATH(voN, nxt); } else { _Pragma("unroll") for (int _h = 0; _h < 2; ++_h) _Pragma("unroll") for (int _i = 0; _i < 2; ++_i) voN[_h][_i] = voC[_h][_i]; } }
        const char* nA = has_next ? (const char*)g.A + (size_t)nxt.pm * tstep : cA; const char* nB = has_next ? (const char*)g.Bt + (size_t)nxt.pn * tstep : cB;
        for (int t = 0; t < nt; t += 2) {
            const bool last = (t == nt - 2);
            const char* a1 = cA + (size_t)(t + 1) * kstep;
            const char* a2 = last ? nA : cA + (size_t)(t + 2) * kstep; const char* b2 = last ? nB : cB + (size_t)(t + 2) * kstep;
            const char* a3 = a2 + kstep; const char* b3 = b2 + kstep;
            const char* g1 = gA + (size_t)(t + 1) * kstep; const char* g2 = last ? gA : gA + (size_t)(t + 2) * kstep; const char* g3 = g2 + kstep; unsigned v2[2][2];
            if constexpr (GATHER) { _Pragma("unroll") for (int _h = 0; _h < 2; ++_h) _Pragma("unroll") for (int _i = 0; _i < 2; ++_i) v2[_h][_i] = last ? voN[_h][_i] : voC[_h][_i]; }
            if (last && has_next) S.a_ready(nxt);
            PG8_LDB(B0, 0, 0); PG8_SCHED; PG8_LDA(At, 0, 0); if constexpr (GATHER) PG8_STAGE(PG8_SA(1, 1), g1, voC[1]); else PG8_STAGE(PG8_SA(1, 1), a1 + hstep, voffA);
            PG8_WAIT_L(8); PG8_BAR; PG8_WAIT_L(0); PG8_MMA(0, 0, At, B0); PG8_BAR; PG8_SCHED;
            PG8_LDB(B1, 0, 1); PG8_STAGE(PG8_SB(0, 0), b2, voffB);
            PG8_BAR; PG8_WAIT_L(0); PG8_MMA(0, 1, At, B1); PG8_BAR;
            PG8_LDA(At, 0, 1); if constexpr (GATHER) PG8_STAGE(PG8_SA(0, 0), g2, v2[0]); else PG8_STAGE(PG8_SA(0, 0), a2, voffA);
            PG8_BAR; PG8_WAIT_L(0); PG8_MMA(1, 0, At, B0); PG8_BAR; PG8_SCHED;
            PG8_STAGE(PG8_SB(0, 1), b2 + hstep, voffB);
            PG8_WAIT_V(6); PG8_BAR; PG8_MMA(1, 1, At, B1); PG8_BAR;
            PG8_LDB(B0, 1, 0); PG8_SCHED; PG8_LDA(At, 1, 0); if constexpr (GATHER) PG8_STAGE(PG8_SA(0, 1), g2, v2[1]); else PG8_STAGE(PG8_SA(0, 1), a2 + hstep, voffA);
            PG8_WAIT_L(8); PG8_BAR; PG8_WAIT_L(0); PG8_MMA(0, 0, At, B0); PG8_BAR; PG8_SCHED;
            PG8_LDB(B1, 1, 1); PG8_STAGE(PG8_SB(1, 0), b3, voffB);
            PG8_BAR; PG8_WAIT_L(0); PG8_MMA(0, 1, At, B1); PG8_BAR;
            PG8_LDA(At, 1, 1); if constexpr (GATHER) PG8_STAGE(PG8_SA(1, 0), g3, v2[0]); else PG8_STAGE(PG8_SA(1, 0), a3, voffA);
            PG8_BAR; PG8_WAIT_L(0); PG8_MMA(1, 0, At, B0); PG8_BAR; PG8_SCHED;
            PG8_STAGE(PG8_SB(1, 1), b3 + hstep, voffB);
            PG8_WAIT_V(6); PG8_BAR; PG8_MMA(1, 1, At, B1); PG8_BAR;
        }
        PG8_STAMP();
        if constexpr (!Epi::AFTER_DRAIN) { E(acc, cur, wr, wc, fr, fq); S.done(cur); }
        PG8_STAMP();
        if (!has_next) break;
#pragma unroll
        for (int a = 0; a < 2; ++a)
#pragma unroll
            for (int b = 0; b < 2; ++b)
#pragma unroll
                for (int m = 0; m < 4; ++m)
#pragma unroll
                    for (int n = 0; n < 2; ++n) acc[a][b][m][n] = (f32x4){0.f, 0.f, 0.f, 0.f};
        cur = nxt; cA = nA; cB = nB; ++ui;
        if constexpr (GATHER) { _Pragma("unroll") for (int _h = 0; _h < 2; ++_h) _Pragma("unroll") for (int _i = 0; _i < 2; ++_i) voC[_h][_i] = voN[_h][_i]; }
    }
    PG8_WAIT_V(0);
    if (wr == 0) PG8_BAR;
    PG8_BAR;
    if constexpr (Epi::AFTER_DRAIN) { E.fused(acc, cur, wr, wc, fr, fq, lds, wid, lane); S.done(cur); }
    PG8_STAMP();
    if (STAMP && wid == 0) { stamps[lane] = lane < nts ? (((unsigned long long)(unsigned)ts_hi << 32) | (unsigned)ts_lo) : 0ull;
        if (lane == 62) stamps[62] = rt_entry; if (lane == 63) stamps[63] = (unsigned long long)wall_clock64(); }
#undef PG8_STAMP
#undef PG8_SA
#undef PG8_SB
#undef PG8_STAGE
#undef PG8_GATH
#undef PG8_LDA
#undef PG8_LDB
#undef PG8_MMA
#undef PG8_WAIT_V
#undef PG8_WAIT_L
#undef PG8_BAR
#undef PG8_SCHED
}
}
#define XB_TMO      128
#define XB_XCNT(j)  (256  + 64 * (j))
#define XB_XSUB(j)  (1280 + 64 * (j))
#define XB_XGEN(j)  (2304 + 64 * (j))
#define XB_TOP      3328
#define XB_TOPGEN   3392
#define XCD_BAR_WORDS 3456
#define XB_SPIN_CAP (1u << 18)

__device__ __forceinline__ unsigned xb_ld(unsigned* p)              { return __hip_atomic_load(p, __ATOMIC_RELAXED, __HIP_MEMORY_SCOPE_AGENT); }
__device__ __forceinline__ unsigned xb_add(unsigned* p, unsigned v) { return __hip_atomic_fetch_add(p, v, __ATOMIC_RELAXED, __HIP_MEMORY_SCOPE_AGENT); }
__device__ __forceinline__ unsigned xb_xcc_id() { return (unsigned)__builtin_amdgcn_s_getreg((3 << 11) | 20) & 0xFu; }
#define XB_SPIN(cond, bar) do { unsigned _sp = 0; while (cond) { __builtin_amdgcn_s_sleep(1); \
    if ((++_sp & 255u) == 0u) { if (xb_ld(&(bar)[XB_TMO])) break; if (_sp > XB_SPIN_CAP) { atomicAdd(&(bar)[XB_TMO], 1u); break; } } } } while (0)

struct XcdBarrier {
    unsigned* bar; unsigned x;
    volatile LAS unsigned* st;
};

__device__ __forceinline__ XcdBarrier xcd_barrier_post(unsigned* bar, volatile LAS unsigned* st) {
    XcdBarrier b; b.bar = bar; b.x = xb_xcc_id(); b.st = st;
    if (threadIdx.x == 0) (void)xb_add(&bar[XB_XCNT(b.x)], 1u);
    return b;
}
__device__ __forceinline__ void xcd_barrier_complete(unsigned* bar, unsigned x, unsigned& nloc, unsigned& nx) {
    const unsigned G = gridDim.x * gridDim.y * gridDim.z;
    unsigned sum, cnt, mine, sp = 0u;
    for (;;) {
        sum = 0u; cnt = 0u; mine = 0u;
#pragma unroll
        for (unsigned j = 0; j < 16; ++j) { const unsigned c = xb_ld(&bar[XB_XCNT(j)]); sum += c; cnt += (c > 0u) ? 1u : 0u; mine = (j == x) ? c : mine; }
        if (sum == G) break;
        __builtin_amdgcn_s_sleep(1);
        if ((++sp & 255u) == 0u) { if (xb_ld(&bar[XB_TMO])) break; if (sp > XB_SPIN_CAP) { atomicAdd(&bar[XB_TMO], 1u); break; } }
    }
    nloc = mine > 0u ? mine : 1u; nx = cnt > 0u ? cnt : 1u;
}

__device__ __forceinline__ void xcd_barrier(const XcdBarrier& b) {
    asm volatile("s_waitcnt vmcnt(0)" ::: "memory");
    __syncthreads();
    if (threadIdx.x == 0) {
        unsigned* bar = b.bar;
        __builtin_amdgcn_s_waitcnt(0);
        unsigned nloc = b.st[0], nx = b.st[1];
        if (nloc == 0u) { xcd_barrier_complete(bar, b.x, nloc, nx); b.st[0] = nloc; b.st[1] = nx; }
        const unsigned old = xb_add(&bar[XB_XSUB(b.x)], 1u);
        const unsigned gen = old / nloc;
        if (old + 1u == (gen + 1u) * nloc) {
            __builtin_amdgcn_fence(__ATOMIC_RELEASE, "agent");
            asm volatile("s_waitcnt vmcnt(0)" ::: "memory");
            const unsigned og = xb_add(&bar[XB_TOP], 1u);
            const unsigned tg = og / nx;
            if (og + 1u == (tg + 1u) * nx) xb_add(&bar[XB_TOPGEN], 1u);
            else XB_SPIN(xb_ld(&bar[XB_TOPGEN]) == tg, bar);
            __builtin_amdgcn_fence(__ATOMIC_ACQUIRE, "agent");
            xb_add(&bar[XB_XGEN(b.x)], 1u);
            asm volatile("s_waitcnt vmcnt(0)" ::: "memory");
        } else {
            XB_SPIN(xb_ld(&bar[XB_XGEN(b.x)]) == gen, bar);
            __builtin_amdgcn_fence(__ATOMIC_ACQUIRE, "agent");
            asm volatile("s_waitcnt vmcnt(0)" ::: "memory");
        }
    }
    __syncthreads();
}
template <int LD> DI bf16x8 frag_n(const LAS bf16_t* A, int row0, int k0, int lane) {
    return *(const LAS bf16x8*)(A + (row0 + (lane & 15)) * LD + k0 + 8 * (lane >> 4));
}
template <int LD> DI bf16x8 frag_t(const LAS bf16_t* A, int row0, int k0, int lane) {
    const int l = lane & 15, g = lane >> 4;
    const unsigned addr = (unsigned)(uintptr_t)(A + (k0 + 8 * g + (l >> 2)) * LD + row0 + 4 * (l & 3));
    s16x4 lo, hi;
    asm volatile("ds_read_b64_tr_b16 %0, %2\n\tds_read_b64_tr_b16 %1, %2 offset:%3\n\ts_waitcnt lgkmcnt(0)" : "=&v"(lo), "=&v"(hi) : "v"(addr), "n"(4 * LD * 2) : "memory");
    bf16x8 r; r[0] = lo[0]; r[1] = lo[1]; r[2] = lo[2]; r[3] = lo[3]; r[4] = hi[0]; r[5] = hi[1]; r[6] = hi[2]; r[7] = hi[3];
    return r;
}
DI bf16x8 gfrag(const bf16_t* A, int ld, int row0, int k0, int lane) {
    return *(const bf16x8*)(A + (size_t)(row0 + (lane & 15)) * ld + k0 + 8 * (lane >> 4));
}
#define MFMA16(a, b, c) __builtin_amdgcn_mfma_f32_16x16x32_bf16((a), (b), (c), 0, 0, 0)
template <bool XT, bool YT, int KS, int LDX, int LDY>
DI f32x4 mm16(const LAS bf16_t* X, const LAS bf16_t* Y, int p0, int q0, int lane, f32x4 acc) {
#pragma unroll
    for (int ks = 0; ks < KS; ++ks) {
        const bf16x8 xb = XT ? frag_t<LDX>(X, p0, 32 * ks, lane) : frag_n<LDX>(X, p0, 32 * ks, lane);
        const bf16x8 ya = YT ? frag_t<LDY>(Y, q0, 32 * ks, lane) : frag_n<LDY>(Y, q0, 32 * ks, lane);
        acc = MFMA16(ya, xb, acc);
    }
    return acc;
}
DI void st4_bf16(LAS bf16_t* p, const f32x4 v) { *(LAS u32x2*)p = pack4(v[0], v[1], v[2], v[3]); }
DI f32x4 ld4_bf16(const LAS bf16_t* p) { const u32x2 w = *(const LAS u32x2*)p; float f[4]; unpack4(w, f); return (f32x4){f[0], f[1], f[2], f[3]}; }
constexpr f32x4 F4Z = {0.f, 0.f, 0.f, 0.f};

struct TrFrag { s16x4 lo, hi; };
template <int LD> DI void tr_issue(TrFrag& f, const LAS bf16_t* A, int row0, int k0, int lane) {
    const int l = lane & 15, g = lane >> 4;
    const unsigned addr = (unsigned)(uintptr_t)(A + (k0 + 8 * g + (l >> 2)) * LD + row0 + 4 * (l & 3));
    asm volatile("ds_read_b64_tr_b16 %0, %2\n\tds_read_b64_tr_b16 %1, %2 offset:%3" : "=&v"(f.lo), "=&v"(f.hi) : "v"(addr), "n"(4 * LD * 2) : "memory");
}
DI bf16x8 tr_get(const TrFrag& f) { bf16x8 r; r[0] = f.lo[0]; r[1] = f.lo[1]; r[2] = f.lo[2]; r[3] = f.lo[3]; r[4] = f.hi[0]; r[5] = f.hi[1]; r[6] = f.hi[2]; r[7] = f.hi[3]; return r; }
template <int LD> DI void tr_issue4(TrFrag (&f)[2][2], const LAS bf16_t* A, int r0, int lane) {
    tr_issue<LD>(f[0][0], A, r0, 0, lane); tr_issue<LD>(f[0][1], A, r0, 32, lane); tr_issue<LD>(f[1][0], A, r0 + 16, 0, lane); tr_issue<LD>(f[1][1], A, r0 + 16, 32, lane); }
template <int LD> DI void tr_issue2(TrFrag (&f)[2], const LAS bf16_t* A, int r0, int lane) { tr_issue<LD>(f[0], A, r0, 0, lane); tr_issue<LD>(f[1], A, r0, 32, lane); }
#define TRW(f) "+v"((f).lo), "+v"((f).hi)
DI void tr_wait4(TrFrag (&a)[2][2]) { asm volatile("s_waitcnt lgkmcnt(0)" : TRW(a[0][0]), TRW(a[0][1]), TRW(a[1][0]), TRW(a[1][1]) :: "memory"); }
DI void tr_wait8(TrFrag (&a)[2][2], TrFrag (&b)[2][2]) { asm volatile("s_waitcnt lgkmcnt(0)" : TRW(a[0][0]), TRW(a[0][1]), TRW(a[1][0]), TRW(a[1][1]), TRW(b[0][0]), TRW(b[0][1]), TRW(b[1][0]), TRW(b[1][1]) :: "memory"); }
DI void tr_wait2(TrFrag (&a)[2]) { asm volatile("s_waitcnt lgkmcnt(0)" : TRW(a[0]), TRW(a[1]) :: "memory"); }
DI void tr_wait42(TrFrag (&a)[2][2], TrFrag (&b)[2]) { asm volatile("s_waitcnt lgkmcnt(0)" : TRW(a[0][0]), TRW(a[0][1]), TRW(a[1][0]), TRW(a[1][1]), TRW(b[0]), TRW(b[1]) :: "memory"); }
DI f32x4 mma2(const bf16x8 x0, const bf16x8 x1, const bf16x8 y0, const bf16x8 y1, f32x4 acc) { acc = MFMA16(y0, x0, acc); return MFMA16(y1, x1, acc); }
struct Params { const float* in[31]; float* out; unsigned char* ws; int ph_lo, ph_hi; };
#define CAS __attribute__((address_space(4)))
typedef const CAS Params& PR;
enum { I_X = 0, I_NMIX, I_WIN, I_LBRAW, I_ONORM, I_MU, I_W0, I_WUP, I_A0, I_AUP, I_GUP, I_KK, I_KA, I_RK, I_LNW, I_LNB, I_V0, I_VDOWN, I_VUP, I_WBH, I_WBR, I_WOUT, I_NFFN,
       I_RGW, I_RGB, I_REW, I_REB, I_EWG, I_EWU, I_EWD, I_FNW };
struct Ctx { LAS unsigned char* lds; int tid, lane, wave, G, bid; };

struct TItem { const float* W; bf16_t* WT; int ldw, ldt; };
DI void titem_load(const TItem& t, f32x4 (&v)[8], int lane) {
#pragma unroll
    for (int i = 0; i < 8; ++i) v[i] = __builtin_nontemporal_load((const f32x4*)(t.W + (size_t)(8 * i + (lane >> 3)) * t.ldw + 4 * (lane & 7)));
}
DI void titem_store(const TItem& t, const f32x4 (&v)[8], LAS float* scr, int lane) {
#pragma unroll
    for (int i = 0; i < 8; ++i) { LAS float* d = scr + (8 * i + (lane >> 3)) * 33 + 4 * (lane & 7); d[0] = v[i].x; d[1] = v[i].y; d[2] = v[i].z; d[3] = v[i].w; }
    asm volatile("s_waitcnt lgkmcnt(0)" ::: "memory");
    const int c = lane & 7;
#pragma unroll
    for (int j = 0; j < 4; ++j) { const int n = (lane >> 3) + 8 * j; const LAS float* s = scr + (8 * c) * 33 + n;
        u32x4 o; o.x = cvt_pk(s[0 * 33], s[1 * 33]); o.y = cvt_pk(s[2 * 33], s[3 * 33]); o.z = cvt_pk(s[4 * 33], s[5 * 33]); o.w = cvt_pk(s[6 * 33], s[7 * 33]);
        *(u32x4*)(t.WT + (size_t)n * t.ldt + 8 * c) = o; }
    asm volatile("s_waitcnt lgkmcnt(0)" ::: "memory");
}
DI TItem mk_titem(const float* W, int ldw, int k0, int n0, bf16_t* WT, int ldt, int drow0) { TItem t; t.W = W + (size_t)k0 * ldw + n0; t.WT = WT + (size_t)drow0 * ldt + k0; t.ldw = ldw; t.ldt = ldt; return t; }
DI TItem small_item(PR p, int l, int it) {
    unsigned char* ws = p.ws;
    constexpr int I_IN = 32 * 361, I_B = 16 * 64;
    int r = it;
    if (r < I_IN) return mk_titem(p.in[I_WIN] + (size_t)l * D * IN_WIDTH, IN_WIDTH, 64 * (r / 361), 32 * (r % 361), (bf16_t*)(ws + WS_WIN), D, 32 * (r % 361)); r -= I_IN;
    if (r < I_B) return mk_titem(p.in[I_WBH] + (size_t)l * 1024 * D, D, 64 * (r / 64), 32 * (r % 64), (bf16_t*)(ws + WS_WBH), 1024, 32 * (r % 64)); r -= I_B;
    if (r < I_B) return mk_titem(p.in[I_WBR] + (size_t)l * 1024 * D, D, 64 * (r / 64), 32 * (r % 64), (bf16_t*)(ws + WS_WBR), 1024, 32 * (r % 64)); r -= I_B;
    return mk_titem(p.in[I_WOUT] + (size_t)l * D * D, D, 64 * (r / 64), 32 * (r % 64), (bf16_t*)(ws + WS_WO), D, 32 * (r % 64));
}
DI TItem expert_item(PR p, int l, int it) {
    unsigned char* ws = p.ws;
    constexpr int PER_GU = 32 * 16, PER_D = 8 * 64;
    const int e = it / (2 * PER_GU + PER_D); int r = it % (2 * PER_GU + PER_D);
    if (r < 2 * PER_GU) { const int up = r >= PER_GU; if (up) r -= PER_GU; const int kb = r / 16, nb = r % 16, j0 = 32 * nb;
        return mk_titem((up ? p.in[I_EWU] : p.in[I_EWG]) + ((size_t)l * NEXP + e) * D * DEXP, DEXP, 64 * kb, j0, (bf16_t*)(ws + WS_WGU) + (size_t)e * 1024 * D, D, 256 * (j0 >> 7) + (j0 & 127) + (up ? 128 : 0)); }
    r -= 2 * PER_GU; const int kb = r / 64, nb = r % 64;
    return mk_titem(p.in[I_EWD] + ((size_t)l * NEXP + e) * DEXP * D, D, 64 * kb, 32 * nb, (bf16_t*)(ws + WS_WDN) + (size_t)e * D * DEXP, DEXP, 32 * nb);
}
template <bool EXPERT> DI void run_titems(PR p, const Ctx& c, int l, int lo, int hi, int wg0, int nwg) {
    LAS float* scr = (LAS float*)(c.lds + c.wave * 8448);
    const int gw = (c.bid - wg0) * 8 + c.wave, NGW = nwg * 8;
    for (int it = lo + gw; it < hi; it += 2 * NGW) {
        const int it2 = it + NGW; const bool has2 = it2 < hi;
        const TItem a = EXPERT ? expert_item(p, l, it) : small_item(p, l, it), b = EXPERT ? expert_item(p, l, has2 ? it2 : it) : small_item(p, l, has2 ? it2 : it);
        f32x4 va[8], vb[8]; titem_load(a, va, c.lane); titem_load(b, vb, c.lane);
        titem_store(a, va, scr, c.lane); if (has2) titem_store(b, vb, scr, c.lane);
    }
}
constexpr int SMALL_ITEMS = 32 * 361 + 2 * 16 * 64 + 32 * 64;
DI void convert_small(PR p, const Ctx& c, int l, int lo) {
    unsigned char* ws = p.ws;
    const int gw = c.bid * 8 + c.wave, NGW = c.G * 8;
    bf16_t* WIN = (bf16_t*)(ws + WS_WIN);
    const float* w_in = p.in[I_WIN] + (size_t)l * D * IN_WIDTH;
    run_titems<false>(p, c, l, lo, SMALL_ITEMS, 0, c.G);
    const int gt = c.bid * 512 + c.tid, NT = c.G * 512;
    bf16_t* WUPT = (bf16_t*)(ws + WS_LORA + LO_WUP); bf16_t* AUPT = (bf16_t*)(ws + WS_LORA + LO_AUP); bf16_t* GUPT = (bf16_t*)(ws + WS_LORA + LO_GUP); bf16_t* VUPT = (bf16_t*)(ws + WS_LORA + LO_VUP);
    bf16_t* WRH = (bf16_t*)(ws + WS_LORA + LO_WR); bf16_t* WRL = (bf16_t*)(ws + WS_LORA + LO_WRL);
    const float* wup = p.in[I_WUP] + (size_t)l * 64 * 1024; const float* aup = p.in[I_AUP] + (size_t)l * 64 * 1024; const float* gup = p.in[I_GUP] + (size_t)l * 160 * 1024;
    for (int i = gt; i < 1024 * 64; i += NT) { const int n = i >> 6, k = i & 63; WUPT[i] = (bf16_t)(cvt_pk(wup[k * 1024 + n], 0.f) & 0xffff); AUPT[i] = (bf16_t)(cvt_pk(aup[k * 1024 + n], 0.f) & 0xffff); }
    for (int i = gt; i < 1024 * 160; i += NT) { const int n = i / 160, k = i % 160; GUPT[i] = (bf16_t)(cvt_pk(gup[k * 1024 + n], 0.f) & 0xffff); }
    if (l == 1) { const float* vup = p.in[I_VUP]; for (int i = gt; i < 1024 * 32; i += NT) { const int n = i >> 5, k = i & 31; VUPT[i] = (bf16_t)(cvt_pk(vup[k * 1024 + n], 0.f) & 0xffff); } }
    const float* rgw = p.in[I_RGW] + (size_t)l * D * 4; const float* rew = p.in[I_REW] + (size_t)l * D * 32;
    for (int i = gt; i < 48 * 2048; i += NT) { const int cc = i >> 11, k = i & 2047; const float v = cc < 4 ? rgw[k * 4 + cc] : (cc < 36 ? rew[k * 32 + (cc - 4)] : 0.f);
        const unsigned hb = cvt_pk(v, 0.f) & 0xffffu; WRH[i] = (bf16_t)hb; WRL[i] = (bf16_t)(cvt_pk(v - __uint_as_float(hb << 16), 0.f) & 0xffffu); }
    if (l == 1) {
        const float* mu = p.in[I_MU] + 3360 + 2048; const float* vd = p.in[I_VDOWN];
        LAS float* vdT = (LAS float*)c.lds;
        __syncthreads();
#pragma unroll
        for (int i = 0; i < 16; ++i) { const int idx = c.tid + 512 * i, cc = idx >> 3, n4 = (idx & 7) * 4; const f32x4 v = *(const f32x4*)(vd + (size_t)cc * 32 + n4);
            vdT[(n4 + 0) * 1025 + cc] = v.x; vdT[(n4 + 1) * 1025 + cc] = v.y; vdT[(n4 + 2) * 1025 + cc] = v.z; vdT[(n4 + 3) * 1025 + cc] = v.w; }
        __syncthreads();
        for (int k = gw; k < D; k += NGW) {
            float wv[16], wm[16];
#pragma unroll
            for (int j2 = 0; j2 < 16; ++j2) { const int cc = c.lane + 64 * j2; const float w = w_in[(size_t)k * IN_WIDTH + 6144 + cc], m = mu[cc]; wv[j2] = w * (1.f - m); wm[j2] = w * m; }
#pragma unroll 1
            for (int g8 = 0; g8 < 4; ++g8) {
                float v[16];
#pragma unroll
                for (int q = 0; q < 8; ++q) { const int n = 8 * g8 + q; float sa = 0.f, sb = 0.f;
#pragma unroll
                    for (int j2 = 0; j2 < 16; ++j2) { const float x = vdT[n * 1025 + c.lane + 64 * j2]; sa += wv[j2] * x; sb += wm[j2] * x; }
                    v[q] = sa; v[8 + q] = sb; }
#define WVD_STEP(CNT, OFF) { const bool hi_ = (c.lane & (OFF)) != 0; _Pragma("unroll") for (int i = 0; i < (CNT); ++i) { const float snd = hi_ ? v[i] : v[(CNT) + i]; const float kp = hi_ ? v[(CNT) + i] : v[i]; v[i] = kp + __shfl_xor(snd, (OFF)); } }
                WVD_STEP(8, 32) WVD_STEP(4, 16) WVD_STEP(2, 8) WVD_STEP(1, 4)
#undef WVD_STEP
                float r = v[0]; r += __shfl_xor(r, 2); r += __shfl_xor(r, 1);
                const int vi = (c.lane >> 2) & 15;
                if ((c.lane & 3) == 0) WIN[(size_t)((vi < 8 ? ZC_VDA : ZC_VDB - 8) + 8 * g8 + vi) * D + k] = (bf16_t)(cvt_pk(r, 0.f) & 0xffff);
            }
        }
        __syncthreads();
    }
}
constexpr int EXP_ITEMS = NEXP * (2 * 32 * 16 + 8 * 64);
#ifndef EXP_EARLY
#define EXP_EARLY 36864
#endif
DI void convert_experts_early(PR p, const Ctx& c, int l, int wg0, int nwg) { run_titems<true>(p, c, l, 0, EXP_EARLY, wg0, nwg); }
DI void convert_experts(PR p, const Ctx& c, int l, int lo) { run_titems<true>(p, c, l, lo, EXP_ITEMS, 0, c.G); }
DI void rms_row_bf16(const float* xrow, const float* w, bf16_t* orow, int lane) {
    const f32x4* xr = (const f32x4*)xrow + lane; const f32x4* wr = (const f32x4*)w + lane; f32x4 v[8], ww[8]; float s = 0.f;
#pragma unroll
    for (int j = 0; j < 8; ++j) { v[j] = xr[64 * j]; ww[j] = wr[64 * j]; }
#pragma unroll
    for (int j = 0; j < 8; ++j) s += (v[j].x * v[j].x + v[j].y * v[j].y) + (v[j].z * v[j].z + v[j].w * v[j].w);
    const float rstd = rsqrtf(wave_sum(s) * (1.f / D) + NORM_EPS);
    u32x2* o8 = (u32x2*)orow + lane;
#pragma unroll
    for (int j = 0; j < 8; ++j) o8[64 * j] = pack4(v[j].x * rstd * ww[j].x, v[j].y * rstd * ww[j].y, v[j].z * rstd * ww[j].z, v[j].w * rstd * ww[j].w);
}
constexpr int RL = 72;
constexpr int R_SLOT = 64 * RL * 2;
constexpr int R_EXTRA = 12 * R_SLOT;
constexpr int FL = 68;
#define RSLOT(i) ((LAS bf16_t*)(c.lds + (i) * R_SLOT))
struct R1In { u32x4 cur[5], prv[5]; };
DI R1In r1_load(const unsigned char* ws, int task, int tid) {
    R1In in;
    const int bh = task >> 5, ch = task & 31, b = bh >> 4, h = bh & 15, tok0 = ch * 64, m0 = b * TSEQ + tok0, t = tid >> 3, cg = tid & 7, ch0 = 64 * h + 8 * cg;
    const bf16_t* zr = (const bf16_t*)(ws + WS_Z) + (size_t)(m0 + t) * NZ; const bf16_t* zp = (tok0 + t) > 0 ? zr - NZ : zr;
    in.cur[0] = *(const u32x4*)(zr + ZC_R + ch0); in.prv[0] = *(const u32x4*)(zp + ZC_R + ch0); in.cur[1] = *(const u32x4*)(zr + ZC_K + ch0); in.prv[1] = *(const u32x4*)(zp + ZC_K + ch0);
    in.cur[2] = *(const u32x4*)(zr + ZC_V + ch0); in.prv[2] = *(const u32x4*)(zp + ZC_V + ch0); in.cur[3] = *(const u32x4*)(zr + ZC_WD + 8 * cg); in.prv[3] = *(const u32x4*)(zp + ZC_WD + 8 * cg);
    in.cur[4] = *(const u32x4*)(zr + ZC_AD + 8 * cg); in.prv[4] = *(const u32x4*)(zp + ZC_AD + 8 * cg);
    return in;
}
template <int PROF> DI R1In r1_task(PR p, const Ctx& c0, int l, int task, const R1In in, int next_task) {
    R1In nin;
#define SEC(b) (!(PROF & (b)))
#define GST(T, addr, val) do { const T v_ = (val); if (SEC(1)) *(T*)(addr) = v_; else asm volatile("" :: "v"(v_)); } while (0)
    Ctx c = c0; { int t_ = c0.tid; asm volatile("" : "+v"(t_)); c.tid = t_; c.lane = t_ & 63; unsigned lb_ = (unsigned)(uintptr_t)c0.lds; asm volatile("" : "+s"(lb_)); c.lds = (LAS unsigned char*)(uintptr_t)lb_; }
    unsigned char* ws = p.ws;
    const int bh = task >> 5, ch = task & 31, b = bh >> 4, h = bh & 15, tok0 = ch * 64, m0 = b * TSEQ + tok0;
    const int tid = c.tid, lane = c.lane, w = c.wave;
    const bf16_t* Z = (const bf16_t*)(ws + WS_Z);
    const int t = tid >> 3, cg = tid & 7, ch0 = 64 * h + 8 * cg;
    LAS float* LW = (LAS float*)(c.lds + R_EXTRA); LAS float* LA = LW + 64 * FL; LAS float* SEG = LA + 64 * FL;
    LAS float* LV = (LAS float*)(c.lds + 1 * R_SLOT);
    float r[8], k[8], v[8];
    const f32x4 w0A = *(const f32x4*)(p.in[I_W0] + l * 1024 + ch0), w0B = *(const f32x4*)(p.in[I_W0] + l * 1024 + ch0 + 4);
    const f32x4 a0A = *(const f32x4*)(p.in[I_A0] + l * 1024 + ch0), a0B = *(const f32x4*)(p.in[I_A0] + l * 1024 + ch0 + 4);
    const f32x4 kkA = *(const f32x4*)(p.in[I_KK] + l * 1024 + ch0), kkB = *(const f32x4*)(p.in[I_KK] + l * 1024 + ch0 + 4);
    const f32x4 kaA = *(const f32x4*)(p.in[I_KA] + l * 1024 + ch0), kaB = *(const f32x4*)(p.in[I_KA] + l * 1024 + ch0 + 4);
    const f32x4 rkA = *(const f32x4*)(p.in[I_RK] + l * 1024 + ch0), rkB = *(const f32x4*)(p.in[I_RK] + l * 1024 + ch0 + 4);
    if (!SEC(2)) {
#pragma unroll
        for (int j = 0; j < 8; ++j) { r[j] = 0.5f + 1e-3f * tid; k[j] = 0.25f + 1e-3f * lane; v[j] = 0.1f * w + 0.01f * j; } }
    if (SEC(2))
    {
        const bf16_t* zr = Z + (size_t)(m0 + t) * NZ; const bool has_prev = (tok0 + t) > 0; const bf16_t* zp = zr - NZ;
        const float* mu = p.in[I_MU] + (size_t)l * 3360;
        float cur[8], prv[8], wd[8], ad[8];
#define LERP_IN(dst, idx, mucol) do { unpack8(in.cur[idx], cur); if (has_prev) unpack8(in.prv[idx], prv); else { _Pragma("unroll") for (int j = 0; j < 8; ++j) prv[j] = 0.f; } \
            const f32x4 mA = *(const f32x4*)(mu + (mucol)), mB = *(const f32x4*)(mu + (mucol) + 4); const float mm[8] = {mA.x, mA.y, mA.z, mA.w, mB.x, mB.y, mB.z, mB.w}; \
            _Pragma("unroll") for (int j = 0; j < 8; ++j) dst[j] = cur[j] + mm[j] * (prv[j] - cur[j]); } while (0)
        LERP_IN(r, 0, ch0); LERP_IN(k, 1, 1024 + ch0); LERP_IN(v, 2, 2048 + ch0);
        LERP_IN(wd, 3, 3072 + 8 * cg); LERP_IN(ad, 4, 3136 + 8 * cg);
#pragma unroll
        for (int j = 0; j < 8; ++j) wd[j] = 1.0f - 2.0f / (1.0f + __expf(2.0f * wd[j]));
        *(LAS u32x4*)(RSLOT(7) + t * RL + 8 * cg) = pack8(wd);
        *(LAS u32x4*)(RSLOT(8) + t * RL + 8 * cg) = pack8(ad);
        const bf16_t* WUPT = (const bf16_t*)(ws + WS_LORA + LO_WUP) + (size_t)(64 * h) * 64; const bf16_t* AUPT = (const bf16_t*)(ws + WS_LORA + LO_AUP) + (size_t)(64 * h) * 64;
        *(LAS u32x4*)(RSLOT(9) + t * RL + 8 * cg) = *(const u32x4*)(WUPT + t * 64 + 8 * cg);
        *(LAS u32x4*)(RSLOT(10) + t * RL + 8 * cg) = *(const u32x4*)(AUPT + t * 64 + 8 * cg);
        if (l == 1) {
            if (cg < 4) { float a8[8], b8[8]; unpack8(*(const u32x4*)(zr + ZC_VDA + 8 * cg), a8); if (has_prev) unpack8(*(const u32x4*)(zp + ZC_VDB + 8 * cg), b8); else {
#pragma unroll
                    for (int j = 0; j < 8; ++j) b8[j] = 0.f; }
#pragma unroll
                for (int j = 0; j < 8; ++j) a8[j] += b8[j];
                *(LAS u32x4*)(RSLOT(11) + t * 40 + 8 * cg) = pack8(a8);
                const bf16_t* VUPT = (const bf16_t*)(ws + WS_LORA + LO_VUP) + (size_t)(64 * h) * 32;
                *(LAS u32x4*)(RSLOT(0) + t * 40 + 8 * cg) = *(const u32x4*)(VUPT + t * 32 + 8 * cg); }
        }
    }
    lds_barrier();
    const int pt = w >> 1, qb = 2 * (w & 1), fr = lane & 15, fq = lane >> 4;
    if (SEC(4)) {
#pragma unroll
        for (int i = 0; i < 2; ++i) { const int qt = qb + i;
            const f32x4 aw = mm16<false, false, 2, RL, RL>(RSLOT(7), RSLOT(9), 16 * pt, 16 * qt, lane, F4Z);
            const f32x4 aa = mm16<false, false, 2, RL, RL>(RSLOT(8), RSLOT(10), 16 * pt, 16 * qt, lane, F4Z);
            *(LAS f32x4*)(LW + (16 * pt + fr) * FL + 16 * qt + 4 * fq) = aw; *(LAS f32x4*)(LA + (16 * pt + fr) * FL + 16 * qt + 4 * fq) = aa;
            if (l == 1) { const f32x4 av = mm16<false, false, 1, 40, 40>(RSLOT(11), RSLOT(0), 16 * pt, 16 * qt, lane, F4Z); *(LAS f32x4*)(LV + (16 * pt + fr) * FL + 16 * qt + 4 * fq) = av; }
        }
    }
    lds_barrier();
    float lw[8], a[8], kk[8], kp[8];
    {
        const float w0[8] = {w0A.x, w0A.y, w0A.z, w0A.w, w0B.x, w0B.y, w0B.z, w0B.w}, a0[8] = {a0A.x, a0A.y, a0A.z, a0A.w, a0B.x, a0B.y, a0B.z, a0B.w};
        const float k_k[8] = {kkA.x, kkA.y, kkA.z, kkA.w, kkB.x, kkB.y, kkB.z, kkB.w}, k_a[8] = {kaA.x, kaA.y, kaA.z, kaA.w, kaB.x, kaB.y, kaB.z, kaB.w};
        const float r_k[8] = {rkA.x, rkA.y, rkA.z, rkA.w, rkB.x, rkB.y, rkB.z, rkB.w};
        const f32x4 lwA = *(const LAS f32x4*)(LW + t * FL + 8 * cg), lwB = *(const LAS f32x4*)(LW + t * FL + 8 * cg + 4);
        const f32x4 laA = *(const LAS f32x4*)(LA + t * FL + 8 * cg), laB = *(const LAS f32x4*)(LA + t * FL + 8 * cg + 4);
        const float lwr[8] = {lwA.x, lwA.y, lwA.z, lwA.w, lwB.x, lwB.y, lwB.z, lwB.w}, lar[8] = {laA.x, laA.y, laA.z, laA.w, laB.x, laB.y, laB.z, laB.w};
        bf16_t* VFIRST = (bf16_t*)(ws + WS_VFIRST) + (size_t)(m0 + t) * 1024 + ch0;
        if (l == 1) {
            const f32x4 lvA = *(const LAS f32x4*)(LV + t * FL + 8 * cg), lvB = *(const LAS f32x4*)(LV + t * FL + 8 * cg + 4);
            const float lvr[8] = {lvA.x, lvA.y, lvA.z, lvA.w, lvB.x, lvB.y, lvB.z, lvB.w};
            const f32x4 v0A = *(const f32x4*)(p.in[I_V0] + ch0), v0B = *(const f32x4*)(p.in[I_V0] + ch0 + 4); const float v0[8] = {v0A.x, v0A.y, v0A.z, v0A.w, v0B.x, v0B.y, v0B.z, v0B.w};
            float vf[8]; unpack8(*(const u32x4*)VFIRST, vf);
#pragma unroll
            for (int j = 0; j < 8; ++j) v[j] = v[j] + (vf[j] - v[j]) * sigm(v0[j] + lvr[j]);
            GST(u32x4, (bf16_t*)(ws + WS_VF) + (size_t)(m0 + t) * 1024 + ch0, pack8(v));
        } else { GST(u32x4, VFIRST, pack8(v)); }
        float ss = 0.f, rks = 0.f;
#pragma unroll
        for (int j = 0; j < 8; ++j) { lw[j] = -0.60653066f * sigm(w0[j] + lwr[j]); a[j] = sigm(a0[j] + lar[j]); kk[j] = k[j] * k_k[j]; ss += kk[j] * kk[j];
            kp[j] = k[j] * (1.0f + (a[j] - 1.0f) * k_a[j]); rks += r[j] * kp[j] * r_k[j]; }
        ss += __shfl_xor(ss, 1); ss += __shfl_xor(ss, 2); ss += __shfl_xor(ss, 4);
        rks += __shfl_xor(rks, 1); rks += __shfl_xor(rks, 2); rks += __shfl_xor(rks, 4);
        const float inv = rsqrtf(fmaxf(ss, 1e-12f));
#pragma unroll
        for (int j = 0; j < 8; ++j) kk[j] *= inv;
        if (SEC(1) && cg == 0) ((float*)(ws + WS_RK))[(size_t)(m0 + t) * 16 + h] = rks;
    }
    nin = r1_load(ws, next_task, tid);
    lds_barrier();
    *(LAS f32x4*)(LW + t * FL + 8 * cg) = (f32x4){lw[0], lw[1], lw[2], lw[3]}; *(LAS f32x4*)(LW + t * FL + 8 * cg + 4) = (f32x4){lw[4], lw[5], lw[6], lw[7]};
    lds_barrier();
    if (SEC(8)) {
        const int j = tid & 63, sg = tid >> 6; float s = 0.f;
#pragma unroll
        for (int i = 0; i < 8; ++i) s += LW[(8 * sg + i) * FL + j];
        SEG[sg * 64 + j] = s;
        lds_barrier();
        float off = 0.f;
        for (int s2 = 0; s2 < sg; ++s2) off += SEG[s2 * 64 + j];
#pragma unroll
        for (int i = 0; i < 8; ++i) { off += LW[(8 * sg + i) * FL + j]; LW[(8 * sg + i) * FL + j] = off; }
    }
    lds_barrier();
    {
        const f32x4 cA = *(const LAS f32x4*)(LW + t * FL + 8 * cg), cB = *(const LAS f32x4*)(LW + t * FL + 8 * cg + 4);
        const f32x4 eA = *(const LAS f32x4*)(LW + 63 * FL + 8 * cg), eB = *(const LAS f32x4*)(LW + 63 * FL + 8 * cg + 4);
        const float cs[8] = {cA.x, cA.y, cA.z, cA.w, cB.x, cB.y, cB.z, cB.w}, ce[8] = {eA.x, eA.y, eA.z, eA.w, eB.x, eB.y, eB.z, eB.w};
        float Rt[8], At[8], Bt[8], Kt[8], Bp[8], Kp[8];
#pragma unroll
        for (int j = 0; j < 8; ++j) { const float ep = __expf(cs[j]), em = __expf(-cs[j]), el = __expf(ce[j] - cs[j]), ex = __expf(cs[j] - lw[j]); const float bv = kk[j] * a[j];
            Rt[j] = r[j] * ep; At[j] = -kk[j] * ex; Bt[j] = bv * em; Kt[j] = kp[j] * em; Bp[j] = bv * el; Kp[j] = kp[j] * el; }
        *(LAS u32x4*)(RSLOT(0) + t * RL + 8 * cg) = pack8(Rt); *(LAS u32x4*)(RSLOT(1) + t * RL + 8 * cg) = pack8(At); *(LAS u32x4*)(RSLOT(2) + t * RL + 8 * cg) = pack8(Bt);
        *(LAS u32x4*)(RSLOT(3) + t * RL + 8 * cg) = pack8(Kt); *(LAS u32x4*)(RSLOT(4) + t * RL + 8 * cg) = pack8(Bp); *(LAS u32x4*)(RSLOT(5) + t * RL + 8 * cg) = pack8(Kp);
        *(LAS u32x4*)(RSLOT(6) + t * RL + 8 * cg) = pack8(v);
    }
    lds_barrier();
    const int p0 = 16 * pt, prow = p0 + fr;
    if (SEC(16)) {
#pragma unroll
        for (int i = 0; i < 2; ++i) { const int q0 = 16 * (qb + i), qc = q0 + 4 * fq;
            f32x4 ab = mm16<false, false, 2, RL, RL>(RSLOT(1), RSLOT(2), p0, q0, lane, F4Z);
            f32x4 ak = mm16<false, false, 2, RL, RL>(RSLOT(1), RSLOT(3), p0, q0, lane, F4Z);
            f32x4 rb = mm16<false, false, 2, RL, RL>(RSLOT(0), RSLOT(2), p0, q0, lane, F4Z);
            f32x4 rk = mm16<false, false, 2, RL, RL>(RSLOT(0), RSLOT(3), p0, q0, lane, F4Z);
#pragma unroll
            for (int rr = 0; rr < 4; ++rr) { const int s = qc + rr; if (s >= prow) { ab[rr] = 0.f; ak[rr] = 0.f; } if (s > prow) { rb[rr] = 0.f; rk[rr] = 0.f; } }
            st4_bf16(RSLOT(7) + prow * RL + qc, ab); st4_bf16(RSLOT(9) + prow * RL + qc, ak); st4_bf16(RSLOT(10) + prow * RL + qc, rb); st4_bf16(RSLOT(11) + prow * RL + qc, rk); }
    }
    lds_barrier();
    const int qa = 16 * qb, qca = qa + 4 * fq, qcb = qca + 16;
    if (SEC(32)) {
        TrFrag yl[2][2]; tr_issue4<RL>(yl, RSLOT(7), qa, lane);
        const bf16x8 xl0 = frag_n<RL>(RSLOT(7), p0, 0, lane), xl1 = frag_n<RL>(RSLOT(7), p0, 32, lane);
        f32x4 t1a = ld4_bf16(RSLOT(7) + prow * RL + qca), t1b = ld4_bf16(RSLOT(7) + prow * RL + qcb);
        tr_wait4(yl);
        const f32x4 la = mma2(xl0, xl1, tr_get(yl[0][0]), tr_get(yl[0][1]), F4Z), lb = mma2(xl0, xl1, tr_get(yl[1][0]), tr_get(yl[1][1]), F4Z);
#pragma unroll
        for (int rr = 0; rr < 4; ++rr) { if (qca + rr == prow) t1a[rr] += 1.0f; if (qcb + rr == prow) t1b[rr] += 1.0f; }
        st4_bf16(RSLOT(8) + prow * RL + qca, la); st4_bf16(RSLOT(8) + prow * RL + qcb, lb); st4_bf16(RSLOT(2) + prow * RL + qca, t1a); st4_bf16(RSLOT(2) + prow * RL + qcb, t1b);
    }
    lds_barrier();
#define NSTEP(LS, LD_, TS, TD, SQ) do { TrFrag yl[2][2]; tr_issue4<RL>(yl, RSLOT(LS), qa, lane); \
        const bf16x8 xt0 = frag_n<RL>(RSLOT(TS), p0, 0, lane), xt1 = frag_n<RL>(RSLOT(TS), p0, 32, lane), xl0 = frag_n<RL>(RSLOT(LS), p0, 0, lane), xl1 = frag_n<RL>(RSLOT(LS), p0, 32, lane); \
        const f32x4 ta0 = ld4_bf16(RSLOT(TS) + prow * RL + qca), tb0 = ld4_bf16(RSLOT(TS) + prow * RL + qcb); \
        tr_wait4(yl); const bf16x8 y00 = tr_get(yl[0][0]), y01 = tr_get(yl[0][1]), y10 = tr_get(yl[1][0]), y11 = tr_get(yl[1][1]); \
        const f32x4 tna = mma2(xt0, xt1, y00, y01, ta0), tnb = mma2(xt0, xt1, y10, y11, tb0); \
        if (SQ) { const f32x4 la = mma2(xl0, xl1, y00, y01, F4Z), lb = mma2(xl0, xl1, y10, y11, F4Z); st4_bf16(RSLOT(LD_) + prow * RL + qca, la); st4_bf16(RSLOT(LD_) + prow * RL + qcb, lb); } \
        st4_bf16(RSLOT(TD) + prow * RL + qca, tna); st4_bf16(RSLOT(TD) + prow * RL + qcb, tnb); lds_barrier(); } while (0)
    if (SEC(32)) NSTEP(8, 7, 2, 3, 1);
    if (SEC(32)) NSTEP(7, 8, 3, 2, 1);
    if (SEC(32)) NSTEP(8, 7, 2, 3, 1);
    if (SEC(32)) NSTEP(7, 8, 3, 2, 1);
    if (SEC(32)) NSTEP(8, 7, 2, 3, 0);
#undef NSTEP
    if (SEC(64)) {
        TrFrag ya[2][2], yv[2][2]; tr_issue4<RL>(ya, RSLOT(1), qa, lane); tr_issue4<RL>(yv, RSLOT(6), qa, lane);
        const bf16x8 xt0 = frag_n<RL>(RSLOT(3), p0, 0, lane), xt1 = frag_n<RL>(RSLOT(3), p0, 32, lane), xk0 = frag_n<RL>(RSLOT(9), p0, 0, lane), xk1 = frag_n<RL>(RSLOT(9), p0, 32, lane);
        tr_wait8(ya, yv);
        const f32x4 pa = mma2(xt0, xt1, tr_get(ya[0][0]), tr_get(ya[0][1]), F4Z), pb2 = mma2(xt0, xt1, tr_get(ya[1][0]), tr_get(ya[1][1]), F4Z);
        const f32x4 ga = mma2(xk0, xk1, tr_get(yv[0][0]), tr_get(yv[0][1]), F4Z), gb = mma2(xk0, xk1, tr_get(yv[1][0]), tr_get(yv[1][1]), F4Z);
        st4_bf16(RSLOT(7) + prow * RL + qca, pa); st4_bf16(RSLOT(7) + prow * RL + qcb, pb2); st4_bf16(RSLOT(8) + prow * RL + qca, ga); st4_bf16(RSLOT(8) + prow * RL + qcb, gb);
    }
    lds_barrier();
    if (SEC(64)) {
        TrFrag yg[2][2]; tr_issue4<RL>(yg, RSLOT(8), qa, lane);
        const bf16x8 xt0 = frag_n<RL>(RSLOT(3), p0, 0, lane), xt1 = frag_n<RL>(RSLOT(3), p0, 32, lane);
        tr_wait4(yg);
        const f32x4 q0v = mma2(xt0, xt1, tr_get(yg[0][0]), tr_get(yg[0][1]), F4Z), q1v = mma2(xt0, xt1, tr_get(yg[1][0]), tr_get(yg[1][1]), F4Z);
        st4_bf16(RSLOT(9) + prow * RL + qca, q0v); st4_bf16(RSLOT(9) + prow * RL + qcb, q1v);
    }
    lds_barrier();
    if (SEC(64)) {
        const size_t blk = (size_t)task * 4096;
        const int pia = 16 * fq + 4 * qb, pib = pia + 4, mka = 32 * (qb >> 1) + 8 * fq, mkb = mka + 4;
        bf16_t* RP = (bf16_t*)(ws + WS_RP) + blk; bf16_t* Y0 = (bf16_t*)(ws + WS_Y0) + blk; bf16_t* MT = (bf16_t*)(ws + WS_MT) + blk; bf16_t* NN = (bf16_t*)(ws + WS_NN) + blk;
        {
            TrFrag yp[2][2], yq[2][2]; tr_issue4<RL>(yp, RSLOT(7), qa, lane); tr_issue4<RL>(yq, RSLOT(9), qa, lane);
            const bf16x8 xb0 = frag_n<RL>(RSLOT(10), p0, 0, lane), xb1 = frag_n<RL>(RSLOT(10), p0, 32, lane), xk0 = frag_n<RL>(RSLOT(11), p0, 0, lane), xk1 = frag_n<RL>(RSLOT(11), p0, 32, lane);
            const f32x4 r0a = ld4_bf16(RSLOT(0) + prow * RL + qca), r0b = ld4_bf16(RSLOT(0) + prow * RL + qcb);
            tr_wait8(yp, yq);
            const f32x4 rpa = mma2(xb0, xb1, tr_get(yp[0][0]), tr_get(yp[0][1]), r0a), rpb = mma2(xb0, xb1, tr_get(yp[1][0]), tr_get(yp[1][1]), r0b);
            f32x4 y0a = mma2(xb0, xb1, tr_get(yq[0][0]), tr_get(yq[0][1]), F4Z), y0b = mma2(xb0, xb1, tr_get(yq[1][0]), tr_get(yq[1][1]), F4Z);
            TrFrag yv[2][2]; tr_issue4<RL>(yv, RSLOT(6), qa, lane); tr_wait4(yv);
            y0a = mma2(xk0, xk1, tr_get(yv[0][0]), tr_get(yv[0][1]), y0a); y0b = mma2(xk0, xk1, tr_get(yv[1][0]), tr_get(yv[1][1]), y0b);
            GST(u32x2, RP + prow * 64 + pia, pack4(rpa[0], rpa[1], rpa[2], rpa[3])); GST(u32x2, RP + prow * 64 + pib, pack4(rpb[0], rpb[1], rpb[2], rpb[3]));
            GST(u32x2, Y0 + prow * 64 + qca, pack4(y0a[0], y0a[1], y0a[2], y0a[3])); GST(u32x2, Y0 + prow * 64 + qcb, pack4(y0b[0], y0b[1], y0b[2], y0b[3]));
        }
        {
            TrFrag xbp[2], yp[2][2]; tr_issue2<RL>(xbp, RSLOT(4), p0, lane); tr_issue4<RL>(yp, RSLOT(7), qa, lane); tr_wait42(yp, xbp);
            const bf16x8 xb0 = tr_get(xbp[0]), xb1 = tr_get(xbp[1]);
            f32x4 mta = mma2(xb0, xb1, tr_get(yp[0][0]), tr_get(yp[0][1]), F4Z), mtb = mma2(xb0, xb1, tr_get(yp[1][0]), tr_get(yp[1][1]), F4Z);
            const float dg = __expf(LW[63 * FL + prow]);
#pragma unroll
            for (int rr = 0; rr < 4; ++rr) { if (qca + rr == prow) mta[rr] += dg; if (qcb + rr == prow) mtb[rr] += dg; }
            GST(u32x2, MT + prow * 64 + mka, pack4(mta[0], mta[1], mta[2], mta[3])); GST(u32x2, MT + prow * 64 + mkb, pack4(mtb[0], mtb[1], mtb[2], mtb[3]));
            TrFrag xq[2], ybp[2][2]; tr_issue2<RL>(xq, RSLOT(9), p0, lane); tr_issue4<RL>(ybp, RSLOT(4), qa, lane); tr_wait42(ybp, xq);
            f32x4 nna = mma2(tr_get(xq[0]), tr_get(xq[1]), tr_get(ybp[0][0]), tr_get(ybp[0][1]), F4Z), nnb = mma2(tr_get(xq[0]), tr_get(xq[1]), tr_get(ybp[1][0]), tr_get(ybp[1][1]), F4Z);
            TrFrag xv[2], ykp[2][2]; tr_issue2<RL>(xv, RSLOT(6), p0, lane); tr_issue4<RL>(ykp, RSLOT(5), qa, lane); tr_wait42(ykp, xv);
            nna = mma2(tr_get(xv[0]), tr_get(xv[1]), tr_get(ykp[0][0]), tr_get(ykp[0][1]), nna); nnb = mma2(tr_get(xv[0]), tr_get(xv[1]), tr_get(ykp[1][0]), tr_get(ykp[1][1]), nnb);
            GST(u32x2, NN + prow * 64 + pia, pack4(nna[0], nna[1], nna[2], nna[3])); GST(u32x2, NN + prow * 64 + pib, pack4(nnb[0], nnb[1], nnb[2], nnb[3]));
        }
    }
    lds_barrier();
    return nin;
}
#undef SEC
#undef GST
constexpr int HL = 136, HCL = 132, SCL = 72, HC = 64;
constexpr int H_QT = 0, H_KT = HC * HL * 2  , H_KP = 2 * H_KT, H_V = 3 * H_KT, H_CS = 4 * H_KT  , H_SEG = H_CS + HC * HCL * 4  , H_SC = H_SEG + 4 * 128 * 4  ,
              H_NTS = H_CS;
DI float hg_lb(PR p, int l, int chn) { if (l == 0) return 0.f; const float* raw = p.in[I_LBRAW]; return sigm(raw[1024 + chn] - raw[chn]); }
struct H1In { u32x4 zq[2], zf[2], zi[2]; };
DI H1In h1_load(const unsigned char* ws, int task, int tid) {
    const int bh = task >> 5, ch = task & 31, b = bh >> 3, h = bh & 7, m0 = b * TSEQ + ch * HC, t0 = tid >> 4, cg = tid & 15, chn = 128 * h + 8 * cg;
    H1In in;
#pragma unroll
    for (int u = 0; u < 2; ++u) { const bf16_t* zr = (const bf16_t*)(ws + WS_Z) + (size_t)(m0 + t0 + 32 * u) * NZ;
        in.zq[u] = *(const u32x4*)(zr + ZC_Q + chn); in.zf[u] = *(const u32x4*)(zr + ZC_F + chn); in.zi[u] = *(const u32x4*)(zr + ZC_I + chn); }
    return in;
}
DI H1In h1_task(PR p, const Ctx& c0, int l, int task, const H1In in, int next_task) {
    Ctx c = c0; { int t_ = c0.tid; asm volatile("" : "+v"(t_)); c.tid = t_; c.lane = t_ & 63; unsigned lb_ = (unsigned)(uintptr_t)c0.lds; asm volatile("" : "+s"(lb_)); c.lds = (LAS unsigned char*)(uintptr_t)lb_; }
    unsigned char* ws = p.ws;
    const int bh = task >> 5, ch = task & 31, b = bh >> 3, h = bh & 7, m0 = b * TSEQ + ch * HC;
    const int tid = c.tid, lane = c.lane, w = c.wave, fr = lane & 15, fq = lane >> 4;
    const bf16_t* Z = (const bf16_t*)(ws + WS_Z);
    LAS bf16_t* QTs = (LAS bf16_t*)(c.lds + H_QT); LAS bf16_t* KTs = (LAS bf16_t*)(c.lds + H_KT); LAS bf16_t* KPs = (LAS bf16_t*)(c.lds + H_KP); LAS bf16_t* Vs = (LAS bf16_t*)(c.lds + H_V);
    LAS float* CS = (LAS float*)(c.lds + H_CS); LAS float* SEG = (LAS float*)(c.lds + H_SEG); LAS bf16_t* SC = (LAS bf16_t*)(c.lds + H_SC); LAS bf16_t* NTS = (LAS bf16_t*)(c.lds + H_NTS);
    const int t0 = tid >> 4, cg = tid & 15, chn = 128 * h + 8 * cg;
    float q[2][8], kf[2][8];
    u32x4 vraw[2];
    {
        float lbv[8];
#pragma unroll
        for (int j = 0; j < 8; ++j) lbv[j] = hg_lb(p, l, chn + j);
#pragma unroll
        for (int u = 0; u < 2; ++u) { const int t = t0 + 32 * u;
            float zq[8], zf[8]; unpack8(in.zq[u], zq); unpack8(in.zf[u], zf); vraw[u] = in.zi[u];
            float g[8];
#pragma unroll
            for (int j = 0; j < 8; ++j) { const float f = lbv[j] + (1.0f - lbv[j]) * sigm(zf[j]); q[u][j] = zq[j] * sigm(zq[j]); kf[u][j] = 1.0f - f; g[j] = __logf(f); }
            *(LAS f32x4*)(CS + t * HCL + 8 * cg) = (f32x4){g[0], g[1], g[2], g[3]}; *(LAS f32x4*)(CS + t * HCL + 8 * cg + 4) = (f32x4){g[4], g[5], g[6], g[7]}; }
    }
    const H1In nin = h1_load(ws, next_task, tid);
    lds_barrier();
    {   const int j = tid & 127, sg = tid >> 7; float s = 0.f;
#pragma unroll
        for (int i = 0; i < 16; ++i) s += CS[(16 * sg + i) * HCL + j];
        SEG[sg * 128 + j] = s;
        lds_barrier();
        float off = 0.f;
        for (int s2 = 0; s2 < sg; ++s2) off += SEG[s2 * 128 + j];
#pragma unroll
        for (int i = 0; i < 16; ++i) { off += CS[(16 * sg + i) * HCL + j]; CS[(16 * sg + i) * HCL + j] = off; }
    }
    lds_barrier();
    {
        const f32x4 rA = *(const LAS f32x4*)(CS + 31 * HCL + 8 * cg), rB = *(const LAS f32x4*)(CS + 31 * HCL + 8 * cg + 4);
        const f32x4 eA = *(const LAS f32x4*)(CS + 63 * HCL + 8 * cg), eB = *(const LAS f32x4*)(CS + 63 * HCL + 8 * cg + 4);
        const float cr[8] = {rA.x, rA.y, rA.z, rA.w, rB.x, rB.y, rB.z, rB.w}, ce[8] = {eA.x, eA.y, eA.z, eA.w, eB.x, eB.y, eB.z, eB.w};
#pragma unroll
        for (int u = 0; u < 2; ++u) { const int t = t0 + 32 * u;
            const f32x4 cA = *(const LAS f32x4*)(CS + t * HCL + 8 * cg), cB = *(const LAS f32x4*)(CS + t * HCL + 8 * cg + 4);
            const float cs[8] = {cA.x, cA.y, cA.z, cA.w, cB.x, cB.y, cB.z, cB.w};
            float qh[8], qt[8], kt[8], kp[8];
#pragma unroll
            for (int j = 0; j < 8; ++j) { qh[j] = q[u][j] * __expf(cs[j]); qt[j] = q[u][j] * __expf(cs[j] - cr[j]); kt[j] = kf[u][j] * __expf(cr[j] - cs[j]); kp[j] = kf[u][j] * __expf(ce[j] - cs[j]); }
            *(LAS u32x4*)(QTs + t * HL + 8 * cg) = pack8(qt); *(LAS u32x4*)(KTs + t * HL + 8 * cg) = pack8(kt); *(LAS u32x4*)(KPs + t * HL + 8 * cg) = pack8(kp); *(LAS u32x4*)(Vs + t * HL + 8 * cg) = vraw[u];
            *(u32x4*)((bf16_t*)(ws + WS_QH) + (size_t)(m0 + t) * 1024 + chn) = pack8(qh);
            if (t == 63) { float* DC = (float*)(ws + WS_DC) + (size_t)task * 128 + 8 * cg; *(f32x4*)DC = (f32x4){__expf(ce[0]), __expf(ce[1]), __expf(ce[2]), __expf(ce[3])}; *(f32x4*)(DC + 4) = (f32x4){__expf(ce[4]), __expf(ce[5]), __expf(ce[6]), __expf(ce[7])}; } }
    }
    lds_barrier();
    {
        const int p0 = 16 * (w >> 1), prow = p0 + fr;
#pragma unroll
        for (int i = 0; i < 2; ++i) { const int q0 = 16 * (2 * (w & 1) + i), qc = q0 + 4 * fq;
            f32x4 sc = mm16<false, false, 4, HL, HL>(QTs, KTs, p0, q0, lane, F4Z);
#pragma unroll
            for (int rr = 0; rr < 4; ++rr) if (qc + rr > prow) sc[rr] = 0.f;
            st4_bf16(SC + prow * SCL + qc, sc); }
        TrFrag xv[2]; tr_issue2<HL>(xv, Vs, 16 * w, lane);
#pragma unroll
        for (int dp = 0; dp < 4; ++dp) { TrFrag yk[2][2]; tr_issue4<HL>(yk, KPs, 32 * dp, lane);
            if (dp == 0) tr_wait42(yk, xv); else tr_wait4(yk);
            const bf16x8 x0 = tr_get(xv[0]), x1 = tr_get(xv[1]);
            const f32x4 na = mma2(x0, x1, tr_get(yk[0][0]), tr_get(yk[0][1]), F4Z), nb = mma2(x0, x1, tr_get(yk[1][0]), tr_get(yk[1][1]), F4Z);
            st4_bf16(NTS + (16 * w + fr) * HL + 32 * dp + 4 * fq, na); st4_bf16(NTS + (16 * w + fr) * HL + 32 * dp + 16 + 4 * fq, nb); }
    }
    lds_barrier();
    {
        bf16_t* OI = (bf16_t*)(ws + WS_OI);
        TrFrag yv[2]; tr_issue2<HL>(yv, Vs, 16 * w, lane); tr_wait2(yv);
        const bf16x8 y0 = tr_get(yv[0]), y1 = tr_get(yv[1]);
#pragma unroll
        for (int pt = 0; pt < 4; ++pt) { const f32x4 o = mma2(frag_n<SCL>(SC, 16 * pt, 0, lane), frag_n<SCL>(SC, 16 * pt, 32, lane), y0, y1, F4Z);
            *(u32x2*)(OI + (size_t)(m0 + 16 * pt + fr) * 1024 + 128 * h + 16 * w + 4 * fq) = pack4(o[0], o[1], o[2], o[3]); }
        bf16_t* NT = (bf16_t*)(ws + WS_NT) + (size_t)task * 16384;
        const int row = tid >> 2, cq = tid & 3;
#pragma unroll
        for (int i = 0; i < 4; ++i) *(u32x4*)(NT + row * 128 + 32 * cq + 8 * i) = *(const LAS u32x4*)(NTS + row * HL + 32 * cq + 8 * i);
    }
    lds_barrier();
    return nin;
}
DI void h2_item(PR p, const Ctx& c, int item) {
    unsigned char* ws = p.ws;
    const int gidx = item * 512 + c.tid, bh = gidx >> 11, e = (gidx >> 4) & 127, dg = gidx & 15;
    bf16_t* NT = (bf16_t*)(ws + WS_NT) + (size_t)bh * 32 * 16384 + e * 128 + 8 * dg; const float* DC = (const float*)(ws + WS_DC) + (size_t)bh * 32 * 128 + 8 * dg;
    float s[8];
#pragma unroll
    for (int j = 0; j < 8; ++j) s[j] = 0.f;
    for (int c0 = 0; c0 < 32; c0 += 8) {
        u32x4 nt[8]; f32x4 da[8], db[8];
#pragma unroll
        for (int i = 0; i < 8; ++i) { nt[i] = *(const u32x4*)(NT + (size_t)(c0 + i) * 16384); da[i] = *(const f32x4*)(DC + (c0 + i) * 128); db[i] = *(const f32x4*)(DC + (c0 + i) * 128 + 4); }
#pragma unroll
        for (int i = 0; i < 8; ++i) { *(u32x4*)(NT + (size_t)(c0 + i) * 16384) = pack8(s); float nf[8]; unpack8(nt[i], nf);
            s[0] = s[0] * da[i].x + nf[0]; s[1] = s[1] * da[i].y + nf[1]; s[2] = s[2] * da[i].z + nf[2]; s[3] = s[3] * da[i].w + nf[3];
            s[4] = s[4] * db[i].x + nf[4]; s[5] = s[5] * db[i].y + nf[5]; s[6] = s[6] * db[i].z + nf[6]; s[7] = s[7] * db[i].w + nf[7]; }
    }
}
DI void h3_wave(const f32x4 (&onw)[8], PR p, int l, int wt, int lane) {
    unsigned char* ws = p.ws;
    const int task = wt >> 2, tt = wt & 3, bh = task >> 5, ch = task & 31, b = bh >> 3, h = bh & 7, m0 = b * TSEQ + ch * 64 + 16 * tt, fr = lane & 15, fq = lane >> 4;
    const bf16_t* Z = (const bf16_t*)(ws + WS_Z); const bf16_t* QH = (const bf16_t*)(ws + WS_QH); const bf16_t* OI = (const bf16_t*)(ws + WS_OI); const bf16_t* S = (const bf16_t*)(ws + WS_NT) + (size_t)task * 16384;
    bf16_t* YHG = (bf16_t*)(ws + WS_YHG);
    const size_t row = (size_t)(m0 + fr);
    bf16x8 qf[4];
#pragma unroll
    for (int ks = 0; ks < 4; ++ks) qf[ks] = *(const bf16x8*)(QH + row * 1024 + 128 * h + 32 * ks + 8 * fq);
    u32x2 oi[8], zo[8];
#pragma unroll
    for (int et = 0; et < 8; ++et) { oi[et] = *(const u32x2*)(OI + row * 1024 + 128 * h + 16 * et + 4 * fq); zo[et] = *(const u32x2*)(Z + row * NZ + ZC_O + 128 * h + 16 * et + 4 * fq); }
    f32x4 o[8]; float ssq = 0.f;
#pragma unroll
    for (int et = 0; et < 8; ++et) { bf16x8 sa[4];
#pragma unroll
        for (int ks = 0; ks < 4; ++ks) sa[ks] = *(const bf16x8*)(S + (16 * et + fr) * 128 + 32 * ks + 8 * fq);
        float f[4]; unpack4(oi[et], f); f32x4 acc = {f[0], f[1], f[2], f[3]};
#pragma unroll
        for (int ks = 0; ks < 4; ++ks) acc = MFMA16(sa[ks], qf[ks], acc);
        o[et] = acc; ssq += (acc[0] * acc[0] + acc[1] * acc[1]) + (acc[2] * acc[2] + acc[3] * acc[3]); }
    ssq += __shfl_xor(ssq, 16); ssq += __shfl_xor(ssq, 32);
    const float rstd = rsqrtf(ssq * (1.0f / 128.0f) + NORM_EPS);
#pragma unroll
    for (int et = 0; et < 8; ++et) { float g[4]; unpack4(zo[et], g);
        *(u32x2*)(YHG + row * 1024 + 128 * h + 16 * et + 4 * fq) = pack4(o[et][0] * rstd * onw[et].x * sigm(g[0]), o[et][1] * rstd * onw[et].y * sigm(g[1]), o[et][2] * rstd * onw[et].z * sigm(g[2]), o[et][3] * rstd * onw[et].w * sigm(g[3])); }
}
struct R2Regs { bf16x8 ma[4][2]; u32x4 nv[2]; };
DI void r2_load(R2Regs& r, const bf16_t* mt, const bf16_t* nn, int et, int fr, int fq) {
#pragma unroll
    for (int n = 0; n < 4; ++n)
#pragma unroll
        for (int ks = 0; ks < 2; ++ks) r.ma[n][ks] = *(const bf16x8*)(mt + (16 * n + fr) * 64 + 32 * ks + 8 * fq);
    r.nv[0] = *(const u32x4*)(nn + (16 * et + fr) * 64 + 16 * fq); r.nv[1] = *(const u32x4*)(nn + (16 * et + fr) * 64 + 16 * fq + 8);
}
DI void r2_step(const R2Regs& r, f32x4 (&S)[4], bf16_t* ss, int et, int fr, int fq) {
    { float f[8] = {S[0][0], S[0][1], S[0][2], S[0][3], S[1][0], S[1][1], S[1][2], S[1][3]}, g[8] = {S[2][0], S[2][1], S[2][2], S[2][3], S[3][0], S[3][1], S[3][2], S[3][3]};
      *(u32x4*)(ss + (16 * et + fr) * 64 + 16 * fq) = pack8(f); *(u32x4*)(ss + (16 * et + fr) * 64 + 16 * fq + 8) = pack8(g); }
    bf16x8 sb[2];
#pragma unroll
    for (int ks = 0; ks < 2; ++ks) { u32x4 sp; sp.x = cvt_pk(S[2 * ks][0], S[2 * ks][1]); sp.y = cvt_pk(S[2 * ks][2], S[2 * ks][3]); sp.z = cvt_pk(S[2 * ks + 1][0], S[2 * ks + 1][1]); sp.w = cvt_pk(S[2 * ks + 1][2], S[2 * ks + 1][3]);
        sb[ks] = __builtin_bit_cast(bf16x8, sp); }
    float nf[16]; { float a[8], b[8]; unpack8(r.nv[0], a); unpack8(r.nv[1], b);
#pragma unroll
        for (int j = 0; j < 8; ++j) { nf[j] = a[j]; nf[8 + j] = b[j]; } }
#pragma unroll
    for (int n = 0; n < 4; ++n) { f32x4 acc = {nf[4 * n], nf[4 * n + 1], nf[4 * n + 2], nf[4 * n + 3]};
        acc = MFMA16(r.ma[n][0], sb[0], acc); acc = MFMA16(r.ma[n][1], sb[1], acc); S[n] = acc; }
}
DI void r2_task(PR p, const Ctx& c, int item) {
    unsigned char* ws = p.ws;
    const int lane = c.lane, w = c.wave, fr = lane & 15, fq = lane >> 4, bh = 2 * item + (w >> 2), et = w & 3;
    const bf16_t* MT = (const bf16_t*)(ws + WS_MT) + (size_t)bh * 32 * 4096; const bf16_t* NN = (const bf16_t*)(ws + WS_NN) + (size_t)bh * 32 * 4096;
    bf16_t* SS = (bf16_t*)(ws + WS_SS) + (size_t)bh * 32 * 4096;
    f32x4 S[4] = {F4Z, F4Z, F4Z, F4Z};
    R2Regs ra, rb;
    r2_load(ra, MT, NN, et, fr, fq);
    for (int ch = 0; ch < 32; ch += 2) {
        r2_load(rb, MT + (size_t)(ch + 1) * 4096, NN + (size_t)(ch + 1) * 4096, et, fr, fq);
        r2_step(ra, S, SS + (size_t)ch * 4096, et, fr, fq);
        { const int c2 = ch + 2 < 32 ? ch + 2 : 31; r2_load(ra, MT + (size_t)c2 * 4096, NN + (size_t)c2 * 4096, et, fr, fq); }
        r2_step(rb, S, SS + (size_t)(ch + 1) * 4096, et, fr, fq);
    }
}
struct R3Const { bf16x8 gup[4][5]; f32x4 lnw[4], lnb[4]; };
DI void r3_const(R3Const& k, PR p, int l, int h, int lane) {
    const int fr = lane & 15, fq = lane >> 4; (void)fr;
    const bf16_t* GUPT = (const bf16_t*)(p.ws + WS_LORA + LO_GUP) + (size_t)(64 * h) * 160;
#pragma unroll
    for (int et = 0; et < 4; ++et) { const int col = 64 * h + 16 * et + 4 * fq; k.lnw[et] = *(const f32x4*)(p.in[I_LNW] + l * 1024 + col); k.lnb[et] = *(const f32x4*)(p.in[I_LNB] + l * 1024 + col);
#pragma unroll
        for (int ks = 0; ks < 5; ++ks) k.gup[et][ks] = gfrag(GUPT, 160, 16 * et, 32 * ks, lane); }
}
DI void r3_wave(const R3Const& K, PR p, int l, int wt, int lane) {
    unsigned char* ws = p.ws;
    const int task = wt >> 2, pt = wt & 3, bh = task >> 5, ch = task & 31, b = bh >> 4, h = bh & 15, tok0 = ch * 64 + 16 * pt, m0 = b * TSEQ + tok0, fr = lane & 15, fq = lane >> 4;
    const bf16_t* Z = (const bf16_t*)(ws + WS_Z);
    const size_t blk = (size_t)task * 4096, m = (size_t)(m0 + fr);
    const bf16_t* SS = (const bf16_t*)(ws + WS_SS) + blk; const bf16_t* RP = (const bf16_t*)(ws + WS_RP) + blk; const bf16_t* Y0 = (const bf16_t*)(ws + WS_Y0) + blk;
    bf16x8 sg[5];
    {   const float* mu = p.in[I_MU] + (size_t)l * 3360 + 3200; const bf16_t* zr = Z + m * NZ + ZC_GD; const bool has_prev = (tok0 + fr) > 0;
#pragma unroll
        for (int ks = 0; ks < 5; ++ks) { float cur[8], prv[8]; unpack8(*(const u32x4*)(zr + 32 * ks + 8 * fq), cur);
            if (has_prev) unpack8(*(const u32x4*)(zr - NZ + 32 * ks + 8 * fq), prv); else {
#pragma unroll
                for (int j = 0; j < 8; ++j) prv[j] = 0.f; }
            const f32x4 mA = *(const f32x4*)(mu + 32 * ks + 8 * fq), mB = *(const f32x4*)(mu + 32 * ks + 8 * fq + 4); const float mm[8] = {mA.x, mA.y, mA.z, mA.w, mB.x, mB.y, mB.z, mB.w};
#pragma unroll
            for (int j = 0; j < 8; ++j) cur[j] = sigm(cur[j] + mm[j] * (prv[j] - cur[j]));
            sg[ks] = __builtin_bit_cast(bf16x8, pack8(cur)); } }
    const bf16x8 rp0 = gfrag(RP, 64, 16 * pt, 0, lane), rp1 = gfrag(RP, 64, 16 * pt, 32, lane);
    const float rk = ((const float*)(ws + WS_RK))[m * 16 + h];
    const bf16_t* vsrc = (const bf16_t*)(ws + (l == 0 ? WS_VFIRST : WS_VF));
    u32x2 vraw[4], y0raw[4];
#pragma unroll
    for (int et = 0; et < 4; ++et) { const int col = 64 * h + 16 * et + 4 * fq;
        vraw[et] = *(const u32x2*)(vsrc + m * 1024 + col); y0raw[et] = *(const u32x2*)(Y0 + (16 * pt + fr) * 64 + 16 * et + 4 * fq); }
    f32x4 y[4], g[4]; float s1 = 0.f, s2 = 0.f;
#pragma unroll
    for (int et = 0; et < 4; ++et) { float f[4]; unpack4(y0raw[et], f); f32x4 acc = {f[0], f[1], f[2], f[3]};
        acc = MFMA16(gfrag(SS, 64, 16 * et, 0, lane), rp0, acc); acc = MFMA16(gfrag(SS, 64, 16 * et, 32, lane), rp1, acc);
        y[et] = acc; s1 += (acc[0] + acc[1]) + (acc[2] + acc[3]); s2 += (acc[0] * acc[0] + acc[1] * acc[1]) + (acc[2] * acc[2] + acc[3] * acc[3]);
        f32x4 ga = F4Z;
#pragma unroll
        for (int ks = 0; ks < 5; ++ks) ga = MFMA16(K.gup[et][ks], sg[ks], ga);
        g[et] = ga; }
    s1 += __shfl_xor(s1, 16); s1 += __shfl_xor(s1, 32); s2 += __shfl_xor(s2, 16); s2 += __shfl_xor(s2, 32);
    const float mean = s1 * (1.0f / 64.0f), var = fmaxf(s2 * (1.0f / 64.0f) - mean * mean, 0.f), rstd = rsqrtf(var + RW_GN_EPS);
    bf16_t* YRW = (bf16_t*)(ws + WS_YRW);
#pragma unroll
    for (int et = 0; et < 4; ++et) { const int col = 64 * h + 16 * et + 4 * fq;
        float vv[4]; unpack4(vraw[et], vv);
        float o[4];
#pragma unroll
        for (int r = 0; r < 4; ++r) o[r] = ((y[et][r] - mean) * rstd * K.lnw[et][r] + K.lnb[et][r] + rk * vv[r]) * g[et][r];
        *(u32x2*)(YRW + m * 1024 + col) = pack4(o[0], o[1], o[2], o[3]); }
}
constexpr int P7L = 264;
constexpr int P7_HI = 0, P7_LO = 64 * P7L * 2, P7_LG = 2 * P7_LO, P7_RS = P7_LG + 2 * 64 * 48 * 4, P7_HIST = P7_RS + 256;
DI void p7_route(PR p, const Ctx& c, int l) {
    unsigned char* ws = p.ws;
    const int lane = c.lane, w = c.wave, fr = lane & 15, fq = lane >> 4;
    const float* H = p.out; bf16_t* HN = (bf16_t*)(ws + WS_XN);
    const float* nw = p.in[I_NFFN] + (size_t)l * D; const bf16_t* WRH = (const bf16_t*)(ws + WS_LORA + LO_WR); const bf16_t* WRL = (const bf16_t*)(ws + WS_LORA + LO_WRL);
    const float* bg = p.in[I_RGB] + l * 4; const float* be = p.in[I_REB] + l * 32;
    int* TOKE = (int*)(ws + WS_TOKE); float* TOKW = (float*)(ws + WS_TOKW); int* CNT = (int*)(ws + WS_CNT); float* TRSTD = (float*)(ws + WS_TRSTD);
    LAS bf16_t* HI = (LAS bf16_t*)(c.lds + P7_HI); LAS bf16_t* LO = (LAS bf16_t*)(c.lds + P7_LO); LAS float* LG = (LAS float*)(c.lds + P7_LG); LAS float* RS = (LAS float*)(c.lds + P7_RS); LAS int* hist = (LAS int*)(c.lds + P7_HIST);
    for (int tile = c.bid; tile < M / 64; tile += c.G) {
        if (c.tid < 32) hist[c.tid] = 0;
        const int tt = w & 3, kh = w >> 2, mb = tile * 64 + 8 * w;
        f32x4 acc[3] = {F4Z, F4Z, F4Z}; float ss[8];
#pragma unroll
        for (int i = 0; i < 8; ++i) ss[i] = 0.f;
        for (int kc = 0; kc < 8; ++kc) {
            const f32x4 ww = *(const f32x4*)(nw + 256 * kc + 4 * lane);
            f32x4 hv[8];
#pragma unroll
            for (int i = 0; i < 8; ++i) hv[i] = *(const f32x4*)(H + (size_t)(mb + i) * D + 256 * kc + 4 * lane);
            bf16x8 wh[4][3], wl[4][3];
#pragma unroll
            for (int k4 = 0; k4 < 4; ++k4)
#pragma unroll
                for (int ct = 0; ct < 3; ++ct) { const int kg = 256 * kc + 32 * (4 * kh + k4); wh[k4][ct] = gfrag(WRH, D, 16 * ct, kg, lane); wl[k4][ct] = gfrag(WRL, D, 16 * ct, kg, lane); }
#pragma unroll
            for (int i = 0; i < 8; ++i) { ss[i] += (hv[i].x * hv[i].x + hv[i].y * hv[i].y) + (hv[i].z * hv[i].z + hv[i].w * hv[i].w);
                const f32x4 x = hv[i] * ww; const u32x2 hp = pack4(x.x, x.y, x.z, x.w); float hf[4]; unpack4(hp, hf);
                *(u32x2*)(HN + (size_t)(mb + i) * D + 256 * kc + 4 * lane) = hp;
                *(LAS u32x2*)(HI + (8 * w + i) * P7L + 4 * lane) = hp; *(LAS u32x2*)(LO + (8 * w + i) * P7L + 4 * lane) = pack4(x.x - hf[0], x.y - hf[1], x.z - hf[2], x.w - hf[3]); }
            lds_barrier();
#pragma unroll
            for (int k4 = 0; k4 < 4; ++k4) { const int ks = 4 * kh + k4;
                const bf16x8 xh = frag_n<P7L>(HI, 16 * tt, 32 * ks, lane), xl = frag_n<P7L>(LO, 16 * tt, 32 * ks, lane);
#pragma unroll
                for (int ct = 0; ct < 3; ++ct) { acc[ct] = MFMA16(wh[k4][ct], xh, acc[ct]); acc[ct] = MFMA16(wh[k4][ct], xl, acc[ct]); acc[ct] = MFMA16(wl[k4][ct], xh, acc[ct]); } }
            lds_barrier();
        }
#pragma unroll
        for (int i = 0; i < 8; ++i) { const float r = rsqrtf(wave_sum(ss[i]) * (1.f / D) + NORM_EPS); if (lane == i) { RS[8 * w + i] = r; TRSTD[mb + i] = r; } }
#pragma unroll
        for (int ct = 0; ct < 3; ++ct) *(LAS f32x4*)(LG + (kh * 64 + 16 * tt + fr) * 48 + 16 * ct + 4 * fq) = acc[ct];
        __syncthreads();
        if (c.tid < 64) { const int t = c.tid, m = tile * 64 + t; const float rstd = RS[t];
            const LAS float* l0 = LG + t * 48; const LAS float* l1 = LG + (64 + t) * 48;
            float gl[4]; int gs = 0;
#pragma unroll
            for (int i = 0; i < 4; ++i) gl[i] = (l0[i] + l1[i]) * rstd + bg[i];
#pragma unroll
            for (int i = 1; i < 4; ++i) if (gl[i] > gl[gs]) gs = i;
            float den = 0.f;
#pragma unroll
            for (int i = 0; i < 4; ++i) den += __expf(gl[i] - gl[gs]);
            const float pg = 1.0f / den;
            float el[8]; int i1 = 0, i2 = -1;
#pragma unroll
            for (int i = 0; i < 8; ++i) el[i] = (l0[4 + 8 * gs + i] + l1[4 + 8 * gs + i]) * rstd + be[8 * gs + i];
#pragma unroll
            for (int i = 1; i < 8; ++i) if (el[i] > el[i1]) i1 = i;
#pragma unroll
            for (int i = 0; i < 8; ++i) if (i != i1 && (i2 < 0 || el[i] > el[i2])) i2 = i;
            const float e2 = __expf(el[i2] - el[i1]), w1 = pg / (1.0f + e2), w2 = pg * e2 / (1.0f + e2);
            TOKE[2 * m] = 8 * gs + i1; TOKE[2 * m + 1] = 8 * gs + i2; TOKW[2 * m] = w1; TOKW[2 * m + 1] = w2;
            atomicAdd((int*)&hist[8 * gs + i1], 1); atomicAdd((int*)&hist[8 * gs + i2], 1); }
        __syncthreads();
        if (c.tid < 32) CNT[tile * 32 + c.tid] = hist[c.tid];
        __syncthreads();
    }
}
DI void moe_tables(PR p, const Ctx& c) {
    const int* CNT = (const int*)(p.ws + WS_CNT);
    LAS int* LC = (LAS int*)(c.lds + LDS_CTL_OFF);
    LAS int* part = (LAS int*)(c.lds + 72000);
    { const int e = c.tid & 31, pr = c.tid >> 5; int v[16];
#pragma unroll
      for (int i = 0; i < 16; ++i) v[i] = CNT[(pr + 16 * i) * 32 + e];
      int s = 0;
#pragma unroll
      for (int i = 0; i < 16; ++i) s += v[i];
      part[pr * 32 + e] = s; }
    __syncthreads();
    if (c.tid < 32) { int s = 0;
#pragma unroll 1
        for (int pr = 0; pr < 16; ++pr) s += part[pr * 32 + c.tid];
        LC[LC_TOT + c.tid] = s; }
    __syncthreads();
    if (c.tid < 64) {
        const int e = c.tid & 31; const int nt = (LC[LC_TOT + e] + 255) >> 8; int inc = nt;
#pragma unroll
        for (int o = 1; o < 32; o <<= 1) { const int v = __shfl_up(inc, o, 32); if ((c.tid & 31) >= o) inc += v; }
        if (c.tid < 32) { LC[LC_PAD + e] = (inc - nt) << 8; if (e == 31) LC[LC_PAD + 32] = inc << 8; }
    }
    __syncthreads();
    if (c.tid < 160) { int e = 0;
#pragma unroll 1
        for (int i = 0; i < 32; ++i) if ((LC[LC_PAD + i] >> 8) <= c.tid) e = i;
        LC[LC_TILE + c.tid] = e; }
    __syncthreads();
}
DI void p8_dispatch(PR p, const Ctx& c) {
    unsigned char* ws = p.ws;
    const int* CNT = (const int*)(ws + WS_CNT); const int* TOKE = (const int*)(ws + WS_TOKE); int* TOKS = (int*)(ws + WS_TOKS);
    const bf16_t* HN = (const bf16_t*)(ws + WS_XN); bf16_t* XS = (bf16_t*)(ws + WS_XS);
    LAS int* LC = (LAS int*)(c.lds + LDS_CTL_OFF);
    LAS int* base = (LAS int*)(c.lds + 76000); LAS int* part = (LAS int*)(c.lds + 72000); LAS int* eids = (LAS int*)(c.lds + 77000); LAS int* slots = (LAS int*)(c.lds + 78000);
    for (int tile = c.bid; tile < M / 64; tile += c.G) {
        { const int e = c.tid & 31, pr = c.tid >> 5; int v[16];
#pragma unroll
          for (int i = 0; i < 16; ++i) { const int tl = pr + 16 * i; v[i] = CNT[(tl < tile ? tl : 0) * 32 + e]; }
          int s = 0;
#pragma unroll
          for (int i = 0; i < 16; ++i) s += (pr + 16 * i < tile) ? v[i] : 0;
          part[pr * 32 + e] = s; }
        if (c.tid < 128) eids[c.tid] = TOKE[tile * 128 + c.tid];
        __syncthreads();
        if (c.tid < 32) { int s = 0; for (int pr = 0; pr < 16; ++pr) s += part[pr * 32 + c.tid]; base[c.tid] = s; }
        __syncthreads();
        if (c.tid < 128) { const int e = eids[c.tid]; int lp = 0; for (int i = 0; i < c.tid; ++i) lp += (eids[i] == e) ? 1 : 0;
            const int s = LC[LC_PAD + e] + base[e] + lp; slots[c.tid] = s; TOKS[tile * 128 + c.tid] = s; ((int*)(ws + WS_CTL + CTL_SLOTTOK))[s] = tile * 64 + (c.tid >> 1); ((float*)(ws + WS_SRSTD))[s] = ((const float*)(ws + WS_TRSTD))[tile * 64 + (c.tid >> 1)]; }
        __syncthreads();
        __syncthreads();
    }
}
DI void p11_combine(PR p, const Ctx& c, int l) {
    unsigned char* ws = p.ws;
    const int lane = c.lane; const int gw = c.bid * 8 + c.wave, NGW = c.G * 8;
    float* H = p.out; const bf16_t* YS = (const bf16_t*)(ws + WS_YS); const int* TOKS = (const int*)(ws + WS_TOKS); const float* TOKW = (const float*)(ws + WS_TOKW);
    bf16_t* XN = (bf16_t*)(ws + WS_XN);
    const float* nw = (l == 0) ? p.in[I_NMIX] + D : p.in[I_FNW];
    f32x4 ww[8];
#pragma unroll
    for (int j = 0; j < 8; ++j) ww[j] = ((const f32x4*)nw)[lane + 64 * j];
    if (gw >= M) return;
    int s0 = TOKS[2 * gw], s1 = TOKS[2 * gw + 1]; float w0 = TOKW[2 * gw], w1 = TOKW[2 * gw + 1];
    for (int m = gw; m < M; m += NGW) {
        f32x4* hr = (f32x4*)(H + (size_t)m * D) + lane; const u32x2* y0 = (const u32x2*)(YS + (size_t)s0 * D) + lane; const u32x2* y1 = (const u32x2*)(YS + (size_t)s1 * D) + lane;
        f32x4 hv[8]; u32x2 ya[8], yb[8];
#pragma unroll
        for (int j = 0; j < 8; ++j) { hv[j] = hr[64 * j]; ya[j] = y0[64 * j]; yb[j] = y1[64 * j]; }
        const float cw0 = w0, cw1 = w1;
        { const int mn = (m + NGW < M) ? m + NGW : m; s0 = TOKS[2 * mn]; s1 = TOKS[2 * mn + 1]; w0 = TOKW[2 * mn]; w1 = TOKW[2 * mn + 1]; }
        float s = 0.f;
#pragma unroll
        for (int j = 0; j < 8; ++j) { float a[4], b[4]; unpack4(ya[j], a); unpack4(yb[j], b);
            hv[j].x += cw0 * a[0] + cw1 * b[0]; hv[j].y += cw0 * a[1] + cw1 * b[1]; hv[j].z += cw0 * a[2] + cw1 * b[2]; hv[j].w += cw0 * a[3] + cw1 * b[3];
            s += (hv[j].x * hv[j].x + hv[j].y * hv[j].y) + (hv[j].z * hv[j].z + hv[j].w * hv[j].w); }
        const float rstd = rsqrtf(wave_sum(s) * (1.f / D) + NORM_EPS);
#pragma unroll
        for (int j = 0; j < 8; ++j) {
            if (l == 0) { hr[64 * j] = hv[j]; ((u32x2*)(XN + (size_t)m * D))[lane + 64 * j] = pack4(hv[j].x * rstd * ww[j].x, hv[j].y * rstd * ww[j].y, hv[j].z * rstd * ww[j].z, hv[j].w * rstd * ww[j].w); }
            else hr[64 * j] = hv[j] * rstd * ww[j]; }
    }
}
#ifndef DBG_CUT
#define DBG_CUT 1000
#endif
constexpr int NPHASE = 23;
#ifndef WGM_P1
#define WGM_P1 4
#endif
#ifndef WGM_P56
#define WGM_P56 2
#endif
#ifndef REP_R1
#define REP_R1 1
#endif
#ifndef REP_H1
#define REP_H1 1
#endif
#ifndef REP_R2
#define REP_R2 1
#endif
#ifndef REP_H3
#define REP_H3 1
#endif
#ifndef REP_R3
#define REP_R3 1
#endif
#ifndef PH_MASK
#define PH_MASK 0xFFFF
#endif
#define PH_EN(n) ((PH_MASK >> (n)) & 1)
__global__ void __launch_bounds__(512, 2) mk_fwd(Params p_byval) {
    const CAS Params* pp = (const CAS Params*)__builtin_amdgcn_kernarg_segment_ptr();
#define p (*pp)
    extern __shared__ __attribute__((aligned(16))) unsigned char lds_raw[];
    Ctx c; unsigned char* ws;
#define FRESH() do { int t_ = threadIdx.x; asm volatile("" : "+v"(t_)); int b_ = blockIdx.x; asm volatile("" : "+s"(b_)); unsigned lb_ = (unsigned)(uintptr_t)(LAS unsigned char*)lds_raw; asm volatile("" : "+s"(lb_)); c.lds = (LAS unsigned char*)(uintptr_t)lb_; c.tid = t_; c.lane = t_ & 63; \
        c.wave = __builtin_amdgcn_readfirstlane(t_ >> 6); c.G = gridDim.x; c.bid = b_; pp = (const CAS Params*)__builtin_amdgcn_kernarg_segment_ptr(); asm volatile("" : "+s"(pp)); ws = p.ws; asm volatile("" : "+s"(ws)); glds = (LAS unsigned char*)c.lds; } while (0)
    LAS unsigned char* glds;
    FRESH();
    LAS unsigned* LCU = (LAS unsigned*)(c.lds + LDS_CTL_OFF);
    if (c.tid < 4) LCU[c.tid] = 0u;
    __syncthreads();
#if MK_ONE_LAUNCH
    XcdBarrier bar = xcd_barrier_post((unsigned*)(ws + WS_CTL) + CW_BAR, (volatile LAS unsigned*)LCU);
#define GRID_BAR() xcd_barrier(bar)
#else
#define GRID_BAR() do { } while (0)
#endif
    const int lo = p.ph_lo, hi_raw = p.ph_hi; int hi = hi_raw & 0xffff; const int dbgflag = hi_raw >> 16; (void)dbgflag;
#define IN(k) (lo <= (k) && (k) < hi)
#define SEAM(k) do { if (IN(k) && IN((k) + 1)) GRID_BAR(); } while (0)
    if (PH_EN(0) && IN(0)) { FRESH();
        convert_small(p, c, 0, 0);
        const int gw = c.bid * 8 + c.wave, NGW = c.G * 8;
        for (int m = gw; m < M; m += NGW) rms_row_bf16(p.in[I_X] + (size_t)m * D, p.in[I_NMIX], (bf16_t*)(ws + WS_XN) + (size_t)m * D, c.lane);
    }
    SEAM(0);
    for (int l = 0; l < 2; ++l) {
        const int pb = 1 + 11 * l;
        if (PH_EN(1) && IN(pb + 0)) { FRESH();
            pg8::Gemm g{(const bf16_t*)(ws + WS_XN), (const bf16_t*)(ws + WS_WIN), M, NZ, D}; pg8::StaticOrder S; S.init(M, NZ, c.G, c.bid, WGM_P1);
            if (dbgflag == 3) { S.nM = 1; S.nN = 1; S.hot = 1; }
            pg8::EpiBf16P E{(bf16_t*)(ws + WS_Z), NZ, dbgflag == 3 ? 1 : dbgflag};
#ifdef STAGGER_TICKS
            if (c.bid & 1) { const unsigned long long t0 = __builtin_amdgcn_s_memrealtime(); while (__builtin_amdgcn_s_memrealtime() - t0 < STAGGER_TICKS) __builtin_amdgcn_s_sleep(32); }
#endif
            pg8::gemm_phase<pg8::EpiBf16P, pg8::StaticOrder>(glds, g, S, E, nullptr);
            const int nunits = (M / 256) * (NZ / 256), rem = nunits % c.G;
            if (rem != 0 && c.bid >= rem && EXP_EARLY > 0) { __syncthreads(); FRESH(); convert_experts_early(p, c, l, rem, c.G - rem); }
        }
        SEAM(pb + 0);
        if (PH_EN(2) && IN(pb + 1)) { FRESH();
            if (c.bid < 4096) { R1In rin = r1_load(ws, c.bid, c.tid);
              for (int it = c.bid; it < 4096; it += c.G) rin = r1_task<0>(p, c, l, it, rin, it + c.G < 4096 ? it + c.G : it); }
            if (c.bid < 2048) { H1In hin = h1_load(ws, c.bid, c.tid);
              for (int it = c.bid; it < 2048; it += c.G) hin = h1_task(p, c, l, it, hin, it + c.G < 2048 ? it + c.G : it); }
        }
        SEAM(pb + 1);
        if (PH_EN(3) && IN(pb + 2)) { FRESH();
            if (c.G >= 128) { if (c.bid < 64) { for (int rep = 0; rep < REP_R2; ++rep) r2_task(p, c, c.bid); } else for (int it = c.bid - 64; it < 256; it += c.G - 64) h2_item(p, c, it); }
            else { for (int it = c.bid; it < 64; it += c.G) r2_task(p, c, it); for (int it = c.bid; it < 256; it += c.G) h2_item(p, c, it); }
        }
        SEAM(pb + 2);
        if (PH_EN(4) && IN(pb + 3)) { FRESH();
            { const int gw = c.bid * 8 + c.wave, NGW = c.G * 8;
              { f32x4 onw[8];
#pragma unroll
                for (int et = 0; et < 8; ++et) onw[et] = *(const f32x4*)(p.in[I_ONORM] + l * 128 + 16 * et + 4 * (c.lane >> 4));
                for (int wt = gw; wt < 8192; wt += NGW) h3_wave(onw, p, l, wt, c.lane); }
              if (gw < 16384) { R3Const K3; const bool inv = (NGW % 2048) == 0;
                r3_const(K3, p, l, ((gw >> 2) >> 5) & 15, c.lane);
                for (int wt = gw; wt < 16384; wt += NGW) { if (!inv) r3_const(K3, p, l, ((wt >> 2) >> 5) & 15, c.lane); r3_wave(K3, p, l, wt, c.lane); } } }
        }
        SEAM(pb + 3);
        if (PH_EN(5) && IN(pb + 4)) { FRESH();
            pg8::StaticOrder S; S.init(M, D, c.G, c.bid, WGM_P56);
#ifndef DBG_NO_HG
            { pg8::Gemm g{(const bf16_t*)(ws + WS_YHG), (const bf16_t*)(ws + WS_WBH), M, D, 1024};
              pg8::EpiGate E{(bf16_t*)(ws + WS_XN), D, (const bf16_t*)(ws + WS_Z) + ZC_GA, NZ, 0, dbgflag};
              pg8::gemm_phase<pg8::EpiGate, pg8::StaticOrder>(glds, g, S, E, nullptr); }
#endif
#ifndef DBG_NO_RW
            { pg8::Gemm g{(const bf16_t*)(ws + WS_YRW), (const bf16_t*)(ws + WS_WBR), M, D, 1024};
#ifdef DBG_NO_HG
              pg8::EpiGate E{(bf16_t*)(ws + WS_XN), D, (const bf16_t*)(ws + WS_Z) + ZC_GB, NZ, 0, dbgflag};
#else
              pg8::EpiGate E{(bf16_t*)(ws + WS_XN), D, (const bf16_t*)(ws + WS_Z) + ZC_GB, NZ, 1, dbgflag};
#endif
              pg8::gemm_phase<pg8::EpiGate, pg8::StaticOrder>(glds, g, S, E, nullptr); }
#endif
        }
        SEAM(pb + 4);
        if (PH_EN(6) && IN(pb + 5)) { FRESH();
            pg8::Gemm g{(const bf16_t*)(ws + WS_XN), (const bf16_t*)(ws + WS_WO), M, D, D}; pg8::StaticOrder S; S.init(M, D, c.G, c.bid, WGM_P56);
            pg8::EpiRes E{l == 0 ? p.in[I_X] : p.out, p.out, D, dbgflag};
            pg8::gemm_phase<pg8::EpiRes, pg8::StaticOrder>(glds, g, S, E, nullptr);
        }
        SEAM(pb + 5);
        if (PH_EN(7) && IN(pb + 6)) { FRESH();
            { const int nunits = (M / 256) * (NZ / 256); convert_experts(p, c, l, (nunits % c.G) != 0 ? EXP_EARLY : 0); }
            __syncthreads();
            p7_route(p, c, l);
        }
        SEAM(pb + 6);
        if (PH_EN(8) && IN(pb + 7)) { FRESH(); moe_tables(p, c); p8_dispatch(p, c); }
        SEAM(pb + 7);
        if (PH_EN(9) && IN(pb + 8)) { FRESH();
            moe_tables(p, c); FRESH();
            const LAS int* LC = (const LAS int*)(c.lds + LDS_CTL_OFF);
            pg8::Gemm g{(const bf16_t*)(ws + WS_XN), (const bf16_t*)(ws + WS_WGU), MAXSLOTS, NEXP * 1024, D, (const int*)(ws + WS_CTL + CTL_SLOTTOK)};
            pg8::GroupedOrder<4> S{(LC[LC_PAD + 32] >> 8) * 4, c.G, c.bid, LC + LC_TILE};
            pg8::EpiSwiGLU E{(bf16_t*)(ws + WS_ACT), (const float*)(ws + WS_SRSTD), dbgflag};
            pg8::gemm_phase<pg8::EpiSwiGLU, pg8::GroupedOrder<4>, false, true>(glds, g, S, E, nullptr);
        }
        SEAM(pb + 8);
        if (PH_EN(10) && IN(pb + 9)) { FRESH();
            moe_tables(p, c); FRESH();
            const LAS int* LC = (const LAS int*)(c.lds + LDS_CTL_OFF);
            pg8::Gemm g{(const bf16_t*)(ws + WS_ACT), (const bf16_t*)(ws + WS_WDN), MAXSLOTS, NEXP * D, DEXP};
            pg8::GroupedOrder<8> S{(LC[LC_PAD + 32] >> 8) * 8, c.G, c.bid, LC + LC_TILE};
            pg8::EpiDown E{(bf16_t*)(ws + WS_YS), dbgflag};
            pg8::gemm_phase<pg8::EpiDown, pg8::GroupedOrder<8>>(glds, g, S, E, nullptr);
        }
        SEAM(pb + 9);
        if (PH_EN(11) && IN(pb + 10)) { FRESH();
            if (dbgflag == 0) p11_combine(p, c, l);
            if (l == 0 && dbgflag != 2) convert_small(p, c, 1, 0);
        }
        SEAM(pb + 10);
    }
}
#undef p
__global__ void __launch_bounds__(512) dbg_final(const float* src, const float* fw, float* out) {
    const int lane = threadIdx.x & 63, gw = blockIdx.x * 8 + (threadIdx.x >> 6), NGW = gridDim.x * 8;
    for (int m = gw; m < M; m += NGW) { const f32x4* xr = (const f32x4*)(src + (size_t)m * D) + lane; f32x4 v[8]; float s = 0.f;
#pragma unroll
        for (int j = 0; j < 8; ++j) { v[j] = xr[64 * j]; s += (v[j].x * v[j].x + v[j].y * v[j].y) + (v[j].z * v[j].z + v[j].w * v[j].w); }
        const float rstd = rsqrtf(wave_sum(s) * (1.f / D) + NORM_EPS);
#pragma unroll
        for (int j = 0; j < 8; ++j) ((f32x4*)(out + (size_t)m * D))[lane + 64 * j] = v[j] * rstd * ((const f32x4*)fw)[lane + 64 * j]; }
}
#ifdef DBG_CHECK
__global__ void __launch_bounds__(512) dbg_check(const void* buf, size_t n, int is_f32, unsigned* flag, unsigned idx) {
    size_t i = (size_t)blockIdx.x * 512 + threadIdx.x, st = (size_t)gridDim.x * 512; bool bad = false;
#ifdef DBG_DEAD
    bool alive = false;
    for (; i < n; i += st) { float v = is_f32 ? ((const float*)buf)[i] : bf2f(((const bf16_t*)buf)[i]); if (fabsf(v) > 0.01f && fabsf(v) < 1e6f) alive = true; }
    __shared__ int anyalive; if (threadIdx.x == 0) anyalive = 0; __syncthreads(); if (alive) anyalive = 1; __syncthreads();
    if (threadIdx.x == 0 && anyalive) atomicOr(flag + 1 + idx, 1u);
#else
    for (; i < n; i += st) { float v = is_f32 ? ((const float*)buf)[i] : bf2f(((const bf16_t*)buf)[i]); if (!(v - v == 0.f)) bad = true; }
    if (bad) atomicMin(flag, idx);
#endif
}
__global__ void __launch_bounds__(512) dbg_scale(float* out, const unsigned* flag) {
#ifdef DBG_DEAD
    unsigned f = 1000u; for (unsigned i = 1; i <= 18; ++i) if (flag[1 + i] == 0u) { f = i; break; }
#else
    const unsigned f = *flag;
#endif
    const float s = f < 100u ? 1.0f + 0.25f * (float)f : 1.0f;
    for (size_t i = (size_t)blockIdx.x * 512 + threadIdx.x; i < (size_t)M * D; i += (size_t)gridDim.x * 512) out[i] *= s;
}
#endif
#ifdef DBG_TRTEST
__global__ void __launch_bounds__(64) dbg_trtest(unsigned* flag) {
    __shared__ __attribute__((aligned(16))) bf16_t A[64 * 72];
    const int lane = threadIdx.x;
    for (int i = lane; i < 64 * 72; i += 64) { const int r = i / 72, cc = i % 72; const float v = (float)((r * 5 + cc * 3) & 255); A[i] = (bf16_t)(cvt_pk(v, 0.f) & 0xffff); }
    __syncthreads();
    unsigned bad = 0;
    for (int row0 = 0; row0 < 64; row0 += 16) for (int k0 = 0; k0 < 64; k0 += 32) {
        const bf16x8 f = frag_t<72>((const LAS bf16_t*)A, row0, k0, lane);
        for (int j = 0; j < 8; ++j) { const int k = k0 + 8 * (lane >> 4) + j, i = row0 + (lane & 15); if ((bf16_t)f[j] != A[k * 72 + i]) bad = 1; }
    }
    if (bad) atomicMin(flag, 2u);
    f32x4 acc = {0.f, 0.f, 0.f, 0.f}; bf16x8 xa, yb;
    for (int j = 0; j < 8; ++j) { const int k = 8 * (lane >> 4) + j, r = lane & 15; xa[j] = (short)(cvt_pk(r == k ? 1.f : 0.f, 0.f) & 0xffff); yb[j] = (short)(cvt_pk((float)(r * 8 + (k & 7)), 0.f) & 0xffff); }
    acc = MFMA16(yb, xa, acc);
    for (int r = 0; r < 4; ++r) { const int pp_ = lane & 15, q = 4 * (lane >> 4) + r; if (acc[r] != (float)(q * 8 + (pp_ & 7))) bad |= 2; }
    if (bad & 2) atomicMin(flag, 3u);
}
#endif
#ifdef DBG_H1TEST
__global__ void __launch_bounds__(512) dbg_h1test(unsigned* flag) {
    extern __shared__ __attribute__((aligned(16))) unsigned char lraw[];
    LAS unsigned char* lds = (LAS unsigned char*)lraw;
    LAS bf16_t* Vs = (LAS bf16_t*)(lds + H_V); LAS bf16_t* KPs = (LAS bf16_t*)(lds + H_KP); LAS bf16_t* QHs = (LAS bf16_t*)(lds + H_QH); LAS bf16_t* KTs = (LAS bf16_t*)(lds + H_KT);
    const int tid = threadIdx.x, lane = tid & 63, w = tid >> 6, fr = lane & 15, fq = lane >> 4;
    for (int i = tid; i < 32 * HL; i += 512) { const int r = i / HL, cc = i % HL;
        Vs[i] = (bf16_t)(cvt_pk((float)((r * 3 + cc) % 7 - 3), 0.f) & 0xffff); KPs[i] = (bf16_t)(cvt_pk((float)((r + cc * 5) % 5 - 2), 0.f) & 0xffff);
        QHs[i] = (bf16_t)(cvt_pk((float)((r * 2 + cc) % 3 - 1), 0.f) & 0xffff); KTs[i] = (bf16_t)(cvt_pk((float)((r + cc) % 4 - 1), 0.f) & 0xffff); }
    __syncthreads();
    unsigned bad = 0;
    const bf16x8 xb = frag_t<HL>(Vs, 16 * w, 0, lane);
    for (int dn = 0; dn < 8; ++dn) { const bf16x8 ya = frag_t<HL>(KPs, 16 * dn, 0, lane); const f32x4 nt = MFMA16(ya, xb, F4Z);
        for (int r = 0; r < 4; ++r) { const int e = 16 * w + fr, d = 16 * dn + 4 * fq + r; float ref = 0.f; for (int s = 0; s < 32; ++s) ref += (float)((s * 3 + e) % 7 - 3) * (float)((s + d * 5) % 5 - 2); if (nt[r] != ref) bad |= 1; } }
    if (w < 4) { const int p0 = 16 * (w >> 1), q0 = 16 * (w & 1);
        const f32x4 sc = mm16<false, false, 4, HL, HL>(QHs, KTs, p0, q0, lane, F4Z);
        for (int r = 0; r < 4; ++r) { const int t = p0 + fr, s = q0 + 4 * fq + r; float ref = 0.f; for (int d = 0; d < 128; ++d) ref += (float)((t * 2 + d) % 3 - 1) * (float)((s + d) % 4 - 1); if (sc[r] != ref) bad |= 2; } }
    if (bad & 1) atomicMin(flag, 2u);
    if (bad & 2) atomicMin(flag, 3u);
}
#endif
#ifdef DBG_CLASS
__global__ void __launch_bounds__(512) dbg_class(const bf16_t* buf, size_t n, unsigned* flag) {
    unsigned m = 0;
    for (size_t i = (size_t)blockIdx.x * 512 + threadIdx.x; i < n; i += (size_t)gridDim.x * 512) { const bf16_t b = buf[i]; const float v = bf2f(b); const float a = fabsf(v);
        if (b == 0xAAAA) m |= 4; else if (a == 0.f) m |= 2; else if (a > 0.01f && a < 1e6f) m |= 1; else if (!(a < 1e6f)) m |= 8; else m |= 16; }
    if (m) atomicOr(flag + 40, m);
}
__global__ void __launch_bounds__(512) dbg_scale2(float* out, const unsigned* flag) {
    const unsigned f = flag[40]; const float s = 1.0f + 0.25f * (float)f;
    for (size_t i = (size_t)blockIdx.x * 512 + threadIdx.x; i < (size_t)M * D; i += (size_t)gridDim.x * 512) out[i] *= s;
}
#endif
#ifdef DBG_CSUM
__global__ void __launch_bounds__(512) dbg_csum(const unsigned* buf, size_t nwords, unsigned* flag) {
    unsigned long long s = 0;
    for (size_t i = (size_t)blockIdx.x * 512 + threadIdx.x; i < nwords; i += (size_t)gridDim.x * 512) s += (unsigned long long)buf[i] * (unsigned long long)((i & 1023) + 1);
    atomicAdd((unsigned long long*)(flag + 42), s);
}
__global__ void __launch_bounds__(512) dbg_scale3(float* out, const unsigned* flag) {
    const unsigned long long c = *(const unsigned long long*)(flag + 42); const float s = 1.0f + 0.25f * (float)((c >> 7) & 3ull);
    for (size_t i = (size_t)blockIdx.x * 512 + threadIdx.x; i < (size_t)M * D; i += (size_t)gridDim.x * 512) out[i] *= s;
}
#endif
#ifdef DBG_ZCOLS
__global__ void __launch_bounds__(512) dbg_zcols(const bf16_t* Z, unsigned* flag) {
    const int starts[13] = {0, 1024, 2048, 3072, 4096, 5120, 6144, 7168, 7232, 7296, 7456, 9504, 11552};
    __shared__ int alive[12];
    if (threadIdx.x < 12) alive[threadIdx.x] = 0; __syncthreads();
    for (int row = blockIdx.x; row < M; row += gridDim.x) { const bf16_t* zr = Z + (size_t)row * NZ;
        for (int cidx = threadIdx.x; cidx < 11552; cidx += 512) { const float a = fabsf(bf2f(zr[cidx])); if (a > 0.01f && a < 1e6f) { int seg = 0; for (int s = 0; s < 12; ++s) if (cidx >= starts[s]) seg = s; alive[seg] = 1; } } }
    __syncthreads();
    if (threadIdx.x < 12 && alive[threadIdx.x]) atomicOr(flag + 2 + threadIdx.x, 1u);
}
#endif
#ifdef DBG_WROWS
__global__ void __launch_bounds__(512) dbg_wrows(const bf16_t* W, unsigned* flag) {
    const int starts[13] = {0, 1024, 2048, 3072, 4096, 5120, 6144, 7168, 7232, 7296, 7456, 9504, 11552};
    for (int row = blockIdx.x; row < 11552; row += gridDim.x) { bool alive = false;
        for (int cidx = threadIdx.x; cidx < 2048; cidx += 512) { const float a = fabsf(bf2f(W[(size_t)row * 2048 + cidx])); if (a > 0.001f && a < 1e6f) alive = true; }
        if (alive) { int seg = 0; for (int s = 0; s < 12; ++s) if (row >= starts[s]) seg = s; atomicOr(flag + 2 + seg, 1u); } }
}
#endif
extern "C" void kernel_launch(void* const* d_in, const int* in_sizes, int n_in, void* d_out, int out_size, void* d_ws, size_t ws_size, hipStream_t stream) {
    static int grid = 0;
    if (grid == 0) {
        if (n_in != 31 || out_size != M * D || ws_size < WS_END) { fprintf(stderr, "kernel_launch: unexpected shapes (n_in %d out %d ws %zu)\n", n_in, out_size, ws_size); grid = -1; return; }
        int dev = 0, cus = 0;
        if (hipGetDevice(&dev) != hipSuccess || hipDeviceGetAttribute(&cus, hipDeviceAttributeMultiprocessorCount, dev) != hipSuccess) { grid = -1; return; }
        if (hipFuncSetAttribute((const void*)mk_fwd, hipFuncAttributeMaxDynamicSharedMemorySize, LDS_BYTES) != hipSuccess) { fprintf(stderr, "kernel_launch: hipFuncSetAttribute failed\n"); grid = -1; return; }
        int per_cu = 0;
        if (hipOccupancyMaxActiveBlocksPerMultiprocessor(&per_cu, (const void*)mk_fwd, 512, LDS_BYTES) != hipSuccess || per_cu < 1) { fprintf(stderr, "kernel_launch: occupancy query says %d\n", per_cu); }
        (void)hipGetLastError();
        grid = cus;
    }
    if (grid < 0) return;
    (void)hipMemsetAsync((char*)d_ws + WS_CTL, 0, CTL_BYTES, stream);
    Params p{};
    for (int i = 0; i < 31; ++i) p.in[i] = (const float*)d_in[i];
    p.out = (float*)d_out; p.ws = (unsigned char*)d_ws;
    const int nph = NPHASE < DBG_CUT ? NPHASE : DBG_CUT;
#if MK_ONE_LAUNCH
    p.ph_lo = 0; p.ph_hi = nph;
    hipLaunchKernelGGL(mk_fwd, dim3(grid), dim3(512), LDS_BYTES, stream, p);
#else
    for (int ph = 0; ph < nph; ++ph) { p.ph_lo = ph; p.ph_hi = ph + 1; hipLaunchKernelGGL(mk_fwd, dim3(grid), dim3(512), LDS_BYTES, stream, p);
#ifdef DUP_PID
        if (ph == DUP_PID) {
#ifdef DUP_FLAG
            p.ph_hi |= (DUP_FLAG << 16);
#endif
            hipLaunchKernelGGL(mk_fwd, dim3(grid), dim3(512), LDS_BYTES, stream, p); }
#endif
    }
#endif
#if defined(DBG_ZCOLS)
    { unsigned* flag = (unsigned*)((char*)d_ws + 512 * 1024); (void)hipMemsetAsync(flag, 0, 256, stream);
#ifdef DBG_WROWS
      hipLaunchKernelGGL(dbg_wrows, dim3(1024), dim3(512), 0, stream, (const bf16_t*)((char*)d_ws + WS_WIN), flag);
#else
      hipLaunchKernelGGL(dbg_zcols, dim3(1024), dim3(512), 0, stream, (const bf16_t*)((char*)d_ws + WS_Z), flag);
#endif
      for (int i = 13; i <= 18; ++i) (void)hipMemsetAsync(flag + 1 + i, 1, 4, stream);
      hipLaunchKernelGGL(dbg_final, dim3(grid), dim3(512), 0, stream, (const float*)d_in[0], (const float*)d_in[30], (float*)d_out);
      hipLaunchKernelGGL(dbg_scale, dim3(1024), dim3(512), 0, stream, (float*)d_out, (const unsigned*)flag); }
#elif defined(DBG_CSUM)
    { unsigned* flag = (unsigned*)((char*)d_ws + 512 * 1024); (void)hipMemsetAsync(flag, 0, 256, stream);
      hipLaunchKernelGGL(dbg_csum, dim3(1024), dim3(512), 0, stream, (const unsigned*)((char*)d_ws + DBG_CSUM_OFF), (size_t)DBG_CSUM_WORDS, flag);
      hipLaunchKernelGGL(dbg_final, dim3(grid), dim3(512), 0, stream, (const float*)d_in[0], (const float*)d_in[30], (float*)d_out);
      hipLaunchKernelGGL(dbg_scale3, dim3(1024), dim3(512), 0, stream, (float*)d_out, (const unsigned*)flag); }
#elif defined(DBG_CLASS)
    { unsigned* flag = (unsigned*)((char*)d_ws + 512 * 1024); (void)hipMemsetAsync(flag, 0, 256, stream);
      hipLaunchKernelGGL(dbg_class, dim3(1024), dim3(512), 0, stream, (const bf16_t*)((char*)d_ws + DBG_CLASS_OFF), (size_t)DBG_CLASS_N, flag);
      hipLaunchKernelGGL(dbg_final, dim3(grid), dim3(512), 0, stream, (const float*)d_in[0], (const float*)d_in[30], (float*)d_out);
      hipLaunchKernelGGL(dbg_scale2, dim3(1024), dim3(512), 0, stream, (float*)d_out, (const unsigned*)flag); }
#elif defined(DBG_CHECK)
    { unsigned* flag = (unsigned*)((char*)d_ws + 512 * 1024); (void)hipMemsetAsync(flag, 0x7f, 4, stream); (void)hipMemsetAsync(flag + 1, 0, 128, stream);
      struct B { size_t off, n; int f32; }; const B bl[] = {
#ifdef DBG_DEAD
        {WS_WIN, (size_t)IN_WIDTH * D, 0}, {WS_XN, (size_t)M * D, 0},
#endif
        {WS_Z, (size_t)M * NZ, 0}, {WS_QH, (size_t)M * 1024, 0}, {WS_QH, (size_t)M * 1024, 0}, {WS_NT, (size_t)64 * 64 * 16384, 0}, {WS_DC, (size_t)64 * 64 * 128, 1},
        {WS_RP, (size_t)M * 1024, 0}, {WS_Y0, (size_t)M * 1024, 0}, {WS_MT, (size_t)M * 1024, 0}, {WS_NN, (size_t)M * 1024, 0}, {WS_RK, (size_t)M * 16, 1}, {WS_VFIRST, (size_t)M * 1024, 0},
        {WS_YHG, (size_t)M * 1024, 0}, {WS_SS, (size_t)M * 1024, 0}, {WS_YRW, (size_t)M * 1024, 0}, {WS_XN, (size_t)M * D, 0} };
#ifdef DBG_TRTEST
      hipLaunchKernelGGL(dbg_trtest, dim3(1), dim3(64), 0, stream, flag);
#endif
#ifdef DBG_H1TEST
      hipLaunchKernelGGL(dbg_h1test, dim3(1), dim3(512), 65536, stream, flag);
#endif
      for (unsigned i = 0; i < sizeof(bl) / sizeof(bl[0]); ++i) hipLaunchKernelGGL(dbg_check, dim3(1024), dim3(512), 0, stream, (const void*)((char*)d_ws + bl[i].off), bl[i].n, bl[i].f32, flag, i + 1);
      hipLaunchKernelGGL(dbg_check, dim3(1024), dim3(512), 0, stream, (const void*)d_out, (size_t)M * D, 1, flag, 18u);
      hipLaunchKernelGGL(dbg_final, dim3(grid), dim3(512), 0, stream, (const float*)d_in[0], (const float*)d_in[30], (float*)d_out);
      hipLaunchKernelGGL(dbg_scale, dim3(1024), dim3(512), 0, stream, (float*)d_out, (const unsigned*)flag); }
#elif DBG_CUT < 1000
    hipLaunchKernelGGL(dbg_final, dim3(grid), dim3(512), 0, stream, (const float*)(DBG_CUT <= 6 ? d_in[0] : d_out), (const float*)d_in[30], (float*)d_out);
#endif
}
```

```cpp
#include <hip/hip_runtime.h>
#include <stdint.h>
#include <stdio.h>
#ifndef MK_ONE_LAUNCH
#define MK_ONE_LAUNCH 1
#endif
#define DI __device__ __forceinline__
#define LAS __attribute__((address_space(3)))
typedef unsigned short bf16_t;
typedef short bf16x8 __attribute__((ext_vector_type(8)));
typedef short s16x4 __attribute__((ext_vector_type(4)));
typedef float f32x4 __attribute__((ext_vector_type(4)));
typedef float f32x2 __attribute__((ext_vector_type(2)));
typedef unsigned u32x4 __attribute__((ext_vector_type(4)));
typedef unsigned u32x2 __attribute__((ext_vector_type(2)));

constexpr int M = 16384, D = 2048, TSEQ = 2048, NBATCH = 8;
constexpr int NZ = 6656;
constexpr int NZG = 5120, ZG_O = 4096;
constexpr int ZC_Q = 0, ZC_F = 1024, ZC_I = 2048, ZC_R = 3072, ZC_K = 4096, ZC_V = 5120, ZC_WD = 6144, ZC_AD = 6208, ZC_GD = 6272,
              ZC_VDA = 6432, ZC_VDB = 6464;
constexpr int IN_WIDTH = 11552;
constexpr int NEXP = 32, DEXP = 512, MAXSLOTS = 40960;
constexpr float NORM_EPS = 1e-6f, RW_GN_EPS = 64e-5f;
constexpr size_t MiB = 1u << 20;
constexpr size_t WS_CTL = 0, CTL_BYTES = 1 * MiB;
constexpr size_t WS_TOKE = 1 * MiB, WS_TOKW = WS_TOKE + 128 * 1024, WS_TOKS = WS_TOKW + 128 * 1024, WS_CNT = WS_TOKS + 128 * 1024, WS_SRSTD = WS_CNT + 64 * 1024, WS_TRSTD = WS_SRSTD + 192 * 1024;
constexpr size_t WS_LORA = 2 * MiB;
constexpr size_t LO_WUP = 0, LO_AUP = 128 * 1024, LO_GUP = 256 * 1024, LO_VUP = 576 * 1024, LO_WR = 640 * 1024, LO_WRL = 832 * 1024;
constexpr size_t WS_WG8 = 36 * MiB;
constexpr size_t WS_XN8 = 1109 * MiB;
constexpr size_t WS_WIN = 4 * MiB, WS_WBH = 50 * MiB, WS_WBR = 54 * MiB, WS_WO = 58 * MiB;
constexpr size_t WS_Z = 66 * MiB;
constexpr size_t WS_ZG = WS_Z + 208 * MiB;
constexpr size_t WS_XS = WS_Z, WS_ACT = WS_Z + 160 * MiB, WS_YS = WS_Z + 200 * MiB;
constexpr size_t WS_XN = 434 * MiB;
constexpr size_t WS_YHG = 498 * MiB, WS_YRW = 530 * MiB, WS_VFIRST = 562 * MiB;
constexpr size_t WS_HB2 = 1045 * MiB;
constexpr size_t WS_HB = WS_YHG;
constexpr size_t WS_X = 594 * MiB;
constexpr size_t WS_NT = WS_X, WS_DC = WS_X + 128 * MiB, WS_QH = WS_X + 130 * MiB, WS_OI = WS_X + 162 * MiB;
constexpr size_t WS_MT = WS_X + 194 * MiB, WS_NN = WS_X + 226 * MiB, WS_RP = WS_X + 258 * MiB, WS_Y0 = WS_X + 290 * MiB, WS_SS = WS_X + 322 * MiB,
                 WS_RK = WS_X + 354 * MiB, WS_VF = WS_X + 355 * MiB;
constexpr size_t WS_WGU = 981 * MiB, WS_WDN = WS_X + 64 * MiB;
constexpr size_t WS_END = 1141 * MiB;
constexpr int CW_BAR = 4096;
constexpr size_t CTL_SLOTTOK = 256 * 1024;
constexpr int LDS_CTL_OFF = 148 * 1024, LDS_BYTES = 152 * 1024;
constexpr int LC_TOT = 16, LC_PAD = 48, LC_TILE = 96, LC_MISC = 256;

DI float bf2f(unsigned short b) { return __uint_as_float(((unsigned)b) << 16); }
typedef __bf16 nbf16x2 __attribute__((ext_vector_type(2)));
DI unsigned cvt_pk(float lo, float hi) { const f32x2 f = {lo, hi}; const nbf16x2 v = __builtin_convertvector(f, nbf16x2); return __builtin_bit_cast(unsigned, v); }
DI void unpack8(const u32x4 v, float (&f)[8]) {
    f[0] = __uint_as_float(v.x << 16); f[1] = __uint_as_float(v.x & 0xffff0000u); f[2] = __uint_as_float(v.y << 16); f[3] = __uint_as_float(v.y & 0xffff0000u);
    f[4] = __uint_as_float(v.z << 16); f[5] = __uint_as_float(v.z & 0xffff0000u); f[6] = __uint_as_float(v.w << 16); f[7] = __uint_as_float(v.w & 0xffff0000u); }
DI u32x4 pack8(const float (&f)[8]) { u32x4 v; v.x = cvt_pk(f[0], f[1]); v.y = cvt_pk(f[2], f[3]); v.z = cvt_pk(f[4], f[5]); v.w = cvt_pk(f[6], f[7]); return v; }
typedef float f32x2_t __attribute__((ext_vector_type(2)));
DI void unpack4_fp8(const unsigned v, float (&f)[4]) { const f32x2_t lo = __builtin_amdgcn_cvt_pk_f32_fp8((int)v, false), hi = __builtin_amdgcn_cvt_pk_f32_fp8((int)v, true); f[0] = lo.x; f[1] = lo.y; f[2] = hi.x; f[3] = hi.y; }
DI void unpack4(const u32x2 v, float (&f)[4]) { f[0] = __uint_as_float(v.x << 16); f[1] = __uint_as_float(v.x & 0xffff0000u); f[2] = __uint_as_float(v.y << 16); f[3] = __uint_as_float(v.y & 0xffff0000u); }
DI u32x2 pack4(float a, float b, float c, float d) { u32x2 v; v.x = cvt_pk(a, b); v.y = cvt_pk(c, d); return v; }
DI unsigned pk4_fp8(float a, float b, float c2, float d) { int r = 0; r = __builtin_amdgcn_cvt_pk_fp8_f32(a, b, r, false); r = __builtin_amdgcn_cvt_pk_fp8_f32(c2, d, r, true); return (unsigned)r; }
DI float sigm(float x) { return __builtin_amdgcn_rcpf(1.0f + __expf(-x)); }
DI float wave_sum(float v) {
#pragma unroll
    for (int o = 1; o < 64; o <<= 1) v += __shfl_xor(v, o);
    return v;
}

DI void lds_barrier() { asm volatile("s_waitcnt lgkmcnt(0)\n\ts_barrier" ::: "memory"); }
namespace pg8 {
#define PG8_LAS __attribute__((address_space(3)))
typedef unsigned short bf16_t;
typedef short bf16x8 __attribute__((ext_vector_type(8)));
typedef float f32x4 __attribute__((ext_vector_type(4)));
typedef unsigned u32x4 __attribute__((ext_vector_type(4)));
typedef int pg8_v8i __attribute__((ext_vector_type(8)));
constexpr int BM = 256, BK = 64, HALF = 128, HTB = HALF * BK * 2  , STAGE_BYTES = 8 * HTB, NXCD = 8, WGM = 8;

__host__ __device__ __forceinline__ int lds_byte(int r, int c) { const int st = (r >> 4) * 2 + (c >> 5), rr = r & 15, cc = c & 31, ob = rr * 64 + cc * 2; return st * 1024 + (ob ^ (((ob >> 9) & 1) << 5)); }
__host__ __device__ __forceinline__ void stage_rc(int b, int& R, int& C) { const int st = b / 1024, sb = b % 1024, swz = sb ^ (((sb >> 9) & 1) << 5); R = (st >> 1) * 16 + swz / 64; C = (st & 1) * 32 + (swz % 64) / 2; }
__host__ __device__ __forceinline__ int perm32(int rho) { const int n = rho >> 4, i = rho & 15; return 8 * (i >> 2) + 4 * n + (i & 3); }

struct Unit { int pm, pn; };
struct Gemm { const bf16_t* A; const bf16_t* Bt; int M, N, K; const int* amap = nullptr; };

struct StaticOrder {
    int nM, nN, nwg, G, c, wgm, hot = 0;
    __host__ __device__ void init(int M, int N, int G_, int c_, int wgm_ = WGM) { nM = M / BM; nN = N / BM; nwg = nM * nN; G = G_; c = c_; wgm = wgm_; }
    __host__ __device__ bool next(int i, Unit& u) const {
        const long L = (long)i * G + c; if (L >= nwg) return false;
        int wgid = (int)L; { const int q = nwg / NXCD, r = nwg % NXCD, xcd = wgid % NXCD, off = wgid / NXCD; wgid = (xcd < r ? xcd * (q + 1) : r * (q + 1) + (xcd - r) * q) + off; }
        const int nig = wgm * nN, gid = wgid / nig, fm = gid * wgm, gsz = (nM - fm) < wgm ? (nM - fm) : wgm;
        if (hot) { u.pm = 0; u.pn = 0; return true; }
        u.pm = fm + ((wgid % nig) % gsz); u.pn = (wgid % nig) / gsz; return true;
    }
    __device__ __forceinline__ void a_ready(const Unit&) const {}
    __device__ __forceinline__ void done(const Unit&) const {}
};
__device__ __forceinline__ unsigned cvt_pk_bf16(float lo, float hi) { return ::cvt_pk(lo, hi); }
typedef float f32x2 __attribute__((ext_vector_type(2)));
struct EpiBf16P {
    static constexpr bool PERM = true, AFTER_DRAIN = false;
    bf16_t* O; int ldc; int dbg;
    __device__ __forceinline__ void operator()(const f32x4 (&acc)[2][2][4][2], const Unit& u, int wr, int wc, int fr, int fq) const {
        if (dbg == 1) { float s = 0.f; _Pragma("unroll") for (int ai = 0; ai < 2; ++ai) _Pragma("unroll") for (int bj = 0; bj < 2; ++bj) _Pragma("unroll") for (int m = 0; m < 4; ++m) _Pragma("unroll") for (int n = 0; n < 2; ++n) s += acc[ai][bj][m][n][0] + acc[ai][bj][m][n][3]; asm volatile("" :: "v"(s)); return; }
        const int row0 = u.pm * BM + wr * 64 + fr, col0 = u.pn * BM + wc * 32 + 8 * fq;
#pragma unroll
        for (int ai = 0; ai < 2; ++ai)
#pragma unroll
            for (int m = 0; m < 4; ++m) { bf16_t* rowp = (dbg == 2 ? O + (size_t)(658 * 1024 * 1024 / 2) : O) + (size_t)(dbg == 2 ? (int)(blockIdx.x * 16 + fr) : row0 + ai * HALF + m * 16) * ldc + col0;
#pragma unroll
                for (int bj = 0; bj < 2; ++bj) { const f32x4 v0 = acc[ai][bj][m][0], v1 = acc[ai][bj][m][1];
                    u32x4 w; w.x = cvt_pk_bf16(v0[0], v0[1]); w.y = cvt_pk_bf16(v0[2], v0[3]); w.z = cvt_pk_bf16(v1[0], v1[1]); w.w = cvt_pk_bf16(v1[2], v1[3]);
                    *(u32x4*)(rowp + bj * HALF) = w; } asm volatile("" ::: "memory"); }
    }
};
struct EpiF8P {
    static constexpr bool PERM = true, AFTER_DRAIN = false;
    unsigned char* O; int ldc; int dbg;
    __device__ __forceinline__ void operator()(const f32x4 (&acc)[2][2][4][2], const Unit& u, int wr, int wc, int fr, int fq) const {
        const int row0 = u.pm * BM + wr * 64 + fr, col0 = u.pn * BM + wc * 32 + 8 * fq;
#pragma unroll
        for (int ai = 0; ai < 2; ++ai)
#pragma unroll
            for (int m = 0; m < 4; ++m) { unsigned char* rowp = O + (size_t)(row0 + ai * HALF + m * 16) * ldc + col0;
#pragma unroll
                for (int bj = 0; bj < 2; ++bj) { const f32x4 v0 = acc[ai][bj][m][0], v1 = acc[ai][bj][m][1];
                    u32x2 w; w.x = ::pk4_fp8(v0[0], v0[1], v0[2], v0[3]); w.y = ::pk4_fp8(v1[0], v1[1], v1[2], v1[3]);
                    *(u32x2*)(rowp + bj * HALF) = w; } asm volatile("" ::: "memory"); }
    }
};
struct EpiGate {
    static constexpr bool PERM = true, AFTER_DRAIN = false;
    bf16_t* O; int ldo; const unsigned char* Zg; int ldz; int accum; int dbg;
    __device__ __forceinline__ void operator()(const f32x4 (&acc)[2][2][4][2], const Unit& u, int wr, int wc, int fr, int fq) const {
        if (dbg) { float s = 0.f; _Pragma("unroll") for (int ai = 0; ai < 2; ++ai) _Pragma("unroll") for (int bj = 0; bj < 2; ++bj) _Pragma("unroll") for (int m = 0; m < 4; ++m) _Pragma("unroll") for (int n = 0; n < 2; ++n) s += acc[ai][bj][m][n][0] + acc[ai][bj][m][n][3]; asm volatile("" :: "v"(s)); return; }
        const int row0 = u.pm * BM + wr * 64 + fr, col0 = u.pn * BM + wc * 32 + 8 * fq;
#pragma unroll
        for (int ai = 0; ai < 2; ++ai) {
            u32x2 zg[4][2]; u32x4 pv[4][2];
#pragma unroll
            for (int m = 0; m < 4; ++m)
#pragma unroll
                for (int bj = 0; bj < 2; ++bj) { const size_t row = (size_t)(row0 + ai * HALF + m * 16); zg[m][bj] = *(const u32x2*)(Zg + row * ldz + col0 + bj * HALF);
                    if (accum) pv[m][bj] = *(const u32x4*)(O + row * ldo + col0 + bj * HALF); else pv[m][bj] = (u32x4){0u, 0u, 0u, 0u}; }
#pragma unroll
            for (int m = 0; m < 4; ++m)
#pragma unroll
                for (int bj = 0; bj < 2; ++bj) { const size_t row = (size_t)(row0 + ai * HALF + m * 16); const f32x4 v0 = acc[ai][bj][m][0], v1 = acc[ai][bj][m][1];
                    float zf[8]; { float t4[4]; ::unpack4_fp8(zg[m][bj].x, t4); zf[0] = t4[0]; zf[1] = t4[1]; zf[2] = t4[2]; zf[3] = t4[3]; ::unpack4_fp8(zg[m][bj].y, t4); zf[4] = t4[0]; zf[5] = t4[1]; zf[6] = t4[2]; zf[7] = t4[3]; }
                    const unsigned pw[4] = {pv[m][bj].x, pv[m][bj].y, pv[m][bj].z, pv[m][bj].w};
                    float o[8];
#pragma unroll
                    for (int j = 0; j < 4; ++j) { const float z0 = zf[2 * j], z1 = zf[2 * j + 1]; const float a0 = j < 2 ? v0[2 * j] : v1[2 * j - 4], a1 = j < 2 ? v0[2 * j + 1] : v1[2 * j - 3];
                        o[2 * j] = a0 * __builtin_amdgcn_rcpf(1.0f + __expf(-z0)) + __uint_as_float(pw[j] << 16); o[2 * j + 1] = a1 * __builtin_amdgcn_rcpf(1.0f + __expf(-z1)) + __uint_as_float(pw[j] & 0xffff0000u); }
                    u32x4 w; w.x = cvt_pk_bf16(o[0], o[1]); w.y = cvt_pk_bf16(o[2], o[3]); w.z = cvt_pk_bf16(o[4], o[5]); w.w = cvt_pk_bf16(o[6], o[7]);
                    *(u32x4*)(O + row * ldo + col0 + bj * HALF) = w; }
            asm volatile("" ::: "memory");
        }
    }
};
struct EpiResB {
    static constexpr bool PERM = true, AFTER_DRAIN = false;
    const bf16_t* base; bf16_t* O; int ldc; int dbg;
    __device__ __forceinline__ void operator()(const f32x4 (&acc)[2][2][4][2], const Unit& u, int wr, int wc, int fr, int fq) const {
        const int row0 = u.pm * BM + wr * 64 + fr, col0 = u.pn * BM + wc * 32 + 8 * fq;
#pragma unroll
        for (int ai = 0; ai < 2; ++ai) {
            u32x4 bq[4][2];
#pragma unroll
            for (int m = 0; m < 4; ++m)
#pragma unroll
                for (int bj = 0; bj < 2; ++bj) bq[m][bj] = *(const u32x4*)(base + (size_t)(row0 + ai * HALF + m * 16) * ldc + col0 + bj * HALF);
#pragma unroll
            for (int m = 0; m < 4; ++m)
#pragma unroll
                for (int bj = 0; bj < 2; ++bj) { const size_t off = (size_t)(row0 + ai * HALF + m * 16) * ldc + col0 + bj * HALF; const u32x4 q = bq[m][bj];
                    const f32x4 v0 = acc[ai][bj][m][0] + (f32x4){__uint_as_float(q.x << 16), __uint_as_float(q.x & 0xffff0000u), __uint_as_float(q.y << 16), __uint_as_float(q.y & 0xffff0000u)};
                    const f32x4 v1 = acc[ai][bj][m][1] + (f32x4){__uint_as_float(q.z << 16), __uint_as_float(q.z & 0xffff0000u), __uint_as_float(q.w << 16), __uint_as_float(q.w & 0xffff0000u)};
                    u32x4 w; w.x = cvt_pk_bf16(v0[0], v0[1]); w.y = cvt_pk_bf16(v0[2], v0[3]); w.z = cvt_pk_bf16(v1[0], v1[1]); w.w = cvt_pk_bf16(v1[2], v1[3]);
                    *(u32x4*)(O + off) = w; }
            asm volatile("" ::: "memory");
        }
    }
};
struct EpiRes {
    static constexpr bool PERM = false, AFTER_DRAIN = false;
    const float* base; float* out; int ldc; int dbg;
    __device__ __forceinline__ void operator()(const f32x4 (&acc)[2][2][4][2], const Unit& u, int wr, int wc, int fr, int fq) const {
        if (dbg) { float s = 0.f; _Pragma("unroll") for (int ai = 0; ai < 2; ++ai) _Pragma("unroll") for (int bj = 0; bj < 2; ++bj) _Pragma("unroll") for (int m = 0; m < 4; ++m) _Pragma("unroll") for (int n = 0; n < 2; ++n) s += acc[ai][bj][m][n][0] + acc[ai][bj][m][n][3]; asm volatile("" :: "v"(s)); return; }
        const int row0 = u.pm * BM + wr * 64 + fr, col0 = u.pn * BM + wc * 32 + 4 * fq;
#pragma unroll
        for (int ai = 0; ai < 2; ++ai) {
            f32x4 bs[4][2][2];
#pragma unroll
            for (int m = 0; m < 4; ++m) { const size_t off = (size_t)(row0 + ai * HALF + m * 16) * ldc + col0;
#pragma unroll
                for (int bj = 0; bj < 2; ++bj)
#pragma unroll
                    for (int n = 0; n < 2; ++n) bs[m][bj][n] = *(const f32x4*)(base + off + bj * HALF + n * 16); }
#pragma unroll
            for (int m = 0; m < 4; ++m) { const size_t off = (size_t)(row0 + ai * HALF + m * 16) * ldc + col0;
#pragma unroll
                for (int bj = 0; bj < 2; ++bj)
#pragma unroll
                    for (int n = 0; n < 2; ++n) *(f32x4*)(out + off + bj * HALF + n * 16) = bs[m][bj][n] + acc[ai][bj][m][n]; }
            asm volatile("" ::: "memory");
        }
    }
};
struct EpiSwiGLU {
    static constexpr bool PERM = true, AFTER_DRAIN = false;
    bf16_t* O; const float* rstd; int dbg;
    __device__ __forceinline__ void operator()(const f32x4 (&acc)[2][2][4][2], const Unit& u, int wr, int wc, int fr, int fq) const {
        if (dbg) { float s = 0.f; _Pragma("unroll") for (int ai = 0; ai < 2; ++ai) _Pragma("unroll") for (int bj = 0; bj < 2; ++bj) _Pragma("unroll") for (int m = 0; m < 4; ++m) _Pragma("unroll") for (int n = 0; n < 2; ++n) s += acc[ai][bj][m][n][0] + acc[ai][bj][m][n][3]; asm volatile("" :: "v"(s)); return; }
        const int row0 = u.pm * BM + wr * 64 + fr, col0 = (u.pn & 3) * 128 + wc * 32 + 8 * fq;
        float rsv[2][4];
#pragma unroll
        for (int ai = 0; ai < 2; ++ai)
#pragma unroll
            for (int m = 0; m < 4; ++m) rsv[ai][m] = rstd[row0 + ai * HALF + m * 16];
#pragma unroll
        for (int ai = 0; ai < 2; ++ai)
#pragma unroll
            for (int m = 0; m < 4; ++m) { bf16_t* rowp = O + (size_t)(row0 + ai * HALF + m * 16) * 512 + col0; const float rs = rsv[ai][m];
                float o[8];
#pragma unroll
                for (int n = 0; n < 2; ++n)
#pragma unroll
                    for (int j = 0; j < 4; ++j) { const float g = acc[ai][0][m][n][j] * rs, up = acc[ai][1][m][n][j] * rs; o[4 * n + j] = g * __builtin_amdgcn_rcpf(1.0f + __expf(-g)) * up; }
                u32x4 w; w.x = cvt_pk_bf16(o[0], o[1]); w.y = cvt_pk_bf16(o[2], o[3]); w.z = cvt_pk_bf16(o[4], o[5]); w.w = cvt_pk_bf16(o[6], o[7]);
                *(u32x4*)rowp = w; asm volatile("" ::: "memory"); }
    }
};
struct EpiSwiGLU8 {
    static constexpr bool PERM = true, AFTER_DRAIN = false;
    unsigned char* O; const float* rstd; int dbg;
    __device__ __forceinline__ void operator()(const f32x4 (&acc)[2][2][4][2], const Unit& u, int wr, int wc, int fr, int fq) const {
        const int row0 = u.pm * BM + wr * 64 + fr, col0 = (u.pn & 3) * 128 + wc * 32 + 8 * fq;
        float rsv[2][4];
#pragma unroll
        for (int ai = 0; ai < 2; ++ai)
#pragma unroll
            for (int m = 0; m < 4; ++m) rsv[ai][m] = rstd[row0 + ai * HALF + m * 16];
#pragma unroll
        for (int ai = 0; ai < 2; ++ai)
#pragma unroll
            for (int m = 0; m < 4; ++m) { unsigned char* rowp = O + (size_t)(row0 + ai * HALF + m * 16) * 512 + col0; const float rs = rsv[ai][m];
                float o[8];
#pragma unroll
                for (int n = 0; n < 2; ++n)
#pragma unroll
                    for (int j = 0; j < 4; ++j) { const float g = acc[ai][0][m][n][j] * rs, up = acc[ai][1][m][n][j] * rs; o[4 * n + j] = g * __builtin_amdgcn_rcpf(1.0f + __expf(-g)) * up; }
                u32x2 w; w.x = ::pk4_fp8(o[0], o[1], o[2], o[3]); w.y = ::pk4_fp8(o[4], o[5], o[6], o[7]);
                *(u32x2*)rowp = w; asm volatile("" ::: "memory"); }
    }
};
struct EpiDown {
    static constexpr bool PERM = true, AFTER_DRAIN = false;
    unsigned char* O; int dbg;
    __device__ __forceinline__ void operator()(const f32x4 (&acc)[2][2][4][2], const Unit& u, int wr, int wc, int fr, int fq) const {
        const int row0 = u.pm * BM + wr * 64 + fr, col0 = (u.pn & 7) * BM + wc * 32 + 8 * fq;
#pragma unroll
        for (int ai = 0; ai < 2; ++ai)
#pragma unroll
            for (int m = 0; m < 4; ++m) { unsigned char* rowp = O + (size_t)(row0 + ai * HALF + m * 16) * 2048 + col0;
#pragma unroll
                for (int bj = 0; bj < 2; ++bj) { const f32x4 v0 = acc[ai][bj][m][0] * 16.0f, v1 = acc[ai][bj][m][1] * 16.0f;
                    u32x2 w; w.x = ::pk4_fp8(v0[0], v0[1], v0[2], v0[3]); w.y = ::pk4_fp8(v1[0], v1[1], v1[2], v1[3]);
                    *(u32x2*)(rowp + bj * HALF) = w; } asm volatile("" ::: "memory"); }
    }
};
template <int NTN> struct GroupedOrder {
    static constexpr int ntn = NTN; int nunits, G, c; const PG8_LAS int* tile_e;
    __device__ __forceinline__ bool next(int i, Unit& u) const { const long L = (long)i * G + c; if (L >= nunits) return false;
        int wgid = (int)L; { const int q = nunits / NXCD, r = nunits % NXCD, xcd = wgid % NXCD, off = wgid / NXCD; wgid = (xcd < r ? xcd * (q + 1) : r * (q + 1) + (xcd - r) * q) + off; }
        const int rt = wgid / ntn, pl = wgid % ntn; u.pm = rt; u.pn = tile_e[rt] * ntn + pl; return true; }
    __device__ __forceinline__ void a_ready(const Unit&) const {}
    __device__ __forceinline__ void done(const Unit&) const {}
};
template <class Epi, class Sched, bool STAMP = false, bool GATHER = false, bool FP8 = false>
__device__ __forceinline__ void gemm_phase(PG8_LAS unsigned char* lds, const Gemm g, const Sched& S, const Epi& E, unsigned long long* stamps) {
    int tid_ = threadIdx.x; asm volatile("" : "+v"(tid_));
    const int tid = tid_, wid = __builtin_amdgcn_readfirstlane(tid >> 6), lane = tid & 63, wr = wid >> 2, wc = wid & 3, fr = lane & 15, fq = lane >> 4;
    const int K = g.K, nt = K / BK;
    int ts_lo = 0, ts_hi = 0, nts = 0; const unsigned long long rt_entry = STAMP ? (unsigned long long)wall_clock64() : 0ull;
#define PG8_STAMP() do { if (STAMP && wid == 0 && nts < 64) { const unsigned long long _c = (unsigned long long)clock64(); \
        ts_lo = (lane == nts) ? (int)(unsigned)_c : ts_lo; ts_hi = (lane == nts) ? (int)(unsigned)(_c >> 32) : ts_hi; ++nts; } } while (0)
    PG8_STAMP();
    unsigned voffA[2], voffB[2]; int gR[2]; unsigned gC[2];
#pragma unroll
    for (int i = 0; i < 2; ++i) { int R, C; stage_rc(tid * 16 + i * 8192, R, C); const int Rb = Epi::PERM ? ((R & ~31) + perm32(R & 31)) : R;
        voffA[i] = (unsigned)(R * K + C) * 2u; voffB[i] = (unsigned)(Rb * K + C) * 2u; gR[i] = R; gC[i] = (unsigned)C * 2u; }
    const size_t kstep = (size_t)(BK * 2);
    const size_t hstep = (size_t)HALF * K * 2;
    const size_t tstep = 2 * hstep;
    const unsigned ldsw = (unsigned)wid * 1024u;
    const int aoff = lds_byte(wr * 64 + fr, fq * 8), boff = lds_byte(wc * 32 + fr, fq * 8);
#define PG8_SA(b, h) (((b) * 2 + (h)) * HTB)
#define PG8_SB(b, h) ((4 + (b) * 2 + (h)) * HTB)
#define PG8_STAGE(bufoff, gbase, voff) do { _Pragma("unroll") for (int _i = 0; _i < 2; ++_i) \
        __builtin_amdgcn_global_load_lds((const unsigned*)((const char*)(gbase) + (voff)[_i]), (PG8_LAS unsigned*)(lds + (bufoff) + ldsw + _i * 8192), 16, 0, 0); } while (0)
#define PG8_LD8(dst8, i_, base_) do { const u32x4 lo_ = *(const PG8_LAS u32x4*)(lds + (base_)), hi_ = *(const PG8_LAS u32x4*)(lds + (base_) + 1024); \
        dst8[i_] = (pg8_v8i){(int)lo_.x, (int)lo_.y, (int)lo_.z, (int)lo_.w, (int)hi_.x, (int)hi_.y, (int)hi_.z, (int)hi_.w}; } while (0)
#define PG8_LDA(dst, b, h) do { if constexpr (FP8) { _Pragma("unroll") for (int m = 0; m < 4; ++m) PG8_LD8(dst##8, m, PG8_SA(b, h) + aoff + m * 2048); } \
        else { _Pragma("unroll") for (int m = 0; m < 4; ++m) _Pragma("unroll") for (int k = 0; k < 2; ++k) dst[m][k] = *(const PG8_LAS bf16x8*)(lds + PG8_SA(b, h) + aoff + m * 2048 + k * 1024); } } while (0)
#define PG8_LDB(dst, b, h) do { if constexpr (FP8) { _Pragma("unroll") for (int n = 0; n < 2; ++n) PG8_LD8(dst##8, n, PG8_SB(b, h) + boff + n * 2048); } \
        else { _Pragma("unroll") for (int n = 0; n < 2; ++n) _Pragma("unroll") for (int k = 0; k < 2; ++k) dst[n][k] = *(const PG8_LAS bf16x8*)(lds + PG8_SB(b, h) + boff + n * 2048 + k * 1024); } } while (0)
#define PG8_MMA(ai, bj, At, Bt) do { __builtin_amdgcn_s_setprio(1); if constexpr (FP8) { _Pragma("unroll") for (int m = 0; m < 4; ++m) _Pragma("unroll") for (int n = 0; n < 2; ++n) \
        asm volatile("v_mfma_scale_f32_16x16x128_f8f6f4 %0, %1, %2, %0, %3, %4 op_sel_hi:[0,0,0]" : "+v"(acc[ai][bj][m][n]) : "v"(Bt##8[n]), "v"(At##8[m]), "v"(sc_w), "v"(sc_x)); } \
    else { _Pragma("unroll") for (int m = 0; m < 4; ++m) _Pragma("unroll") for (int n = 0; n < 2; ++n) _Pragma("unroll") for (int k = 0; k < 2; ++k) \
        acc[ai][bj][m][n] = __builtin_amdgcn_mfma_f32_16x16x32_bf16(Bt[n][k], At[m][k], acc[ai][bj][m][n], 0, 0, 0); } __builtin_amdgcn_s_setprio(0); } while (0)
#define PG8_WAIT_V(n) asm volatile("s_waitcnt vmcnt(" #n ")" ::: "memory")
#define PG8_WAIT_L(n) asm volatile("s_waitcnt lgkmcnt(" #n ")" ::: "memory")
#define PG8_BAR __builtin_amdgcn_s_barrier()
#define PG8_SCHED __builtin_amdgcn_sched_barrier(0)
    Unit cur, nxt; int ui = 0;
    if (!S.next(0, cur)) return;
    f32x4 acc[2][2][4][2];
#pragma unroll
    for (int a = 0; a < 2; ++a)
#pragma unroll
        for (int b = 0; b < 2; ++b)
#pragma unroll
            for (int m = 0; m < 4; ++m)
#pragma unroll
                for (int n = 0; n < 2; ++n) acc[a][b][m][n] = (f32x4){0.f, 0.f, 0.f, 0.f};
    bf16x8 At[4][2], B0[2][2], B1[2][2]; pg8_v8i At8[4], B08[2], B18[2]; const int sc_w = 0x79797979, sc_x = 0x7f7f7f7f;
    const char* cA = (const char*)g.A + (size_t)cur.pm * tstep; const char* cB = (const char*)g.Bt + (size_t)cur.pn * tstep;
    const char* gA = (const char*)g.A; unsigned voC[2][2], voN[2][2];
#define PG8_GATH(vo, u) do { int t2_ = tid; asm volatile("" : "+v"(t2_));   \
        _Pragma("unroll") for (int _i = 0; _i < 2; ++_i) { int R_, C_; stage_rc(t2_ * 16 + _i * 8192, R_, C_); \
        _Pragma("unroll") for (int _h = 0; _h < 2; ++_h) vo[_h][_i] = (unsigned)g.amap[(u).pm * BM + _h * HALF + R_] * (unsigned)(K * 2) + (unsigned)C_ * 2u; } } while (0)
    if constexpr (GATHER) { PG8_GATH(voC, cur); }
    S.a_ready(cur);
    PG8_STAGE(PG8_SB(0, 0), cB, voffB); if constexpr (GATHER) PG8_STAGE(PG8_SA(0, 0), gA, voC[0]); else PG8_STAGE(PG8_SA(0, 0), cA, voffA);
    PG8_STAGE(PG8_SB(0, 1), cB + hstep, voffB); if constexpr (GATHER) PG8_STAGE(PG8_SA(0, 1), gA, voC[1]); else PG8_STAGE(PG8_SA(0, 1), cA + hstep, voffA);
    if (wr == 1) PG8_BAR;
    PG8_WAIT_V(4); PG8_BAR;
    PG8_STAGE(PG8_SB(1, 0), cB + kstep, voffB); if constexpr (GATHER) PG8_STAGE(PG8_SA(1, 0), gA + kstep, voC[0]); else PG8_STAGE(PG8_SA(1, 0), cA + kstep, voffA);
    PG8_STAGE(PG8_SB(1, 1), cB + hstep + kstep, voffB);
    PG8_WAIT_V(6); PG8_BAR;
    PG8_STAMP();
    for (;;) {
        const bool has_next = S.next(ui + 1, nxt);
        if constexpr (GATHER) { if (has_next) { PG8_GATH(voN, nxt); } else { _Pragma("unroll") for (int _h = 0; _h < 2; ++_h) _Pragma("unroll") for (int _i = 0; _i < 2; ++_i) voN[_h][_i] = voC[_h][_i]; } }
        const char* nA = has_next ? (const char*)g.A + (size_t)nxt.pm * tstep : cA; const char* nB = has_next ? (const char*)g.Bt + (size_t)nxt.pn * tstep : cB;
        for (int t = 0; t < nt; t += 2) {
            const bool last = (t == nt - 2);
            const char* a1 = cA + (size_t)(t + 1) * kstep;
            const char* a2 = last ? nA : cA + (size_t)(t + 2) * kstep; const char* b2 = last ? nB : cB + (size_t)(t + 2) * kstep;
            const char* a3 = a2 + kstep; const char* b3 = b2 + kstep;
            const char* g1 = gA + (size_t)(t + 1) * kstep; const char* g2 = last ? gA : gA + (size_t)(t + 2) * kstep; const char* g3 = g2 + kstep; unsigned v2[2][2];
            if constexpr (GATHER) { _Pragma("unroll") for (int _h = 0; _h < 2; ++_h) _Pragma("unroll") for (int _i = 0; _i < 2; ++_i) v2[_h][_i] = last ? voN[_h][_i] : voC[_h][_i]; }
            if (last && has_next) S.a_ready(nxt);
            PG8_LDB(B0, 0, 0); PG8_SCHED; PG8_LDA(At, 0, 0); if constexpr (GATHER) PG8_STAGE(PG8_SA(1, 1), g1, voC[1]); else PG8_STAGE(PG8_SA(1, 1), a1 + hstep, voffA);
            PG8_WAIT_L(8); PG8_BAR; PG8_WAIT_L(0); PG8_MMA(0, 0, At, B0); PG8_BAR; PG8_SCHED;
            PG8_LDB(B1, 0, 1); PG8_STAGE(PG8_SB(0, 0), b2, voffB);
            PG8_BAR; PG8_WAIT_L(0); PG8_MMA(0, 1, At, B1); PG8_BAR;
            PG8_LDA(At, 0, 1); if constexpr (GATHER) PG8_STAGE(PG8_SA(0, 0), g2, v2[0]); else PG8_STAGE(PG8_SA(0, 0), a2, voffA);
            PG8_BAR; PG8_WAIT_L(0); PG8_MMA(1, 0, At, B0); PG8_BAR; PG8_SCHED;
            PG8_STAGE(PG8_SB(0, 1), b2 + hstep, voffB);
            PG8_WAIT_V(6); PG8_BAR; PG8_MMA(1, 1, At, B1); PG8_BAR;
            PG8_LDB(B0, 1, 0); PG8_SCHED; PG8_LDA(At, 1, 0); if constexpr (GATHER) PG8_STAGE(PG8_SA(0, 1), g2, v2[1]); else PG8_STAGE(PG8_SA(0, 1), a2 + hstep, voffA);
            PG8_WAIT_L(8); PG8_BAR; PG8_WAIT_L(0); PG8_MMA(0, 0, At, B0); PG8_BAR; PG8_SCHED;
            PG8_LDB(B1, 1, 1); PG8_STAGE(PG8_SB(1, 0), b3, voffB);
            PG8_BAR; PG8_WAIT_L(0); PG8_MMA(0, 1, At, B1); PG8_BAR;
            PG8_LDA(At, 1, 1); if constexpr (GATHER) PG8_STAGE(PG8_SA(1, 0), g3, v2[0]); else PG8_STAGE(PG8_SA(1, 0), a3, voffA);
            PG8_BAR; PG8_WAIT_L(0); PG8_MMA(1, 0, At, B0); PG8_BAR; PG8_SCHED;
            PG8_STAGE(PG8_SB(1, 1), b3 + hstep, voffB);
            PG8_WAIT_V(6); PG8_BAR; PG8_MMA(1, 1, At, B1); PG8_BAR;
        }
        PG8_STAMP();
        if constexpr (FP8) asm volatile("s_nop 15\n\ts_nop 15" ::: "memory");
        if constexpr (!Epi::AFTER_DRAIN) { E(acc, cur, wr, wc, fr, fq); S.done(cur); }
        PG8_STAMP();
        if (!has_next) break;
#pragma unroll
        for (int a = 0; a < 2; ++a)
#pragma unroll
            for (int b = 0; b < 2; ++b)
#pragma unroll
                for (int m = 0; m < 4; ++m)
#pragma unroll
                    for (int n = 0; n < 2; ++n) acc[a][b][m][n] = (f32x4){0.f, 0.f, 0.f, 0.f};
        cur = nxt; cA = nA; cB = nB; ++ui;
        if constexpr (GATHER) { _Pragma("unroll") for (int _h = 0; _h < 2; ++_h) _Pragma("unroll") for (int _i = 0; _i < 2; ++_i) voC[_h][_i] = voN[_h][_i]; }
    }
    PG8_WAIT_V(0);
    if (wr == 0) PG8_BAR;
    PG8_BAR;
    if constexpr (Epi::AFTER_DRAIN) { E.fused(acc, cur, wr, wc, fr, fq, lds, wid, lane); S.done(cur); }
    PG8_STAMP();
    if (STAMP && wid == 0) { stamps[lane] = lane < nts ? (((unsigned long long)(unsigned)ts_hi << 32) | (unsigned)ts_lo) : 0ull;
        if (lane == 62) stamps[62] = rt_entry; if (lane == 63) stamps[63] = (unsigned long long)wall_clock64(); }
#undef PG8_STAMP
#undef PG8_SA
#undef PG8_SB
#undef PG8_STAGE
#undef PG8_GATH
#undef PG8_LDA
#undef PG8_LDB
#undef PG8_MMA
#undef PG8_LD8
#undef PG8_WAIT_V
#undef PG8_WAIT_L
#undef PG8_BAR
#undef PG8_SCHED
}
}
#define XB_TMO      128
#define XB_XCNT(j)  (256  + 64 * (j))
#define XB_XSUB(j)  (1280 + 64 * (j))
#define XB_XGEN(j)  (2304 + 64 * (j))
#define XB_TOP      3328
#define XB_TOPGEN   3392
#define XCD_BAR_WORDS 3456
#define XB_SPIN_CAP (1u << 18)

__device__ __forceinline__ unsigned xb_ld(unsigned* p)              { return __hip_atomic_load(p, __ATOMIC_RELAXED, __HIP_MEMORY_SCOPE_AGENT); }
__device__ __forceinline__ unsigned xb_add(unsigned* p, unsigned v) { return __hip_atomic_fetch_add(p, v, __ATOMIC_RELAXED, __HIP_MEMORY_SCOPE_AGENT); }
__device__ __forceinline__ unsigned xb_xcc_id() { return (unsigned)__builtin_amdgcn_s_getreg((3 << 11) | 20) & 0xFu; }
#define XB_SPIN(cond, bar) do { unsigned _sp = 0; while (cond) { __builtin_amdgcn_s_sleep(1); \
    if ((++_sp & 255u) == 0u) { if (xb_ld(&(bar)[XB_TMO])) break; if (_sp > XB_SPIN_CAP) { atomicAdd(&(bar)[XB_TMO], 1u); break; } } } } while (0)

struct XcdBarrier {
    unsigned* bar; unsigned x;
    volatile LAS unsigned* st;
};

__device__ __forceinline__ XcdBarrier xcd_barrier_post(unsigned* bar, volatile LAS unsigned* st) {
    XcdBarrier b; b.bar = bar; b.x = xb_xcc_id(); b.st = st;
    if (threadIdx.x == 0) (void)xb_add(&bar[XB_XCNT(b.x)], 1u);
    return b;
}
__device__ __forceinline__ void xcd_barrier_complete(unsigned* bar, unsigned x, unsigned& nloc, unsigned& nx) {
    const unsigned G = gridDim.x * gridDim.y * gridDim.z;
    unsigned sum, cnt, mine, sp = 0u;
    for (;;) {
        sum = 0u; cnt = 0u; mine = 0u;
#pragma unroll
        for (unsigned j = 0; j < 16; ++j) { const unsigned c = xb_ld(&bar[XB_XCNT(j)]); sum += c; cnt += (c > 0u) ? 1u : 0u; mine = (j == x) ? c : mine; }
        if (sum == G) break;
        __builtin_amdgcn_s_sleep(1);
        if ((++sp & 255u) == 0u) { if (xb_ld(&bar[XB_TMO])) break; if (sp > XB_SPIN_CAP) { atomicAdd(&bar[XB_TMO], 1u); break; } }
    }
    nloc = mine > 0u ? mine : 1u; nx = cnt > 0u ? cnt : 1u;
}

__device__ __forceinline__ void xcd_barrier(const XcdBarrier& b) {
    asm volatile("s_waitcnt vmcnt(0)" ::: "memory");
    __syncthreads();
    if (threadIdx.x == 0) {
        unsigned* bar = b.bar;
        __builtin_amdgcn_s_waitcnt(0);
        unsigned nloc = b.st[0], nx = b.st[1];
        if (nloc == 0u) { xcd_barrier_complete(bar, b.x, nloc, nx); b.st[0] = nloc; b.st[1] = nx; }
        const unsigned old = xb_add(&bar[XB_XSUB(b.x)], 1u);
        const unsigned gen = old / nloc;
        if (old + 1u == (gen + 1u) * nloc) {
            __builtin_amdgcn_fence(__ATOMIC_RELEASE, "agent");
            asm volatile("s_waitcnt vmcnt(0)" ::: "memory");
            const unsigned og = xb_add(&bar[XB_TOP], 1u);
            const unsigned tg = og / nx;
            if (og + 1u == (tg + 1u) * nx) xb_add(&bar[XB_TOPGEN], 1u);
            else XB_SPIN(xb_ld(&bar[XB_TOPGEN]) == tg, bar);
            __builtin_amdgcn_fence(__ATOMIC_ACQUIRE, "agent");
            xb_add(&bar[XB_XGEN(b.x)], 1u);
            asm volatile("s_waitcnt vmcnt(0)" ::: "memory");
        } else {
            XB_SPIN(xb_ld(&bar[XB_XGEN(b.x)]) == gen, bar);
            __builtin_amdgcn_fence(__ATOMIC_ACQUIRE, "agent");
            asm volatile("s_waitcnt vmcnt(0)" ::: "memory");
        }
    }
    __syncthreads();
}
template <int LD> DI bf16x8 frag_n(const LAS bf16_t* A, int row0, int k0, int lane) {
    return *(const LAS bf16x8*)(A + (row0 + (lane & 15)) * LD + k0 + 8 * (lane >> 4));
}
template <int LD> DI bf16x8 frag_t(const LAS bf16_t* A, int row0, int k0, int lane) {
    const int l = lane & 15, g = lane >> 4;
    const unsigned addr = (unsigned)(uintptr_t)(A + (k0 + 8 * g + (l >> 2)) * LD + row0 + 4 * (l & 3));
    s16x4 lo, hi;
    asm volatile("ds_read_b64_tr_b16 %0, %2\n\tds_read_b64_tr_b16 %1, %2 offset:%3\n\ts_waitcnt lgkmcnt(0)" : "=&v"(lo), "=&v"(hi) : "v"(addr), "n"(4 * LD * 2) : "memory");
    bf16x8 r; r[0] = lo[0]; r[1] = lo[1]; r[2] = lo[2]; r[3] = lo[3]; r[4] = hi[0]; r[5] = hi[1]; r[6] = hi[2]; r[7] = hi[3];
    return r;
}
DI bf16x8 gfrag(const bf16_t* A, int ld, int row0, int k0, int lane) {
    return *(const bf16x8*)(A + (size_t)(row0 + (lane & 15)) * ld + k0 + 8 * (lane >> 4));
}
#define MFMA16(a, b, c) __builtin_amdgcn_mfma_f32_16x16x32_bf16((a), (b), (c), 0, 0, 0)
template <bool XT, bool YT, int KS, int LDX, int LDY>
DI f32x4 mm16(const LAS bf16_t* X, const LAS bf16_t* Y, int p0, int q0, int lane, f32x4 acc) {
#pragma unroll
    for (int ks = 0; ks < KS; ++ks) {
        const bf16x8 xb = XT ? frag_t<LDX>(X, p0, 32 * ks, lane) : frag_n<LDX>(X, p0, 32 * ks, lane);
        const bf16x8 ya = YT ? frag_t<LDY>(Y, q0, 32 * ks, lane) : frag_n<LDY>(Y, q0, 32 * ks, lane);
        acc = MFMA16(ya, xb, acc);
    }
    return acc;
}
DI void st4_bf16(LAS bf16_t* p, const f32x4 v) { *(LAS u32x2*)p = pack4(v[0], v[1], v[2], v[3]); }
DI f32x4 ld4_bf16(const LAS bf16_t* p) { const u32x2 w = *(const LAS u32x2*)p; float f[4]; unpack4(w, f); return (f32x4){f[0], f[1], f[2], f[3]}; }
constexpr f32x4 F4Z = {0.f, 0.f, 0.f, 0.f};

struct TrFrag { s16x4 lo, hi; };
template <int LD> DI void tr_issue(TrFrag& f, const LAS bf16_t* A, int row0, int k0, int lane) {
    const int l = lane & 15, g = lane >> 4;
    const unsigned addr = (unsigned)(uintptr_t)(A + (k0 + 8 * g + (l >> 2)) * LD + row0 + 4 * (l & 3));
    asm volatile("ds_read_b64_tr_b16 %0, %2\n\tds_read_b64_tr_b16 %1, %2 offset:%3" : "=&v"(f.lo), "=&v"(f.hi) : "v"(addr), "n"(4 * LD * 2) : "memory");
}
DI bf16x8 tr_get(const TrFrag& f) { bf16x8 r; r[0] = f.lo[0]; r[1] = f.lo[1]; r[2] = f.lo[2]; r[3] = f.lo[3]; r[4] = f.hi[0]; r[5] = f.hi[1]; r[6] = f.hi[2]; r[7] = f.hi[3]; return r; }
template <int LD> DI void tr_issue4(TrFrag (&f)[2][2], const LAS bf16_t* A, int r0, int lane) {
    tr_issue<LD>(f[0][0], A, r0, 0, lane); tr_issue<LD>(f[0][1], A, r0, 32, lane); tr_issue<LD>(f[1][0], A, r0 + 16, 0, lane); tr_issue<LD>(f[1][1], A, r0 + 16, 32, lane); }
template <int LD> DI void tr_issue2(TrFrag (&f)[2], const LAS bf16_t* A, int r0, int lane) { tr_issue<LD>(f[0], A, r0, 0, lane); tr_issue<LD>(f[1], A, r0, 32, lane); }
#define TRW(f) "+v"((f).lo), "+v"((f).hi)
DI void tr_wait4(TrFrag (&a)[2][2]) { asm volatile("s_waitcnt lgkmcnt(0)" : TRW(a[0][0]), TRW(a[0][1]), TRW(a[1][0]), TRW(a[1][1]) :: "memory"); }
DI void tr_wait8(TrFrag (&a)[2][2], TrFrag (&b)[2][2]) { asm volatile("s_waitcnt lgkmcnt(0)" : TRW(a[0][0]), TRW(a[0][1]), TRW(a[1][0]), TRW(a[1][1]), TRW(b[0][0]), TRW(b[0][1]), TRW(b[1][0]), TRW(b[1][1]) :: "memory"); }
DI void tr_wait2(TrFrag (&a)[2]) { asm volatile("s_waitcnt lgkmcnt(0)" : TRW(a[0]), TRW(a[1]) :: "memory"); }
DI void tr_wait42(TrFrag (&a)[2][2], TrFrag (&b)[2]) { asm volatile("s_waitcnt lgkmcnt(0)" : TRW(a[0][0]), TRW(a[0][1]), TRW(a[1][0]), TRW(a[1][1]), TRW(b[0]), TRW(b[1]) :: "memory"); }
DI f32x4 mma2(const bf16x8 x0, const bf16x8 x1, const bf16x8 y0, const bf16x8 y1, f32x4 acc) { acc = MFMA16(y0, x0, acc); return MFMA16(y1, x1, acc); }
struct Params { const float* in[31]; float* out; unsigned char* ws; int ph_lo, ph_hi; };
#define CAS __attribute__((address_space(4)))
typedef const CAS Params& PR;
enum { I_X = 0, I_NMIX, I_WIN, I_LBRAW, I_ONORM, I_MU, I_W0, I_WUP, I_A0, I_AUP, I_GUP, I_KK, I_KA, I_RK, I_LNW, I_LNB, I_V0, I_VDOWN, I_VUP, I_WBH, I_WBR, I_WOUT, I_NFFN,
       I_RGW, I_RGB, I_REW, I_REB, I_EWG, I_EWU, I_EWD, I_FNW };
struct Ctx { LAS unsigned char* lds; int tid, lane, wave, G, bid; };

struct TItem { const float* W; bf16_t* WT; int ldw, ldt; int f8; };
DI void titem_load(const TItem& t, f32x4 (&v)[8], int lane) {
#pragma unroll
    for (int i = 0; i < 8; ++i) v[i] = __builtin_nontemporal_load((const f32x4*)(t.W + (size_t)(8 * i + (lane >> 3)) * t.ldw + 4 * (lane & 7)));
}
DI void titem_store(const TItem& t, const f32x4 (&v)[8], LAS float* scr, int lane) {
#pragma unroll
    for (int i = 0; i < 8; ++i) { LAS float* d = scr + (8 * i + (lane >> 3)) * 33 + 4 * (lane & 7); d[0] = v[i].x; d[1] = v[i].y; d[2] = v[i].z; d[3] = v[i].w; }
    asm volatile("s_waitcnt lgkmcnt(0)" ::: "memory");
    const int c = lane & 7;
#pragma unroll
    for (int j = 0; j < 4; ++j) { const int n = (lane >> 3) + 8 * j; const LAS float* s = scr + (8 * c) * 33 + n;
        if (t.f8) { u32x2 o; o.x = pk4_fp8(64.f * s[0 * 33], 64.f * s[1 * 33], 64.f * s[2 * 33], 64.f * s[3 * 33]); o.y = pk4_fp8(64.f * s[4 * 33], 64.f * s[5 * 33], 64.f * s[6 * 33], 64.f * s[7 * 33]);
            *(u32x2*)((unsigned char*)t.WT + (size_t)n * t.ldt + 8 * c) = o; }
        else { u32x4 o; o.x = cvt_pk(s[0 * 33], s[1 * 33]); o.y = cvt_pk(s[2 * 33], s[3 * 33]); o.z = cvt_pk(s[4 * 33], s[5 * 33]); o.w = cvt_pk(s[6 * 33], s[7 * 33]);
            *(u32x4*)(t.WT + (size_t)n * t.ldt + 8 * c) = o; } }
    asm volatile("s_waitcnt lgkmcnt(0)" ::: "memory");
}
DI TItem mk_titem(const float* W, int ldw, int k0, int n0, bf16_t* WT, int ldt, int drow0) { TItem t; t.W = W + (size_t)k0 * ldw + n0; t.WT = WT + (size_t)drow0 * ldt + k0; t.ldw = ldw; t.ldt = ldt; t.f8 = 0; return t; }
DI TItem mk_titem8(const float* W, int ldw, int k0, int n0, unsigned char* WT8, int ldt_bytes, int drow0) { TItem t; t.W = W + (size_t)k0 * ldw + n0; t.WT = (bf16_t*)(WT8 + (size_t)drow0 * ldt_bytes + k0); t.ldw = ldw; t.ldt = ldt_bytes; t.f8 = 1; return t; }
DI TItem small_item(PR p, int l, int it) {
    unsigned char* ws = p.ws;
    constexpr int I_IN = 32 * 361, I_B = 16 * 64;
    int r = it;
    if (r < I_IN) { const int n0 = 32 * (r % 361);
        if (n0 >= 7456 || (n0 >= 3072 && n0 < 4096)) return mk_titem8(p.in[I_WIN] + (size_t)l * D * IN_WIDTH, IN_WIDTH, 64 * (r / 361), n0, ws + WS_WG8, D, n0 >= 7456 ? n0 - 7456 : ZG_O + (n0 - 3072));
        return mk_titem(p.in[I_WIN] + (size_t)l * D * IN_WIDTH, IN_WIDTH, 64 * (r / 361), n0, (bf16_t*)(ws + WS_WIN), D, n0 < 3072 ? n0 : n0 - 1024); } r -= I_IN;
    if (r < I_B) return mk_titem(p.in[I_WBH] + (size_t)l * 1024 * D, D, 64 * (r / 64), 32 * (r % 64), (bf16_t*)(ws + WS_WBH), 1024, 32 * (r % 64)); r -= I_B;
    if (r < I_B) return mk_titem(p.in[I_WBR] + (size_t)l * 1024 * D, D, 64 * (r / 64), 32 * (r % 64), (bf16_t*)(ws + WS_WBR), 1024, 32 * (r % 64)); r -= I_B;
    return mk_titem(p.in[I_WOUT] + (size_t)l * D * D, D, 64 * (r / 64), 32 * (r % 64), (bf16_t*)(ws + WS_WO), D, 32 * (r % 64));
}
DI TItem expert_item(PR p, int l, int it) {
    unsigned char* ws = p.ws;
    constexpr int PER_GU = 32 * 16, PER_D = 8 * 64;
    const int e = it / (2 * PER_GU + PER_D); int r = it % (2 * PER_GU + PER_D);
    if (r < 2 * PER_GU) { const int up = r >= PER_GU; if (up) r -= PER_GU; const int kb = r / 16, nb = r % 16, j0 = 32 * nb;
        return mk_titem8((up ? p.in[I_EWU] : p.in[I_EWG]) + ((size_t)l * NEXP + e) * D * DEXP, DEXP, 64 * kb, j0, ws + WS_WGU + (size_t)e * 1024 * D, D, 256 * (j0 >> 7) + (j0 & 127) + (up ? 128 : 0)); }
    r -= 2 * PER_GU; const int kb = r / 64, nb = r % 64;
    return mk_titem8(p.in[I_EWD] + ((size_t)l * NEXP + e) * DEXP * D, D, 64 * kb, 32 * nb, ws + WS_WDN + (size_t)e * D * DEXP, DEXP, 32 * nb);
}
template <bool EXPERT> DI void run_titems(PR p, const Ctx& c, int l, int lo, int hi, int wg0, int nwg) {
    LAS float* scr = (LAS float*)(c.lds + c.wave * 8448);
    const int gw = (c.bid - wg0) * 8 + c.wave, NGW = nwg * 8;
    for (int it = lo + gw; it < hi; it += 2 * NGW) {
        const int it2 = it + NGW; const bool has2 = it2 < hi;
        const TItem a = EXPERT ? expert_item(p, l, it) : small_item(p, l, it), b = EXPERT ? expert_item(p, l, has2 ? it2 : it) : small_item(p, l, has2 ? it2 : it);
        f32x4 va[8], vb[8]; titem_load(a, va, c.lane); titem_load(b, vb, c.lane);
        titem_store(a, va, scr, c.lane); if (has2) titem_store(b, vb, scr, c.lane);
    }
}
constexpr int SMALL_ITEMS = 32 * 361 + 2 * 16 * 64 + 32 * 64;
constexpr int SMALL_WIN_ITEMS = 32 * 361;
DI void convert_small(PR p, const Ctx& c, int l, int lo) {
    unsigned char* ws = p.ws;
    const int gw = c.bid * 8 + c.wave, NGW = c.G * 8;
    bf16_t* WIN = (bf16_t*)(ws + WS_WIN);
    const float* w_in = p.in[I_WIN] + (size_t)l * D * IN_WIDTH;
    run_titems<false>(p, c, l, lo, SMALL_ITEMS, 0, c.G);
    int NT_ = c.G * 512; asm volatile("" : "+s"(NT_));
    const int gt = c.bid * 512 + c.tid, NT = NT_;
    bf16_t* WUPT = (bf16_t*)(ws + WS_LORA + LO_WUP); bf16_t* AUPT = (bf16_t*)(ws + WS_LORA + LO_AUP); bf16_t* GUPT = (bf16_t*)(ws + WS_LORA + LO_GUP); bf16_t* VUPT = (bf16_t*)(ws + WS_LORA + LO_VUP);
    bf16_t* WRH = (bf16_t*)(ws + WS_LORA + LO_WR); bf16_t* WRL = (bf16_t*)(ws + WS_LORA + LO_WRL);
    const float* wup = p.in[I_WUP] + (size_t)l * 64 * 1024; const float* aup = p.in[I_AUP] + (size_t)l * 64 * 1024; const float* gup = p.in[I_GUP] + (size_t)l * 160 * 1024;
    _Pragma("unroll 1") for (int i = gt; i < 1024 * 64; i += NT) { const int n = i >> 6, k = i & 63; WUPT[i] = (bf16_t)(cvt_pk(wup[k * 1024 + n], 0.f) & 0xffff); AUPT[i] = (bf16_t)(cvt_pk(aup[k * 1024 + n], 0.f) & 0xffff); }
    _Pragma("unroll 1") for (int i = gt; i < 1024 * 160; i += NT) { const int n = i / 160, k = i % 160; GUPT[i] = (bf16_t)(cvt_pk(gup[k * 1024 + n], 0.f) & 0xffff); }
    if (l == 1) { const float* vup = p.in[I_VUP]; _Pragma("unroll 1") for (int i = gt; i < 1024 * 32; i += NT) { const int n = i >> 5, k = i & 31; VUPT[i] = (bf16_t)(cvt_pk(vup[k * 1024 + n], 0.f) & 0xffff); } }
    const float* rgw = p.in[I_RGW] + (size_t)l * D * 4; const float* rew = p.in[I_REW] + (size_t)l * D * 32;
    _Pragma("unroll 1") for (int i = gt; i < 48 * 2048; i += NT) { const int cc = i >> 11, k = i & 2047; const float v = cc < 4 ? rgw[k * 4 + cc] : (cc < 36 ? rew[k * 32 + (cc - 4)] : 0.f);
        const unsigned hb = cvt_pk(v, 0.f) & 0xffffu; WRH[i] = (bf16_t)hb; WRL[i] = (bf16_t)(cvt_pk(v - __uint_as_float(hb << 16), 0.f) & 0xffffu); }
    if (l == 1) {
        const float* mu = p.in[I_MU] + 3360 + 2048; const float* vd = p.in[I_VDOWN];
        LAS float* vdT = (LAS float*)c.lds;
        __syncthreads();
#pragma unroll
        for (int i = 0; i < 16; ++i) { const int idx = c.tid + 512 * i, cc = idx >> 3, n4 = (idx & 7) * 4; const f32x4 v = *(const f32x4*)(vd + (size_t)cc * 32 + n4);
            vdT[(n4 + 0) * 1025 + cc] = v.x; vdT[(n4 + 1) * 1025 + cc] = v.y; vdT[(n4 + 2) * 1025 + cc] = v.z; vdT[(n4 + 3) * 1025 + cc] = v.w; }
        __syncthreads();
        for (int k = gw; k < D; k += NGW) {
            float wv[16], wm[16];
#pragma unroll
            for (int j2 = 0; j2 < 16; ++j2) { const int cc = c.lane + 64 * j2; const float w = w_in[(size_t)k * IN_WIDTH + 6144 + cc], m = mu[cc]; wv[j2] = w * (1.f - m); wm[j2] = w * m; }
#pragma unroll 1
            for (int g8 = 0; g8 < 4; ++g8) {
                float v[16];
#pragma unroll
                for (int q = 0; q < 8; ++q) { const int n = 8 * g8 + q; float sa = 0.f, sb = 0.f;
#pragma unroll
                    for (int j2 = 0; j2 < 16; ++j2) { const float x = vdT[n * 1025 + c.lane + 64 * j2]; sa += wv[j2] * x; sb += wm[j2] * x; }
                    v[q] = sa; v[8 + q] = sb; }
#define WVD_STEP(CNT, OFF) { const bool hi_ = (c.lane & (OFF)) != 0; _Pragma("unroll") for (int i = 0; i < (CNT); ++i) { const float snd = hi_ ? v[i] : v[(CNT) + i]; const float kp = hi_ ? v[(CNT) + i] : v[i]; v[i] = kp + __shfl_xor(snd, (OFF)); } }
                WVD_STEP(8, 32) WVD_STEP(4, 16) WVD_STEP(2, 8) WVD_STEP(1, 4)
#undef WVD_STEP
                float r = v[0]; r += __shfl_xor(r, 2); r += __shfl_xor(r, 1);
                const int vi = (c.lane >> 2) & 15;
                if ((c.lane & 3) == 0) WIN[(size_t)((vi < 8 ? ZC_VDA : ZC_VDB - 8) + 8 * g8 + vi) * D + k] = (bf16_t)(cvt_pk(r, 0.f) & 0xffff);
            }
        }
        __syncthreads();
    }
}
constexpr int EXP_ITEMS = NEXP * (2 * 32 * 16 + 8 * 64);
#ifndef EXP_EARLY
#define EXP_EARLY 24576
#endif
#ifndef PB0_EXP
#define PB0_EXP 8192
#endif
DI void convert_experts_early(PR p, const Ctx& c, int l, int wg0, int nwg) { run_titems<true>(p, c, l, 0, EXP_EARLY, wg0, nwg); }
DI void convert_experts(PR p, const Ctx& c, int l, int lo) { run_titems<true>(p, c, l, lo, EXP_ITEMS, 0, c.G); }
DI void rms_row_bf16(const float* xrow, const f32x4 (&ww)[8], bf16_t* orow, unsigned char* orow8, int lane, bf16_t* xbrow) {
    const f32x4* xr = (const f32x4*)xrow + lane; f32x4 v[8]; float s = 0.f;
#pragma unroll
    for (int j = 0; j < 8; ++j) v[j] = xr[64 * j];
#pragma unroll
    for (int j = 0; j < 8; ++j) s += (v[j].x * v[j].x + v[j].y * v[j].y) + (v[j].z * v[j].z + v[j].w * v[j].w);
    const float rstd = rsqrtf(wave_sum(s) * (1.f / D) + NORM_EPS);
    u32x2* o8 = (u32x2*)orow + lane; unsigned* o4 = (unsigned*)orow8 + lane;
#pragma unroll
    for (int j = 0; j < 8; ++j) { const float a = v[j].x * rstd * ww[j].x, b = v[j].y * rstd * ww[j].y, c2 = v[j].z * rstd * ww[j].z, d = v[j].w * rstd * ww[j].w;
        o8[64 * j] = pack4(a, b, c2, d); o4[64 * j] = pk4_fp8(a, b, c2, d); ((u32x2*)xbrow + lane)[64 * j] = pack4(v[j].x, v[j].y, v[j].z, v[j].w); }
}
constexpr int RL = 72;
constexpr int R_SLOT = 64 * RL * 2;
constexpr int R_EXTRA = 12 * R_SLOT;
constexpr int FL = 68;
#define RSLOT(i) ((LAS bf16_t*)(c.lds + (i) * R_SLOT))
DI int r1_perm(int it) { const int lo = it & 255, hi = it >> 8; return (lo >> 1) * 32 + 16 * (lo & 1) + hi; }
constexpr int R1_PARS_OFF = LDS_CTL_OFF + 1536;
DI void r1_fill_params(PR p, const Ctx& c, int l, int h) {
    LAS float* PARS = (LAS float*)(c.lds + R1_PARS_OFF); const float* mu = p.in[I_MU] + (size_t)l * 3360;
    for (int i = c.tid; i < 640; i += 512) { const int a = i >> 6, j = i & 63; float v;
        if (a == 0) v = p.in[I_W0][l * 1024 + 64 * h + j]; else if (a == 1) v = p.in[I_A0][l * 1024 + 64 * h + j]; else if (a == 2) v = p.in[I_KK][l * 1024 + 64 * h + j];
        else if (a == 3) v = p.in[I_KA][l * 1024 + 64 * h + j]; else if (a == 4) v = p.in[I_RK][l * 1024 + 64 * h + j]; else if (a == 5) v = mu[64 * h + j];
        else if (a == 6) v = mu[1024 + 64 * h + j]; else if (a == 7) v = mu[2048 + 64 * h + j]; else if (a == 8) v = mu[3072 + j]; else v = mu[3136 + j];
        PARS[i] = v; }
    lds_barrier();
}
struct R1In { u32x4 cur[5], prv[5], wu, au; };
DI R1In r1_load(const unsigned char* ws, int task, int tid) {
    R1In in;
    const int bh = task >> 5, ch = task & 31, b = bh >> 4, h = bh & 15, tok0 = ch * 64, m0 = b * TSEQ + tok0, t = tid >> 3, cg = tid & 7, ch0 = 64 * h + 8 * cg;
    const bf16_t* zr = (const bf16_t*)(ws + WS_Z) + (size_t)(m0 + t) * NZ; const bf16_t* zp = (tok0 + t) > 0 ? zr - NZ : zr;
    in.cur[0] = *(const u32x4*)(zr + ZC_R + ch0); in.prv[0] = *(const u32x4*)(zp + ZC_R + ch0); in.cur[1] = *(const u32x4*)(zr + ZC_K + ch0); in.prv[1] = *(const u32x4*)(zp + ZC_K + ch0);
    in.cur[2] = *(const u32x4*)(zr + ZC_V + ch0); in.prv[2] = *(const u32x4*)(zp + ZC_V + ch0); in.cur[3] = *(const u32x4*)(zr + ZC_WD + 8 * cg); in.prv[3] = *(const u32x4*)(zp + ZC_WD + 8 * cg);
    in.cur[4] = *(const u32x4*)(zr + ZC_AD + 8 * cg); in.prv[4] = *(const u32x4*)(zp + ZC_AD + 8 * cg);
    in.wu = *(const u32x4*)((const bf16_t*)(ws + WS_LORA + LO_WUP) + (size_t)(64 * h + t) * 64 + 8 * cg); in.au = *(const u32x4*)((const bf16_t*)(ws + WS_LORA + LO_AUP) + (size_t)(64 * h + t) * 64 + 8 * cg);
    return in;
}
template <int PROF> DI R1In r1_task(PR p, const Ctx& c0, int l, int task, const R1In in, int next_task) {
    R1In nin;
#define SEC(b) (!(PROF & (b)))
#define GST(T, addr, val) do { const T v_ = (val); if (SEC(1)) *(T*)(addr) = v_; else asm volatile("" :: "v"(v_)); } while (0)
    Ctx c = c0; { int t_ = c0.tid; asm volatile("" : "+v"(t_)); c.tid = t_; c.lane = t_ & 63; unsigned lb_ = (unsigned)(uintptr_t)c0.lds; asm volatile("" : "+s"(lb_)); c.lds = (LAS unsigned char*)(uintptr_t)lb_; }
    unsigned char* ws = p.ws;
    const int bh = task >> 5, ch = task & 31, b = bh >> 4, h = bh & 15, tok0 = ch * 64, m0 = b * TSEQ + tok0;
    const int tid = c.tid, lane = c.lane, w = c.wave;
    const bf16_t* Z = (const bf16_t*)(ws + WS_Z);
    const int t = tid >> 3, cg = tid & 7, ch0 = 64 * h + 8 * cg;
    LAS float* LW = (LAS float*)(c.lds + R_EXTRA); LAS float* LA = LW + 64 * FL; LAS float* SEG = LA + 64 * FL;
    LAS float* LV = (LAS float*)(c.lds + 1 * R_SLOT);
    float r[8], k[8], v[8];
    const LAS float* PARS = (const LAS float*)(c.lds + R1_PARS_OFF);
#define PAR8(a, A, B) const f32x4 A = *(const LAS f32x4*)(PARS + (a) * 64 + 8 * cg), B = *(const LAS f32x4*)(PARS + (a) * 64 + 8 * cg + 4)
    PAR8(0, w0A, w0B); PAR8(1, a0A, a0B); PAR8(2, kkA, kkB); PAR8(3, kaA, kaB); PAR8(4, rkA, rkB);
#undef PAR8
    if (!SEC(2)) {
#pragma unroll
        for (int j = 0; j < 8; ++j) { r[j] = 0.5f + 1e-3f * tid; k[j] = 0.25f + 1e-3f * lane; v[j] = 0.1f * w + 0.01f * j; } }
    if (SEC(2))
    {
        const bf16_t* zr = Z + (size_t)(m0 + t) * NZ; const bool has_prev = (tok0 + t) > 0; const bf16_t* zp = zr - NZ;
        float cur[8], prv[8], wd[8], ad[8];
#define LERP_IN(dst, idx, mucol) do { unpack8(in.cur[idx], cur); if (has_prev) unpack8(in.prv[idx], prv); else { _Pragma("unroll") for (int j = 0; j < 8; ++j) prv[j] = 0.f; } \
            const f32x4 mA = *(const LAS f32x4*)(PARS + (mucol) * 64 + 8 * cg), mB = *(const LAS f32x4*)(PARS + (mucol) * 64 + 8 * cg + 4); const float mm[8] = {mA.x, mA.y, mA.z, mA.w, mB.x, mB.y, mB.z, mB.w}; \
            _Pragma("unroll") for (int j = 0; j < 8; ++j) dst[j] = cur[j] + mm[j] * (prv[j] - cur[j]); } while (0)
        LERP_IN(r, 0, 5); LERP_IN(k, 1, 6); LERP_IN(v, 2, 7);
        LERP_IN(wd, 3, 8); LERP_IN(ad, 4, 9);
#pragma unroll
        for (int j = 0; j < 8; ++j) wd[j] = 1.0f - 2.0f * __builtin_amdgcn_rcpf(1.0f + __expf(2.0f * wd[j]));
        *(LAS u32x4*)(RSLOT(7) + t * RL + 8 * cg) = pack8(wd);
        *(LAS u32x4*)(RSLOT(8) + t * RL + 8 * cg) = pack8(ad);
        *(LAS u32x4*)(RSLOT(9) + t * RL + 8 * cg) = in.wu; *(LAS u32x4*)(RSLOT(10) + t * RL + 8 * cg) = in.au;
        if (l == 1) {
            if (cg < 4) { float a8[8], b8[8]; unpack8(*(const u32x4*)(zr + ZC_VDA + 8 * cg), a8); if (has_prev) unpack8(*(const u32x4*)(zp + ZC_VDB + 8 * cg), b8); else {
#pragma unroll
                    for (int j = 0; j < 8; ++j) b8[j] = 0.f; }
#pragma unroll
                for (int j = 0; j < 8; ++j) a8[j] += b8[j];
                *(LAS u32x4*)(RSLOT(11) + t * 40 + 8 * cg) = pack8(a8);
                const bf16_t* VUPT = (const bf16_t*)(ws + WS_LORA + LO_VUP) + (size_t)(64 * h) * 32;
                *(LAS u32x4*)(RSLOT(0) + t * 40 + 8 * cg) = *(const u32x4*)(VUPT + t * 32 + 8 * cg); }
        }
    }
    lds_barrier();
    const int pt = w >> 1, qb = 2 * (w & 1), fr = lane & 15, fq = lane >> 4;
    if (SEC(4)) {
#pragma unroll
        for (int i = 0; i < 2; ++i) { const int qt = qb + i;
            const f32x4 aw = mm16<false, false, 2, RL, RL>(RSLOT(7), RSLOT(9), 16 * pt, 16 * qt, lane, F4Z);
            const f32x4 aa = mm16<false, false, 2, RL, RL>(RSLOT(8), RSLOT(10), 16 * pt, 16 * qt, lane, F4Z);
            *(LAS f32x4*)(LW + (16 * pt + fr) * FL + 16 * qt + 4 * fq) = aw; *(LAS f32x4*)(LA + (16 * pt + fr) * FL + 16 * qt + 4 * fq) = aa;
            if (l == 1) { const f32x4 av = mm16<false, false, 1, 40, 40>(RSLOT(11), RSLOT(0), 16 * pt, 16 * qt, lane, F4Z); *(LAS f32x4*)(LV + (16 * pt + fr) * FL + 16 * qt + 4 * fq) = av; }
        }
    }
    lds_barrier();
    float lw[8], a[8], kk[8], kp[8];
    {
        const float w0[8] = {w0A.x, w0A.y, w0A.z, w0A.w, w0B.x, w0B.y, w0B.z, w0B.w}, a0[8] = {a0A.x, a0A.y, a0A.z, a0A.w, a0B.x, a0B.y, a0B.z, a0B.w};
        const float k_k[8] = {kkA.x, kkA.y, kkA.z, kkA.w, kkB.x, kkB.y, kkB.z, kkB.w}, k_a[8] = {kaA.x, kaA.y, kaA.z, kaA.w, kaB.x, kaB.y, kaB.z, kaB.w};
        const float r_k[8] = {rkA.x, rkA.y, rkA.z, rkA.w, rkB.x, rkB.y, rkB.z, rkB.w};
        const f32x4 lwA = *(const LAS f32x4*)(LW + t * FL + 8 * cg), lwB = *(const LAS f32x4*)(LW + t * FL + 8 * cg + 4);
        const f32x4 laA = *(const LAS f32x4*)(LA + t * FL + 8 * cg), laB = *(const LAS f32x4*)(LA + t * FL + 8 * cg + 4);
        const float lwr[8] = {lwA.x, lwA.y, lwA.z, lwA.w, lwB.x, lwB.y, lwB.z, lwB.w}, lar[8] = {laA.x, laA.y, laA.z, laA.w, laB.x, laB.y, laB.z, laB.w};
        bf16_t* VFIRST = (bf16_t*)(ws + WS_VFIRST) + (size_t)(m0 + t) * 1024 + ch0;
        if (l == 1) {
            const f32x4 lvA = *(const LAS f32x4*)(LV + t * FL + 8 * cg), lvB = *(const LAS f32x4*)(LV + t * FL + 8 * cg + 4);
            const float lvr[8] = {lvA.x, lvA.y, lvA.z, lvA.w, lvB.x, lvB.y, lvB.z, lvB.w};
            const f32x4 v0A = *(const f32x4*)(p.in[I_V0] + ch0), v0B = *(const f32x4*)(p.in[I_V0] + ch0 + 4); const float v0[8] = {v0A.x, v0A.y, v0A.z, v0A.w, v0B.x, v0B.y, v0B.z, v0B.w};
            float vf[8]; unpack8(*(const u32x4*)VFIRST, vf);
#pragma unroll
            for (int j = 0; j < 8; ++j) v[j] = v[j] + (vf[j] - v[j]) * sigm(v0[j] + lvr[j]);
            GST(u32x4, (bf16_t*)(ws + WS_VF) + (size_t)(m0 + t) * 1024 + ch0, pack8(v));
        } else { GST(u32x4, VFIRST, pack8(v)); }
        float ss = 0.f, rks = 0.f;
#pragma unroll
        for (int j = 0; j < 8; ++j) { lw[j] = -0.60653066f * sigm(w0[j] + lwr[j]); a[j] = sigm(a0[j] + lar[j]); kk[j] = k[j] * k_k[j]; ss += kk[j] * kk[j];
            kp[j] = k[j] * (1.0f + (a[j] - 1.0f) * k_a[j]); rks += r[j] * kp[j] * r_k[j]; }
        ss += __shfl_xor(ss, 1); ss += __shfl_xor(ss, 2); ss += __shfl_xor(ss, 4);
        rks += __shfl_xor(rks, 1); rks += __shfl_xor(rks, 2); rks += __shfl_xor(rks, 4);
        const float inv = rsqrtf(fmaxf(ss, 1e-12f));
#pragma unroll
        for (int j = 0; j < 8; ++j) kk[j] *= inv;
        if (SEC(1) && cg == 0) ((float*)(ws + WS_RK))[(size_t)(m0 + t) * 16 + h] = rks;
    }
    nin = r1_load(ws, next_task, tid);
    lds_barrier();
    *(LAS f32x4*)(LW + t * FL + 8 * cg) = (f32x4){lw[0], lw[1], lw[2], lw[3]}; *(LAS f32x4*)(LW + t * FL + 8 * cg + 4) = (f32x4){lw[4], lw[5], lw[6], lw[7]};
    lds_barrier();
    if (SEC(8)) {
        const int j = tid & 63, sg = tid >> 6; float s = 0.f;
#pragma unroll
        for (int i = 0; i < 8; ++i) s += LW[(8 * sg + i) * FL + j];
        SEG[sg * 64 + j] = s;
        lds_barrier();
        float off = 0.f;
        for (int s2 = 0; s2 < sg; ++s2) off += SEG[s2 * 64 + j];
#pragma unroll
        for (int i = 0; i < 8; ++i) { off += LW[(8 * sg + i) * FL + j]; LW[(8 * sg + i) * FL + j] = off; }
    }
    lds_barrier();
    {
        const f32x4 cA = *(const LAS f32x4*)(LW + t * FL + 8 * cg), cB = *(const LAS f32x4*)(LW + t * FL + 8 * cg + 4);
        const f32x4 eA = *(const LAS f32x4*)(LW + 63 * FL + 8 * cg), eB = *(const LAS f32x4*)(LW + 63 * FL + 8 * cg + 4);
        const float cs[8] = {cA.x, cA.y, cA.z, cA.w, cB.x, cB.y, cB.z, cB.w}, ce[8] = {eA.x, eA.y, eA.z, eA.w, eB.x, eB.y, eB.z, eB.w};
        float Rt[8], At[8], Bt[8], Kt[8], Bp[8], Kp[8];
#pragma unroll
        for (int j = 0; j < 8; ++j) { const float ep = __expf(cs[j]), em = __expf(-cs[j]), el = __expf(ce[j] - cs[j]), ex = __expf(cs[j] - lw[j]); const float bv = kk[j] * a[j];
            Rt[j] = r[j] * ep; At[j] = -kk[j] * ex; Bt[j] = bv * em; Kt[j] = kp[j] * em; Bp[j] = bv * el; Kp[j] = kp[j] * el; }
        *(LAS u32x4*)(RSLOT(0) + t * RL + 8 * cg) = pack8(Rt); *(LAS u32x4*)(RSLOT(1) + t * RL + 8 * cg) = pack8(At); *(LAS u32x4*)(RSLOT(2) + t * RL + 8 * cg) = pack8(Bt);
        *(LAS u32x4*)(RSLOT(3) + t * RL + 8 * cg) = pack8(Kt); *(LAS u32x4*)(RSLOT(4) + t * RL + 8 * cg) = pack8(Bp); *(LAS u32x4*)(RSLOT(5) + t * RL + 8 * cg) = pack8(Kp);
        *(LAS u32x4*)(RSLOT(6) + t * RL + 8 * cg) = pack8(v);
    }
    lds_barrier();
    const int p0 = 16 * pt, prow = p0 + fr;
    if (SEC(16)) {
#pragma unroll
        for (int i = 0; i < 2; ++i) { const int q0 = 16 * (qb + i), qc = q0 + 4 * fq;
            f32x4 ab = mm16<false, false, 2, RL, RL>(RSLOT(1), RSLOT(2), p0, q0, lane, F4Z);
            f32x4 ak = mm16<false, false, 2, RL, RL>(RSLOT(1), RSLOT(3), p0, q0, lane, F4Z);
            f32x4 rb = mm16<false, false, 2, RL, RL>(RSLOT(0), RSLOT(2), p0, q0, lane, F4Z);
            f32x4 rk = mm16<false, false, 2, RL, RL>(RSLOT(0), RSLOT(3), p0, q0, lane, F4Z);
#pragma unroll
            for (int rr = 0; rr < 4; ++rr) { const int s = qc + rr; if (s >= prow) { ab[rr] = 0.f; ak[rr] = 0.f; } if (s > prow) { rb[rr] = 0.f; rk[rr] = 0.f; } }
            st4_bf16(RSLOT(7) + prow * RL + qc, ab); st4_bf16(RSLOT(9) + prow * RL + qc, ak); st4_bf16(RSLOT(10) + prow * RL + qc, rb); st4_bf16(RSLOT(11) + prow * RL + qc, rk); }
    }
    lds_barrier();
    const int qa = 16 * qb, qca = qa + 4 * fq, qcb = qca + 16;
    if (SEC(32)) {
        TrFrag yl[2][2]; tr_issue4<RL>(yl, RSLOT(7), qa, lane);
        const bf16x8 xl0 = frag_n<RL>(RSLOT(7), p0, 0, lane), xl1 = frag_n<RL>(RSLOT(7), p0, 32, lane);
        f32x4 t1a = ld4_bf16(RSLOT(7) + prow * RL + qca), t1b = ld4_bf16(RSLOT(7) + prow * RL + qcb);
        tr_wait4(yl);
        const f32x4 la = mma2(xl0, xl1, tr_get(yl[0][0]), tr_get(yl[0][1]), F4Z), lb = mma2(xl0, xl1, tr_get(yl[1][0]), tr_get(yl[1][1]), F4Z);
#pragma unroll
        for (int rr = 0; rr < 4; ++rr) { if (qca + rr == prow) t1a[rr] += 1.0f; if (qcb + rr == prow) t1b[rr] += 1.0f; }
        st4_bf16(RSLOT(8) + prow * RL + qca, la); st4_bf16(RSLOT(8) + prow * RL + qcb, lb); st4_bf16(RSLOT(2) + prow * RL + qca, t1a); st4_bf16(RSLOT(2) + prow * RL + qcb, t1b);
    }
    lds_barrier();
#define NSTEP(LS, LD_, TS, TD, SQ) do { TrFrag yl[2][2]; tr_issue4<RL>(yl, RSLOT(LS), qa, lane); \
        const bf16x8 xt0 = frag_n<RL>(RSLOT(TS), p0, 0, lane), xt1 = frag_n<RL>(RSLOT(TS), p0, 32, lane), xl0 = frag_n<RL>(RSLOT(LS), p0, 0, lane), xl1 = frag_n<RL>(RSLOT(LS), p0, 32, lane); \
        const f32x4 ta0 = ld4_bf16(RSLOT(TS) + prow * RL + qca), tb0 = ld4_bf16(RSLOT(TS) + prow * RL + qcb); \
        tr_wait4(yl); const bf16x8 y00 = tr_get(yl[0][0]), y01 = tr_get(yl[0][1]), y10 = tr_get(yl[1][0]), y11 = tr_get(yl[1][1]); \
        const f32x4 tna = mma2(xt0, xt1, y00, y01, ta0), tnb = mma2(xt0, xt1, y10, y11, tb0); \
        if (SQ) { const f32x4 la = mma2(xl0, xl1, y00, y01, F4Z), lb = mma2(xl0, xl1, y10, y11, F4Z); st4_bf16(RSLOT(LD_) + prow * RL + qca, la); st4_bf16(RSLOT(LD_) + prow * RL + qcb, lb); } \
        st4_bf16(RSLOT(TD) + prow * RL + qca, tna); st4_bf16(RSLOT(TD) + prow * RL + qcb, tnb); lds_barrier(); } while (0)
    if (SEC(32)) NSTEP(8, 7, 2, 3, 1);
    if (SEC(32)) NSTEP(7, 8, 3, 2, 1);
    if (SEC(32)) NSTEP(8, 7, 2, 3, 1);
    if (SEC(32)) NSTEP(7, 8, 3, 2, 1);
    if (SEC(32)) NSTEP(8, 7, 2, 3, 0);
#undef NSTEP
    if (SEC(64)) {
        TrFrag ya[2][2], yv[2][2]; tr_issue4<RL>(ya, RSLOT(1), qa, lane); tr_issue4<RL>(yv, RSLOT(6), qa, lane);
        const bf16x8 xt0 = frag_n<RL>(RSLOT(3), p0, 0, lane), xt1 = frag_n<RL>(RSLOT(3), p0, 32, lane), xk0 = frag_n<RL>(RSLOT(9), p0, 0, lane), xk1 = frag_n<RL>(RSLOT(9), p0, 32, lane);
        tr_wait8(ya, yv);
        const f32x4 pa = mma2(xt0, xt1, tr_get(ya[0][0]), tr_get(ya[0][1]), F4Z), pb2 = mma2(xt0, xt1, tr_get(ya[1][0]), tr_get(ya[1][1]), F4Z);
        const f32x4 ga = mma2(xk0, xk1, tr_get(yv[0][0]), tr_get(yv[0][1]), F4Z), gb = mma2(xk0, xk1, tr_get(yv[1][0]), tr_get(yv[1][1]), F4Z);
        st4_bf16(RSLOT(7) + prow * RL + qca, pa); st4_bf16(RSLOT(7) + prow * RL + qcb, pb2); st4_bf16(RSLOT(8) + prow * RL + qca, ga); st4_bf16(RSLOT(8) + prow * RL + qcb, gb);
    }
    lds_barrier();
    if (SEC(64)) {
        TrFrag yg[2][2]; tr_issue4<RL>(yg, RSLOT(8), qa, lane);
        const bf16x8 xt0 = frag_n<RL>(RSLOT(3), p0, 0, lane), xt1 = frag_n<RL>(RSLOT(3), p0, 32, lane);
        tr_wait4(yg);
        const f32x4 q0v = mma2(xt0, xt1, tr_get(yg[0][0]), tr_get(yg[0][1]), F4Z), q1v = mma2(xt0, xt1, tr_get(yg[1][0]), tr_get(yg[1][1]), F4Z);
        st4_bf16(RSLOT(9) + prow * RL + qca, q0v); st4_bf16(RSLOT(9) + prow * RL + qcb, q1v);
    }
    lds_barrier();
    if (SEC(64)) {
        const size_t blk = (size_t)task * 4096;
        const int pia = 16 * fq + 4 * qb, pib = pia + 4, mka = 32 * (qb >> 1) + 8 * fq, mkb = mka + 4;
        bf16_t* RP = (bf16_t*)(ws + WS_RP) + blk; bf16_t* Y0 = (bf16_t*)(ws + WS_Y0) + blk; bf16_t* MT = (bf16_t*)(ws + WS_MT) + blk; bf16_t* NN = (bf16_t*)(ws + WS_NN) + blk;
        {
            TrFrag yp[2][2], yq[2][2]; tr_issue4<RL>(yp, RSLOT(7), qa, lane); tr_issue4<RL>(yq, RSLOT(9), qa, lane);
            const bf16x8 xb0 = frag_n<RL>(RSLOT(10), p0, 0, lane), xb1 = frag_n<RL>(RSLOT(10), p0, 32, lane), xk0 = frag_n<RL>(RSLOT(11), p0, 0, lane), xk1 = frag_n<RL>(RSLOT(11), p0, 32, lane);
            const f32x4 r0a = ld4_bf16(RSLOT(0) + prow * RL + qca), r0b = ld4_bf16(RSLOT(0) + prow * RL + qcb);
            tr_wait8(yp, yq);
            const f32x4 rpa = mma2(xb0, xb1, tr_get(yp[0][0]), tr_get(yp[0][1]), r0a), rpb = mma2(xb0, xb1, tr_get(yp[1][0]), tr_get(yp[1][1]), r0b);
            f32x4 y0a = mma2(xb0, xb1, tr_get(yq[0][0]), tr_get(yq[0][1]), F4Z), y0b = mma2(xb0, xb1, tr_get(yq[1][0]), tr_get(yq[1][1]), F4Z);
            TrFrag yv[2][2]; tr_issue4<RL>(yv, RSLOT(6), qa, lane); tr_wait4(yv);
            y0a = mma2(xk0, xk1, tr_get(yv[0][0]), tr_get(yv[0][1]), y0a); y0b = mma2(xk0, xk1, tr_get(yv[1][0]), tr_get(yv[1][1]), y0b);
            GST(u32x2, RP + prow * 64 + pia, pack4(rpa[0], rpa[1], rpa[2], rpa[3])); GST(u32x2, RP + prow * 64 + pib, pack4(rpb[0], rpb[1], rpb[2], rpb[3]));
            GST(u32x2, Y0 + prow * 64 + qca, pack4(y0a[0], y0a[1], y0a[2], y0a[3])); GST(u32x2, Y0 + prow * 64 + qcb, pack4(y0b[0], y0b[1], y0b[2], y0b[3]));
        }
        {
            TrFrag xbp[2], yp[2][2]; tr_issue2<RL>(xbp, RSLOT(4), p0, lane); tr_issue4<RL>(yp, RSLOT(7), qa, lane); tr_wait42(yp, xbp);
            const bf16x8 xb0 = tr_get(xbp[0]), xb1 = tr_get(xbp[1]);
            f32x4 mta = mma2(xb0, xb1, tr_get(yp[0][0]), tr_get(yp[0][1]), F4Z), mtb = mma2(xb0, xb1, tr_get(yp[1][0]), tr_get(yp[1][1]), F4Z);
            const float dg = __expf(LW[63 * FL + prow]);
#pragma unroll
            for (int rr = 0; rr < 4; ++rr) { if (qca + rr == prow) mta[rr] += dg; if (qcb + rr == prow) mtb[rr] += dg; }
            GST(u32x2, MT + prow * 64 + mka, pack4(mta[0], mta[1], mta[2], mta[3])); GST(u32x2, MT + prow * 64 + mkb, pack4(mtb[0], mtb[1], mtb[2], mtb[3]));
            TrFrag xq[2], ybp[2][2]; tr_issue2<RL>(xq, RSLOT(9), p0, lane); tr_issue4<RL>(ybp, RSLOT(4), qa, lane); tr_wait42(ybp, xq);
            f32x4 nna = mma2(tr_get(xq[0]), tr_get(xq[1]), tr_get(ybp[0][0]), tr_get(ybp[0][1]), F4Z), nnb = mma2(tr_get(xq[0]), tr_get(xq[1]), tr_get(ybp[1][0]), tr_get(ybp[1][1]), F4Z);
            TrFrag xv[2], ykp[2][2]; tr_issue2<RL>(xv, RSLOT(6), p0, lane); tr_issue4<RL>(ykp, RSLOT(5), qa, lane); tr_wait42(ykp, xv);
            nna = mma2(tr_get(xv[0]), tr_get(xv[1]), tr_get(ykp[0][0]), tr_get(ykp[0][1]), nna); nnb = mma2(tr_get(xv[0]), tr_get(xv[1]), tr_get(ykp[1][0]), tr_get(ykp[1][1]), nnb);
            GST(u32x2, NN + prow * 64 + pia, pack4(nna[0], nna[1], nna[2], nna[3])); GST(u32x2, NN + prow * 64 + pib, pack4(nnb[0], nnb[1], nnb[2], nnb[3]));
        }
    }
    lds_barrier();
    return nin;
}
#undef SEC
#undef GST
constexpr int HL = 136, HCL = 132, SCL = 72, HC = 64;
constexpr int H_QT = 0, H_KT = HC * HL * 2  , H_KP = 2 * H_KT, H_V = 3 * H_KT, H_CS = 4 * H_KT  , H_SEG = H_CS + HC * HCL * 4  , H_SC = H_SEG + 4 * 128 * 4  ,
              H_NTS = H_CS;
constexpr int H_LB = 118784;
DI float hg_lb(PR p, int l, int chn) { if (l == 0) return 0.f; const float* raw = p.in[I_LBRAW]; return sigm(raw[1024 + chn] - raw[chn]); }
DI void h1_fill_lb(PR p, const Ctx& c, int l, int h) { __syncthreads(); if (c.tid < 128) ((LAS float*)(c.lds + H_LB))[c.tid] = hg_lb(p, l, 128 * h + c.tid); __syncthreads(); }
struct H1In { u32x4 zq[2], zf[2], zi[2]; };
DI H1In h1_load(const unsigned char* ws, int task, int tid) {
    const int bh = task >> 5, ch = task & 31, b = bh >> 3, h = bh & 7, m0 = b * TSEQ + ch * HC, t0 = tid >> 4, cg = tid & 15, chn = 128 * h + 8 * cg;
    H1In in;
#pragma unroll
    for (int u = 0; u < 2; ++u) { const bf16_t* zr = (const bf16_t*)(ws + WS_Z) + (size_t)(m0 + t0 + 32 * u) * NZ;
        in.zq[u] = *(const u32x4*)(zr + ZC_Q + chn); in.zf[u] = *(const u32x4*)(zr + ZC_F + chn); in.zi[u] = *(const u32x4*)(zr + ZC_I + chn); }
    return in;
}
DI H1In h1_task(PR p, const Ctx& c0, int l, int task, const H1In in, int next_task) {
    Ctx c = c0; { int t_ = c0.tid; asm volatile("" : "+v"(t_)); c.tid = t_; c.lane = t_ & 63; unsigned lb_ = (unsigned)(uintptr_t)c0.lds; asm volatile("" : "+s"(lb_)); c.lds = (LAS unsigned char*)(uintptr_t)lb_; }
    unsigned char* ws = p.ws;
    const int bh = task >> 5, ch = task & 31, b = bh >> 3, h = bh & 7, m0 = b * TSEQ + ch * HC;
    const int tid = c.tid, lane = c.lane, w = c.wave, fr = lane & 15, fq = lane >> 4;
    const bf16_t* Z = (const bf16_t*)(ws + WS_Z);
    LAS bf16_t* QTs = (LAS bf16_t*)(c.lds + H_QT); LAS bf16_t* KTs = (LAS bf16_t*)(c.lds + H_KT); LAS bf16_t* KPs = (LAS bf16_t*)(c.lds + H_KP); LAS bf16_t* Vs = (LAS bf16_t*)(c.lds + H_V);
    LAS float* CS = (LAS float*)(c.lds + H_CS); LAS float* SEG = (LAS float*)(c.lds + H_SEG); LAS bf16_t* SC = (LAS bf16_t*)(c.lds + H_SC); LAS bf16_t* NTS = (LAS bf16_t*)(c.lds + H_NTS);
    const int t0 = tid >> 4, cg = tid & 15, chn = 128 * h + 8 * cg;
    float q[2][8], kf[2][8];
    u32x4 vraw[2];
    {
        const f32x4 lbA = *(const LAS f32x4*)(c.lds + H_LB + 32 * cg), lbB = *(const LAS f32x4*)(c.lds + H_LB + 32 * cg + 16); const float lbv[8] = {lbA.x, lbA.y, lbA.z, lbA.w, lbB.x, lbB.y, lbB.z, lbB.w};
#pragma unroll
        for (int u = 0; u < 2; ++u) { const int t = t0 + 32 * u;
            float zq[8], zf[8]; unpack8(in.zq[u], zq); unpack8(in.zf[u], zf); vraw[u] = in.zi[u];
            float g[8];
#pragma unroll
            for (int j = 0; j < 8; ++j) { const float f = lbv[j] + (1.0f - lbv[j]) * sigm(zf[j]); q[u][j] = zq[j] * sigm(zq[j]); kf[u][j] = 1.0f - f; g[j] = __logf(f); }
            *(LAS f32x4*)(CS + t * HCL + 8 * cg) = (f32x4){g[0], g[1], g[2], g[3]}; *(LAS f32x4*)(CS + t * HCL + 8 * cg + 4) = (f32x4){g[4], g[5], g[6], g[7]}; }
    }
    const H1In nin = h1_load(ws, next_task, tid);
    lds_barrier();
    {   const int j = tid & 127, sg = tid >> 7; float s = 0.f;
#pragma unroll
        for (int i = 0; i < 16; ++i) s += CS[(16 * sg + i) * HCL + j];
        SEG[sg * 128 + j] = s;
        lds_barrier();
        float off = 0.f;
        for (int s2 = 0; s2 < sg; ++s2) off += SEG[s2 * 128 + j];
#pragma unroll
        for (int i = 0; i < 16; ++i) { off += CS[(16 * sg + i) * HCL + j]; CS[(16 * sg + i) * HCL + j] = off; }
    }
    lds_barrier();
    {
        const f32x4 rA = *(const LAS f32x4*)(CS + 31 * HCL + 8 * cg), rB = *(const LAS f32x4*)(CS + 31 * HCL + 8 * cg + 4);
        const f32x4 eA = *(const LAS f32x4*)(CS + 63 * HCL + 8 * cg), eB = *(const LAS f32x4*)(CS + 63 * HCL + 8 * cg + 4);
        const float cr[8] = {rA.x, rA.y, rA.z, rA.w, rB.x, rB.y, rB.z, rB.w}, ce[8] = {eA.x, eA.y, eA.z, eA.w, eB.x, eB.y, eB.z, eB.w};
#pragma unroll
        for (int u = 0; u < 2; ++u) { const int t = t0 + 32 * u;
            const f32x4 cA = *(const LAS f32x4*)(CS + t * HCL + 8 * cg), cB = *(const LAS f32x4*)(CS + t * HCL + 8 * cg + 4);
            const float cs[8] = {cA.x, cA.y, cA.z, cA.w, cB.x, cB.y, cB.z, cB.w};
            float qh[8], qt[8], kt[8], kp[8];
#pragma unroll
            for (int j = 0; j < 8; ++j) { qh[j] = q[u][j] * __expf(cs[j]); qt[j] = q[u][j] * __expf(cs[j] - cr[j]); kt[j] = kf[u][j] * __expf(cr[j] - cs[j]); kp[j] = kf[u][j] * __expf(ce[j] - cs[j]); }
            *(LAS u32x4*)(QTs + t * HL + 8 * cg) = pack8(qt); *(LAS u32x4*)(KTs + t * HL + 8 * cg) = pack8(kt); *(LAS u32x4*)(KPs + t * HL + 8 * cg) = pack8(kp); *(LAS u32x4*)(Vs + t * HL + 8 * cg) = vraw[u];
            *(u32x4*)((bf16_t*)(ws + WS_QH) + (size_t)(m0 + t) * 1024 + chn) = pack8(qh);
            if (t == 63) { float* DC = (float*)(ws + WS_DC) + (size_t)task * 128 + 8 * cg; *(f32x4*)DC = (f32x4){__expf(ce[0]), __expf(ce[1]), __expf(ce[2]), __expf(ce[3])}; *(f32x4*)(DC + 4) = (f32x4){__expf(ce[4]), __expf(ce[5]), __expf(ce[6]), __expf(ce[7])}; } }
    }
    lds_barrier();
    {
        const int p0 = 16 * (w >> 1), prow = p0 + fr;
#pragma unroll
        for (int i = 0; i < 2; ++i) { const int q0 = 16 * (2 * (w & 1) + i), qc = q0 + 4 * fq;
            f32x4 sc = mm16<false, false, 4, HL, HL>(QTs, KTs, p0, q0, lane, F4Z);
#pragma unroll
            for (int rr = 0; rr < 4; ++rr) if (qc + rr > prow) sc[rr] = 0.f;
            st4_bf16(SC + prow * SCL + qc, sc); }
        TrFrag xv[2]; tr_issue2<HL>(xv, Vs, 16 * w, lane);
#pragma unroll
        for (int dp = 0; dp < 4; ++dp) { TrFrag yk[2][2]; tr_issue4<HL>(yk, KPs, 32 * dp, lane);
            if (dp == 0) tr_wait42(yk, xv); else tr_wait4(yk);
            const bf16x8 x0 = tr_get(xv[0]), x1 = tr_get(xv[1]);
            const f32x4 na = mma2(x0, x1, tr_get(yk[0][0]), tr_get(yk[0][1]), F4Z), nb = mma2(x0, x1, tr_get(yk[1][0]), tr_get(yk[1][1]), F4Z);
            st4_bf16(NTS + (16 * w + fr) * HL + 32 * dp + 4 * fq, na); st4_bf16(NTS + (16 * w + fr) * HL + 32 * dp + 16 + 4 * fq, nb); }
    }
    lds_barrier();
    {
        bf16_t* OI = (bf16_t*)(ws + WS_OI);
        TrFrag yv[2]; tr_issue2<HL>(yv, Vs, 16 * w, lane); tr_wait2(yv);
        const bf16x8 y0 = tr_get(yv[0]), y1 = tr_get(yv[1]);
#pragma unroll
        for (int pt = 0; pt < 4; ++pt) { const f32x4 o = mma2(frag_n<SCL>(SC, 16 * pt, 0, lane), frag_n<SCL>(SC, 16 * pt, 32, lane), y0, y1, F4Z);
            *(u32x2*)(OI + (size_t)(m0 + 16 * pt + fr) * 1024 + 128 * h + 16 * w + 4 * fq) = pack4(o[0], o[1], o[2], o[3]); }
        unsigned char* NT = ws + WS_NT + (size_t)task * 16384;
        const int row = tid >> 2, cq = tid & 3;
#pragma unroll
        for (int i = 0; i < 4; ++i) { float f8[8]; unpack8(*(const LAS u32x4*)(NTS + row * HL + 32 * cq + 8 * i), f8);
            u32x2 o8; o8.x = pk4_fp8(8.f * f8[0], 8.f * f8[1], 8.f * f8[2], 8.f * f8[3]); o8.y = pk4_fp8(8.f * f8[4], 8.f * f8[5], 8.f * f8[6], 8.f * f8[7]);
            *(u32x2*)(NT + row * 128 + 32 * cq + 8 * i) = o8; }
    }
    lds_barrier();
    return nin;
}
DI void h2_item(PR p, const Ctx& c, int item) {
    unsigned char* ws = p.ws;
    const int gidx = item * 512 + c.tid, bh = gidx >> 11, e = (gidx >> 4) & 127, dg = gidx & 15;
    unsigned char* NT = ws + WS_NT + (size_t)bh * 32 * 16384 + e * 128 + 8 * dg; const float* DC = (const float*)(ws + WS_DC) + (size_t)bh * 32 * 128 + 8 * dg;
    float s[8];
#pragma unroll
    for (int j = 0; j < 8; ++j) s[j] = 0.f;
    for (int c0 = 0; c0 < 32; c0 += 8) {
        u32x2 nt[8]; f32x4 da[8], db[8];
#pragma unroll
        for (int i = 0; i < 8; ++i) { nt[i] = *(const u32x2*)(NT + (size_t)(c0 + i) * 16384); da[i] = *(const f32x4*)(DC + (c0 + i) * 128); db[i] = *(const f32x4*)(DC + (c0 + i) * 128 + 4); }
#pragma unroll
        for (int i = 0; i < 8; ++i) { u32x2 so; so.x = pk4_fp8(8.f * s[0], 8.f * s[1], 8.f * s[2], 8.f * s[3]); so.y = pk4_fp8(8.f * s[4], 8.f * s[5], 8.f * s[6], 8.f * s[7]);
            *(u32x2*)(NT + (size_t)(c0 + i) * 16384) = so; float nf[8]; { float t4[4]; unpack4_fp8(nt[i].x, t4); nf[0] = 0.125f * t4[0]; nf[1] = 0.125f * t4[1]; nf[2] = 0.125f * t4[2]; nf[3] = 0.125f * t4[3];
                unpack4_fp8(nt[i].y, t4); nf[4] = 0.125f * t4[0]; nf[5] = 0.125f * t4[1]; nf[6] = 0.125f * t4[2]; nf[7] = 0.125f * t4[3]; }
            s[0] = s[0] * da[i].x + nf[0]; s[1] = s[1] * da[i].y + nf[1]; s[2] = s[2] * da[i].z + nf[2]; s[3] = s[3] * da[i].w + nf[3];
            s[4] = s[4] * db[i].x + nf[4]; s[5] = s[5] * db[i].y + nf[5]; s[6] = s[6] * db[i].z + nf[6]; s[7] = s[7] * db[i].w + nf[7]; }
    }
}
DI void h3_wave(const f32x4 (&onw)[8], PR p, int l, int wt, int lane) {
    unsigned char* ws = p.ws;
    const int task = wt >> 1, tp = wt & 1, bh = task >> 5, ch = task & 31, b = bh >> 3, h = bh & 7, m0 = b * TSEQ + ch * 64 + 32 * tp, fr = lane & 15, fq = lane >> 4;
    const unsigned char* ZGp = ws + WS_ZG; const bf16_t* QH = (const bf16_t*)(ws + WS_QH); const bf16_t* OI = (const bf16_t*)(ws + WS_OI); const unsigned char* S = ws + WS_NT + (size_t)task * 16384;
    bf16_t* YHG = (bf16_t*)(ws + WS_YHG);
    bf16x8 qf[2][4]; u32x2 oi[2][8]; unsigned zo[2][8];
#pragma unroll
    for (int u = 0; u < 2; ++u) { const size_t row = (size_t)(m0 + 16 * u + fr);
#pragma unroll
        for (int ks = 0; ks < 4; ++ks) qf[u][ks] = *(const bf16x8*)(QH + row * 1024 + 128 * h + 32 * ks + 8 * fq);
#pragma unroll
        for (int et = 0; et < 8; ++et) { oi[u][et] = *(const u32x2*)(OI + row * 1024 + 128 * h + 16 * et + 4 * fq); zo[u][et] = *(const unsigned*)(ZGp + row * NZG + ZG_O + 128 * h + 16 * et + 4 * fq); } }
    f32x4 o[2][8]; float ssq[2] = {0.f, 0.f};
#pragma unroll
    for (int et = 0; et < 8; ++et) { bf16x8 sa[4];
#pragma unroll
        for (int ks = 0; ks < 4; ++ks) { const u32x2 q8 = *(const u32x2*)(S + (16 * et + fr) * 128 + 32 * ks + 8 * fq); float f8[8], t4[4];
            unpack4_fp8(q8.x, t4); f8[0] = t4[0]; f8[1] = t4[1]; f8[2] = t4[2]; f8[3] = t4[3]; unpack4_fp8(q8.y, t4); f8[4] = t4[0]; f8[5] = t4[1]; f8[6] = t4[2]; f8[7] = t4[3];
            sa[ks] = __builtin_bit_cast(bf16x8, pack8(f8)); }
#pragma unroll
        for (int u = 0; u < 2; ++u) { float f[4]; unpack4(oi[u][et], f); f32x4 acc = {8.f * f[0], 8.f * f[1], 8.f * f[2], 8.f * f[3]};
#pragma unroll
            for (int ks = 0; ks < 4; ++ks) acc = MFMA16(sa[ks], qf[u][ks], acc);
            acc = acc * 0.125f; o[u][et] = acc; ssq[u] += (acc[0] * acc[0] + acc[1] * acc[1]) + (acc[2] * acc[2] + acc[3] * acc[3]); } }
#pragma unroll
    for (int u = 0; u < 2; ++u) { float sq = ssq[u]; sq += __shfl_xor(sq, 16); sq += __shfl_xor(sq, 32);
        const float rstd = rsqrtf(sq * (1.0f / 128.0f) + NORM_EPS); const size_t row = (size_t)(m0 + 16 * u + fr);
#pragma unroll
        for (int et = 0; et < 8; ++et) { float g[4]; unpack4_fp8(zo[u][et], g);
            *(u32x2*)(YHG + row * 1024 + 128 * h + 16 * et + 4 * fq) = pack4(o[u][et][0] * rstd * onw[et].x * sigm(g[0]), o[u][et][1] * rstd * onw[et].y * sigm(g[1]), o[u][et][2] * rstd * onw[et].z * sigm(g[2]), o[u][et][3] * rstd * onw[et].w * sigm(g[3])); } }
}
struct R2Regs { bf16x8 ma[4][2]; u32x4 nv[2]; };
DI void r2_load(R2Regs& r, const bf16_t* mt, const bf16_t* nn, int et, int fr, int fq) {
#pragma unroll
    for (int n = 0; n < 4; ++n)
#pragma unroll
        for (int ks = 0; ks < 2; ++ks) r.ma[n][ks] = *(const bf16x8*)(mt + (16 * n + fr) * 64 + 32 * ks + 8 * fq);
    r.nv[0] = *(const u32x4*)(nn + (16 * et + fr) * 64 + 16 * fq); r.nv[1] = *(const u32x4*)(nn + (16 * et + fr) * 64 + 16 * fq + 8);
}
DI void r2_step(const R2Regs& r, f32x4 (&S)[4], bf16_t* ss, int et, int fr, int fq) {
    { float f[8] = {S[0][0], S[0][1], S[0][2], S[0][3], S[1][0], S[1][1], S[1][2], S[1][3]}, g[8] = {S[2][0], S[2][1], S[2][2], S[2][3], S[3][0], S[3][1], S[3][2], S[3][3]};
      *(u32x4*)(ss + (16 * et + fr) * 64 + 16 * fq) = pack8(f); *(u32x4*)(ss + (16 * et + fr) * 64 + 16 * fq + 8) = pack8(g); }
    bf16x8 sb[2];
#pragma unroll
    for (int ks = 0; ks < 2; ++ks) { u32x4 sp; sp.x = cvt_pk(S[2 * ks][0], S[2 * ks][1]); sp.y = cvt_pk(S[2 * ks][2], S[2 * ks][3]); sp.z = cvt_pk(S[2 * ks + 1][0], S[2 * ks + 1][1]); sp.w = cvt_pk(S[2 * ks + 1][2], S[2 * ks + 1][3]);
        sb[ks] = __builtin_bit_cast(bf16x8, sp); }
    float nf[16]; { float a[8], b[8]; unpack8(r.nv[0], a); unpack8(r.nv[1], b);
#pragma unroll
        for (int j = 0; j < 8; ++j) { nf[j] = a[j]; nf[8 + j] = b[j]; } }
#pragma unroll
    for (int n = 0; n < 4; ++n) { f32x4 acc = {nf[4 * n], nf[4 * n + 1], nf[4 * n + 2], nf[4 * n + 3]};
        acc = MFMA16(r.ma[n][0], sb[0], acc); acc = MFMA16(r.ma[n][1], sb[1], acc); S[n] = acc; }
}
DI void r2_task(PR p, const Ctx& c, int item) {
    unsigned char* ws = p.ws;
    const int lane = c.lane, w = c.wave, fr = lane & 15, fq = lane >> 4, bh = 2 * item + (w >> 2), et = w & 3;
    const bf16_t* MT = (const bf16_t*)(ws + WS_MT) + (size_t)bh * 32 * 4096; const bf16_t* NN = (const bf16_t*)(ws + WS_NN) + (size_t)bh * 32 * 4096;
    bf16_t* SS = (bf16_t*)(ws + WS_SS) + (size_t)bh * 32 * 4096;
    f32x4 S[4] = {F4Z, F4Z, F4Z, F4Z};
    R2Regs ra, rb;
    r2_load(ra, MT, NN, et, fr, fq);
    for (int ch = 0; ch < 32; ch += 2) {
        r2_load(rb, MT + (size_t)(ch + 1) * 4096, NN + (size_t)(ch + 1) * 4096, et, fr, fq);
        r2_step(ra, S, SS + (size_t)ch * 4096, et, fr, fq);
        { const int c2 = ch + 2 < 32 ? ch + 2 : 31; r2_load(ra, MT + (size_t)c2 * 4096, NN + (size_t)c2 * 4096, et, fr, fq); }
        r2_step(rb, S, SS + (size_t)(ch + 1) * 4096, et, fr, fq);
    }
}
constexpr int R3L_MU = 0, R3L_LN = 640, R3L_GUP = 1152;
DI void r3_fill_lds(PR p, const Ctx& c, int l, int h) {
    __syncthreads();
    LAS float* MUG = (LAS float*)(c.lds + R3L_MU);
    if (c.tid < 160) MUG[c.tid] = p.in[I_MU][(size_t)l * 3360 + 3200 + c.tid];
    if (c.tid >= 256 && c.tid < 384) { const int i = c.tid - 256; ((LAS float*)(c.lds + R3L_LN))[i] = i < 64 ? p.in[I_LNW][l * 1024 + 64 * h + i] : p.in[I_LNB][l * 1024 + 64 * h + i - 64]; }
    const bf16_t* GUPT = (const bf16_t*)(p.ws + WS_LORA + LO_GUP) + (size_t)(64 * h) * 160;
    for (int i = c.tid; i < 1280; i += 512) { const int et = i / 320, ks = (i >> 6) % 5, ln = i & 63; *(LAS bf16x8*)(c.lds + R3L_GUP + i * 16) = gfrag(GUPT, 160, 16 * et, 32 * ks, ln); }
    __syncthreads();
}
struct R3In { u32x4 cur[5], prv[5]; bf16x8 rp0, rp1, ss[8]; float rk; };
DI R3In r3_load(PR p, int l, int wt, int lane) {
    unsigned char* ws = p.ws; R3In in;
    const int task = wt >> 2, pt = wt & 3, bh = task >> 5, ch = task & 31, b = bh >> 4, h = bh & 15, tok0 = ch * 64 + 16 * pt, m0 = b * TSEQ + tok0, fr = lane & 15, fq = lane >> 4;
    const size_t blk = (size_t)task * 4096, m = (size_t)(m0 + fr);
    const bf16_t* SS = (const bf16_t*)(ws + WS_SS) + blk; const bf16_t* RP = (const bf16_t*)(ws + WS_RP) + blk;
    const bf16_t* zr = (const bf16_t*)(ws + WS_Z) + m * NZ + ZC_GD; const bf16_t* zp = (tok0 + fr) > 0 ? zr - NZ : zr;
#pragma unroll
    for (int ks = 0; ks < 5; ++ks) { in.cur[ks] = *(const u32x4*)(zr + 32 * ks + 8 * fq); in.prv[ks] = *(const u32x4*)(zp + 32 * ks + 8 * fq); }
    in.rp0 = gfrag(RP, 64, 16 * pt, 0, lane); in.rp1 = gfrag(RP, 64, 16 * pt, 32, lane);
    in.rk = ((const float*)(ws + WS_RK))[m * 16 + h];
#pragma unroll
    for (int et = 0; et < 4; ++et) { in.ss[2 * et] = gfrag(SS, 64, 16 * et, 0, lane); in.ss[2 * et + 1] = gfrag(SS, 64, 16 * et, 32, lane); }
    return in;
}
DI void r3_compute(const R3In in, PR p, int l, int wt, int lane, LAS unsigned char* lds) {
    unsigned char* ws = p.ws;
    const int task = wt >> 2, pt = wt & 3, bh = task >> 5, ch = task & 31, b = bh >> 4, h = bh & 15, tok0 = ch * 64 + 16 * pt, m0 = b * TSEQ + tok0, fr = lane & 15, fq = lane >> 4;
    const size_t m = (size_t)(m0 + fr);
    unsigned lb = (unsigned)(uintptr_t)lds; asm volatile("" : "+v"(lb));
    const LAS float* mul = (const LAS float*)(uintptr_t)(lb + R3L_MU + 32u * (unsigned)fq); const LAS unsigned char* gl = (const LAS unsigned char*)(uintptr_t)(lb + R3L_GUP + 16u * (unsigned)lane); const LAS float* lnl = (const LAS float*)(uintptr_t)(lb + R3L_LN + 16u * (unsigned)fq);
    const bf16_t* Y0 = (const bf16_t*)(ws + WS_Y0) + (size_t)task * 4096; const bf16_t* vsrc = (const bf16_t*)(ws + (l == 0 ? WS_VFIRST : WS_VF));
    u32x2 vraw[4], y0raw[4];
#pragma unroll
    for (int et = 0; et < 4; ++et) { vraw[et] = *(const u32x2*)(vsrc + m * 1024 + 64 * h + 16 * et + 4 * fq); y0raw[et] = *(const u32x2*)(Y0 + (16 * pt + fr) * 64 + 16 * et + 4 * fq); }
    const bool has_prev = (tok0 + fr) > 0;
    f32x4 y[4], g[4]; float s1 = 0.f, s2 = 0.f;
#pragma unroll
    for (int et = 0; et < 4; ++et) { f32x4 acc = F4Z;
        acc = MFMA16(in.ss[2 * et], in.rp0, acc); acc = MFMA16(in.ss[2 * et + 1], in.rp1, acc);
        y[et] = acc; g[et] = F4Z; }
#pragma unroll
    for (int ks = 0; ks < 5; ++ks) { float cur[8], prv[8]; unpack8(in.cur[ks], cur);
        if (has_prev) unpack8(in.prv[ks], prv); else {
#pragma unroll
            for (int j = 0; j < 8; ++j) prv[j] = 0.f; }
        const f32x4 mA = *(const LAS f32x4*)(mul + 32 * ks), mB = *(const LAS f32x4*)(mul + 32 * ks + 4); const float mm[8] = {mA.x, mA.y, mA.z, mA.w, mB.x, mB.y, mB.z, mB.w};
#pragma unroll
        for (int j = 0; j < 8; ++j) cur[j] = sigm(cur[j] + mm[j] * (prv[j] - cur[j]));
        const bf16x8 sgk = __builtin_bit_cast(bf16x8, pack8(cur));
#pragma unroll
        for (int et = 0; et < 4; ++et) g[et] = MFMA16(*(const LAS bf16x8*)(gl + (et * 5 + ks) * 1024), sgk, g[et]); }
#pragma unroll
    for (int et = 0; et < 4; ++et) { float f[4]; unpack4(y0raw[et], f); f32x4 acc = y[et] + (f32x4){f[0], f[1], f[2], f[3]};
        y[et] = acc; s1 += (acc[0] + acc[1]) + (acc[2] + acc[3]); s2 += (acc[0] * acc[0] + acc[1] * acc[1]) + (acc[2] * acc[2] + acc[3] * acc[3]);
    }
    s1 += __shfl_xor(s1, 16); s1 += __shfl_xor(s1, 32); s2 += __shfl_xor(s2, 16); s2 += __shfl_xor(s2, 32);
    const float mean = s1 * (1.0f / 64.0f), var = fmaxf(s2 * (1.0f / 64.0f) - mean * mean, 0.f), rstd = rsqrtf(var + RW_GN_EPS);
    bf16_t* YRW = (bf16_t*)(ws + WS_YRW);
#pragma unroll
    for (int et = 0; et < 4; ++et) { const int col = 64 * h + 16 * et + 4 * fq;
        float vv[4]; unpack4(vraw[et], vv); const f32x4 lw = *(const LAS f32x4*)(lnl + 16 * et), lb2 = *(const LAS f32x4*)(lnl + 64 + 16 * et);
        float o[4];
#pragma unroll
        for (int r = 0; r < 4; ++r) o[r] = ((y[et][r] - mean) * rstd * lw[r] + lb2[r] + in.rk * vv[r]) * g[et][r];
        *(u32x2*)(YRW + m * 1024 + col) = pack4(o[0], o[1], o[2], o[3]); }
}
constexpr int P7L = 264;
constexpr int P7_HI = 0, P7_LO = 64 * P7L * 2, P7_LG = 2 * P7_LO, P7_RS = P7_LG + 2 * 64 * 48 * 4, P7_HIST = P7_RS + 256;
DI void p7_route(PR p, const Ctx& c, int l) {
    unsigned char* ws = p.ws;
    const int lane = c.lane, w = c.wave, fr = lane & 15, fq = lane >> 4;
    const bf16_t* HB = (const bf16_t*)(ws + WS_HB);
    const float* nw = p.in[I_NFFN] + (size_t)l * D; const bf16_t* WRH = (const bf16_t*)(ws + WS_LORA + LO_WR); const bf16_t* WRL = (const bf16_t*)(ws + WS_LORA + LO_WRL);
    const float* bg = p.in[I_RGB] + l * 4; const float* be = p.in[I_REB] + l * 32;
    int* TOKE = (int*)(ws + WS_TOKE); float* TOKW = (float*)(ws + WS_TOKW); int* CNT = (int*)(ws + WS_CNT); float* TRSTD = (float*)(ws + WS_TRSTD);
    LAS bf16_t* HI = (LAS bf16_t*)(c.lds + P7_HI); LAS bf16_t* LO = (LAS bf16_t*)(c.lds + P7_LO); LAS float* LG = (LAS float*)(c.lds + P7_LG); LAS float* RS = (LAS float*)(c.lds + P7_RS); LAS int* hist = (LAS int*)(c.lds + P7_HIST);
    for (int tile = c.bid; tile < M / 64; tile += c.G) {
        if (c.tid < 32) hist[c.tid] = 0;
        const int tt = w & 3, kh = w >> 2, mb = tile * 64 + 8 * w;
        f32x4 acc[3] = {F4Z, F4Z, F4Z}; float ss[8];
#pragma unroll
        for (int i = 0; i < 8; ++i) ss[i] = 0.f;
        for (int kc = 0; kc < 8; ++kc) {
            const f32x4 ww = *(const f32x4*)(nw + 256 * kc + 4 * lane);
            f32x4 hv[8];
#pragma unroll
            for (int i = 0; i < 8; ++i) { float t4[4]; unpack4(*(const u32x2*)(HB + (size_t)(mb + i) * D + 256 * kc + 4 * lane), t4); hv[i] = (f32x4){t4[0], t4[1], t4[2], t4[3]}; }
            bf16x8 wh[4][3], wl[4][3];
#pragma unroll
            for (int k4 = 0; k4 < 4; ++k4)
#pragma unroll
                for (int ct = 0; ct < 3; ++ct) { const int kg = 256 * kc + 32 * (4 * kh + k4); wh[k4][ct] = gfrag(WRH, D, 16 * ct, kg, lane); wl[k4][ct] = gfrag(WRL, D, 16 * ct, kg, lane); }
#pragma unroll
            for (int i = 0; i < 8; ++i) { ss[i] += (hv[i].x * hv[i].x + hv[i].y * hv[i].y) + (hv[i].z * hv[i].z + hv[i].w * hv[i].w);
                const f32x4 x = hv[i] * ww; const u32x2 hp = pack4(x.x, x.y, x.z, x.w); float hf[4]; unpack4(hp, hf);
                *(unsigned*)(ws + WS_XN8 + (size_t)(mb + i) * D + 256 * kc + 4 * lane) = pk4_fp8(x.x, x.y, x.z, x.w);
                *(LAS u32x2*)(HI + (8 * w + i) * P7L + 4 * lane) = hp; *(LAS u32x2*)(LO + (8 * w + i) * P7L + 4 * lane) = pack4(x.x - hf[0], x.y - hf[1], x.z - hf[2], x.w - hf[3]); }
            lds_barrier();
#pragma unroll
            for (int k4 = 0; k4 < 4; ++k4) { const int ks = 4 * kh + k4;
                const bf16x8 xh = frag_n<P7L>(HI, 16 * tt, 32 * ks, lane), xl = frag_n<P7L>(LO, 16 * tt, 32 * ks, lane);
#pragma unroll
                for (int ct = 0; ct < 3; ++ct) { acc[ct] = MFMA16(wh[k4][ct], xh, acc[ct]); acc[ct] = MFMA16(wh[k4][ct], xl, acc[ct]); acc[ct] = MFMA16(wl[k4][ct], xh, acc[ct]); } }
            lds_barrier();
        }
#pragma unroll
        for (int i = 0; i < 8; ++i) { const float r = rsqrtf(wave_sum(ss[i]) * (1.f / D) + NORM_EPS); if (lane == i) { RS[8 * w + i] = r; TRSTD[mb + i] = r; } }
#pragma unroll
        for (int ct = 0; ct < 3; ++ct) *(LAS f32x4*)(LG + (kh * 64 + 16 * tt + fr) * 48 + 16 * ct + 4 * fq) = acc[ct];
        __syncthreads();
        if (c.tid < 64) { const int t = c.tid, m = tile * 64 + t; const float rstd = RS[t];
            const LAS float* l0 = LG + t * 48; const LAS float* l1 = LG + (64 + t) * 48;
            float gl[4]; int gs = 0;
#pragma unroll
            for (int i = 0; i < 4; ++i) gl[i] = (l0[i] + l1[i]) * rstd + bg[i];
#pragma unroll
            for (int i = 1; i < 4; ++i) if (gl[i] > gl[gs]) gs = i;
            float den = 0.f;
#pragma unroll
            for (int i = 0; i < 4; ++i) den += __expf(gl[i] - gl[gs]);
            const float pg = 1.0f / den;
            float el[8]; int i1 = 0, i2 = -1;
#pragma unroll
            for (int i = 0; i < 8; ++i) el[i] = (l0[4 + 8 * gs + i] + l1[4 + 8 * gs + i]) * rstd + be[8 * gs + i];
#pragma unroll
            for (int i = 1; i < 8; ++i) if (el[i] > el[i1]) i1 = i;
#pragma unroll
            for (int i = 0; i < 8; ++i) if (i != i1 && (i2 < 0 || el[i] > el[i2])) i2 = i;
            const float e2 = __expf(el[i2] - el[i1]), w1 = pg / (1.0f + e2), w2 = pg * e2 / (1.0f + e2);
            TOKE[2 * m] = 8 * gs + i1; TOKE[2 * m + 1] = 8 * gs + i2; TOKW[2 * m] = w1; TOKW[2 * m + 1] = w2;
            atomicAdd((int*)&hist[8 * gs + i1], 1); atomicAdd((int*)&hist[8 * gs + i2], 1); }
        __syncthreads();
        if (c.tid < 32) CNT[tile * 32 + c.tid] = hist[c.tid];
        __syncthreads();
    }
}
DI void moe_tables(PR p, const Ctx& c) {
    const int* CNT = (const int*)(p.ws + WS_CNT);
    LAS int* LC = (LAS int*)(c.lds + LDS_CTL_OFF);
    LAS int* part = (LAS int*)(c.lds + 72000);
    { const int e = c.tid & 31, pr = c.tid >> 5; int v[16];
#pragma unroll
      for (int i = 0; i < 16; ++i) v[i] = CNT[(pr + 16 * i) * 32 + e];
      int s = 0;
#pragma unroll
      for (int i = 0; i < 16; ++i) s += v[i];
      part[pr * 32 + e] = s; }
    __syncthreads();
    if (c.tid < 32) { int s = 0;
#pragma unroll 1
        for (int pr = 0; pr < 16; ++pr) s += part[pr * 32 + c.tid];
        LC[LC_TOT + c.tid] = s; }
    __syncthreads();
    if (c.tid < 64) {
        const int e = c.tid & 31; const int nt = (LC[LC_TOT + e] + 255) >> 8; int inc = nt;
#pragma unroll
        for (int o = 1; o < 32; o <<= 1) { const int v = __shfl_up(inc, o, 32); if ((c.tid & 31) >= o) inc += v; }
        if (c.tid < 32) { LC[LC_PAD + e] = (inc - nt) << 8; if (e == 31) LC[LC_PAD + 32] = inc << 8; }
    }
    __syncthreads();
    if (c.tid < 160) { int e = 0;
#pragma unroll 1
        for (int i = 0; i < 32; ++i) if ((LC[LC_PAD + i] >> 8) <= c.tid) e = i;
        LC[LC_TILE + c.tid] = e; }
    __syncthreads();
}
DI void p8_dispatch(PR p, const Ctx& c) {
    unsigned char* ws = p.ws;
    const int* CNT = (const int*)(ws + WS_CNT); const int* TOKE = (const int*)(ws + WS_TOKE); int* TOKS = (int*)(ws + WS_TOKS);
    const bf16_t* HN = (const bf16_t*)(ws + WS_XN); bf16_t* XS = (bf16_t*)(ws + WS_XS);
    LAS int* LC = (LAS int*)(c.lds + LDS_CTL_OFF);
    LAS int* base = (LAS int*)(c.lds + 76000); LAS int* part = (LAS int*)(c.lds + 72000); LAS int* eids = (LAS int*)(c.lds + 77000); LAS int* slots = (LAS int*)(c.lds + 78000);
    for (int tile = c.bid; tile < M / 64; tile += c.G) {
        { const int e = c.tid & 31, pr = c.tid >> 5; int v[16];
#pragma unroll
          for (int i = 0; i < 16; ++i) { const int tl = pr + 16 * i; v[i] = CNT[(tl < tile ? tl : 0) * 32 + e]; }
          int s = 0;
#pragma unroll
          for (int i = 0; i < 16; ++i) s += (pr + 16 * i < tile) ? v[i] : 0;
          part[pr * 32 + e] = s; }
        if (c.tid < 128) eids[c.tid] = TOKE[tile * 128 + c.tid];
        __syncthreads();
        if (c.tid < 32) { int s = 0; for (int pr = 0; pr < 16; ++pr) s += part[pr * 32 + c.tid]; base[c.tid] = s; }
        __syncthreads();
        if (c.tid < 128) { const int e = eids[c.tid]; int lp = 0; for (int i = 0; i < c.tid; ++i) lp += (eids[i] == e) ? 1 : 0;
            const int s = LC[LC_PAD + e] + base[e] + lp; slots[c.tid] = s; TOKS[tile * 128 + c.tid] = s; ((int*)(ws + WS_CTL + CTL_SLOTTOK))[s] = tile * 64 + (c.tid >> 1); ((float*)(ws + WS_SRSTD))[s] = ((const float*)(ws + WS_TRSTD))[tile * 64 + (c.tid >> 1)]; }
        __syncthreads();
        __syncthreads();
    }
}
DI void p11_combine(PR p, const Ctx& c, int l) {
    unsigned char* ws = p.ws;
    const int lane = c.lane; const int gw = c.bid * 8 + c.wave, NGW = c.G * 8;
    float* H = p.out; const bf16_t* HB = (const bf16_t*)(ws + WS_HB); const unsigned char* YS = ws + WS_YS; const int* TOKS = (const int*)(ws + WS_TOKS); const float* TOKW = (const float*)(ws + WS_TOKW);
    bf16_t* XN = (bf16_t*)(ws + WS_XN);
    const float* nw = (l == 0) ? p.in[I_NMIX] + D : p.in[I_FNW];
    f32x4 ww[8];
#pragma unroll
    for (int j = 0; j < 8; ++j) ww[j] = ((const f32x4*)nw)[lane + 64 * j];
    if (gw >= M) return;
    int s0 = TOKS[2 * gw], s1 = TOKS[2 * gw + 1]; float w0 = TOKW[2 * gw], w1 = TOKW[2 * gw + 1];
    for (int m = gw; m < M; m += NGW) {
        f32x4* hr = (f32x4*)(H + (size_t)m * D) + lane; const unsigned* y0 = (const unsigned*)(YS + (size_t)s0 * D) + lane; const unsigned* y1 = (const unsigned*)(YS + (size_t)s1 * D) + lane;
        const u32x2* hb = (const u32x2*)(HB + (size_t)m * D) + lane;
        f32x4 hv[8]; u32x2 hq[8]; unsigned ya[8], yb[8];
#pragma unroll
        for (int j = 0; j < 8; ++j) { hq[j] = hb[64 * j]; ya[j] = y0[64 * j]; yb[j] = y1[64 * j]; }
#pragma unroll
        for (int j = 0; j < 8; ++j) { float t4[4]; unpack4(hq[j], t4); hv[j] = (f32x4){t4[0], t4[1], t4[2], t4[3]}; }
        const float cw0 = w0 * 0.0625f, cw1 = w1 * 0.0625f;
        { const int mn = (m + NGW < M) ? m + NGW : m; s0 = TOKS[2 * mn]; s1 = TOKS[2 * mn + 1]; w0 = TOKW[2 * mn]; w1 = TOKW[2 * mn + 1]; }
        float s = 0.f;
#pragma unroll
        for (int j = 0; j < 8; ++j) { float a[4], b[4]; unpack4_fp8(ya[j], a); unpack4_fp8(yb[j], b);
            hv[j].x += cw0 * a[0] + cw1 * b[0]; hv[j].y += cw0 * a[1] + cw1 * b[1]; hv[j].z += cw0 * a[2] + cw1 * b[2]; hv[j].w += cw0 * a[3] + cw1 * b[3];
            s += (hv[j].x * hv[j].x + hv[j].y * hv[j].y) + (hv[j].z * hv[j].z + hv[j].w * hv[j].w); }
        const float rstd = rsqrtf(wave_sum(s) * (1.f / D) + NORM_EPS);
#pragma unroll
        for (int j = 0; j < 8; ++j) {
            if (l == 0) { ((u32x2*)(ws + WS_HB2 + (size_t)m * D * 2))[lane + 64 * j] = pack4(hv[j].x, hv[j].y, hv[j].z, hv[j].w); const float a = hv[j].x * rstd * ww[j].x, b = hv[j].y * rstd * ww[j].y, c2 = hv[j].z * rstd * ww[j].z, d = hv[j].w * rstd * ww[j].w;
                ((u32x2*)(XN + (size_t)m * D))[lane + 64 * j] = pack4(a, b, c2, d); ((unsigned*)(ws + WS_XN8 + (size_t)m * D))[lane + 64 * j] = pk4_fp8(a, b, c2, d); }
            else hr[64 * j] = hv[j] * rstd * ww[j]; }
    }
}
#ifndef DBG_CUT
#define DBG_CUT 1000
#endif
constexpr int NPHASE = 23;
#ifndef WGM_P1
#define WGM_P1 4
#endif
#ifndef WGM_P56
#define WGM_P56 2
#endif
#ifndef REP_R1
#define REP_R1 1
#endif
#ifndef REP_H1
#define REP_H1 1
#endif
#ifndef REP_R2
#define REP_R2 1
#endif
#ifndef REP_H3
#define REP_H3 1
#endif
#ifndef REP_R3
#define REP_R3 1
#endif
#ifndef PH_MASK
#define PH_MASK 0xFFFF
#endif
#define PH_EN(n) ((PH_MASK >> (n)) & 1)
__global__ void __launch_bounds__(512, 2) mk_fwd(Params p_byval) {
    const CAS Params* pp = (const CAS Params*)__builtin_amdgcn_kernarg_segment_ptr();
#define p (*pp)
    extern __shared__ __attribute__((aligned(16))) unsigned char lds_raw[];
    Ctx c; unsigned char* ws;
#define FRESH() do { int t_ = threadIdx.x; asm volatile("" : "+v"(t_)); int b_ = blockIdx.x; asm volatile("" : "+s"(b_)); unsigned lb_ = (unsigned)(uintptr_t)(LAS unsigned char*)lds_raw; asm volatile("" : "+s"(lb_)); c.lds = (LAS unsigned char*)(uintptr_t)lb_; c.tid = t_; c.lane = t_ & 63; \
        c.wave = __builtin_amdgcn_readfirstlane(t_ >> 6); c.G = gridDim.x; c.bid = b_; pp = (const CAS Params*)__builtin_amdgcn_kernarg_segment_ptr(); asm volatile("" : "+s"(pp)); ws = p.ws; asm volatile("" : "+s"(ws)); glds = (LAS unsigned char*)c.lds; } while (0)
    LAS unsigned char* glds;
    FRESH();
    LAS unsigned* LCU = (LAS unsigned*)(c.lds + LDS_CTL_OFF);
    if (c.tid < 4) LCU[c.tid] = 0u;
    __syncthreads();
#if MK_ONE_LAUNCH
    XcdBarrier bar = xcd_barrier_post((unsigned*)(ws + WS_CTL) + CW_BAR, (volatile LAS unsigned*)LCU);
#define GRID_BAR() xcd_barrier(bar)
#else
#define GRID_BAR() do { } while (0)
#endif
    const int lo = p.ph_lo, hi_raw = p.ph_hi; int hi = hi_raw & 0xffff; const int dbgflag = hi_raw >> 16; (void)dbgflag;
#define IN(k) (lo <= (k) && (k) < hi)
#define SEAM(k) do { if (IN(k) && IN((k) + 1)) GRID_BAR(); } while (0)
    if (PH_EN(0) && IN(0)) { FRESH();
        convert_small(p, c, 0, 0);
        const int gw = c.bid * 8 + c.wave, NGW = c.G * 8;
        f32x4 nw0[8];
#pragma unroll
        for (int j = 0; j < 8; ++j) nw0[j] = ((const f32x4*)p.in[I_NMIX])[c.lane + 64 * j];
        for (int m = gw; m < M; m += NGW) rms_row_bf16(p.in[I_X] + (size_t)m * D, nw0, (bf16_t*)(ws + WS_XN) + (size_t)m * D, ws + WS_XN8 + (size_t)m * D, c.lane, (bf16_t*)(ws + WS_HB2) + (size_t)m * D);
    }
    SEAM(0);
#ifdef EXTRA_BARS
    for (int eb = 0; eb < EXTRA_BARS; ++eb) GRID_BAR();
#endif
    for (int l = 0; l < 2; ++l) {
        const int pb = 1 + 11 * l;
        if (PH_EN(1) && IN(pb + 0)) { FRESH();
            {
                pg8::Gemm g8{(const bf16_t*)(ws + WS_XN8), (const bf16_t*)(ws + WS_WG8), M, NZG, D / 2}; pg8::StaticOrder S8; S8.init(M, NZG, c.G, c.bid, WGM_P1);
                pg8::EpiF8P E8{ws + WS_ZG, NZG, dbgflag};
                pg8::gemm_phase<pg8::EpiF8P, pg8::StaticOrder, false, false, true>(glds, g8, S8, E8, nullptr); }
            pg8::Gemm g{(const bf16_t*)(ws + WS_XN), (const bf16_t*)(ws + WS_WIN), M, NZ, D}; pg8::StaticOrder S; S.init(M, NZ, c.G, c.bid, WGM_P1);
            if (dbgflag == 3) { S.nM = 1; S.nN = 1; S.hot = 1; }
            pg8::EpiBf16P E{(bf16_t*)(ws + WS_Z), NZ, dbgflag == 3 ? 1 : dbgflag};
            pg8::gemm_phase<pg8::EpiBf16P, pg8::StaticOrder>(glds, g, S, E, nullptr);
            const int nunits = (M / 256) * (NZ / 256), rem = nunits % c.G;
            if (rem != 0 && c.bid >= rem && EXP_EARLY > 0) { __syncthreads(); FRESH(); convert_experts_early(p, c, l, rem, c.G - rem); }
        }
        SEAM(pb + 0);
        if (PH_EN(2) && IN(pb + 1)) { FRESH();
            if (c.bid < 4096) { int bh_c = -1; R1In rin = r1_load(ws, r1_perm(c.bid), c.tid);
              for (int it = c.bid; it < 4096; it += c.G) { const int task = r1_perm(it), bh = task >> 5;
                if (bh != bh_c) { r1_fill_params(p, c, l, bh & 15); bh_c = bh; }
                rin = r1_task<0>(p, c, l, task, rin, it + c.G < 4096 ? r1_perm(it + c.G) : task); } }
#ifdef PROF_R1
            if (c.bid < 4096) { R1In rin = r1_load(ws, r1_perm(c.bid), c.tid);
              for (int it = c.bid; it < 4096; it += c.G) { const int task = r1_perm(it); rin = r1_task<PROF_R1>(p, c, l, task, rin, it + c.G < 4096 ? r1_perm(it + c.G) : task); } }
#endif
            if (c.bid < 2048) { H1In hin = h1_load(ws, c.bid, c.tid); int hlc = -1;
              for (int it = c.bid; it < 2048; it += c.G) { const int hh = (it >> 5) & 7; if (hh != hlc) { h1_fill_lb(p, c, l, hh); hlc = hh; }
                hin = h1_task(p, c, l, it, hin, it + c.G < 2048 ? it + c.G : it); } }
        }
        SEAM(pb + 1);
        if (PH_EN(3) && IN(pb + 2)) { FRESH();
            if (c.G >= 128) { if (c.bid < 64) { for (int rep = 0; rep < REP_R2; ++rep) r2_task(p, c, c.bid); } else { for (int it = c.bid - 64; it < 256; it += c.G - 64) h2_item(p, c, it);
                __syncthreads(); FRESH();
                if (l == 0) { run_titems<false>(p, c, 1, 0, SMALL_WIN_ITEMS, 64, c.G - 64); const int nunits = (M / 256) * (NZ / 256); if ((nunits % c.G) != 0) run_titems<true>(p, c, 0, EXP_EARLY, EXP_EARLY + PB0_EXP, 64, c.G - 64); }
                else { const int nunits = (M / 256) * (NZ / 256); run_titems<true>(p, c, l, (nunits % c.G) != 0 ? EXP_EARLY : 0, EXP_ITEMS, 64, c.G - 64); } } }
            else { for (int it = c.bid; it < 64; it += c.G) r2_task(p, c, it); for (int it = c.bid; it < 256; it += c.G) h2_item(p, c, it); }
        }
        SEAM(pb + 2);
        if (PH_EN(4) && IN(pb + 3)) { FRESH();
            { const int gw = c.bid * 8 + c.wave, NGW = c.G * 8;
              { f32x4 onw[8];
#pragma unroll
                for (int et = 0; et < 8; ++et) onw[et] = *(const f32x4*)(p.in[I_ONORM] + l * 128 + 16 * et + 4 * (c.lane >> 4));
                for (int wt = gw; wt < 4096; wt += NGW) h3_wave(onw, p, l, wt, c.lane); }
              { int h3c = -1;
                R3In rin = r3_load(p, l, gw, c.lane);
#pragma unroll 1
                for (int wt = gw; wt < 16384; wt += NGW) { const int h3 = (wt >> 7) & 15; if (h3 != h3c) { r3_fill_lds(p, c, l, h3); h3c = h3; }
                    const R3In nx = r3_load(p, l, wt + NGW < 16384 ? wt + NGW : wt, c.lane); r3_compute(rin, p, l, wt, c.lane, c.lds); rin = nx; } } }
        }
        SEAM(pb + 3);
        if (PH_EN(5) && IN(pb + 4)) { FRESH();
            pg8::StaticOrder S; S.init(M, D, c.G, c.bid, WGM_P56);
#ifndef DBG_NO_HG
            { pg8::Gemm g{(const bf16_t*)(ws + WS_YHG), (const bf16_t*)(ws + WS_WBH), M, D, 1024};
              pg8::EpiGate E{(bf16_t*)(ws + WS_XN), D, (const unsigned char*)(ws + WS_ZG), NZG, 0, dbgflag};
              pg8::gemm_phase<pg8::EpiGate, pg8::StaticOrder>(glds, g, S, E, nullptr); }
#endif
#ifndef DBG_NO_RW
            { pg8::Gemm g{(const bf16_t*)(ws + WS_YRW), (const bf16_t*)(ws + WS_WBR), M, D, 1024};
#ifdef DBG_NO_HG
              pg8::EpiGate E{(bf16_t*)(ws + WS_XN), D, (const unsigned char*)(ws + WS_ZG) + 2048, NZG, 0, dbgflag};
#else
              pg8::EpiGate E{(bf16_t*)(ws + WS_XN), D, (const unsigned char*)(ws + WS_ZG) + 2048, NZG, 1, dbgflag};
#endif
              pg8::gemm_phase<pg8::EpiGate, pg8::StaticOrder>(glds, g, S, E, nullptr); }
#endif
        }
        SEAM(pb + 4);
        if (PH_EN(6) && IN(pb + 5)) { FRESH();
            pg8::Gemm g{(const bf16_t*)(ws + WS_XN), (const bf16_t*)(ws + WS_WO), M, D, D}; pg8::StaticOrder S; S.init(M, D, c.G, c.bid, WGM_P56);
            pg8::EpiResB E{(const bf16_t*)(ws + WS_HB2), (bf16_t*)(ws + WS_HB), D, dbgflag};
            pg8::gemm_phase<pg8::EpiResB, pg8::StaticOrder>(glds, g, S, E, nullptr);
        }
        SEAM(pb + 5);
        if (PH_EN(7) && IN(pb + 6)) { FRESH();
            if (!(l == 1 && c.G >= 128)) { const int nunits = (M / 256) * (NZ / 256); convert_experts(p, c, l, (nunits % c.G) != 0 ? EXP_EARLY + (c.G >= 128 ? PB0_EXP : 0) : 0); }
            __syncthreads();
            p7_route(p, c, l);
        }
        SEAM(pb + 6);
        if (PH_EN(8) && IN(pb + 7)) { FRESH(); moe_tables(p, c); p8_dispatch(p, c); }
        SEAM(pb + 7);
        if (PH_EN(9) && IN(pb + 8)) { FRESH();
#if !MK_ONE_LAUNCH
            moe_tables(p, c); FRESH();
#endif
            const LAS int* LC = (const LAS int*)(c.lds + LDS_CTL_OFF);
            pg8::Gemm g{(const bf16_t*)(ws + WS_XN8), (const bf16_t*)(ws + WS_WGU), MAXSLOTS, NEXP * 1024, D / 2, (const int*)(ws + WS_CTL + CTL_SLOTTOK)};
            pg8::GroupedOrder<4> S{(LC[LC_PAD + 32] >> 8) * 4, c.G, c.bid, LC + LC_TILE};
            pg8::EpiSwiGLU8 E{(unsigned char*)(ws + WS_ACT), (const float*)(ws + WS_SRSTD), dbgflag};
            pg8::gemm_phase<pg8::EpiSwiGLU8, pg8::GroupedOrder<4>, false, true, true>(glds, g, S, E, nullptr);
        }
        SEAM(pb + 8);
        if (PH_EN(10) && IN(pb + 9)) { FRESH();
#if !MK_ONE_LAUNCH
            moe_tables(p, c); FRESH();
#endif
            const LAS int* LC = (const LAS int*)(c.lds + LDS_CTL_OFF);
            pg8::Gemm g{(const bf16_t*)(ws + WS_ACT), (const bf16_t*)(ws + WS_WDN), MAXSLOTS, NEXP * D, DEXP / 2};
            pg8::GroupedOrder<8> S{(LC[LC_PAD + 32] >> 8) * 8, c.G, c.bid, LC + LC_TILE};
            pg8::EpiDown E{ws + WS_YS, dbgflag};
            pg8::gemm_phase<pg8::EpiDown, pg8::GroupedOrder<8>, false, false, true>(glds, g, S, E, nullptr);
        }
        SEAM(pb + 9);
        if (PH_EN(11) && IN(pb + 10)) { FRESH();
            if (dbgflag == 0) p11_combine(p, c, l);
            if (l == 0 && dbgflag != 2) convert_small(p, c, 1, c.G >= 128 ? SMALL_WIN_ITEMS : 0);
        }
        SEAM(pb + 10);
    }
}
#undef p
__global__ void __launch_bounds__(512) dbg_final(const float* src, const float* fw, float* out) {
    const int lane = threadIdx.x & 63, gw = blockIdx.x * 8 + (threadIdx.x >> 6), NGW = gridDim.x * 8;
    for (int m = gw; m < M; m += NGW) { const f32x4* xr = (const f32x4*)(src + (size_t)m * D) + lane; f32x4 v[8]; float s = 0.f;
#pragma unroll
        for (int j = 0; j < 8; ++j) { v[j] = xr[64 * j]; s += (v[j].x * v[j].x + v[j].y * v[j].y) + (v[j].z * v[j].z + v[j].w * v[j].w); }
        const float rstd = rsqrtf(wave_sum(s) * (1.f / D) + NORM_EPS);
#pragma unroll
        for (int j = 0; j < 8; ++j) ((f32x4*)(out + (size_t)m * D))[lane + 64 * j] = v[j] * rstd * ((const f32x4*)fw)[lane + 64 * j]; }
}
#ifdef DBG_CHECK
__global__ void __launch_bounds__(512) dbg_check(const void* buf, size_t n, int is_f32, unsigned* flag, unsigned idx) {
    size_t i = (size_t)blockIdx.x * 512 + threadIdx.x, st = (size_t)gridDim.x * 512; bool bad = false;
#ifdef DBG_DEAD
    bool alive = false;
    for (; i < n; i += st) { float v = is_f32 ? ((const float*)buf)[i] : bf2f(((const bf16_t*)buf)[i]); if (fabsf(v) > 0.01f && fabsf(v) < 1e6f) alive = true; }
    __shared__ int anyalive; if (threadIdx.x == 0) anyalive = 0; __syncthreads(); if (alive) anyalive = 1; __syncthreads();
    if (threadIdx.x == 0 && anyalive) atomicOr(flag + 1 + idx, 1u);
#else
    for (; i < n; i += st) { float v = is_f32 ? ((const float*)buf)[i] : bf2f(((const bf16_t*)buf)[i]); if (!(v - v == 0.f)) bad = true; }
    if (bad) atomicMin(flag, idx);
#endif
}
__global__ void __launch_bounds__(512) dbg_scale(float* out, const unsigned* flag) {
#ifdef DBG_DEAD
    unsigned f = 1000u; for (unsigned i = 1; i <= 18; ++i) if (flag[1 + i] == 0u) { f = i; break; }
#else
    const unsigned f = *flag;
#endif
    const float s = f < 100u ? 1.0f + 0.25f * (float)f : 1.0f;
    for (size_t i = (size_t)blockIdx.x * 512 + threadIdx.x; i < (size_t)M * D; i += (size_t)gridDim.x * 512) out[i] *= s;
}
#endif
#ifdef DBG_TRTEST
__global__ void __launch_bounds__(64) dbg_trtest(unsigned* flag) {
    __shared__ __attribute__((aligned(16))) bf16_t A[64 * 72];
    const int lane = threadIdx.x;
    for (int i = lane; i < 64 * 72; i += 64) { const int r = i / 72, cc = i % 72; const float v = (float)((r * 5 + cc * 3) & 255); A[i] = (bf16_t)(cvt_pk(v, 0.f) & 0xffff); }
    __syncthreads();
    unsigned bad = 0;
    for (int row0 = 0; row0 < 64; row0 += 16) for (int k0 = 0; k0 < 64; k0 += 32) {
        const bf16x8 f = frag_t<72>((const LAS bf16_t*)A, row0, k0, lane);
        for (int j = 0; j < 8; ++j) { const int k = k0 + 8 * (lane >> 4) + j, i = row0 + (lane & 15); if ((bf16_t)f[j] != A[k * 72 + i]) bad = 1; }
    }
    if (bad) atomicMin(flag, 2u);
    f32x4 acc = {0.f, 0.f, 0.f, 0.f}; bf16x8 xa, yb;
    for (int j = 0; j < 8; ++j) { const int k = 8 * (lane >> 4) + j, r = lane & 15; xa[j] = (short)(cvt_pk(r == k ? 1.f : 0.f, 0.f) & 0xffff); yb[j] = (short)(cvt_pk((float)(r * 8 + (k & 7)), 0.f) & 0xffff); }
    acc = MFMA16(yb, xa, acc);
    for (int r = 0; r < 4; ++r) { const int pp_ = lane & 15, q = 4 * (lane >> 4) + r; if (acc[r] != (float)(q * 8 + (pp_ & 7))) bad |= 2; }
    if (bad & 2) atomicMin(flag, 3u);
}
#endif
#ifdef DBG_H1TEST
__global__ void __launch_bounds__(512) dbg_h1test(unsigned* flag) {
    extern __shared__ __attribute__((aligned(16))) unsigned char lraw[];
    LAS unsigned char* lds = (LAS unsigned char*)lraw;
    LAS bf16_t* Vs = (LAS bf16_t*)(lds + H_V); LAS bf16_t* KPs = (LAS bf16_t*)(lds + H_KP); LAS bf16_t* QHs = (LAS bf16_t*)(lds + H_QH); LAS bf16_t* KTs = (LAS bf16_t*)(lds + H_KT);
    const int tid = threadIdx.x, lane = tid & 63, w = tid >> 6, fr = lane & 15, fq = lane >> 4;
    for (int i = tid; i < 32 * HL; i += 512) { const int r = i / HL, cc = i % HL;
        Vs[i] = (bf16_t)(cvt_pk((float)((r * 3 + cc) % 7 - 3), 0.f) & 0xffff); KPs[i] = (bf16_t)(cvt_pk((float)((r + cc * 5) % 5 - 2), 0.f) & 0xffff);
        QHs[i] = (bf16_t)(cvt_pk((float)((r * 2 + cc) % 3 - 1), 0.f) & 0xffff); KTs[i] = (bf16_t)(cvt_pk((float)((r + cc) % 4 - 1), 0.f) & 0xffff); }
    __syncthreads();
    unsigned bad = 0;
    const bf16x8 xb = frag_t<HL>(Vs, 16 * w, 0, lane);
    for (int dn = 0; dn < 8; ++dn) { const bf16x8 ya = frag_t<HL>(KPs, 16 * dn, 0, lane); const f32x4 nt = MFMA16(ya, xb, F4Z);
        for (int r = 0; r < 4; ++r) { const int e = 16 * w + fr, d = 16 * dn + 4 * fq + r; float ref = 0.f; for (int s = 0; s < 32; ++s) ref += (float)((s * 3 + e) % 7 - 3) * (float)((s + d * 5) % 5 - 2); if (nt[r] != ref) bad |= 1; } }
    if (w < 4) { const int p0 = 16 * (w >> 1), q0 = 16 * (w & 1);
        const f32x4 sc = mm16<false, false, 4, HL, HL>(QHs, KTs, p0, q0, lane, F4Z);
        for (int r = 0; r < 4; ++r) { const int t = p0 + fr, s = q0 + 4 * fq + r; float ref = 0.f; for (int d = 0; d < 128; ++d) ref += (float)((t * 2 + d) % 3 - 1) * (float)((s + d) % 4 - 1); if (sc[r] != ref) bad |= 2; } }
    if (bad & 1) atomicMin(flag, 2u);
    if (bad & 2) atomicMin(flag, 3u);
}
#endif
#ifdef DBG_CLASS
__global__ void __launch_bounds__(512) dbg_class(const bf16_t* buf, size_t n, unsigned* flag) {
    unsigned m = 0;
    for (size_t i = (size_t)blockIdx.x * 512 + threadIdx.x; i < n; i += (size_t)gridDim.x * 512) { const bf16_t b = buf[i]; const float v = bf2f(b); const float a = fabsf(v);
        if (b == 0xAAAA) m |= 4; else if (a == 0.f) m |= 2; else if (a > 0.01f && a < 1e6f) m |= 1; else if (!(a < 1e6f)) m |= 8; else m |= 16; }
    if (m) atomicOr(flag + 40, m);
}
__global__ void __launch_bounds__(512) dbg_scale2(float* out, const unsigned* flag) {
    const unsigned f = flag[40]; const float s = 1.0f + 0.25f * (float)f;
    for (size_t i = (size_t)blockIdx.x * 512 + threadIdx.x; i < (size_t)M * D; i += (size_t)gridDim.x * 512) out[i] *= s;
}
#endif
#ifdef DBG_CSUM
__global__ void __launch_bounds__(512) dbg_csum(const unsigned* buf, size_t nwords, unsigned* flag) {
    unsigned long long s = 0;
    for (size_t i = (size_t)blockIdx.x * 512 + threadIdx.x; i < nwords; i += (size_t)gridDim.x * 512) s += (unsigned long long)buf[i] * (unsigned long long)((i & 1023) + 1);
    atomicAdd((unsigned long long*)(flag + 42), s);
}
__global__ void __launch_bounds__(512) dbg_scale3(float* out, const unsigned* flag) {
    const unsigned long long c = *(const unsigned long long*)(flag + 42); const float s = 1.0f + 0.25f * (float)((c >> 7) & 3ull);
    for (size_t i = (size_t)blockIdx.x * 512 + threadIdx.x; i < (size_t)M * D; i += (size_t)gridDim.x * 512) out[i] *= s;
}
#endif
#ifdef DBG_ZCOLS
__global__ void __launch_bounds__(512) dbg_zcols(const bf16_t* Z, unsigned* flag) {
    const int starts[13] = {0, 1024, 2048, 3072, 4096, 5120, 6144, 7168, 7232, 7296, 7456, 9504, 11552};
    __shared__ int alive[12];
    if (threadIdx.x < 12) alive[threadIdx.x] = 0; __syncthreads();
    for (int row = blockIdx.x; row < M; row += gridDim.x) { const bf16_t* zr = Z + (size_t)row * NZ;
        for (int cidx = threadIdx.x; cidx < 11552; cidx += 512) { const float a = fabsf(bf2f(zr[cidx])); if (a > 0.01f && a < 1e6f) { int seg = 0; for (int s = 0; s < 12; ++s) if (cidx >= starts[s]) seg = s; alive[seg] = 1; } } }
    __syncthreads();
    if (threadIdx.x < 12 && alive[threadIdx.x]) atomicOr(flag + 2 + threadIdx.x, 1u);
}
#endif
#ifdef DBG_WROWS
__global__ void __launch_bounds__(512) dbg_wrows(const bf16_t* W, unsigned* flag) {
    const int starts[13] = {0, 1024, 2048, 3072, 4096, 5120, 6144, 7168, 7232, 7296, 7456, 9504, 11552};
    for (int row = blockIdx.x; row < 11552; row += gridDim.x) { bool alive = false;
        for (int cidx = threadIdx.x; cidx < 2048; cidx += 512) { const float a = fabsf(bf2f(W[(size_t)row * 2048 + cidx])); if (a > 0.001f && a < 1e6f) alive = true; }
        if (alive) { int seg = 0; for (int s = 0; s < 12; ++s) if (row >= starts[s]) seg = s; atomicOr(flag + 2 + seg, 1u); } }
}
#endif
extern "C" void kernel_launch(void* const* d_in, const int* in_sizes, int n_in, void* d_out, int out_size, void* d_ws, size_t ws_size, hipStream_t stream) {
    static int grid = 0;
    if (grid == 0) {
        if (n_in != 31 || out_size != M * D || ws_size < WS_END) { fprintf(stderr, "kernel_launch: unexpected shapes (n_in %d out %d ws %zu)\n", n_in, out_size, ws_size); grid = -1; return; }
        int dev = 0, cus = 0;
        if (hipGetDevice(&dev) != hipSuccess || hipDeviceGetAttribute(&cus, hipDeviceAttributeMultiprocessorCount, dev) != hipSuccess) { grid = -1; return; }
        if (hipFuncSetAttribute((const void*)mk_fwd, hipFuncAttributeMaxDynamicSharedMemorySize, LDS_BYTES) != hipSuccess) { fprintf(stderr, "kernel_launch: hipFuncSetAttribute failed\n"); grid = -1; return; }
        int per_cu = 0;
        if (hipOccupancyMaxActiveBlocksPerMultiprocessor(&per_cu, (const void*)mk_fwd, 512, LDS_BYTES) != hipSuccess || per_cu < 1) { fprintf(stderr, "kernel_launch: occupancy query says %d\n", per_cu); }
        (void)hipGetLastError();
        grid = cus;
    }
    if (grid < 0) return;
    (void)hipMemsetAsync((char*)d_ws + WS_CTL, 0, CTL_BYTES, stream);
    Params p{};
    for (int i = 0; i < 31; ++i) p.in[i] = (const float*)d_in[i];
    p.out = (float*)d_out; p.ws = (unsigned char*)d_ws;
    const int nph = NPHASE < DBG_CUT ? NPHASE : DBG_CUT;
#if MK_ONE_LAUNCH
    p.ph_lo = 0; p.ph_hi = nph;
    hipLaunchKernelGGL(mk_fwd, dim3(grid), dim3(512), LDS_BYTES, stream, p);
#else
    for (int ph = 0; ph < nph; ++ph) { p.ph_lo = ph; p.ph_hi = ph + 1; hipLaunchKernelGGL(mk_fwd, dim3(grid), dim3(512), LDS_BYTES, stream, p);
#ifdef DUP_PID
        if (ph == DUP_PID) {
#ifdef DUP_FLAG
            p.ph_hi |= (DUP_FLAG << 16);
#endif
            hipLaunchKernelGGL(mk_fwd, dim3(grid), dim3(512), LDS_BYTES, stream, p); }
#endif
    }
#endif
#if defined(DBG_ZCOLS)
    { unsigned* flag = (unsigned*)((char*)d_ws + 512 * 1024); (void)hipMemsetAsync(flag, 0, 256, stream);
#ifdef DBG_WROWS
      hipLaunchKernelGGL(dbg_wrows, dim3(1024), dim3(512), 0, stream, (const bf16_t*)((char*)d_ws + WS_WIN), flag);
#else
      hipLaunchKernelGGL(dbg_zcols, dim3(1024), dim3(512), 0, stream, (const bf16_t*)((char*)d_ws + WS_Z), flag);
#endif
      for (int i = 13; i <= 18; ++i) (void)hipMemsetAsync(flag + 1 + i, 1, 4, stream);
      hipLaunchKernelGGL(dbg_final, dim3(grid), dim3(512), 0, stream, (const float*)d_in[0], (const float*)d_in[30], (float*)d_out);
      hipLaunchKernelGGL(dbg_scale, dim3(1024), dim3(512), 0, stream, (float*)d_out, (const unsigned*)flag); }
#elif defined(DBG_CSUM)
    { unsigned* flag = (unsigned*)((char*)d_ws + 512 * 1024); (void)hipMemsetAsync(flag, 0, 256, stream);
      hipLaunchKernelGGL(dbg_csum, dim3(1024), dim3(512), 0, stream, (const unsigned*)((char*)d_ws + DBG_CSUM_OFF), (size_t)DBG_CSUM_WORDS, flag);
      hipLaunchKernelGGL(dbg_final, dim3(grid), dim3(512), 0, stream, (const float*)d_in[0], (const float*)d_in[30], (float*)d_out);
      hipLaunchKernelGGL(dbg_scale3, dim3(1024), dim3(512), 0, stream, (float*)d_out, (const unsigned*)flag); }
#elif defined(DBG_CLASS)
    { unsigned* flag = (unsigned*)((char*)d_ws + 512 * 1024); (void)hipMemsetAsync(flag, 0, 256, stream);
      hipLaunchKernelGGL(dbg_class, dim3(1024), dim3(512), 0, stream, (const bf16_t*)((char*)d_ws + DBG_CLASS_OFF), (size_t)DBG_CLASS_N, flag);
      hipLaunchKernelGGL(dbg_final, dim3(grid), dim3(512), 0, stream, (const float*)d_in[0], (const float*)d_in[30], (float*)d_out);
      hipLaunchKernelGGL(dbg_scale2, dim3(1024), dim3(512), 0, stream, (float*)d_out, (const unsigned*)flag); }
#elif defined(DBG_CHECK)
    { unsigned* flag = (unsigned*)((char*)d_ws + 512 * 1024); (void)hipMemsetAsync(flag, 0x7f, 4, stream); (void)hipMemsetAsync(flag + 1, 0, 128, stream);
      struct B { size_t off, n; int f32; }; const B bl[] = {
#ifdef DBG_DEAD
        {WS_WIN, (size_t)IN_WIDTH * D, 0}, {WS_XN, (size_t)M * D, 0},
#endif
        {WS_Z, (size_t)M * NZ, 0}, {WS_QH, (size_t)M * 1024, 0}, {WS_QH, (size_t)M * 1024, 0}, {WS_NT, (size_t)64 * 64 * 16384, 0}, {WS_DC, (size_t)64 * 64 * 128, 1},
        {WS_RP, (size_t)M * 1024, 0}, {WS_Y0, (size_t)M * 1024, 0}, {WS_MT, (size_t)M * 1024, 0}, {WS_NN, (size_t)M * 1024, 0}, {WS_RK, (size_t)M * 16, 1}, {WS_VFIRST, (size_t)M * 1024, 0},
        {WS_YHG, (size_t)M * 1024, 0}, {WS_SS, (size_t)M * 1024, 0}, {WS_YRW, (size_t)M * 1024, 0}, {WS_XN, (size_t)M * D, 0} };
#ifdef DBG_TRTEST
      hipLaunchKernelGGL(dbg_trtest, dim3(1), dim3(64), 0, stream, flag);
#endif
#ifdef DBG_H1TEST
      hipLaunchKernelGGL(dbg_h1test, dim3(1), dim3(512), 65536, stream, flag);
#endif
      for (unsigned i = 0; i < sizeof(bl) / sizeof(bl[0]); ++i) hipLaunchKernelGGL(dbg_check, dim3(1024), dim3(512), 0, stream, (const void*)((char*)d_ws + bl[i].off), bl[i].n, bl[i].f32, flag, i + 1);
      hipLaunchKernelGGL(dbg_check, dim3(1024), dim3(512), 0, stream, (const void*)d_out, (size_t)M * D, 1, flag, 18u);
      hipLaunchKernelGGL(dbg_final, dim3(grid), dim3(512), 0, stream, (const float*)d_in[0], (const float*)d_in[30], (float*)d_out);
      hipLaunchKernelGGL(dbg_scale, dim3(1024), dim3(512), 0, stream, (float*)d_out, (const unsigned*)flag); }
#elif DBG_CUT < 1000
    hipLaunchKernelGGL(dbg_final, dim3(grid), dim3(512), 0, stream, (const float*)(DBG_CUT <= 6 ? d_in[0] : d_out), (const float*)d_in[30], (float*)d_out);
#endif
}
```
